# Optimizing an MI355X kernel written in HIP

```python
import jax, jax.numpy as jnp
from jax import lax
import numpy as np

D_MODEL = 1024
BATCH = 16
SEQ = 4096
DEPTH = 1

HEAD_DIM = 64
D_MIX = D_MODEL
RWKV_WIDTH = D_MIX // 2
FOX_WIDTH = D_MIX - RWKV_WIDTH
RWKV_HEADS = RWKV_WIDTH // HEAD_DIM
FOX_HEADS = FOX_WIDTH // HEAD_DIM
DECAY_LORA = 64
AAA_LORA = 64
GATE_LORA = 128
RWKV_COLS = 3 * RWKV_WIDTH + DECAY_LORA + AAA_LORA + GATE_LORA
FOX_COLS = 3 * FOX_WIDTH + FOX_HEADS
IN_COLS = RWKV_COLS + FOX_COLS
Q_BLOCK = 128
N_GROUPS = 4
EXPERTS_PER_GROUP = 8
N_EXPERTS = N_GROUPS * EXPERTS_PER_GROUP
TOP_K = 2
D_EXPERT = D_MODEL // 2
MOE_BLOCK = 128
NORM_EPS = 1e-6
GN_EPS = 64e-5

kernel_name = "hymba_rwkv7_fox_hier_moe_adaln"


def rms_norm(x, g):
    xf = x.astype(jnp.float32)
    y = xf * lax.rsqrt(jnp.mean(xf * xf, axis=-1, keepdims=True) + NORM_EPS)
    return (y * g.astype(jnp.float32)).astype(x.dtype)


def wkv7_scan(r, decay, k, v, kk, a):
    B, S, H, N = r.shape

    def step(state, inp):
        r_t, w_t, k_t, v_t, kk_t, a_t = inp
        sa = jnp.einsum("bhvk,bhk->bhv", state, -kk_t)
        state = (state * w_t[:, :, None, :]
                 + sa[..., None] * (kk_t * a_t)[:, :, None, :]
                 + v_t[..., :, None] * k_t[:, :, None, :])
        y = jnp.einsum("bhvk,bhk->bhv", state, r_t)
        return state, y

    xs = tuple(jnp.moveaxis(t, 1, 0) for t in (r, decay, k, v, kk, a))
    init = jnp.zeros((B, H, N, N), jnp.float32)
    _, ys = lax.scan(step, init, xs)
    return jnp.moveaxis(ys, 0, 1)


def rwkv7_time_mix(p, mu, w0, w_up, a0, a_up, g_up, k_k, k_a, r_k, lnx_g, lnx_b):
    B, S, _ = p.shape
    H, N, C = RWKV_HEADS, HEAD_DIM, RWKV_WIDTH
    f32 = jnp.float32
    p_prev = jnp.pad(p, ((0, 0), (1, 0), (0, 0)))[:, :-1]
    p = p + (p_prev - p) * mu
    r, k, v, wd, ad, gd = jnp.split(
        p, [C, 2 * C, 3 * C, 3 * C + DECAY_LORA, 3 * C + DECAY_LORA + AAA_LORA], axis=-1)
    w_log = -jax.nn.softplus(-(w0 + jnp.tanh(wd) @ w_up).astype(f32)) - 0.5
    decay = jnp.exp(-jnp.exp(w_log))
    a = jax.nn.sigmoid((a0 + ad @ a_up).astype(f32))
    g = (jax.nn.sigmoid(gd) @ g_up).astype(f32)
    heads = lambda t: t.astype(f32).reshape(B, S, H, N)
    r, k, v, decay, a = heads(r), heads(k), heads(v), heads(decay), heads(a)
    kk = k * k_k.astype(f32).reshape(H, N)
    kk = kk / jnp.maximum(jnp.sqrt(jnp.sum(kk * kk, axis=-1, keepdims=True)), 1e-12)
    k = k * (1.0 + (a - 1.0) * k_a.astype(f32).reshape(H, N))
    y = wkv7_scan(r, decay, k, v, kk, a)
    mean = jnp.mean(y, axis=-1, keepdims=True)
    var = jnp.mean(jnp.square(y - mean), axis=-1, keepdims=True)
    y = ((y - mean) * lax.rsqrt(var + GN_EPS)).reshape(B, S, C) * lnx_g + lnx_b
    bonus = jnp.sum(r * k * r_k.astype(f32), axis=-1, keepdims=True) * v
    y = y + bonus.reshape(B, S, C)
    return (y * g).astype(p.dtype)


def forgetting_attention(p, f_bias):
    B, S, _ = p.shape
    H, N, C = FOX_HEADS, HEAD_DIM, FOX_WIDTH
    f32 = jnp.float32
    q, k, v, f = jnp.split(p, [C, 2 * C, 3 * C], axis=-1)
    to_heads = lambda t: t.reshape(B, S, H, N).transpose(0, 2, 1, 3)
    q = to_heads(q).astype(f32) * (N ** -0.5)
    k = to_heads(k).astype(f32)
    v = to_heads(v)
    log_f = jax.nn.log_sigmoid((f + f_bias).astype(f32))
    cum = jnp.cumsum(log_f, axis=1).transpose(0, 2, 1)
    outs = []
    for i in range(S // Q_BLOCK):
        q0, q1 = i * Q_BLOCK, (i + 1) * Q_BLOCK
        s = jnp.einsum("bhqd,bhkd->bhqk", q[:, :, q0:q1], k[:, :, :q1])
        s = s + cum[:, :, q0:q1, None] - cum[:, :, None, :q1]
        causal = jnp.arange(q0, q1)[:, None] >= jnp.arange(q1)[None, :]
        s = jnp.where(causal, s, -jnp.inf)
        prob = jax.nn.softmax(s, axis=-1)
        outs.append(jnp.einsum("bhqk,bhkd->bhqd", prob.astype(v.dtype), v[:, :, :q1]))
    o = jnp.concatenate(outs, axis=2)
    return o.transpose(0, 2, 1, 3).reshape(B, S, C)


def hier_moe(h, w_grp, b_grp, w_rt, b_rt, w_gate, w_up, w_down):
    T, D = h.shape
    f32 = jnp.float32
    grp_prob = jax.nn.softmax((h @ w_grp).astype(f32) + b_grp, axis=-1)
    g_sel = jnp.argmax(grp_prob, axis=-1)
    p_g = jnp.take_along_axis(grp_prob, g_sel[:, None], axis=-1)
    e_logits = ((h @ w_rt).astype(f32) + b_rt).reshape(T, N_GROUPS, EXPERTS_PER_GROUP)
    e_logits = jnp.take_along_axis(e_logits, g_sel[:, None, None], axis=1)[:, 0]
    top_p, top_i = lax.top_k(jax.nn.softmax(e_logits, axis=-1), TOP_K)
    weights = p_g * top_p / jnp.sum(top_p, axis=-1, keepdims=True)
    expert_id = g_sel[:, None].astype(jnp.int32) * EXPERTS_PER_GROUP + top_i.astype(jnp.int32)

    A = T * TOP_K
    flat_e = expert_id.reshape(A)
    flat_w = weights.reshape(A)
    flat_tok = jnp.repeat(jnp.arange(T, dtype=jnp.int32), TOP_K)
    order = jnp.argsort(flat_e)
    se = flat_e[order]
    counts = jnp.bincount(flat_e, length=N_EXPERTS)
    starts = jnp.cumsum(counts) - counts
    padded = (counts + MOE_BLOCK - 1) // MOE_BLOCK * MOE_BLOCK
    pends = jnp.cumsum(padded)
    pstarts = pends - padded
    dest = pstarts[se] + jnp.arange(A, dtype=jnp.int32) - starts[se]
    P = (A + N_EXPERTS * (MOE_BLOCK - 1) + MOE_BLOCK - 1) // MOE_BLOCK * MOE_BLOCK
    n_blocks = P // MOE_BLOCK
    buf_tok = jnp.zeros((P,), jnp.int32).at[dest].set(flat_tok[order])
    buf_w = jnp.zeros((P,), f32).at[dest].set(flat_w[order])
    blk_e = jnp.searchsorted(pends, jnp.arange(n_blocks, dtype=pends.dtype) * MOE_BLOCK, side="right")
    blk_e = jnp.minimum(blk_e, N_EXPERTS - 1).astype(jnp.int32)

    def expert_block(args):
        tok, wgt, e = args
        xb = h[tok]
        hid = jax.nn.silu(xb @ w_gate[e]) * (xb @ w_up[e])
        y = hid @ w_down[e]
        return y * wgt[:, None].astype(y.dtype)

    ys = lax.map(expert_block, (buf_tok.reshape(n_blocks, MOE_BLOCK),
                                buf_w.reshape(n_blocks, MOE_BLOCK), blk_e))
    return jax.ops.segment_sum(ys.reshape(P, D), buf_tok, num_segments=T)


def setup_inputs(seed: int = 0) -> dict:
    key = jax.random.key(seed)
    ks = jax.random.split(key, 28)
    nrm = lambda i, shape, scale: scale * jax.random.normal(ks[i], shape, jnp.float32)
    L, D, C = DEPTH, D_MODEL, RWKV_WIDTH
    chan = jnp.arange(C, dtype=jnp.float32) / (C - 1)
    w0_base = -7.0 + 5.0 * chan ** 0.85 + 0.5
    return {
        "x": nrm(0, (BATCH, SEQ, D), 1.0),
        "c": nrm(1, (BATCH, D), 1.0),
        "w_ada": nrm(2, (L, D, 6 * D), 0.5 * D ** -0.5),
        "b_ada": nrm(3, (L, 6 * D), 0.02),
        "norm1_g": 1.0 + nrm(4, (L, D), 0.05),
        "w_in": nrm(5, (L, D, IN_COLS), D ** -0.5),
        "rwkv_mu": jax.random.uniform(ks[6], (L, RWKV_COLS), jnp.float32),
        "rwkv_w0": w0_base + nrm(7, (L, C), 0.1),
        "rwkv_w_up": nrm(8, (L, DECAY_LORA, C), 0.5 * DECAY_LORA ** -0.5),
        "rwkv_a0": nrm(9, (L, C), 0.1),
        "rwkv_a_up": nrm(10, (L, AAA_LORA, C), AAA_LORA ** -0.5),
        "rwkv_g_up": nrm(11, (L, GATE_LORA, C), GATE_LORA ** -0.5),
        "rwkv_k_k": 0.85 + nrm(12, (L, C), 0.05),
        "rwkv_k_a": 1.0 + nrm(13, (L, C), 0.05),
        "rwkv_r_k": nrm(14, (L, RWKV_HEADS, HEAD_DIM), 0.1),
        "rwkv_lnx_g": 1.0 + nrm(15, (L, C), 0.05),
        "rwkv_lnx_b": nrm(16, (L, C), 0.02),
        "fox_f_bias": jnp.linspace(1.0, 5.0, FOX_HEADS, dtype=jnp.float32) + nrm(17, (L, FOX_HEADS), 0.1),
        "w_out": nrm(18, (L, D_MIX, D), D_MIX ** -0.5),
        "norm2_g": 1.0 + nrm(19, (L, D), 0.05),
        "moe_w_grp": nrm(20, (L, D, N_GROUPS), D ** -0.5),
        "moe_b_grp": nrm(21, (L, N_GROUPS), 0.01),
        "moe_w_rt": nrm(22, (L, D, N_EXPERTS), D ** -0.5),
        "moe_b_rt": nrm(23, (L, N_EXPERTS), 0.01),
        "moe_w_gate": nrm(24, (L, N_EXPERTS, D, D_EXPERT), D ** -0.5),
        "moe_w_up": nrm(25, (L, N_EXPERTS, D, D_EXPERT), D ** -0.5),
        "moe_w_down": nrm(26, (L, N_EXPERTS, D_EXPERT, D), D_EXPERT ** -0.5),
        "norm_f_g": 1.0 + nrm(27, (D,), 0.05),
    }


def reference(x, c, w_ada, b_ada, norm1_g, w_in, rwkv_mu, rwkv_w0, rwkv_w_up, rwkv_a0, rwkv_a_up,
              rwkv_g_up, rwkv_k_k, rwkv_k_a, rwkv_r_k, rwkv_lnx_g, rwkv_lnx_b, fox_f_bias, w_out,
              norm2_g, moe_w_grp, moe_b_grp, moe_w_rt, moe_b_rt, moe_w_gate, moe_w_up, moe_w_down,
              norm_f_g):
    B, S, D = x.shape
    cond = jax.nn.silu(c)
    for l in range(DEPTH):
        mod = (cond @ w_ada[l] + b_ada[l])[:, None, :]
        sh1, sc1, gt1, sh2, sc2, gt2 = jnp.split(mod, 6, axis=-1)
        h = rms_norm(x, norm1_g[l]) * (1.0 + sc1) + sh1
        proj = h @ w_in[l]
        y_rwkv = rwkv7_time_mix(proj[..., :RWKV_COLS], rwkv_mu[l], rwkv_w0[l], rwkv_w_up[l],
                                rwkv_a0[l], rwkv_a_up[l], rwkv_g_up[l], rwkv_k_k[l], rwkv_k_a[l],
                                rwkv_r_k[l], rwkv_lnx_g[l], rwkv_lnx_b[l])
        y_fox = forgetting_attention(proj[..., RWKV_COLS:], fox_f_bias[l])
        mix = jnp.concatenate([y_rwkv, y_fox], axis=-1) @ w_out[l]
        x = x + gt1 * mix
        h = rms_norm(x, norm2_g[l]) * (1.0 + sc2) + sh2
        ff = hier_moe(h.reshape(B * S, D), moe_w_grp[l], moe_b_grp[l], moe_w_rt[l], moe_b_rt[l],
                      moe_w_gate[l], moe_w_up[l], moe_w_down[l]).reshape(B, S, D)
        x = x + gt2 * ff
    return rms_norm(x, norm_f_g)
```

```cpp
#include <hip/hip_runtime.h>
#include <hip/hip_bf16.h>
#include <hip/hip_fp16.h>
#include <cstdio>
#include <cstdint>
#include <cmath>
namespace pg8 {
#define PG8_LAS __attribute__((address_space(3)))
typedef unsigned short bf16_t;
typedef short bf16x8 __attribute__((ext_vector_type(8)));
typedef float f32x4 __attribute__((ext_vector_type(4)));
typedef unsigned u32x4 __attribute__((ext_vector_type(4)));
constexpr int BM = 256, BK = 64, HALF = 128, HTB = HALF * BK * 2  , STAGE_BYTES = 8 * HTB, NXCD = 8, WGM = 8;

__host__ __device__ __forceinline__ int lds_byte(int r, int c) { const int st = (r >> 4) * 2 + (c >> 5), rr = r & 15, cc = c & 31, ob = rr * 64 + cc * 2; return st * 1024 + (ob ^ (((ob >> 9) & 1) << 5)); }
__host__ __device__ __forceinline__ void stage_rc(int b, int& R, int& C) { const int st = b / 1024, sb = b % 1024, swz = sb ^ (((sb >> 9) & 1) << 5); R = (st >> 1) * 16 + swz / 64; C = (st & 1) * 32 + (swz % 64) / 2; }
__host__ __device__ __forceinline__ int perm32(int rho) { const int n = rho >> 4, i = rho & 15; return 8 * (i >> 2) + 4 * n + (i & 3); }

struct Unit { int pm, pn, e, j; };
struct Gemm { const bf16_t* A; const bf16_t* Bt; int M, N, K; };

struct StaticOrder {
    int nM, nN, nwg, G, c;
    __host__ __device__ void init(int M, int N, int G_, int c_) { nM = M / BM; nN = N / BM; nwg = nM * nN; G = G_; c = c_; }
    __host__ __device__ bool next(int i, Unit& u) const {
        const long L = (long)i * G + c; if (L >= nwg) return false;
        int wgid = (int)L; { const int q = nwg / NXCD, r = nwg % NXCD, xcd = wgid % NXCD, off = wgid / NXCD; wgid = (xcd < r ? xcd * (q + 1) : r * (q + 1) + (xcd - r) * q) + off; }
        const int nig = WGM * nN, gid = wgid / nig, fm = gid * WGM, gsz = (nM - fm) < WGM ? (nM - fm) : WGM;
        u.pm = fm + ((wgid % nig) % gsz); u.pn = (wgid % nig) / gsz; u.e = 0; u.j = 0; return true;
    }
    __device__ __forceinline__ void a_ready(const Unit&) const {}
    __device__ __forceinline__ void done(const Unit&) const {}
};


__device__ __forceinline__ unsigned cvt_pk_bf16(float lo, float hi) { unsigned r; asm volatile("v_cvt_pk_bf16_f32 %0, %1, %2" : "=v"(r) : "v"(lo), "v"(hi)); return r; }

struct EpiProj {
    static constexpr bool PERM = true, AFTER_DRAIN = false;
    bf16_t* PR; bf16_t* PF; float qscale;
    __device__ __forceinline__ void operator()(const f32x4 (&acc)[2][2][4][2], const Unit& u, int wr, int wc, int fr, int fq) const {
        const int row0 = u.pm * BM + wr * 64 + fr;
        bf16_t* base; int ldc, colt; float sc = 1.f;
        if (u.pn < 7) { base = PR; ldc = 1792; colt = u.pn * BM; } else { base = PF; ldc = 1536; colt = (u.pn - 7) * BM; if (u.pn < 9) sc = qscale; }
        const int col0 = colt + wc * 32 + 8 * fq;
#pragma unroll
        for (int ai = 0; ai < 2; ++ai)
#pragma unroll
            for (int m = 0; m < 4; ++m) { bf16_t* rowp = base + (size_t)(row0 + ai * HALF + m * 16) * ldc + col0;
#pragma unroll
                for (int bj = 0; bj < 2; ++bj) { const f32x4 v0 = acc[ai][bj][m][0] * sc, v1 = acc[ai][bj][m][1] * sc;
                    u32x4 w; w.x = cvt_pk_bf16(v0[0], v0[1]); w.y = cvt_pk_bf16(v0[2], v0[3]); w.z = cvt_pk_bf16(v1[0], v1[1]); w.w = cvt_pk_bf16(v1[2], v1[3]);
                    *(u32x4*)(rowp + bj * HALF) = w; } }
    }
};
struct EpiRes {
    static constexpr bool PERM = false, AFTER_DRAIN = false;
    const float* x; float* out; const float* gate; int rows_per_batch;
    __device__ __forceinline__ void operator()(const f32x4 (&acc)[2][2][4][2], const Unit& u, int wr, int wc, int fr, int fq) const {
        const int b = (u.pm * BM) / rows_per_batch; const float* g = gate + (size_t)b * 6144;
        const int col0 = u.pn * BM + wc * 32 + 4 * fq;
#pragma unroll
        for (int bj = 0; bj < 2; ++bj)
#pragma unroll
            for (int n = 0; n < 2; ++n) { const f32x4 gv = *(const f32x4*)(g + col0 + bj * HALF + n * 16);
#pragma unroll
                for (int ai = 0; ai < 2; ++ai)
#pragma unroll
                    for (int m = 0; m < 4; ++m) { const size_t off = (size_t)(u.pm * BM + ai * HALF + wr * 64 + m * 16 + fr) * 1024 + col0 + bj * HALF + n * 16;
                        const f32x4 xv = *(const f32x4*)(x + off); *(f32x4*)(out + off) = xv + gv * acc[ai][bj][m][n]; } }
    }
};
template <class Epi, class Sched, bool ALIGN_EPI = false, bool SP2 = false>
__device__ __forceinline__ void gemm_phase(PG8_LAS unsigned char* lds, const Gemm g, const Sched& S, const Epi& E) {
    const int tid = threadIdx.x, wid = __builtin_amdgcn_readfirstlane(tid >> 6), lane = tid & 63, wr = wid >> 2, wc = wid & 3, fr = lane & 15, fq = lane >> 4;
    const int K = g.K, nt = K / BK;
    unsigned voffA[2], voffB[2];
#pragma unroll
    for (int i = 0; i < 2; ++i) { int R, C; stage_rc(tid * 16 + i * 8192, R, C); const int Rb = Epi::PERM ? ((R & ~31) + perm32(R & 31)) : R;
        voffA[i] = (unsigned)(R * K + C) * 2u; voffB[i] = (unsigned)(Rb * K + C) * 2u; }
    const size_t kstep = (size_t)(BK * 2);
    const size_t hstep = (size_t)HALF * K * 2;
    const size_t tstep = 2 * hstep;
    const unsigned ldsw = (unsigned)wid * 1024u;
    const int aoff = lds_byte(wr * 64 + fr, fq * 8), boff = lds_byte(wc * 32 + fr, fq * 8);
#define PG8_SA(b, h) (((b) * 2 + (h)) * HTB)
#define PG8_SB(b, h) ((4 + (b) * 2 + (h)) * HTB)
#define PG8_STAGE(bufoff, gbase, voff) do { _Pragma("unroll") for (int _i = 0; _i < 2; ++_i) \
        __builtin_amdgcn_global_load_lds((const unsigned*)((const char*)(gbase) + (voff)[_i]), (PG8_LAS unsigned*)(lds + (bufoff) + ldsw + _i * 8192), 16, 0, 0); } while (0)
#define PG8_LDA(dst, b, h) do { _Pragma("unroll") for (int m = 0; m < 4; ++m) _Pragma("unroll") for (int k = 0; k < 2; ++k) dst[m][k] = *(const PG8_LAS bf16x8*)(lds + PG8_SA(b, h) + aoff + m * 2048 + k * 1024); } while (0)
#define PG8_LDB(dst, b, h) do { _Pragma("unroll") for (int n = 0; n < 2; ++n) _Pragma("unroll") for (int k = 0; k < 2; ++k) dst[n][k] = *(const PG8_LAS bf16x8*)(lds + PG8_SB(b, h) + boff + n * 2048 + k * 1024); } while (0)
#define PG8_MMA(ai, bj, At, Bt) do { __builtin_amdgcn_s_setprio(1); _Pragma("unroll") for (int m = 0; m < 4; ++m) _Pragma("unroll") for (int n = 0; n < 2; ++n) _Pragma("unroll") for (int k = 0; k < 2; ++k) \
        acc[ai][bj][m][n] = __builtin_amdgcn_mfma_f32_16x16x32_bf16(Bt[n][k], At[m][k], acc[ai][bj][m][n], 0, 0, 0); __builtin_amdgcn_s_setprio(0); } while (0)
#define PG8_WAIT_V(n) asm volatile("s_waitcnt vmcnt(" #n ")" ::: "memory")
#define PG8_WAIT_L(n) asm volatile("s_waitcnt lgkmcnt(" #n ")" ::: "memory")
#define PG8_BAR __builtin_amdgcn_s_barrier()
#define PG8_SCHED __builtin_amdgcn_sched_barrier(0)
    Unit cur, nxt; int ui = 0;
    if (!S.next(0, cur)) return;
    f32x4 acc[2][2][4][2];
#pragma unroll
    for (int a = 0; a < 2; ++a)
#pragma unroll
        for (int b = 0; b < 2; ++b)
#pragma unroll
            for (int m = 0; m < 4; ++m)
#pragma unroll
                for (int n = 0; n < 2; ++n) acc[a][b][m][n] = (f32x4){0.f, 0.f, 0.f, 0.f};
    bf16x8 At[4][2], B0[2][2], B1[2][2];
    const char* cA = (const char*)g.A + (size_t)cur.pm * tstep; const char* cB = (const char*)g.Bt + (size_t)cur.pn * tstep;
    S.a_ready(cur);
    if constexpr (SP2) {
        PG8_STAGE(PG8_SB(0, 0), cB, voffB); PG8_STAGE(PG8_SB(0, 1), cB + hstep, voffB); PG8_STAGE(PG8_SA(0, 0), cA, voffA); PG8_STAGE(PG8_SA(0, 1), cA + hstep, voffA);
        if (wr == 1) PG8_BAR;
        PG8_WAIT_V(2); PG8_BAR;
        PG8_STAGE(PG8_SB(1, 0), cB + kstep, voffB); PG8_STAGE(PG8_SA(1, 0), cA + kstep, voffA); PG8_STAGE(PG8_SB(1, 1), cB + hstep + kstep, voffB);
        PG8_WAIT_V(6); PG8_BAR;
    } else {
        PG8_STAGE(PG8_SB(0, 0), cB, voffB); PG8_STAGE(PG8_SA(0, 0), cA, voffA); PG8_STAGE(PG8_SB(0, 1), cB + hstep, voffB); PG8_STAGE(PG8_SA(0, 1), cA + hstep, voffA);
        if (wr == 1) PG8_BAR;
        PG8_WAIT_V(4); PG8_BAR;
        PG8_STAGE(PG8_SB(1, 0), cB + kstep, voffB); PG8_STAGE(PG8_SA(1, 0), cA + kstep, voffA); PG8_STAGE(PG8_SB(1, 1), cB + hstep + kstep, voffB);
        PG8_WAIT_V(6); PG8_BAR;
    }
    for (;;) {
        const bool has_next = S.next(ui + 1, nxt);
        const char* nA = has_next ? (const char*)g.A + (size_t)nxt.pm * tstep : cA; const char* nB = has_next ? (const char*)g.Bt + (size_t)nxt.pn * tstep : cB;
        for (int t = 0; t < nt; t += 2) {
            const bool last = (t == nt - 2);
            const char* a1 = cA + (size_t)(t + 1) * kstep;
            const char* a2 = last ? nA : cA + (size_t)(t + 2) * kstep; const char* b2 = last ? nB : cB + (size_t)(t + 2) * kstep;
            const char* a3 = a2 + kstep; const char* b3 = b2 + kstep;
            if (last && has_next) S.a_ready(nxt);
            if constexpr (SP2) {
            PG8_LDB(B0, 0, 0); PG8_LDB(B1, 0, 1); PG8_SCHED; PG8_LDA(At, 0, 0); PG8_STAGE(PG8_SA(1, 1), a1 + hstep, voffA);
            PG8_WAIT_V(8); PG8_WAIT_L(0); PG8_BAR; PG8_MMA(0, 0, At, B0); PG8_MMA(0, 1, At, B1); PG8_BAR; PG8_SCHED;
            PG8_LDA(At, 0, 1); PG8_STAGE(PG8_SB(0, 0), b2, voffB); PG8_STAGE(PG8_SB(0, 1), b2 + hstep, voffB); PG8_STAGE(PG8_SA(0, 0), a2, voffA);
            PG8_WAIT_V(8); PG8_WAIT_L(0); PG8_BAR; PG8_MMA(1, 0, At, B0); PG8_MMA(1, 1, At, B1); PG8_BAR; PG8_SCHED;
            PG8_LDB(B0, 1, 0); PG8_LDB(B1, 1, 1); PG8_SCHED; PG8_LDA(At, 1, 0); PG8_STAGE(PG8_SA(0, 1), a2 + hstep, voffA);
            PG8_WAIT_V(8); PG8_WAIT_L(0); PG8_BAR; PG8_MMA(0, 0, At, B0); PG8_MMA(0, 1, At, B1); PG8_BAR; PG8_SCHED;
            PG8_LDA(At, 1, 1); PG8_STAGE(PG8_SB(1, 0), b3, voffB); PG8_STAGE(PG8_SB(1, 1), b3 + hstep, voffB); PG8_STAGE(PG8_SA(1, 0), a3, voffA);
            PG8_WAIT_V(8); PG8_WAIT_L(0); PG8_BAR; PG8_MMA(1, 0, At, B0); PG8_MMA(1, 1, At, B1); PG8_BAR; PG8_SCHED;
            } else {
            PG8_LDB(B0, 0, 0); PG8_SCHED; PG8_LDA(At, 0, 0); PG8_STAGE(PG8_SA(1, 1), a1 + hstep, voffA);
            PG8_WAIT_L(8); PG8_BAR; PG8_WAIT_L(0); PG8_MMA(0, 0, At, B0); PG8_BAR; PG8_SCHED;
            PG8_LDB(B1, 0, 1); PG8_STAGE(PG8_SB(0, 0), b2, voffB);
            PG8_BAR; PG8_WAIT_L(0); PG8_MMA(0, 1, At, B1); PG8_BAR;
            PG8_LDA(At, 0, 1); PG8_STAGE(PG8_SA(0, 0), a2, voffA);
            PG8_BAR; PG8_WAIT_L(0); PG8_MMA(1, 0, At, B0); PG8_BAR; PG8_SCHED;
            PG8_STAGE(PG8_SB(0, 1), b2 + hstep, voffB);
            PG8_WAIT_V(6); PG8_BAR; PG8_MMA(1, 1, At, B1); PG8_BAR;
            PG8_LDB(B0, 1, 0); PG8_SCHED; PG8_LDA(At, 1, 0); PG8_STAGE(PG8_SA(0, 1), a2 + hstep, voffA);
            PG8_WAIT_L(8); PG8_BAR; PG8_WAIT_L(0); PG8_MMA(0, 0, At, B0); PG8_BAR; PG8_SCHED;
            PG8_LDB(B1, 1, 1); PG8_STAGE(PG8_SB(1, 0), b3, voffB);
            PG8_BAR; PG8_WAIT_L(0); PG8_MMA(0, 1, At, B1); PG8_BAR;
            PG8_LDA(At, 1, 1); PG8_STAGE(PG8_SA(1, 0), a3, voffA);
            PG8_BAR; PG8_WAIT_L(0); PG8_MMA(1, 0, At, B0); PG8_BAR; PG8_SCHED;
            PG8_STAGE(PG8_SB(1, 1), b3 + hstep, voffB);
            PG8_WAIT_V(6); PG8_BAR; PG8_MMA(1, 1, At, B1); PG8_BAR;
            }
        }
        if constexpr (ALIGN_EPI) { if (wr == 0) PG8_BAR; }
        if constexpr (!Epi::AFTER_DRAIN) { E(acc, cur, wr, wc, fr, fq); S.done(cur); }
        if (!has_next) break;
#pragma unroll
        for (int a = 0; a < 2; ++a)
#pragma unroll
            for (int b = 0; b < 2; ++b)
#pragma unroll
                for (int m = 0; m < 4; ++m)
#pragma unroll
                    for (int n = 0; n < 2; ++n) acc[a][b][m][n] = (f32x4){0.f, 0.f, 0.f, 0.f};
        cur = nxt; cA = nA; cB = nB; ++ui;
        if constexpr (ALIGN_EPI) { if (wr == 1) PG8_BAR; }
    }
    PG8_WAIT_V(0);
    if constexpr (!ALIGN_EPI) { if (wr == 0) PG8_BAR; }
    PG8_BAR;
    if constexpr (Epi::AFTER_DRAIN) { E.fused(acc, cur, wr, wc, fr, fq, lds, wid, lane); S.done(cur); }
#undef PG8_SA
#undef PG8_SB
#undef PG8_STAGE
#undef PG8_LDA
#undef PG8_LDB
#undef PG8_MMA
#undef PG8_WAIT_V
#undef PG8_WAIT_L
#undef PG8_BAR
#undef PG8_SCHED
}
}

#ifndef PG8_SP2
#define PG8_SP2 true
#endif
#ifndef PG8_ALIGN
#define PG8_ALIGN true
#endif
namespace attn_body {
using bf16=__hip_bfloat16;
using bf16x8=__attribute__((ext_vector_type(8)))short;
using s16x4=__attribute__((ext_vector_type(4)))short;
using f32x16=__attribute__((ext_vector_type(16)))float;
using u32x4=__attribute__((ext_vector_type(4)))unsigned;
constexpr int BATCH=16,NHEAD=8,SEQ=4096,D=64,DMQ=1536,DMO=1024;
constexpr int NW=8,QBLK=32,QB=QBLK*NW,KVBLK=64,NQB=SEQ/QB;
constexpr int ATTN_UNIT_ROWS=QB;
__device__ __forceinline__ int crow(int r,int hi){return (r&3)+8*(r>>2)+4*hi;}
#define SBAR() __builtin_amdgcn_sched_barrier(0)
__device__ __forceinline__ void cmask(f32x16&p0,f32x16&p1,int jb,int qrel,int hi){
  const float NEG=-INFINITY; int kb=64*jb+4*hi;
  #pragma unroll
  for(int r=0;r<16;++r){int kv=kb+(r&3)+8*(r>>2); if(kv>qrel)p0[r]=NEG; if(kv+32>qrel)p1[r]=NEG;}
}

constexpr int NSLOT=3, SLOTB=8192;
constexpr int LDS_K=0, LDS_V=NSLOT*SLOTB, LDS_WS=2*NSLOT*SLOTB, LDS_OST=LDS_WS+NW*64*4, LDS_KX=LDS_OST+NW*4096, LDS_BYTES=LDS_KX+SEQ*16+16;
constexpr float C2=0.125f*1.4426950408889634f;
__device__ __forceinline__ void glds16(const void*gsrc,unsigned lds_dst){unsigned keep;
  asm volatile("s_mov_b32 %0, m0\n\ts_mov_b32 m0, %2\n\ts_nop 0\n\tglobal_load_lds_dwordx4 %1, off\n\ts_mov_b32 m0, %0":"=&s"(keep):"v"(gsrc),"s"(lds_dst):"memory");}
__device__ __forceinline__ float max3f(float a,float b,float c){float r;asm("v_max3_f32 %0, %1, %2, %3":"=v"(r):"v"(a),"v"(b),"v"(c));return r;}
__device__ __forceinline__ float max2f(float a,float b){float r;asm("v_max_f32_e32 %0, %1, %2":"=v"(r):"v"(a),"v"(b));return r;}
__device__ __forceinline__ float fadd_s(float a,float b){float r;asm("v_add_f32_e32 %0, %1, %2":"=v"(r):"v"(a),"v"(b));return r;}
__device__ __forceinline__ float fsub_s(float a,float b){float r;asm("v_sub_f32_e32 %0, %1, %2":"=v"(r):"v"(a),"v"(b));return r;}
typedef float f32x2_t __attribute__((ext_vector_type(2))); typedef __bf16 bf16x2_t __attribute__((ext_vector_type(2)));
__device__ __forceinline__ unsigned cvtpk_s(float lo,float hi){f32x2_t v={lo,hi};bf16x2_t b=__builtin_convertvector(v,bf16x2_t);return __builtin_bit_cast(unsigned,b);}
#define WAIT_BAR(N) asm volatile("s_waitcnt vmcnt(" #N ") lgkmcnt(0)\n\ts_barrier":::"memory")

__device__ __forceinline__ void qkt(f32x16&p0,f32x16&p1,const char*Kslot,const bf16x8*qr,bf16x8 kx0,bf16x8 kx1,bf16x8 qx,int r32,int hi){
  const char*kb=Kslot+hi*1024+r32*16; const f32x16 z16=f32x16{};
  p0=__builtin_amdgcn_mfma_f32_32x32x16_bf16(kx0,qx,z16,0,0,0);p1=__builtin_amdgcn_mfma_f32_32x32x16_bf16(kx1,qx,z16,0,0,0);
  #pragma unroll
  for(int d0=0;d0<4;++d0){
    const bf16x8 b0=*reinterpret_cast<const bf16x8*>(kb+d0*2048);
    const bf16x8 b1=*reinterpret_cast<const bf16x8*>(kb+d0*2048+512);
    p0=__builtin_amdgcn_mfma_f32_32x32x16_bf16(b0,qr[d0],p0,0,0,0);p1=__builtin_amdgcn_mfma_f32_32x32x16_bf16(b1,qr[d0],p1,0,0,0);}
}
typedef __attribute__((address_space(3))) const char* lds_cptr;
typedef short v4i16_t __attribute__((ext_vector_type(4)));
__device__ __forceinline__ void kload8(bf16x8*kf,lds_cptr kp){
  kf[0]=*(const __attribute__((address_space(3))) bf16x8*)(kp);      kf[1]=*(const __attribute__((address_space(3))) bf16x8*)(kp+512);
  kf[2]=*(const __attribute__((address_space(3))) bf16x8*)(kp+2048); kf[3]=*(const __attribute__((address_space(3))) bf16x8*)(kp+2560);
  kf[4]=*(const __attribute__((address_space(3))) bf16x8*)(kp+4096); kf[5]=*(const __attribute__((address_space(3))) bf16x8*)(kp+4608);
  kf[6]=*(const __attribute__((address_space(3))) bf16x8*)(kp+6144); kf[7]=*(const __attribute__((address_space(3))) bf16x8*)(kp+6656);
}
__device__ __forceinline__ void kload2(bf16x8*kf,lds_cptr kp,int j){ kf[2*j]=*(const __attribute__((address_space(3))) bf16x8*)(kp+j*2048); kf[2*j+1]=*(const __attribute__((address_space(3))) bf16x8*)(kp+j*2048+512); }
__device__ __forceinline__ s16x4 vtr(lds_cptr p){ return __builtin_bit_cast(s16x4,__builtin_amdgcn_ds_read_tr16_b64_v4i16((__attribute__((address_space(3))) v4i16_t*)p)); }
__device__ __forceinline__ float rowmax(const f32x16&p0,const f32x16&p1){
  float a=max3f(p0[0],p0[1],p1[0]),b=max3f(p0[2],p0[3],p1[1]);a=max3f(a,p1[2],p1[3]);
  #pragma unroll
  for(int r=4;r<16;r+=4){a=max3f(a,p0[r],p0[r+1]);b=max3f(b,p0[r+2],p0[r+3]);a=max3f(a,p1[r],p1[r+1]);b=max3f(b,p1[r+2],p1[r+3]);}
  const float m=max2f(a,b);
  auto rr=__builtin_amdgcn_permlane32_swap(__float_as_uint(m),__float_as_uint(m),false,false);
  return max2f(__uint_as_float(rr[0]),__uint_as_float(rr[1]));
}
__device__ __forceinline__ void pv(f32x16*o,int vb,bf16x8 pa0,bf16x8 pa1,bf16x8 pa2,bf16x8 pa3){
  #pragma unroll
  for(int d0=0;d0<2;++d0){s16x4 lo[4],hi[4];
    #pragma unroll
    for(int ks=0;ks<4;++ks){
      asm volatile("ds_read_b64_tr_b16 %0,%1 offset:%c2":"=&v"(lo[ks]):"v"(vb),"i"(d0*4096+ks*1024):"memory");
      asm volatile("ds_read_b64_tr_b16 %0,%1 offset:%c2":"=&v"(hi[ks]):"v"(vb),"i"(d0*4096+ks*1024+512):"memory");}
    asm volatile("s_waitcnt lgkmcnt(0)":::"memory");SBAR();
    #define PK(k) (bf16x8){lo[k][0],lo[k][1],lo[k][2],lo[k][3],hi[k][0],hi[k][1],hi[k][2],hi[k][3]}
    o[d0]=__builtin_amdgcn_mfma_f32_32x32x16_bf16(pa0,PK(0),o[d0],0,0,0);
    o[d0]=__builtin_amdgcn_mfma_f32_32x32x16_bf16(pa1,PK(1),o[d0],0,0,0);
    o[d0]=__builtin_amdgcn_mfma_f32_32x32x16_bf16(pa2,PK(2),o[d0],0,0,0);
    o[d0]=__builtin_amdgcn_mfma_f32_32x32x16_bf16(pa3,PK(3),o[d0],0,0,0);
    #undef PK
  }
}

#ifndef ATTN_STORE16
#define ATTN_STORE16(p,v) (*(u32x4*)(p)=(v))
#endif
template<int THRL> __device__ __forceinline__ void attn_unit(int b,int h,int qb,const bf16*Q,const bf16*__restrict__ K,const bf16*__restrict__ V,bf16*O,char*shm){
  const int tid=threadIdx.x,lane=tid&63,r32=lane&31,hi=lane>>5; const int wid=__builtin_amdgcn_readfirstlane(tid>>6);
  const long rowbase=(long)b*SEQ; const int q0=qb*QB;
  const bf16*Qw=Q+(rowbase+q0+wid*QBLK)*DMQ+h*D;
  const bf16*Kh=K+rowbase*DMQ+h*D,*Vh=V+rowbase*DMQ+h*D;
  const unsigned lds0=(unsigned)(uintptr_t)shm;
  float*wsf=(float*)(shm+LDS_WS)+wid*64;
  const bf16*ksrc=Kh+(long)lane*DMQ+wid*8;
  const bf16*vsrc=Vh+(long)(16*(wid&3)+(lane>>2))*DMQ+(wid>>2)*32+(lane&3)*8;
  const unsigned kdst=lds0+LDS_K+wid*1024, vdst=lds0+LDS_V+wid*1024;
  #define DMA_K(t,slot) glds16(ksrc+(long)(t)*KVBLK*DMQ,(unsigned)__builtin_amdgcn_readfirstlane(kdst+(slot)))
  #define DMA_V(t,slot) glds16(vsrc+(long)(t)*KVBLK*DMQ,(unsigned)__builtin_amdgcn_readfirstlane(vdst+(slot)))
  const int vb0=(int)(lds0+LDS_V)+((lane>>4)&1)*32+(lane&3)*8+(4*hi+((lane&15)>>2))*64;
  const char*Kbase=shm+LDS_K; bf16x8 kf[8];
  const lds_cptr shm3=(lds_cptr)shm; const lds_cptr kp0=shm3+LDS_K+hi*1024+r32*16; const lds_cptr vp0=shm3+LDS_V+((lane>>4)&1)*32+(lane&3)*8+(4*hi+((lane&15)>>2))*64;
  const int NT=(q0+QB)/KVBLK;
  DMA_K(0,0);DMA_V(0,0);DMA_K(1,SLOTB);
  bf16x8 qr[4];
  #pragma unroll
  for(int d0=0;d0<4;++d0)qr[d0]=*reinterpret_cast<const bf16x8*>(&Qw[(long)r32*DMQ+d0*16+hi*8]);
  float mhat=0.f,l_reg=0.f;f32x16 o[2];o[0]=f32x16{};o[1]=f32x16{};
  const lds_cptr kxp0=(lds_cptr)shm+LDS_KX+r32*16;
  u32x4 qxw; qxw[0]=hi?0u:0x3F803F80u; qxw[1]=hi?0u:0x00003F80u; qxw[2]=0u; qxw[3]=0u;
  #define SETQX() do{ const float m_=-mhat; const unsigned h1_=cvtpk_s(m_,0.f)&0xffffu; const float r1_=m_-__uint_as_float(h1_<<16); const unsigned h2_=cvtpk_s(r1_,0.f)&0xffffu; const float r2_=r1_-__uint_as_float(h2_<<16); \
      const unsigned h3_=cvtpk_s(r2_,0.f)&0xffffu; qxw[1]=hi?0u:(0x3F80u|(h1_<<16)); qxw[2]=hi?0u:(h2_|(h3_<<16)); asm volatile("":"+v"(qxw)); }while(0)
  #define QX __builtin_bit_cast(bf16x8,qxw)
  #define KXF(t,n) (*(const __attribute__((address_space(3))) bf16x8*)(kxp0+(t)*1024+(n)*512))
  const int qrel=wid*QBLK+r32;
  #define CMASK(P0,P1,t) do{int jb_=(t)-(NT-4); if(jb_>=0)cmask(P0,P1,jb_,qrel,hi);}while(0)
  bool resc=false;
  #define START(P0,P1) do{ const float rm=rowmax(P0,P1); resc=false; \
    { const float dl=rm; mhat=fadd_s(mhat,dl); \
      _Pragma("unroll") for(int r=0;r<16;++r){P0[r]=fsub_s(P0[r],dl);P1[r]=fsub_s(P1[r],dl);} \
      SETQX(); } \
    _Pragma("unroll") for(int r=0;r<16;++r)P0[r]=__builtin_amdgcn_exp2f(P0[r]); }while(0)
  #define RESC() do{ if(resc){ asm volatile("s_waitcnt lgkmcnt(0)":::"memory"); \
      _Pragma("unroll") for(int d_=0;d_<2;++d_) _Pragma("unroll") for(int r=0;r<16;++r)o[d_][r]*=wsf[crow(r,hi)]; } }while(0)
  f32x16 pA0,pA1,pB0,pB1;
  int sl_prev=0,sl_cur=0,sl_next=SLOTB;
  #define ROT() do{sl_prev=sl_cur;sl_cur=sl_next;sl_next=(sl_next==(NSLOT-1)*SLOTB)?0:sl_next+SLOTB;}while(0)
  DMA_K(2,2*SLOTB);
  WAIT_BAR(3);
  qkt(pA0,pA1,Kbase,qr,KXF(0,0),KXF(0,1),QX,r32,hi);asm volatile("s_nop 15\n\ts_nop 7":"+v"(pA0),"+v"(pA1));CMASK(pA0,pA1,0);
  START(pA0,pA1);
  _Pragma("unroll") for(int r=0;r<16;++r)pA1[r]=__builtin_amdgcn_exp2f(pA1[r]);
  WAIT_BAR(0);
  DMA_K(3,0);DMA_V(1,SLOTB);
  ROT();
  kload8(kf,kp0+sl_cur);
  WAIT_BAR(2);
  s16x4 vlo[8],vhi[8]; u32x4 pw0,pw1,pw2,pw3;
  #define PKW(P,B) cvtpk_s(P[B],P[B+1])
  #define PAF(k) __builtin_bit_cast(bf16x8,pw##k)
  #define VFR(i) (bf16x8){vlo[i][0],vlo[i][1],vlo[i][2],vlo[i][3],vhi[i][0],vhi[i][1],vhi[i][2],vhi[i][3]}
  #define PIN(x) asm volatile("":"+v"(x))
  #define MX3(a,b,c) __builtin_fmaxf(__builtin_fmaxf((a),(b)),(c))
  #define GAPA(MF,A0,A1,A2,A3,W0,W1,PW) do{ MF; sacc+=A0; sacc+=A1; sacc+=A2; sacc+=A3; PIN(sacc); W0; W1; PIN(PW); SBAR(); }while(0)
  #define EX(v) __builtin_amdgcn_exp2f(v)
  #define GAPB(MF,X,B) do{ MF; X[B]=EX(X[B]); X[B+1]=EX(X[B+1]); X[B+2]=EX(X[B+2]); X[B+3]=EX(X[B+3]); PIN(X); SBAR(); }while(0)
  #define VRD(i) do{ vlo[i]=vtr(vp_+(((i)>>2)*4096+((i)&3)*1024)); vhi[i]=vtr(vp_+(((i)>>2)*4096+((i)&3)*1024+512)); }while(0)
  #define KRD(G,j) do{ if(G){ kload2(kf,kp0+sl_next,j); SBAR(); } }while(0)
  #define STEP(C0,C1,P0,P1,t,GK,GV,GL) do{ SBAR(); \
    const lds_cptr vp_=vp0+sl_prev; const f32x16 z16_=f32x16{}; \
    const bf16x8 kx0_=KXF(t,0), kx1_=KXF(t,1); \
    VRD(0); SBAR(); float sacc=(P0[0]+P0[1]); \
    GAPA(C0=__builtin_amdgcn_mfma_f32_32x32x16_bf16(kf[0],qr[0],z16_,0,0,0), P0[2],P0[3],P0[4],P0[5],     pw0[0]=PKW(P0,0), pw0[1]=PKW(P0,2), pw0); \
    VRD(4); SBAR(); GAPA(C1=__builtin_amdgcn_mfma_f32_32x32x16_bf16(kf[1],qr[0],z16_,0,0,0), P0[6],P0[7],P0[8],P0[9],     pw0[2]=PKW(P0,4), pw0[3]=PKW(P0,6), pw0); \
    VRD(1); SBAR(); GAPA(C0=__builtin_amdgcn_mfma_f32_32x32x16_bf16(kf[2],qr[1],C0,0,0,0),   P0[10],P0[11],P0[12],P0[13], pw1[0]=PKW(P0,8), pw1[1]=PKW(P0,10), pw1); \
    VRD(5); SBAR(); GAPA(C1=__builtin_amdgcn_mfma_f32_32x32x16_bf16(kf[3],qr[1],C1,0,0,0),   P0[14],P0[15],P1[0],P1[1],   pw1[2]=PKW(P0,12),pw1[3]=PKW(P0,14), pw1); \
    VRD(2); SBAR(); GAPA(C0=__builtin_amdgcn_mfma_f32_32x32x16_bf16(kf[4],qr[2],C0,0,0,0),   P1[2],P1[3],P1[4],P1[5],     pw2[0]=PKW(P1,0), pw2[1]=PKW(P1,2), pw2); \
    VRD(6); SBAR(); GAPA(C1=__builtin_amdgcn_mfma_f32_32x32x16_bf16(kf[5],qr[2],C1,0,0,0),   P1[6],P1[7],P1[8],P1[9],     pw2[2]=PKW(P1,4), pw2[3]=PKW(P1,6), pw2); \
    VRD(3); SBAR(); GAPA(C0=__builtin_amdgcn_mfma_f32_32x32x16_bf16(kf[6],qr[3],C0,0,0,0),   P1[10],P1[11],P1[12],P1[13], pw3[0]=PKW(P1,8), pw3[1]=PKW(P1,10), pw3); \
    VRD(7); SBAR(); GAPA(C1=__builtin_amdgcn_mfma_f32_32x32x16_bf16(kf[7],qr[3],C1,0,0,0),   P1[14],P1[15],0.f,0.f,       pw3[2]=PKW(P1,12),pw3[3]=PKW(P1,14), pw3); \
    C0=__builtin_amdgcn_mfma_f32_32x32x16_bf16(kx0_,QX,C0,0,0,0); SBAR(); C1=__builtin_amdgcn_mfma_f32_32x32x16_bf16(kx1_,QX,C1,0,0,0); SBAR(); \
    l_reg+=sacc; \
    if(GK){DMA_K((t)+3,sl_cur);} if(GV){DMA_V((t)+1,sl_next);} \
    CMASK(C0,C1,t); \
    { float a=MX3(C0[0],C0[1],C1[0]),b=MX3(C0[2],C0[3],C1[1]); a=MX3(a,C1[2],C1[3]); \
      _Pragma("unroll") for(int r=4;r<16;r+=4){a=MX3(a,C0[r],C0[r+1]);b=MX3(b,C0[r+2],C0[r+3]);a=MX3(a,C1[r],C1[r+1]);b=MX3(b,C1[r+2],C1[r+3]);} \
      float rm=__builtin_fmaxf(a,b); { auto rr=__builtin_amdgcn_permlane32_swap(__float_as_uint(rm),__float_as_uint(rm),false,false); rm=__builtin_fmaxf(__uint_as_float(rr[0]),__uint_as_float(rr[1])); } \
      resc=false; \
      if(__builtin_expect(__any(rm>(float)THRL),0)){ const float dl=__builtin_fmaxf(rm,0.f); mhat+=dl; \
        _Pragma("unroll") for(int r=0;r<16;++r){C0[r]-=dl;C1[r]-=dl;} \
        SETQX(); \
        const float f=__builtin_amdgcn_exp2f(-dl); l_reg*=f; if(hi==0)wsf[r32]=f; resc=true; } } \
    SBAR(); \
    GAPB(o[0]=__builtin_amdgcn_mfma_f32_32x32x16_bf16(PAF(0),VFR(0),o[0],0,0,0), C0,0); \
    GAPB(o[1]=__builtin_amdgcn_mfma_f32_32x32x16_bf16(PAF(0),VFR(4),o[1],0,0,0), C0,4); \
    KRD(GL,0); GAPB(o[0]=__builtin_amdgcn_mfma_f32_32x32x16_bf16(PAF(1),VFR(1),o[0],0,0,0), C0,8); \
    KRD(GL,1); GAPB(o[1]=__builtin_amdgcn_mfma_f32_32x32x16_bf16(PAF(1),VFR(5),o[1],0,0,0), C0,12); \
    KRD(GL,2); GAPB(o[0]=__builtin_amdgcn_mfma_f32_32x32x16_bf16(PAF(2),VFR(2),o[0],0,0,0), C1,0); \
    KRD(GL,3); GAPB(o[1]=__builtin_amdgcn_mfma_f32_32x32x16_bf16(PAF(2),VFR(6),o[1],0,0,0), C1,4); \
    GAPB(o[0]=__builtin_amdgcn_mfma_f32_32x32x16_bf16(PAF(3),VFR(3),o[0],0,0,0), C1,8); \
    GAPB(o[1]=__builtin_amdgcn_mfma_f32_32x32x16_bf16(PAF(3),VFR(7),o[1],0,0,0), C1,12); \
    }while(0)
  int t=1;
  #undef CMASK
  #define CMASK(P0,P1,t) do{}while(0)
  for(;t+5<NT;t+=2){
    STEP(pB0,pB1,pA0,pA1,t,true,true,true);     WAIT_BAR(2); RESC(); ROT();
    STEP(pA0,pA1,pB0,pB1,t+1,true,true,true);   WAIT_BAR(2); RESC(); ROT();
  }
  #undef CMASK
  #define CMASK(P0,P1,t) do{int jb_=(t)-(NT-4); if(jb_>=0)cmask(P0,P1,jb_,qrel,hi);}while(0)
  #define ENDW(tt) do{ if((tt)+3<NT){WAIT_BAR(2);} else if((tt)+2<NT){WAIT_BAR(1);} else {WAIT_BAR(0);} }while(0)
  for(;t+1<NT;t+=2){
    STEP(pB0,pB1,pA0,pA1,t,(t+3<NT),(t+1<NT),(t+1<NT));       ENDW(t);   RESC(); ROT();
    STEP(pA0,pA1,pB0,pB1,t+1,(t+4<NT),(t+2<NT),(t+2<NT));     ENDW(t+1); RESC(); ROT();
  }
  STEP(pB0,pB1,pA0,pA1,NT-1,false,false,false); RESC();
  { float sacc=pB0[0]+pB0[1]; _Pragma("unroll") for(int r=2;r<16;++r)sacc+=pB0[r]; _Pragma("unroll") for(int r=0;r<16;++r)sacc+=pB1[r]; l_reg+=sacc;
    pw0=(u32x4){PKW(pB0,0),PKW(pB0,2),PKW(pB0,4),PKW(pB0,6)};pw1=(u32x4){PKW(pB0,8),PKW(pB0,10),PKW(pB0,12),PKW(pB0,14)};pw2=(u32x4){PKW(pB1,0),PKW(pB1,2),PKW(pB1,4),PKW(pB1,6)};pw3=(u32x4){PKW(pB1,8),PKW(pB1,10),PKW(pB1,12),PKW(pB1,14)};
    SBAR(); pv(o,vb0+sl_cur,PAF(0),PAF(1),PAF(2),PAF(3)); }
  #undef PKW
  #undef PAF
  #undef VFR
  #undef PIN
  #undef MX3
  #undef GAPA
  #undef GAPB
  #undef EX
  #undef VRD
  #undef KRD
  #undef STEP
  #undef ENDW
  {auto rr=__builtin_amdgcn_permlane32_swap(__float_as_uint(l_reg),__float_as_uint(l_reg),false,false);l_reg=__uint_as_float(rr[0])+__uint_as_float(rr[1]);}
  if(hi==0)wsf[32+r32]=l_reg;asm volatile("s_waitcnt lgkmcnt(0)":::"memory");
  float rli[16];
  #pragma unroll
  for(int r=0;r<16;++r)rli[r]=__builtin_amdgcn_rcpf(wsf[32+crow(r,hi)]);
  bf16*Ow=O+(rowbase+q0+wid*QBLK)*DMO+h*D;
  { bf16*stg=(bf16*)(shm+LDS_OST)+wid*2048;
    #pragma unroll
    for(int r=0;r<16;++r){const int orow=crow(r,hi);
      #pragma unroll
      for(int d0=0;d0<2;++d0)stg[orow*64+d0*32+r32]=__float2bfloat16(o[d0][r]*rli[r]);}
    asm volatile("s_waitcnt lgkmcnt(0)":::"memory");
    #pragma unroll
    for(int i=0;i<4;++i){const int row=i*8+(lane>>3),ch=lane&7; const u32x4 v=*(const u32x4*)(stg+row*64+ch*8); ATTN_STORE16(Ow+(long)row*DMO+ch*8,v);} }
  asm volatile("s_waitcnt lgkmcnt(0)\n\ts_barrier":::"memory");
  #undef DMA_K
  #undef DMA_V
  #undef SETQX
  #undef QX
  #undef KXF
  #undef CMASK
  #undef START
  #undef RESC
  #undef ROT
}
constexpr int ATTN_LDS_BYTES=LDS_BYTES;
__device__ __forceinline__ void fill_kx(char*shm,const float*FG,float fbias,int b,int h){
  const int tid=threadIdx.x,lane=tid&63,wid=tid>>6;
  double*wtot=(double*)(shm+LDS_WS);
  float ls[8]; double run=0.0;
  #pragma unroll
  for(int j=0;j<8;++j){ const float x=FG[((long)b*SEQ+8*tid+j)*8+h]+fbias; const float e=__expf(-fabsf(x)); ls[j]=fminf(x,0.f)-log1pf(e); }
  #pragma unroll
  for(int j=0;j<8;++j)run+=(double)ls[j];
  double inc=run;
  #pragma unroll
  for(int o=1;o<64;o<<=1){ const double v=__shfl_up(inc,o); if(lane>=o)inc+=v; }
  if(lane==63)wtot[wid]=inc;
  __syncthreads();
  double base=inc-run;
  for(int w=0;w<wid;++w)base+=wtot[w];
  u32x4*dst=(u32x4*)(shm+LDS_KX)+8*tid;
  #pragma unroll
  for(int j=0;j<8;++j){ base+=(double)ls[j]; const float c=(float)(-base*1.4426950408889634);
    const unsigned h1=cvtpk_s(c,0.f)&0xffffu; const float r1=c-__uint_as_float(h1<<16); const unsigned h2=cvtpk_s(r1,0.f)&0xffffu; const float r2=r1-__uint_as_float(h2<<16); const unsigned h3=cvtpk_s(r2,0.f)&0xffffu;
    dst[j]=(u32x4){h1|(h2<<16),h3|0x3F800000u,0x3F803F80u,0u}; }
  if(tid==0)((u32x4*)(shm+LDS_KX))[SEQ]=(u32x4){0u,0u,0u,0u};
  __syncthreads();
}
struct AttnTensors { const bf16* Q; const bf16* K; const bf16* V; bf16* O; };
struct AttnUnit { int bh; int qb; };
struct StaticOrder {
  int vcu;
  __device__ __forceinline__ explicit StaticOrder(int grid,int block):vcu((block%8)*(grid/8)+block/8){}
  __device__ __forceinline__ bool next(int i,AttnUnit&u)const{ if(i>=8)return false; const int s=vcu&1, j=2*(i>>1)+s; u.bh=vcu>>1; u.qb=(i&1)?15-j:j; return true; }
  __device__ __forceinline__ void a_ready(const AttnUnit&)const{}
  __device__ __forceinline__ void done(const AttnUnit&)const{}
};
template<class Sched,int THRL=8> __device__ __forceinline__ void attn_phase(char*lds,const AttnTensors&T,const Sched&S){
  AttnUnit u;
  for(int i=0;S.next(i,u);++i){ S.a_ready(u); attn_unit<THRL>(u.bh/NHEAD,u.bh%NHEAD,u.qb,T.Q,T.K,T.V,T.O,lds); S.done(u); }
}
#undef SBAR
#undef WAIT_BAR
}
#define GAS __attribute__((address_space(1)))
#define LAS __attribute__((address_space(3)))
typedef unsigned short bf16;
typedef unsigned v4u __attribute__((ext_vector_type(4)));
typedef float f32x4 __attribute__((ext_vector_type(4)));
typedef short bf16x8 __attribute__((ext_vector_type(8)));
typedef GAS unsigned gu32;
typedef GAS unsigned long long gu64;
#define RLX_AGENT __ATOMIC_RELAXED, __HIP_MEMORY_SCOPE_AGENT
#define LDS_WAIT() asm volatile("s_waitcnt lgkmcnt(0)" ::: "memory")
#define VM_WAIT() asm volatile("s_waitcnt vmcnt(0)" ::: "memory")
__device__ __forceinline__ unsigned long long rt() { return __builtin_amdgcn_s_memrealtime(); }
__device__ __forceinline__ unsigned f2bf(float f) { unsigned u = __builtin_bit_cast(unsigned, f); return (u + 0x7fffu + ((u >> 16) & 1u)) >> 16; }
__device__ __forceinline__ unsigned pk2(float lo, float hi) { return f2bf(lo) | (f2bf(hi) << 16); }

#define XB_TMO      128
#define XB_XCNT(j)  (256  + 64 * (j))
#define XB_XSUB(j)  (1280 + 64 * (j))
#define XB_XGEN(j)  (2304 + 64 * (j))
#define XB_TOP      3328
#define XB_TOPGEN   3392
#define XCD_BAR_WORDS 3456
#define XB_SPIN_CAP (1u << 20)

__device__ __forceinline__ unsigned xb_ld(unsigned* p)              { return __hip_atomic_load(p, __ATOMIC_RELAXED, __HIP_MEMORY_SCOPE_AGENT); }
__device__ __forceinline__ unsigned xb_add(unsigned* p, unsigned v) { return __hip_atomic_fetch_add(p, v, __ATOMIC_RELAXED, __HIP_MEMORY_SCOPE_AGENT); }
__device__ __forceinline__ unsigned xb_xcc_id() { return (unsigned)__builtin_amdgcn_s_getreg((3 << 11) | 20) & 0xFu; }
#define XB_SPIN(cond, bar) do { unsigned _sp = 0; while (cond) { __builtin_amdgcn_s_sleep(1); \
    if ((++_sp & 255u) == 0u) { if (xb_ld(&(bar)[XB_TMO])) break; if (_sp > XB_SPIN_CAP) { atomicAdd(&(bar)[XB_TMO], 1u); break; } } } } while (0)

struct XcdBarrier {
    unsigned* bar; unsigned x;
    volatile LAS unsigned* st;
};

__device__ __forceinline__ XcdBarrier xcd_barrier_post(unsigned* bar, volatile LAS unsigned* st) {
    XcdBarrier b; b.bar = bar; b.x = xb_xcc_id(); b.st = st;
    if (threadIdx.x == 0) (void)xb_add(&bar[XB_XCNT(b.x)], 1u);
    return b;
}
__device__ __forceinline__ void xcd_barrier_complete(unsigned* bar, unsigned x, unsigned& nloc, unsigned& nx) {
    const unsigned G = gridDim.x * gridDim.y * gridDim.z;
    unsigned sum, cnt, mine, sp = 0u;
    for (;;) {
        sum = 0u; cnt = 0u; mine = 0u;
#pragma unroll
        for (unsigned j = 0; j < 16; ++j) { const unsigned c = xb_ld(&bar[XB_XCNT(j)]); sum += c; cnt += (c > 0u) ? 1u : 0u; mine = (j == x) ? c : mine; }
        if (sum == G) break;
        __builtin_amdgcn_s_sleep(1);
        if ((++sp & 255u) == 0u) { if (xb_ld(&bar[XB_TMO])) break; if (sp > XB_SPIN_CAP) { atomicAdd(&bar[XB_TMO], 1u); break; } }
    }
    nloc = mine > 0u ? mine : 1u; nx = cnt > 0u ? cnt : 1u;
}

__device__ __forceinline__ void xcd_barrier(const XcdBarrier& b) {
    asm volatile("s_waitcnt vmcnt(0)" ::: "memory");
    __syncthreads();
    if (threadIdx.x == 0) {
        unsigned* bar = b.bar;
        __builtin_amdgcn_s_waitcnt(0);
        unsigned nloc = b.st[0], nx = b.st[1];
        if (nloc == 0u) { xcd_barrier_complete(bar, b.x, nloc, nx); b.st[0] = nloc; b.st[1] = nx; }
        const unsigned old = xb_add(&bar[XB_XSUB(b.x)], 1u);
        const unsigned gen = old / nloc;
        if (old + 1u == (gen + 1u) * nloc) {
            __builtin_amdgcn_fence(__ATOMIC_RELEASE, "agent");
            asm volatile("s_waitcnt vmcnt(0)" ::: "memory");
            const unsigned og = xb_add(&bar[XB_TOP], 1u);
            const unsigned tg = og / nx;
            if (og + 1u == (tg + 1u) * nx) xb_add(&bar[XB_TOPGEN], 1u);
            else XB_SPIN(xb_ld(&bar[XB_TOPGEN]) == tg, bar);
            __builtin_amdgcn_fence(__ATOMIC_ACQUIRE, "agent");
            xb_add(&bar[XB_XGEN(b.x)], 1u);
            asm volatile("s_waitcnt vmcnt(0)" ::: "memory");
        } else {
            XB_SPIN(xb_ld(&bar[XB_XGEN(b.x)]) == gen, bar);
            __builtin_amdgcn_fence(__ATOMIC_ACQUIRE, "agent");
            asm volatile("s_waitcnt vmcnt(0)" ::: "memory");
        }
    }
    __syncthreads();
}

constexpr int NWAVES = 8;
constexpr int NB = 16, SEQ = 4096, DMODEL = 1024, NTOK = NB * SEQ;
constexpr int RC = 1792, FQKV = 1536, NPROJ = 3328, ICOLS = 3336, NMOD = 6144;
constexpr int NEXP = 32, DEXP = 512;
constexpr size_t MiB = 1u << 20;
constexpr size_t WS_CTL = 0, CTL_ZERO_BYTES = 1 * MiB;
constexpr size_t WS_MOD = 1 * MiB, WS_FG = 2 * MiB, WS_WIN = 8 * MiB, WS_WOUT = 16 * MiB, WS_LORA = 18 * MiB, WS_TOKINFO = 19 * MiB;
constexpr size_t WS_SLOT_TOK = 24 * MiB, WS_SLOT_W = 32 * MiB, WS_W1 = 40 * MiB, WS_W2 = 104 * MiB;
constexpr size_t WS_H = 136 * MiB, WS_PR = 264 * MiB, WS_PF = 488 * MiB, WS_MIX = 680 * MiB, WS_END = 1024 * MiB;
constexpr int CW_TMO = 0, CW_CODE = 1, CW_BAR = 4096, CW_CNT = 16384;
constexpr int RING_OFF = 0, RING_BYTES = 131072, LDS_BYTES = 163840, LDSCTL_OFF = LDS_BYTES - 512, MISC_OFF = LDSCTL_OFF;
static_assert(attn_body::ATTN_LDS_BYTES <= LDSCTL_OFF, "attention LDS");

struct Frame {
    LAS unsigned char* lds;
    volatile LAS unsigned* MISC;
    gu32* ctl;
    int tid, lane, wave;
    int vcu, G;
    const float* in[28]; float* out; unsigned char* ws;
};
#define IN_X 0
#define IN_C 1
#define IN_WADA 2
#define IN_BADA 3
#define IN_N1G 4
#define IN_WIN 5
#define IN_MU 6
#define IN_W0 7
#define IN_WUP 8
#define IN_A0 9
#define IN_AUP 10
#define IN_GUP 11
#define IN_KK 12
#define IN_KA 13
#define IN_RK 14
#define IN_LNG 15
#define IN_LNB 16
#define IN_FB 17
#define IN_WOUT 18
#define IN_N2G 19
#define IN_WGRP 20
#define IN_BGRP 21
#define IN_WRT 22
#define IN_BRT 23
#define IN_WGATE 24
#define IN_WUPM 25
#define IN_WDOWN 26
#define IN_NFG 27

__device__ __forceinline__ float wave_sum(float v) {
#pragma unroll
    for (int o = 1; o < 64; o <<= 1) v += __shfl_xor(v, o);
    return v;
}
__device__ __forceinline__ void wave_reduce8(float (&v)[8], int lane) {
    { const bool up = lane & 32;
#pragma unroll
      for (int j = 0; j < 4; ++j) { const float send = up ? v[j] : v[j + 4], keep = up ? v[j + 4] : v[j]; v[j] = keep + __shfl_xor(send, 32); } }
    { const bool up = lane & 16;
#pragma unroll
      for (int j = 0; j < 2; ++j) { const float send = up ? v[j] : v[j + 2], keep = up ? v[j + 2] : v[j]; v[j] = keep + __shfl_xor(send, 16); } }
    { const bool up = lane & 8; const float send = up ? v[0] : v[1], keep = up ? v[1] : v[0]; v[0] = keep + __shfl_xor(send, 8); }
    v[0] += __shfl_xor(v[0], 4); v[0] += __shfl_xor(v[0], 2); v[0] += __shfl_xor(v[0], 1);
}

__device__ __forceinline__ void p0_transpose_item(const float* W, int ldw, bf16* WT, int ldt, int dst_row0, int k0, int n0, LAS float* scr, int lane) {
#pragma unroll 8
    for (int i = 0; i < 32; ++i) { const int kk = 2 * i + (lane >> 5); scr[kk * 33 + (lane & 31)] = W[(size_t)(k0 + kk) * ldw + n0 + (lane & 31)]; }
    LDS_WAIT(); asm volatile("" ::: "memory");
    const int c = lane & 7;
#pragma unroll
    for (int j = 0; j < 4; ++j) { const int n = (lane >> 3) + 8 * j; const LAS float* s = scr + (8 * c) * 33 + n;
        v4u o; o.x = pk2(s[0 * 33], s[1 * 33]); o.y = pk2(s[2 * 33], s[3 * 33]); o.z = pk2(s[4 * 33], s[5 * 33]); o.w = pk2(s[6 * 33], s[7 * 33]);
        *(GAS v4u*)(WT + (size_t)(dst_row0 + n) * ldt + k0 + 8 * c) = o; }
    LDS_WAIT(); asm volatile("" ::: "memory");
}
__device__ __forceinline__ void p0_prologue(Frame& F) {
    {
        LAS float* cond = (LAS float*)(F.lds);
        LAS float* red = (LAS float*)(F.lds + 65536);
        const float* c = F.in[IN_C]; const float* wada = F.in[IN_WADA]; const float* bada = F.in[IN_BADA]; float* mod = (float*)(F.ws + WS_MOD);
        for (int u = F.vcu; u < NMOD / 32; u += F.G) {
            for (int idx = F.tid; idx < 16384; idx += 512) { const int k = idx >> 4, b = idx & 15; const float v = c[b * 1024 + k]; cond[idx] = v / (1.f + __expf(-v)); }
            __syncthreads();
            const int ks = F.tid >> 5, cl = F.tid & 31, col = u * 32 + cl;
            float acc[16];
#pragma unroll
            for (int b = 0; b < 16; ++b) acc[b] = 0.f;
            for (int i = 0; i < 64; ++i) { const int k = ks + 16 * i; const float w = wada[(size_t)k * NMOD + col];
                const LAS f32x4* cv = (const LAS f32x4*)(cond + k * 16);
#pragma unroll
                for (int q = 0; q < 4; ++q) { const f32x4 t = cv[q]; acc[4 * q] += t[0] * w; acc[4 * q + 1] += t[1] * w; acc[4 * q + 2] += t[2] * w; acc[4 * q + 3] += t[3] * w; } }
#pragma unroll
            for (int b = 0; b < 16; ++b) red[(ks * 16 + b) * 32 + cl] = acc[b];
            __syncthreads();
            { const int b = F.tid >> 5; float s = bada[col];
#pragma unroll
              for (int k2 = 0; k2 < 16; ++k2) s += red[(k2 * 16 + b) * 32 + cl];
              mod[(size_t)b * NMOD + col] = s; }
            __syncthreads();
        }
    }
    {
        LAS float* scr = (LAS float*)(F.lds + F.wave * 16384);
        const int gw = F.vcu * NWAVES + F.wave, NGW = F.G * NWAVES;
        constexpr int I_IN = 16 * (NPROJ / 32), I_OUT = 16 * 32, I_E = 768, NITEMS = I_IN + I_OUT + NEXP * I_E;
        bf16* Win_t = (bf16*)(F.ws + WS_WIN); bf16* Wout_t = (bf16*)(F.ws + WS_WOUT); bf16* W1_t = (bf16*)(F.ws + WS_W1); bf16* W2_t = (bf16*)(F.ws + WS_W2);
        for (int it = gw; it < NITEMS; it += NGW) {
            int r = it;
            if (r < I_IN) { const int nblk = NPROJ / 32, kb = r / nblk, nb = r % nblk; p0_transpose_item(F.in[IN_WIN], ICOLS, Win_t, 1024, 32 * nb, 64 * kb, 32 * nb, scr, F.lane); continue; } r -= I_IN;
            if (r < I_OUT) { const int kb = r / 32, nb = r % 32; p0_transpose_item(F.in[IN_WOUT], 1024, Wout_t, 1024, 32 * nb, 64 * kb, 32 * nb, scr, F.lane); continue; } r -= I_OUT;
            const int e = r / I_E; r -= e * I_E;
            if (r < 512) { const int up = r >> 8, q = r & 255, kb = q >> 4, nb = q & 15, n0 = 32 * nb;
                if (up) p0_transpose_item(F.in[IN_WUPM] + (size_t)e * 1024 * 512, 512, W1_t + (size_t)e * 1024 * 1024, 1024, 256 * (n0 >> 7) + 128 + (n0 & 127), 64 * kb, n0, scr, F.lane);
                else    p0_transpose_item(F.in[IN_WGATE] + (size_t)e * 1024 * 512, 512, W1_t + (size_t)e * 1024 * 1024, 1024, 256 * (n0 >> 7) + (n0 & 127), 64 * kb, n0, scr, F.lane); }
            else { const int q = r - 512, kb = q >> 5, nb = q & 31;
                p0_transpose_item(F.in[IN_WDOWN] + (size_t)e * 512 * 1024, 1024, W2_t + (size_t)e * 1024 * 512, 512, 32 * nb, 64 * kb, 32 * nb, scr, F.lane); }
        }
    }
}

__device__ __forceinline__ void p1_norm(Frame& F) {
    LAS f32x4* Wf4 = (LAS f32x4*)(F.lds);
    const float* win = F.in[IN_WIN];
    for (int idx = F.tid; idx < 8192; idx += 512) { const int c = idx >> 3, j = idx & 7; const float v = win[(size_t)c * ICOLS + NPROJ + j];
        const int l = (c & 255) >> 2, jq = c >> 8, i = c & 3, jj = jq * 4 + i; ((LAS float*)Wf4)[(((j >> 2) * 16 + jj) * 64 + l) * 4 + (j & 3)] = v; }
    __syncthreads();
    const float* x = F.in[IN_X]; const float* g1 = F.in[IN_N1G]; const float* mod = (const float*)(F.ws + WS_MOD);
    bf16* H = (bf16*)(F.ws + WS_H); float* FG = (float*)(F.ws + WS_FG);
    for (int rb = F.vcu; rb < NTOK / 256; rb += F.G) {
        const int b = (rb * 256) / SEQ;
        f32x4 A[4], Bc[4];
#pragma unroll
        for (int j = 0; j < 4; ++j) { const int c = 4 * F.lane + 256 * j; const f32x4 g = *(const f32x4*)(g1 + c), sc = *(const f32x4*)(mod + (size_t)b * NMOD + 1024 + c); A[j] = g * (sc + 1.0f); Bc[j] = *(const f32x4*)(mod + (size_t)b * NMOD + c); }
        for (int r = F.wave; r < 256; r += NWAVES) {
            const size_t m = (size_t)rb * 256 + r;
            const GAS f32x4* xr = (const GAS f32x4*)(x + m * 1024) + F.lane;
            f32x4 v[4]; float ss = 0.f;
#pragma unroll
            for (int j = 0; j < 4; ++j) { v[j] = xr[64 * j]; ss += (v[j].x * v[j].x + v[j].y * v[j].y) + (v[j].z * v[j].z + v[j].w * v[j].w); }
            const float rstd = 1.0f / sqrtf(wave_sum(ss) * (1.f / 1024.f) + 1e-6f);
            GAS unsigned long long* o8 = (GAS unsigned long long*)(H + m * 1024) + F.lane;
            float acc[8];
#pragma unroll
            for (int q = 0; q < 8; ++q) acc[q] = 0.f;
#pragma unroll
            for (int j = 0; j < 4; ++j) { v[j] = v[j] * rstd * A[j] + Bc[j];
                o8[64 * j] = (unsigned long long)pk2(v[j].x, v[j].y) | ((unsigned long long)pk2(v[j].z, v[j].w) << 32);
#pragma unroll
                for (int i = 0; i < 4; ++i) { const f32x4 w0 = Wf4[(j * 4 + i) * 64 + F.lane], w1 = Wf4[(16 + j * 4 + i) * 64 + F.lane]; const float hv = v[j][i];
                    acc[0] += hv * w0[0]; acc[1] += hv * w0[1]; acc[2] += hv * w0[2]; acc[3] += hv * w0[3]; acc[4] += hv * w1[0]; acc[5] += hv * w1[1]; acc[6] += hv * w1[2]; acc[7] += hv * w1[3]; } }
            wave_reduce8(acc, F.lane);
            if ((F.lane & 7) == 0) FG[m * 8 + 4 * ((F.lane >> 5) & 1) + 2 * ((F.lane >> 4) & 1) + ((F.lane >> 3) & 1)] = acc[0];
        }
    }
}

__device__ __forceinline__ void p_final_nomoe(Frame& F) {
    const float* gf = F.in[IN_NFG];
    f32x4 G4[4];
#pragma unroll
    for (int j = 0; j < 4; ++j) G4[j] = *(const f32x4*)(gf + 4 * F.lane + 256 * j);
    const int gw = F.vcu * NWAVES + F.wave, NGW = F.G * NWAVES;
    for (int m = gw; m < NTOK; m += NGW) {
        GAS f32x4* xr = (GAS f32x4*)(F.out + (size_t)m * 1024) + F.lane;
        f32x4 v[4]; float ss = 0.f;
#pragma unroll
        for (int j = 0; j < 4; ++j) { v[j] = xr[64 * j]; ss += (v[j].x * v[j].x + v[j].y * v[j].y) + (v[j].z * v[j].z + v[j].w * v[j].w); }
        const float rstd = 1.0f / sqrtf(wave_sum(ss) * (1.f / 1024.f) + 1e-6f);
#pragma unroll
        for (int j = 0; j < 4; ++j) xr[64 * j] = v[j] * rstd * G4[j];
    }
}


constexpr size_t WS_ALORA = 808 * MiB;
constexpr size_t OUT_Y = 0, OUT_GG = 128 * MiB, OUT_Z = 192 * MiB;
typedef unsigned v2u __attribute__((ext_vector_type(2)));
typedef float f32x2 __attribute__((ext_vector_type(2)));
__device__ __forceinline__ float bf2f(unsigned short u) { return __uint_as_float((unsigned)u << 16); }
__device__ __forceinline__ float sigmoidf_(float v) { return 1.0f / (1.0f + __expf(-v)); }

__device__ __forceinline__ void r0_lora_inputs(Frame& F) {
    const bf16* PR = (const bf16*)(F.ws + WS_PR); bf16* AL = (bf16*)(F.ws + WS_ALORA); const float* mu = F.in[IN_MU] + 1536;
    const int gw = F.vcu * NWAVES + F.wave, NGW = F.G * NWAVES, l = F.lane & 31;
    float m8[8];
#pragma unroll
    for (int i = 0; i < 8; ++i) m8[i] = mu[8 * l + i];
    for (int m = gw; m < NTOK; m += NGW) {
        if (F.lane < 32) {
            const v4u cur = *(const GAS v4u*)(PR + (size_t)m * RC + 1536 + 8 * l);
            v4u prv = (v4u){0u, 0u, 0u, 0u}; if ((m & (SEQ - 1)) != 0) prv = *(const GAS v4u*)(PR + (size_t)(m - 1) * RC + 1536 + 8 * l);
            float o[8];
#pragma unroll
            for (int i = 0; i < 4; ++i) { const unsigned cw = cur[i], pw = prv[i];
                const float c0 = __uint_as_float(cw << 16), c1 = __uint_as_float(cw & 0xffff0000u), p0 = __uint_as_float(pw << 16), p1 = __uint_as_float(pw & 0xffff0000u);
                o[2 * i] = c0 + (p0 - c0) * m8[2 * i]; o[2 * i + 1] = c1 + (p1 - c1) * m8[2 * i + 1]; }
            if (l < 8) {
#pragma unroll
                for (int i = 0; i < 8; ++i) o[i] = tanhf(o[i]);
            } else if (l >= 16) {
#pragma unroll
                for (int i = 0; i < 8; ++i) o[i] = sigmoidf_(o[i]);
            }
            *(GAS v4u*)(AL + (size_t)m * 256 + 8 * l) = (v4u){pk2(o[0], o[1]), pk2(o[2], o[3]), pk2(o[4], o[5]), pk2(o[6], o[7])};
        }
    }
}

namespace scan {
typedef _Float16 h16x4 __attribute__((ext_vector_type(4)));
constexpr int TC = 32;
constexpr int RECB = 896;
constexpr int L_RAW = 0;
constexpr int L_AL = 13312;
constexpr int L_REC = L_AL + 16 * 1056;
constexpr int L_AV = L_REC + TC * RECB;
constexpr int L_GV = L_AV + 8192;
constexpr int L_YB = L_GV + 4096;
constexpr int L_BF = L_YB + 4096 + 256;
constexpr int L_END = L_BF + 24576;
template <int N> __device__ __forceinline__ float ror16(float x) { return __int_as_float(__builtin_amdgcn_update_dpp(0, __float_as_int(x), 0x120 + N, 0xf, 0xf, false)); }
__device__ __forceinline__ float allsum16(float x) { x += ror16<8>(x); x += ror16<4>(x); x += ror16<2>(x); x += ror16<1>(x); return x; }
typedef float f32x16 __attribute__((ext_vector_type(16)));
__device__ __forceinline__ float fmix_lo(float a, unsigned h2, float c) { float d; asm("v_fma_mix_f32 %0, %1, %2, %3 op_sel_hi:[0,1,0]" : "=v"(d) : "v"(a), "v"(h2), "v"(c)); return d; }
__device__ __forceinline__ float fmix_hi(float a, unsigned h2, float c) { float d; asm("v_fma_mix_f32 %0, %1, %2, %3 op_sel:[0,1,0] op_sel_hi:[0,1,0]" : "=v"(d) : "v"(a), "v"(h2), "v"(c)); return d; }
__device__ __forceinline__ float fmix_hi_nop(float a, unsigned h2, float c) { float d; asm("v_fma_mix_f32 %0, %1, %2, %3 op_sel:[0,1,0] op_sel_hi:[0,1,0]\n\ts_nop 1" : "=v"(d) : "v"(a), "v"(h2), "v"(c)); return d; }
__device__ __forceinline__ float fmix_lo0(float a, unsigned h2) { float d; asm("v_fma_mix_f32 %0, %1, %2, 0 op_sel_hi:[0,1,0]" : "=v"(d) : "v"(a), "v"(h2)); return d; }
__device__ __forceinline__ float fmix_hi0(float a, unsigned h2) { float d; asm("v_fma_mix_f32 %0, %1, %2, 0 op_sel:[0,1,0] op_sel_hi:[0,1,0]" : "=v"(d) : "v"(a), "v"(h2)); return d; }

__device__ __forceinline__ void phase(Frame& F) {
    const int tid = F.tid, lane = F.lane, wave = F.wave;
    const int half = F.vcu & 1, hd = (F.vcu >> 1) & 7, b = F.vcu >> 4;
    LAS unsigned char* L = F.lds;
    const unsigned lds0 = (unsigned)(uintptr_t)(unsigned char*)F.lds;
    const bf16* PR = (const bf16*)(F.ws + WS_PR); const bf16* AL = (const bf16*)(F.ws + WS_ALORA);
    float* Y = (float*)((unsigned char*)F.out + OUT_Y); bf16* GG = (bf16*)((unsigned char*)F.out + OUT_GG); bf16* Z = (bf16*)((unsigned char*)F.out + OUT_Z);
    const int et = tid >> 4, cg = tid & 15, chb = hd * 64 + 4 * cg;
    float mu_r[4], mu_k[4], mu_v[4], kkc[4], kac[4], rkc[4], lng[4], lnb[4];
#pragma unroll
    for (int i = 0; i < 4; ++i) { mu_r[i] = F.in[IN_MU][chb + i]; mu_k[i] = F.in[IN_MU][512 + chb + i]; kkc[i] = F.in[IN_KK][chb + i]; kac[i] = F.in[IN_KA][chb + i]; rkc[i] = F.in[IN_RK][chb + i]; }
    const int vch = hd * 64 + half * 32 + 4 * (cg & 7);
#pragma unroll
    for (int i = 0; i < 4; ++i) { mu_v[i] = F.in[IN_MU][1024 + vch + i]; lng[i] = F.in[IN_LNG][vch + i]; lnb[i] = F.in[IN_LNB][vch + i]; }
    if (wave < 5) {
        const int r32 = lane & 31, hi = lane >> 5;
        const int col = (wave < 4) ? hd * 64 + (wave & 1) * 32 + r32 : hd * 64 + half * 32 + r32;
        const int ns = (wave < 4) ? 4 : 8;
        const float* wup = F.in[IN_WUP]; const float* aup = F.in[IN_AUP]; const float* gup = F.in[IN_GUP];
        for (int s = 0; s < ns; ++s) { float f[8];
            if (wave < 2) {
#pragma unroll
                for (int jj = 0; jj < 8; ++jj) f[jj] = wup[(size_t)(16 * s + 8 * hi + jj) * 512 + col];
            } else if (wave < 4) {
#pragma unroll
                for (int jj = 0; jj < 8; ++jj) f[jj] = aup[(size_t)(16 * s + 8 * hi + jj) * 512 + col];
            } else {
#pragma unroll
                for (int jj = 0; jj < 8; ++jj) f[jj] = gup[(size_t)(16 * s + 8 * hi + jj) * 512 + col];
            }
            *(LAS v4u*)(L + L_BF + ((wave < 4 ? wave * 4 : 16) + s) * 1024 + lane * 16) = (v4u){pk2(f[0], f[1]), pk2(f[2], f[3]), pk2(f[4], f[5]), pk2(f[6], f[7])}; }
    }
    float w0c = 0.f, a0c = 0.f;
    if (wave < 2) w0c = F.in[IN_W0][hd * 64 + (wave & 1) * 32 + (lane & 31)]; else if (wave < 4) a0c = F.in[IN_A0][hd * 64 + (wave & 1) * 32 + (lane & 31)];
    long raw_off[2];
#pragma unroll
    for (int i = 0; i < 2; ++i) { int q = 64 * (wave + 8 * i) + lane; if (q > 791) q = 791; const int row = q / 24, cc = q % 24; raw_off[i] = (long)(row - 1) * RC + (cc >> 3) * 512 + hd * 64 + (cc & 7) * 8; }
    const size_t mrow0 = (size_t)b * SEQ;
#define SCAN_DMA(c) do { const size_t m0_ = mrow0 + (size_t)(c) * TC; \
        _Pragma("unroll") for (int i_ = 0; i_ < 2; ++i_) { const int p_ = wave + 8 * i_; if (p_ < 13) { long o_ = raw_off[i_]; if ((c) == 0 && o_ < 0) o_ += RC; \
            attn_body::glds16(PR + m0_ * RC + o_, (unsigned)__builtin_amdgcn_readfirstlane(lds0 + L_RAW + p_ * 1024)); } } \
        _Pragma("unroll") for (int i_ = 0; i_ < 2; ++i_) { const int p_ = wave + 8 * i_; \
            attn_body::glds16(AL + (m0_ + 2 * p_) * 256 + lane * 8, (unsigned)__builtin_amdgcn_readfirstlane(lds0 + L_AL + p_ * 1056)); } } while (0)
    float S0 = 0.f, S1 = 0.f, S2 = 0.f, S3 = 0.f;
    const int vloc = 4 * wave + (lane >> 4), ks = lane & 15;
    SCAN_DMA(0);
    for (int c = 0; c < SEQ / TC; ++c) {
        asm volatile("s_waitcnt vmcnt(0)" ::: "memory"); __syncthreads();
        float rs[4], ksv[4], vs[4], rn;
        {
            const bool first = (c == 0 && et == 0);
            const LAS unsigned char* rowc = L + L_RAW + (et + 1) * 384; const LAS unsigned char* rowp = L + L_RAW + et * 384;
            const v2u rc = *(const LAS v2u*)(rowc + cg * 8), rp = *(const LAS v2u*)(rowp + cg * 8);
            const v2u kc = *(const LAS v2u*)(rowc + 128 + cg * 8), kp = *(const LAS v2u*)(rowp + 128 + cg * 8);
            const int vo = 256 + (half * 32 + 4 * (cg & 7)) * 2;
            const v2u vc = *(const LAS v2u*)(rowc + vo), vp = *(const LAS v2u*)(rowp + vo);
#define SH4(dst, cu, pr, mu) do { const float c0 = __uint_as_float(cu.x << 16), c1 = __uint_as_float(cu.x & 0xffff0000u), c2 = __uint_as_float(cu.y << 16), c3 = __uint_as_float(cu.y & 0xffff0000u); \
            const float p0 = first ? 0.f : __uint_as_float(pr.x << 16), p1 = first ? 0.f : __uint_as_float(pr.x & 0xffff0000u), p2 = first ? 0.f : __uint_as_float(pr.y << 16), p3 = first ? 0.f : __uint_as_float(pr.y & 0xffff0000u); \
            dst[0] = c0 + (p0 - c0) * mu[0]; dst[1] = c1 + (p1 - c1) * mu[1]; dst[2] = c2 + (p2 - c2) * mu[2]; dst[3] = c3 + (p3 - c3) * mu[3]; } while (0)
            SH4(rs, rc, rp, mu_r); SH4(ksv, kc, kp, mu_k); SH4(vs, vc, vp, mu_v);
#undef SH4
            float q = 0.f;
#pragma unroll
            for (int i = 0; i < 4; ++i) { const float u = ksv[i] * kkc[i]; q += u * u; }
            q = allsum16(q); rn = 1.0f / fmaxf(sqrtf(q), 1e-12f);
            LAS unsigned char* rec = L + L_REC + et * RECB;
            *(LAS h16x4*)(rec + cg * 48) = (h16x4){(_Float16)rs[0], (_Float16)rs[1], (_Float16)rs[2], (_Float16)rs[3]};
            if (cg < 8) *(LAS f32x4*)(rec + 768 + cg * 16) = (f32x4){vs[0], vs[1], vs[2], vs[3]};
        }
        if (wave < 5) {
            const int r32 = lane & 31, hi = lane >> 5;
            const LAS unsigned char* arow = L + L_AL + (r32 >> 1) * 1056 + (r32 & 1) * 512 + hi * 16;
            const int colb = (wave < 2) ? 0 : (wave < 4) ? 128 : 256;
            const LAS unsigned char* bfr = L + L_BF + (wave < 4 ? wave * 4 : 16) * 1024 + lane * 16;
            f32x16 acc = f32x16{};
            if (wave < 4) {
#pragma unroll
                for (int s = 0; s < 4; ++s) acc = __builtin_amdgcn_mfma_f32_32x32x16_bf16(*(const LAS bf16x8*)(arow + colb + 32 * s), *(const LAS bf16x8*)(bfr + s * 1024), acc, 0, 0, 0);
            } else {
#pragma unroll
                for (int s = 0; s < 8; ++s) acc = __builtin_amdgcn_mfma_f32_32x32x16_bf16(*(const LAS bf16x8*)(arow + colb + 32 * s), *(const LAS bf16x8*)(bfr + s * 1024), acc, 0, 0, 0);
            }
            const int ch = (wave & 1) * 32 + r32;
#pragma unroll
            for (int r = 0; r < 16; ++r) { const int t = (r & 3) + 8 * (r >> 2) + 4 * hi;
                if (wave < 2) { const float val = acc[r] + w0c, z = -val; const float sp = fmaxf(z, 0.f) + __logf(1.0f + __expf(-fabsf(z)));
                    const float dec = __expf(-__expf(-sp - 0.5f)); *(LAS float*)(L + L_REC + t * RECB + (ch >> 2) * 48 + 32 + (ch & 3) * 4) = dec; }
                else if (wave < 4) { *(LAS float*)(L + L_AV + (t * 64 + ch) * 4) = sigmoidf_(acc[r] + a0c); }
                else { *(LAS float*)(L + L_GV + (t * 32 + r32) * 4) = acc[r]; } }
        }
        __syncthreads();
        {
            const f32x4 a4 = *(const LAS f32x4*)(L + L_AV + (et * 64 + 4 * cg) * 4);
            float kp[4], nk[4], bb[4], rk = 0.f;
#pragma unroll
            for (int i = 0; i < 4; ++i) { const float kn = ksv[i] * kkc[i] * rn; nk[i] = -kn; bb[i] = kn * a4[i]; kp[i] = ksv[i] * (1.0f + (a4[i] - 1.0f) * kac[i]); rk += rs[i] * kp[i] * rkc[i]; }
            rk = allsum16(rk);
            LAS unsigned char* rec = L + L_REC + et * RECB + cg * 48;
            *(LAS h16x4*)(rec + 8) = (h16x4){(_Float16)nk[0], (_Float16)nk[1], (_Float16)nk[2], (_Float16)nk[3]};
            *(LAS h16x4*)(rec + 16) = (h16x4){(_Float16)bb[0], (_Float16)bb[1], (_Float16)bb[2], (_Float16)bb[3]};
            *(LAS h16x4*)(rec + 24) = (h16x4){(_Float16)kp[0], (_Float16)kp[1], (_Float16)kp[2], (_Float16)kp[3]};
            if (cg < 8) {
                const f32x4 g4 = *(const LAS f32x4*)(L + L_GV + (et * 32 + 4 * cg) * 4);
                float zz[4], gg[4];
#pragma unroll
                for (int i = 0; i < 4; ++i) { zz[i] = (lnb[i] + rk * vs[i]) * g4[i]; gg[i] = g4[i] * lng[i]; }
                const size_t o = (mrow0 + (size_t)c * TC + et) * 512 + vch;
                *(GAS v2u*)(Z + o) = (v2u){pk2(zz[0], zz[1]), pk2(zz[2], zz[3])};
                *(GAS v2u*)(GG + o) = (v2u){pk2(gg[0], gg[1]), pk2(gg[2], gg[3])};
            }
        }
        __syncthreads();
        if (c + 1 < SEQ / TC) SCAN_DMA(c + 1);
        {
            const LAS unsigned char* rec = L + L_REC + ks * 48; const LAS unsigned char* vrow = L + L_REC + 768 + vloc * 4;
            const unsigned ydump = L_YB + 4096 + lane * 4;
            v4u ra, rb; f32x4 rw; float rv;
#define LOADREC(st_) do { ra = *(const LAS v4u*)(rec + (st_) * RECB); rb = *(const LAS v4u*)(rec + (st_) * RECB + 16); rw = *(const LAS f32x4*)(rec + (st_) * RECB + 32); rv = *(const LAS float*)(vrow + (st_) * RECB); } while (0)
            LOADREC(0);
            float y4 = 0.f;
#pragma unroll
            for (int st = 0; st < TC; ++st) {
                const v4u ca = ra, cb = rb; const f32x4 cw = rw; const float vv = rv;
                if (st + 1 < TC) LOADREC(st + 1);
                float p1 = fmix_lo0(S0, ca[2]); p1 = fmix_hi(S1, ca[2], p1); p1 = fmix_lo(S2, ca[3], p1); p1 = fmix_hi_nop(S3, ca[3], p1);
                const float sa = allsum16(p1);
                { float t0 = fmix_lo0(vv, cb[2]), t1 = fmix_hi0(vv, cb[2]), t2 = fmix_lo0(vv, cb[3]), t3 = fmix_hi0(vv, cb[3]);
                  t0 = fmix_lo(sa, cb[0], t0); t1 = fmix_hi(sa, cb[0], t1); t2 = fmix_lo(sa, cb[1], t2); t3 = fmix_hi(sa, cb[1], t3);
                  S0 = fmaf(S0, cw[0], t0); S1 = fmaf(S1, cw[1], t1); S2 = fmaf(S2, cw[2], t2); S3 = fmaf(S3, cw[3], t3); }
                float p2 = fmix_lo0(S0, ca[0]); p2 = fmix_hi(S1, ca[0], p2); p2 = fmix_lo(S2, ca[1], p2); p2 = fmix_hi_nop(S3, ca[1], p2);
                const float yv = allsum16(p2);
                y4 = (ks == (st & 3)) ? yv : y4;
                if ((st & 3) == 3) { const unsigned ya = (ks < 4) ? (unsigned)(L_YB + (((st & ~3) + ks) * 32 + vloc) * 4) : ydump; *(LAS float*)(L + ya) = y4; }
            }
#undef LOADREC
        }
        __syncthreads();
        { const int st = tid >> 4, v2 = (tid & 15) * 2; const f32x2 y2 = *(const LAS f32x2*)(L + L_YB + (st * 32 + v2) * 4);
          *(GAS f32x2*)(Y + (mrow0 + (size_t)c * TC + st) * 512 + hd * 64 + half * 32 + v2) = y2; }
    }
    asm volatile("s_waitcnt vmcnt(0)" ::: "memory"); __syncthreads();
#undef SCAN_DMA
}
}
static_assert(scan::L_END <= LDSCTL_OFF, "scan LDS");

__device__ __forceinline__ void r2_post(Frame& F) {
    const float* Y = (const float*)((unsigned char*)F.out + OUT_Y); const bf16* GG = (const bf16*)((unsigned char*)F.out + OUT_GG); const bf16* Z = (const bf16*)((unsigned char*)F.out + OUT_Z);
    bf16* MIX = (bf16*)(F.ws + WS_MIX);
    const int gw = F.vcu * NWAVES + F.wave, NGW = F.G * NWAVES;
    for (int m = gw; m < NTOK; m += NGW) {
        const size_t o = (size_t)m * 512 + 8 * F.lane;
        const f32x4 y0 = *(const GAS f32x4*)(Y + o), y1 = *(const GAS f32x4*)(Y + o + 4); const v4u g = *(const GAS v4u*)(GG + o), z = *(const GAS v4u*)(Z + o);
        float s = (y0[0] + y0[1]) + (y0[2] + y0[3]) + (y1[0] + y1[1]) + (y1[2] + y1[3]);
        s += __shfl_xor(s, 1); s += __shfl_xor(s, 2); s += __shfl_xor(s, 4);
        const float mean = s * (1.f / 64.f);
        float yv[8] = {y0[0] - mean, y0[1] - mean, y0[2] - mean, y0[3] - mean, y1[0] - mean, y1[1] - mean, y1[2] - mean, y1[3] - mean};
        float q = 0.f;
#pragma unroll
        for (int i = 0; i < 8; ++i) q += yv[i] * yv[i];
        q += __shfl_xor(q, 1); q += __shfl_xor(q, 2); q += __shfl_xor(q, 4);
        const float rstd = 1.0f / sqrtf(q * (1.f / 64.f) + 64e-5f);
        float ov[8];
#pragma unroll
        for (int i = 0; i < 4; ++i) { ov[2 * i] = yv[2 * i] * rstd * __uint_as_float(g[i] << 16) + __uint_as_float(z[i] << 16); ov[2 * i + 1] = yv[2 * i + 1] * rstd * __uint_as_float(g[i] & 0xffff0000u) + __uint_as_float(z[i] & 0xffff0000u); }
        *(GAS v4u*)(MIX + (size_t)m * 1024 + 8 * F.lane) = (v4u){pk2(ov[0], ov[1]), pk2(ov[2], ov[3]), pk2(ov[4], ov[5]), pk2(ov[6], ov[7])};
    }
}

constexpr size_t WS_XS = 264 * MiB, WS_HID = 536 * MiB, WS_YB = 672 * MiB;
constexpr int SLOT_CAP = 65536;
constexpr int L_TB = 131072;
__device__ __forceinline__ float wave_allsum(float x) {
    x += scan::ror16<1>(x); x += scan::ror16<2>(x); x += scan::ror16<4>(x); x += scan::ror16<8>(x);
    x += __shfl_xor(x, 16); x += __shfl_xor(x, 32); return x;
}
__device__ __forceinline__ void moe_tile_table(Frame& F) {
    LAS int* cnt = (LAS int*)(F.lds + L_TB); LAS int* tb = cnt + 32;
    if (F.tid < 32) cnt[F.tid] = (int)__hip_atomic_load(F.ctl + CW_CNT + 64 * F.tid, RLX_AGENT);
    __syncthreads();
    if (F.tid == 0) { int s = 0; for (int e = 0; e < 32; ++e) { tb[e] = s; s += (cnt[e] + 255) >> 8; } tb[32] = s; }
    __syncthreads();
}
__device__ __forceinline__ void m0_route(Frame& F) {
    LAS f32x4* Wg4 = (LAS f32x4*)(F.lds);
    LAS f32x4* Wr4 = (LAS f32x4*)(F.lds + 16384);
    LAS int* tokE = (LAS int*)(F.lds + 147456);
    LAS float* tokW = (LAS float*)(F.lds + 147456 + 2048);
    LAS int* hist = (LAS int*)(F.lds + 147456 + 4096);
    const float* wgrp = F.in[IN_WGRP]; const float* wrt = F.in[IN_WRT];
    for (int idx = F.tid; idx < 1024 * 4; idx += 512) { const int c = idx >> 2, j = idx & 3; const int l = (c & 255) >> 2, jj = (c >> 8) * 4 + (c & 3); ((LAS float*)Wg4)[(jj * 64 + l) * 4 + j] = wgrp[idx]; }
    for (int idx = F.tid; idx < 1024 * 32; idx += 512) { const int c = idx >> 5, e = idx & 31; const int l = (c & 255) >> 2, jj = (c >> 8) * 4 + (c & 3); ((LAS float*)Wr4)[(((e >> 2) * 16 + jj) * 64 + l) * 4 + (e & 3)] = wrt[idx]; }
    const float* g2 = F.in[IN_N2G]; const float* mod = (const float*)(F.ws + WS_MOD); const float* bgrp = F.in[IN_BGRP]; const float* brt = F.in[IN_BRT];
    bf16* H2 = (bf16*)(F.ws + WS_H); int* slot_tok = (int*)(F.ws + WS_SLOT_TOK); float* slot_w = (float*)(F.ws + WS_SLOT_W); unsigned* tokinfo = (unsigned*)(F.ws + WS_TOKINFO);
    const float bg0 = bgrp[0], bg1 = bgrp[1], bg2 = bgrp[2], bg3 = bgrp[3];
    for (int rb = F.vcu; rb < NTOK / 256; rb += F.G) {
        if (F.tid < 32) hist[F.tid] = 0;
        __syncthreads();
        const int b = (rb * 256) / SEQ;
        f32x4 A[4], Bc[4];
#pragma unroll
        for (int j = 0; j < 4; ++j) { const int c = 4 * F.lane + 256 * j; const f32x4 g = *(const f32x4*)(g2 + c), sc = *(const f32x4*)(mod + (size_t)b * NMOD + 4096 + c); A[j] = g * (sc + 1.0f); Bc[j] = *(const f32x4*)(mod + (size_t)b * NMOD + 3072 + c); }
        for (int r = F.wave; r < 256; r += NWAVES) {
            const size_t m = (size_t)rb * 256 + r;
            const GAS f32x4* xr = (const GAS f32x4*)(F.out + m * 1024) + F.lane;
            f32x4 v[4]; float ss = 0.f;
#pragma unroll
            for (int j = 0; j < 4; ++j) { v[j] = xr[64 * j]; ss += (v[j].x * v[j].x + v[j].y * v[j].y) + (v[j].z * v[j].z + v[j].w * v[j].w); }
            const float rstd = 1.0f / sqrtf(wave_sum(ss) * (1.f / 1024.f) + 1e-6f);
            GAS unsigned long long* o8 = (GAS unsigned long long*)(H2 + m * 1024) + F.lane;
            f32x4 ga = (f32x4){0.f, 0.f, 0.f, 0.f};
#pragma unroll
            for (int j = 0; j < 4; ++j) { v[j] = v[j] * rstd * A[j] + Bc[j];
                o8[64 * j] = (unsigned long long)pk2(v[j].x, v[j].y) | ((unsigned long long)pk2(v[j].z, v[j].w) << 32);
#pragma unroll
                for (int i = 0; i < 4; ++i) ga += Wg4[(j * 4 + i) * 64 + F.lane] * v[j][i]; }
            const float l0 = wave_allsum(ga[0]) + bg0, l1 = wave_allsum(ga[1]) + bg1, l2 = wave_allsum(ga[2]) + bg2, l3 = wave_allsum(ga[3]) + bg3;
            int gs = 0; float lm = l0; if (l1 > lm) { lm = l1; gs = 1; } if (l2 > lm) { lm = l2; gs = 2; } if (l3 > lm) { lm = l3; gs = 3; }
            const float pg = 1.0f / (__expf(l0 - lm) + __expf(l1 - lm) + __expf(l2 - lm) + __expf(l3 - lm));
            gs = __builtin_amdgcn_readfirstlane(gs);
            f32x4 e0 = (f32x4){0.f, 0.f, 0.f, 0.f}, e1 = e0;
            const LAS f32x4* w0p = Wr4 + (gs * 2) * 1024 + F.lane; const LAS f32x4* w1p = w0p + 1024;
#pragma unroll
            for (int j = 0; j < 4; ++j)
#pragma unroll
                for (int i = 0; i < 4; ++i) { e0 += w0p[(j * 4 + i) * 64] * v[j][i]; e1 += w1p[(j * 4 + i) * 64] * v[j][i]; }
            float el[8];
#pragma unroll
            for (int q = 0; q < 4; ++q) { el[q] = wave_allsum(e0[q]) + brt[gs * 8 + q]; el[4 + q] = wave_allsum(e1[q]) + brt[gs * 8 + 4 + q]; }
            int i1 = 0; float m1 = el[0];
#pragma unroll
            for (int q = 1; q < 8; ++q) if (el[q] > m1) { m1 = el[q]; i1 = q; }
            int i2 = -1; float m2 = -3.0e38f;
#pragma unroll
            for (int q = 0; q < 8; ++q) if (q != i1 && el[q] > m2) { m2 = el[q]; i2 = q; }
            const float t = __expf(m2 - m1), w1 = pg / (1.0f + t), w2 = pg * t / (1.0f + t);
            if (F.lane == 0) { tokE[2 * r] = gs * 8 + i1; tokE[2 * r + 1] = gs * 8 + i2; tokW[2 * r] = w1; tokW[2 * r + 1] = w2; }
        }
        __syncthreads();
        const int ar = F.tid >> 1, ak = F.tid & 1, ae = tokE[2 * ar + ak];
        const int lpos = __hip_atomic_fetch_add(hist + ae, 1, __ATOMIC_RELAXED, __HIP_MEMORY_SCOPE_WORKGROUP);
        __syncthreads();
        if (F.tid < 32) { const int n = hist[F.tid]; hist[32 + F.tid] = n ? (int)__hip_atomic_fetch_add(F.ctl + CW_CNT + 64 * F.tid, (unsigned)n, RLX_AGENT) : 0; }
        __syncthreads();
        { const int pos = hist[32 + ae] + lpos; const int tok = rb * 256 + ar;
          slot_tok[(size_t)ae * SLOT_CAP + pos] = tok; slot_w[(size_t)ae * SLOT_CAP + pos] = tokW[2 * ar + ak]; tokinfo[2 * tok + ak] = ((unsigned)ae << 20) | (unsigned)pos; }
        __syncthreads();
    }
}
__device__ __forceinline__ void m1_permute(Frame& F) {
    moe_tile_table(F);
    const LAS int* cnt = (const LAS int*)(F.lds + L_TB); const LAS int* tb = cnt + 32;
    const bf16* H2 = (const bf16*)(F.ws + WS_H); bf16* XS = (bf16*)(F.ws + WS_XS); const int* slot_tok = (const int*)(F.ws + WS_SLOT_TOK);
    const int nrows = tb[32] * 256, gw = F.vcu * NWAVES + F.wave, NGW = F.G * NWAVES;
    for (int R = gw; R < nrows; R += NGW) {
        const int rt = R >> 8; int e = 0;
        for (int q = 1; q < 32; ++q) if (tb[q] <= rt) e = q;
        const int slot = (rt - tb[e]) * 256 + (R & 255);
        v4u a = (v4u){0u, 0u, 0u, 0u}, c = a;
        if (slot < cnt[e]) { const int tok = slot_tok[(size_t)e * SLOT_CAP + slot]; const GAS v4u* src = (const GAS v4u*)(H2 + (size_t)tok * 1024) + F.lane; a = src[0]; c = src[64]; }
        GAS v4u* dst = (GAS v4u*)(XS + (size_t)R * 1024) + F.lane; dst[0] = a; dst[64] = c;
    }
}
struct MoeOrder {
    const LAS int* tb; int G, c, nwg;
    __device__ __forceinline__ bool next(int i, pg8::Unit& u) const {
        const int Lq = i * G + c; if (Lq >= nwg) return false;
        const int rt = Lq >> 2; int e = 0;
        for (int q = 1; q < 32; ++q) if (tb[q] <= rt) e = q;
        u.pm = rt; u.pn = 4 * e + (Lq & 3); u.e = e; u.j = rt - tb[e]; return true;
    }
    __device__ __forceinline__ void a_ready(const pg8::Unit&) const {}
    __device__ __forceinline__ void done(const pg8::Unit&) const {}
};
namespace pg8 {
struct EpiSwiGLU {
    static constexpr bool PERM = true, AFTER_DRAIN = false;
    bf16_t* HID;
    __device__ __forceinline__ void operator()(const f32x4 (&acc)[2][2][4][2], const Unit& u, int wr, int wc, int fr, int fq) const {
        const int row0 = u.pm * BM + wr * 64 + fr, col0 = (u.pn & 3) * 128 + wc * 32 + 8 * fq;
#pragma unroll
        for (int ai = 0; ai < 2; ++ai)
#pragma unroll
            for (int m = 0; m < 4; ++m) { f32x4 h[2];
#pragma unroll
                for (int n = 0; n < 2; ++n) { const f32x4 g = acc[ai][0][m][n], up = acc[ai][1][m][n];
#pragma unroll
                    for (int i = 0; i < 4; ++i) h[n][i] = g[i] / (1.0f + __expf(-g[i])) * up[i]; }
                u32x4 w; w.x = cvt_pk_bf16(h[0][0], h[0][1]); w.y = cvt_pk_bf16(h[0][2], h[0][3]); w.z = cvt_pk_bf16(h[1][0], h[1][1]); w.w = cvt_pk_bf16(h[1][2], h[1][3]);
                *(u32x4*)(HID + (size_t)(row0 + ai * HALF + m * 16) * 512 + col0) = w; }
    }
};
struct EpiDown {
    static constexpr bool PERM = true, AFTER_DRAIN = false;
    bf16_t* YB; const float* slot_w; const PG8_LAS int* cnt;
    __device__ __forceinline__ void operator()(const f32x4 (&acc)[2][2][4][2], const Unit& u, int wr, int wc, int fr, int fq) const {
        const int rloc0 = wr * 64 + fr, col0 = (u.pn & 3) * BM + wc * 32 + 8 * fq; const int n_e = cnt[u.e];
#pragma unroll
        for (int ai = 0; ai < 2; ++ai)
#pragma unroll
            for (int m = 0; m < 4; ++m) { const int rloc = rloc0 + ai * HALF + m * 16, slot = u.j * BM + rloc; const float sc = slot < n_e ? slot_w[(size_t)u.e * 65536 + slot] : 0.f;
                bf16_t* rowp = YB + (size_t)(u.pm * BM + rloc) * 1024 + col0;
#pragma unroll
                for (int bj = 0; bj < 2; ++bj) { const f32x4 v0 = acc[ai][bj][m][0] * sc, v1 = acc[ai][bj][m][1] * sc;
                    u32x4 w; w.x = cvt_pk_bf16(v0[0], v0[1]); w.y = cvt_pk_bf16(v0[2], v0[3]); w.z = cvt_pk_bf16(v1[0], v1[1]); w.w = cvt_pk_bf16(v1[2], v1[3]);
                    *(u32x4*)(rowp + bj * HALF) = w; } }
    }
};
}
__device__ __forceinline__ void p_final(Frame& F) {
    moe_tile_table(F);
    const LAS int* tb = (const LAS int*)(F.lds + L_TB) + 32;
    const float* gf = F.in[IN_NFG]; const float* mod = (const float*)(F.ws + WS_MOD); const bf16* YB = (const bf16*)(F.ws + WS_YB); const unsigned* tokinfo = (const unsigned*)(F.ws + WS_TOKINFO);
    f32x4 G4[4];
#pragma unroll
    for (int j = 0; j < 4; ++j) G4[j] = *(const f32x4*)(gf + 4 * F.lane + 256 * j);
    const int gw = F.vcu * NWAVES + F.wave, NGW = F.G * NWAVES;
    for (int m = gw; m < NTOK; m += NGW) {
        const int b = m / SEQ;
        const unsigned i0 = tokinfo[2 * m], i1 = tokinfo[2 * m + 1];
        const size_t r0 = (size_t)tb[i0 >> 20] * 256 + (i0 & 0xfffffu), r1 = (size_t)tb[i1 >> 20] * 256 + (i1 & 0xfffffu);
        GAS f32x4* xr = (GAS f32x4*)(F.out + (size_t)m * 1024) + F.lane;
        const GAS v2u* y0 = (const GAS v2u*)(YB + r0 * 1024) + F.lane; const GAS v2u* y1 = (const GAS v2u*)(YB + r1 * 1024) + F.lane;
        f32x4 v[4]; float ss = 0.f;
#pragma unroll
        for (int j = 0; j < 4; ++j) { const f32x4 gt = *(const f32x4*)(mod + (size_t)b * NMOD + 5120 + 4 * F.lane + 256 * j); const v2u a = y0[64 * j], c = y1[64 * j];
            f32x4 ff; ff[0] = __uint_as_float(a[0] << 16) + __uint_as_float(c[0] << 16); ff[1] = __uint_as_float(a[0] & 0xffff0000u) + __uint_as_float(c[0] & 0xffff0000u);
            ff[2] = __uint_as_float(a[1] << 16) + __uint_as_float(c[1] << 16); ff[3] = __uint_as_float(a[1] & 0xffff0000u) + __uint_as_float(c[1] & 0xffff0000u);
            v[j] = xr[64 * j] + gt * ff; ss += (v[j].x * v[j].x + v[j].y * v[j].y) + (v[j].z * v[j].z + v[j].w * v[j].w); }
        const float rstd = 1.0f / sqrtf(wave_sum(ss) * (1.f / 1024.f) + 1e-6f);
#pragma unroll
        for (int j = 0; j < 4; ++j) xr[64 * j] = v[j] * rstd * G4[j];
    }
}
#ifndef MK_ONE_LAUNCH
#define MK_ONE_LAUNCH 1
#endif
constexpr int N_PHASES = 12;
struct Args { const float* in[28]; float* out; unsigned char* ws; int ph_lo, ph_hi; };
__global__ void __launch_bounds__(NWAVES * 64, 2) mk_fwd(Args args) {
    extern __shared__ __attribute__((aligned(16))) unsigned char lds[];
    Frame F;
    F.lds = (LAS unsigned char*)lds;
    F.MISC = (volatile LAS unsigned*)(F.lds + MISC_OFF);
    F.tid = threadIdx.x; F.lane = F.tid & 63; F.wave = __builtin_amdgcn_readfirstlane(F.tid >> 6);
    F.G = gridDim.x; { const int bx = blockIdx.x; F.vcu = (F.G % 8 == 0) ? (bx % 8) * (F.G / 8) + bx / 8 : bx; }
    F.ws = args.ws; F.out = args.out; F.ctl = (gu32*)(args.ws + WS_CTL);
#pragma unroll
    for (int i = 0; i < 28; ++i) F.in[i] = args.in[i];
    for (int u = F.tid; u < (LDS_BYTES - LDSCTL_OFF) / 4; u += NWAVES * 64) ((LAS unsigned*)(F.lds + LDSCTL_OFF))[u] = 0u;
    __syncthreads();
    const int lo = args.ph_lo, hi = args.ph_hi;
    const bool multi = (hi - lo) > 1;
    XcdBarrier bar; bar.bar = (unsigned*)(F.ctl + CW_BAR); bar.x = 0; bar.st = nullptr;
    if (multi) bar = xcd_barrier_post((unsigned*)(F.ctl + CW_BAR), F.MISC + 8);
#define IN(k) (lo <= (k) && (k) < hi)
#define BOTH(k) (IN(k) && IN((k) + 1))
#define GRID_BAR() xcd_barrier(bar)

    if (IN(0)) { p0_prologue(F); if (BOTH(0)) GRID_BAR(); }
    if (IN(1)) { p1_norm(F); if (BOTH(1)) GRID_BAR(); }
    if (IN(2)) {
        pg8::Gemm g{(const pg8::bf16_t*)(F.ws + WS_H), (const pg8::bf16_t*)(F.ws + WS_WIN), NTOK, NPROJ, DMODEL}; pg8::StaticOrder S; S.init(NTOK, NPROJ, F.G, (int)blockIdx.x);
        pg8::EpiProj E{(pg8::bf16_t*)(F.ws + WS_PR), (pg8::bf16_t*)(F.ws + WS_PF), attn_body::C2};
        pg8::gemm_phase<pg8::EpiProj, pg8::StaticOrder, PG8_ALIGN, PG8_SP2>(F.lds + RING_OFF, g, S, E);
        if (BOTH(2)) GRID_BAR();
    }
    if (IN(3)) {
        r0_lora_inputs(F);
        if (F.G == 256) {
            const int bh = F.vcu >> 1, b = bh >> 3, h = bh & 7;
            attn_body::fill_kx((char*)lds, (const float*)(F.ws + WS_FG), F.in[IN_FB][h], b, h);
            const attn_body::bf16* PF = (const attn_body::bf16*)(F.ws + WS_PF);
            const attn_body::AttnTensors AT{PF, PF + 512, PF + 1024, (attn_body::bf16*)(F.ws + WS_MIX) + 512};
            const attn_body::StaticOrder S((int)F.G, (int)blockIdx.x);
            attn_body::attn_phase<attn_body::StaticOrder>((char*)lds + RING_OFF, AT, S);
        }
        if (BOTH(3)) GRID_BAR();
    }
    if (IN(4)) { if (F.G == 256) scan::phase(F); if (BOTH(4)) GRID_BAR(); }
    if (IN(5)) { r2_post(F); if (BOTH(5)) GRID_BAR(); }
    if (IN(6)) {
        pg8::Gemm g{(const pg8::bf16_t*)(F.ws + WS_MIX), (const pg8::bf16_t*)(F.ws + WS_WOUT), NTOK, DMODEL, DMODEL}; pg8::StaticOrder S; S.init(NTOK, DMODEL, F.G, (int)blockIdx.x);
        pg8::EpiRes E{F.in[IN_X], F.out, (const float*)(F.ws + WS_MOD) + 2048, SEQ};
        pg8::gemm_phase<pg8::EpiRes, pg8::StaticOrder, PG8_ALIGN, PG8_SP2>(F.lds + RING_OFF, g, S, E);
        if (BOTH(6)) GRID_BAR();
    }
    if (IN(7)) { m0_route(F); if (BOTH(7)) GRID_BAR(); }
    if (IN(8)) { m1_permute(F); if (BOTH(8)) GRID_BAR(); }
    if (IN(9)) {
        moe_tile_table(F);
        const LAS int* tb = (const LAS int*)(F.lds + L_TB) + 32;
        pg8::Gemm g{(const pg8::bf16_t*)(F.ws + WS_XS), (const pg8::bf16_t*)(F.ws + WS_W1), 0, 0, DMODEL}; MoeOrder S{tb, F.G, F.vcu, tb[32] * 4};
        pg8::EpiSwiGLU E{(pg8::bf16_t*)(F.ws + WS_HID)};
        pg8::gemm_phase<pg8::EpiSwiGLU, MoeOrder, PG8_ALIGN, PG8_SP2>(F.lds + RING_OFF, g, S, E);
        if (BOTH(9)) GRID_BAR();
    }
    if (IN(10)) {
        moe_tile_table(F);
        const LAS int* tb = (const LAS int*)(F.lds + L_TB) + 32;
        pg8::Gemm g{(const pg8::bf16_t*)(F.ws + WS_HID), (const pg8::bf16_t*)(F.ws + WS_W2), 0, 0, DEXP}; MoeOrder S{tb, F.G, F.vcu, tb[32] * 4};
        pg8::EpiDown E{(pg8::bf16_t*)(F.ws + WS_YB), (const float*)(F.ws + WS_SLOT_W), (const LAS int*)(F.lds + L_TB)};
        pg8::gemm_phase<pg8::EpiDown, MoeOrder, PG8_ALIGN, PG8_SP2>(F.lds + RING_OFF, g, S, E);
        if (BOTH(10)) GRID_BAR();
    }
    if (IN(11)) { p_final(F); }
#undef IN
#undef BOTH
}

extern "C" void kernel_launch(void* const* d_in, const int* in_sizes, int n_in, void* d_out, int out_size, void* d_ws, size_t ws_size, hipStream_t stream) {
    static int grid = 0;
    if (grid == 0) {
        if (n_in != 28 || in_sizes[0] != NTOK * DMODEL || out_size != NTOK * DMODEL || ws_size < WS_END) {
            fprintf(stderr, "kernel_launch: unexpected shapes: n_in %d in0 %d out %d ws %zu (need %zu); nothing launched\n", n_in, n_in > 0 ? in_sizes[0] : -1, out_size, ws_size, (size_t)WS_END); grid = -1; return; }
        int dev = 0, cus = 0, per_cu = 0;
        if (hipGetDevice(&dev) != hipSuccess || hipDeviceGetAttribute(&cus, hipDeviceAttributeMultiprocessorCount, dev) != hipSuccess) { grid = -1; return; }
        if (hipFuncSetAttribute((const void*)mk_fwd, hipFuncAttributeMaxDynamicSharedMemorySize, LDS_BYTES) != hipSuccess) { fprintf(stderr, "kernel_launch: hipFuncSetAttribute failed\n"); grid = -1; return; }
        if (hipOccupancyMaxActiveBlocksPerMultiprocessor(&per_cu, (const void*)mk_fwd, NWAVES * 64, LDS_BYTES) != hipSuccess || per_cu < 1) { fprintf(stderr, "kernel_launch: occupancy query says %d blocks per CU\n", per_cu); per_cu = 1; }
        (void)hipGetLastError();
        grid = cus;
        if (grid != 256) fprintf(stderr, "kernel_launch: %d CUs; this kernel is tuned for 256\n", grid);
    }
    if (grid < 0) return;
    if (hipMemsetAsync((char*)d_ws + WS_CTL, 0, CTL_ZERO_BYTES, stream) != hipSuccess) return;
    Args a{};
    for (int i = 0; i < 28; ++i) a.in[i] = (const float*)d_in[i];
    a.out = (float*)d_out; a.ws = (unsigned char*)d_ws;
#if MK_ONE_LAUNCH
    a.ph_lo = 0; a.ph_hi = N_PHASES;
    hipLaunchKernelGGL(mk_fwd, dim3(grid), dim3(NWAVES * 64), LDS_BYTES, stream, a);
#else
    for (int p = 0; p < N_PHASES; ++p) { a.ph_lo = p; a.ph_hi = p + 1; hipLaunchKernelGGL(mk_fwd, dim3(grid), dim3(NWAVES * 64), LDS_BYTES, stream, a); }
#endif
}
```

```cpp
#include <hip/hip_runtime.h>
#include <hip/hip_bf16.h>
#include <hip/hip_fp16.h>
#include <cstdio>
#include <cstdint>
#include <cmath>
namespace pg8 {
#define PG8_LAS __attribute__((address_space(3)))
typedef unsigned short bf16_t;
typedef short bf16x8 __attribute__((ext_vector_type(8)));
typedef float f32x4 __attribute__((ext_vector_type(4)));
typedef unsigned u32x4 __attribute__((ext_vector_type(4)));
constexpr int BM = 256, BK = 64, HALF = 128, HTB = HALF * BK * 2  , STAGE_BYTES = 8 * HTB, NXCD = 8, WGM = 2;

__host__ __device__ __forceinline__ int lds_byte(int r, int c) { const int st = (r >> 4) * 2 + (c >> 5), rr = r & 15, cc = c & 31, ob = rr * 64 + cc * 2; return st * 1024 + (ob ^ (((ob >> 9) & 1) << 5)); }
__host__ __device__ __forceinline__ void stage_rc(int b, int& R, int& C) { const int st = b / 1024, sb = b % 1024, swz = sb ^ (((sb >> 9) & 1) << 5); R = (st >> 1) * 16 + swz / 64; C = (st & 1) * 32 + (swz % 64) / 2; }
__host__ __device__ __forceinline__ int perm32(int rho) { const int n = rho >> 4, i = rho & 15; return 8 * (i >> 2) + 4 * n + (i & 3); }

struct Unit { int pm, pn, e, j; };
struct Gemm { const bf16_t* A; const bf16_t* Bt; int M, N, K; };

#ifndef MK_BWGM
#define MK_BWGM 2
#endif
constexpr int BWGM = MK_BWGM;
struct BatchOrder {
    static constexpr bool GATHER = false;
    __device__ __forceinline__ unsigned a_row(int, int) const { return 0u; }
    int nN, nwb, vcu;
    __host__ __device__ void init(int N, int vcu_) { nN = N / BM; nwb = 16 * nN; vcu = vcu_; }
    __host__ __device__ bool next(int i, Unit& u) const {
        const int w = i * 16 + (vcu & 15); if (w >= nwb) return false;
        const int nig = BWGM * nN, gid = w / nig, r = w % nig;
        u.pm = (vcu >> 4) * 16 + gid * BWGM + r % BWGM; u.pn = r / BWGM; u.e = 0; u.j = 0; return true;
    }
    __device__ __forceinline__ void a_ready(const Unit&) const {}
    __device__ __forceinline__ void done(const Unit&) const {}
};
struct StaticOrder {
    static constexpr bool GATHER = false;
    __device__ __forceinline__ unsigned a_row(int, int) const { return 0u; }
    int nM, nN, nwg, G, c;
    __host__ __device__ void init(int M, int N, int G_, int c_) { nM = M / BM; nN = N / BM; nwg = nM * nN; G = G_; c = c_; }
    __host__ __device__ bool next(int i, Unit& u) const {
        const long L = (long)i * G + c; if (L >= nwg) return false;
        int wgid = (int)L; { const int q = nwg / NXCD, r = nwg % NXCD, xcd = wgid % NXCD, off = wgid / NXCD; wgid = (xcd < r ? xcd * (q + 1) : r * (q + 1) + (xcd - r) * q) + off; }
        const int nig = WGM * nN, gid = wgid / nig, fm = gid * WGM, gsz = (nM - fm) < WGM ? (nM - fm) : WGM;
        u.pm = fm + ((wgid % nig) % gsz); u.pn = (wgid % nig) / gsz; u.e = 0; u.j = 0; return true;
    }
    __device__ __forceinline__ void a_ready(const Unit&) const {}
    __device__ __forceinline__ void done(const Unit&) const {}
};


__device__ __forceinline__ unsigned cvt_pk_bf16(float lo, float hi) { unsigned r; asm volatile("v_cvt_pk_bf16_f32 %0, %1, %2" : "=v"(r) : "v"(lo), "v"(hi)); return r; }

struct EpiProj {
    static constexpr bool PERM = true, AFTER_DRAIN = false;
    bf16_t* PR; bf16_t* PF; float qscale;
    __device__ __forceinline__ void operator()(const f32x4 (&acc)[2][2][4][2], const Unit& u, int wr, int wc, int fr, int fq) const {
        const int row0 = u.pm * BM + wr * 64 + fr;
        bf16_t* base; int ldc, colt; float sc = 1.f;
        if (u.pn < 7) { base = PR; ldc = 1792; colt = u.pn * BM; } else { base = PF; ldc = 1536; colt = (u.pn - 7) * BM; if (u.pn < 9) sc = qscale; }
        const int col0 = colt + wc * 32 + 8 * fq;
#pragma unroll
        for (int ai = 0; ai < 2; ++ai)
#pragma unroll
            for (int m = 0; m < 4; ++m) { bf16_t* rowp = base + (size_t)(row0 + ai * HALF + m * 16) * ldc + col0;
#pragma unroll
                for (int bj = 0; bj < 2; ++bj) { const f32x4 v0 = acc[ai][bj][m][0] * sc, v1 = acc[ai][bj][m][1] * sc;
                    u32x4 w; w.x = cvt_pk_bf16(v0[0], v0[1]); w.y = cvt_pk_bf16(v0[2], v0[3]); w.z = cvt_pk_bf16(v1[0], v1[1]); w.w = cvt_pk_bf16(v1[2], v1[3]);
                    *(u32x4*)(rowp + bj * HALF) = w; } }
    }
};
struct EpiRes {
    static constexpr bool PERM = false, AFTER_DRAIN = false;
    const float* x; float* out; const float* gate; int rows_per_batch;
    __device__ __forceinline__ void operator()(const f32x4 (&acc)[2][2][4][2], const Unit& u, int wr, int wc, int fr, int fq) const {
        const int b = (u.pm * BM) / rows_per_batch; const float* g = gate + (size_t)b * 6144;
        const int col0 = u.pn * BM + wc * 32 + 4 * fq;
#pragma unroll
        for (int bj = 0; bj < 2; ++bj)
#pragma unroll
            for (int n = 0; n < 2; ++n) { const f32x4 gv = *(const f32x4*)(g + col0 + bj * HALF + n * 16);
#pragma unroll
                for (int ai = 0; ai < 2; ++ai)
#pragma unroll
                    for (int m = 0; m < 4; ++m) { const size_t off = (size_t)(u.pm * BM + ai * HALF + wr * 64 + m * 16 + fr) * 1024 + col0 + bj * HALF + n * 16;
                        const f32x4 xv = *(const f32x4*)(x + off); *(f32x4*)(out + off) = xv + gv * acc[ai][bj][m][n]; } }
    }
};

struct EpiResB {
    static constexpr bool PERM = true, AFTER_DRAIN = false;
    const float* x; bf16_t* out; const float* gate; int rows_per_batch; size_t out_xtra;
    __device__ __forceinline__ void operator()(const f32x4 (&acc)[2][2][4][2], const Unit& u, int wr, int wc, int fr, int fq) const {
        const int b = (u.pm * BM) / rows_per_batch; const float* g = gate + (size_t)b * 6144; bf16_t* outb = out + (size_t)b * out_xtra;
        const int col0 = u.pn * BM + wc * 32 + 8 * fq;
#pragma unroll
        for (int bj = 0; bj < 2; ++bj) { const f32x4 g0 = *(const f32x4*)(g + col0 + bj * HALF), g1 = *(const f32x4*)(g + col0 + bj * HALF + 4);
#pragma unroll
            for (int ai = 0; ai < 2; ++ai)
#pragma unroll
                for (int m = 0; m < 4; ++m) { const size_t off = (size_t)(u.pm * BM + ai * HALF + wr * 64 + m * 16 + fr) * 1024 + col0 + bj * HALF;
                    const f32x4 v0 = *(const f32x4*)(x + off) + g0 * acc[ai][bj][m][0], v1 = *(const f32x4*)(x + off + 4) + g1 * acc[ai][bj][m][1];
                    u32x4 w; w.x = cvt_pk_bf16(v0[0], v0[1]); w.y = cvt_pk_bf16(v0[2], v0[3]); w.z = cvt_pk_bf16(v1[0], v1[1]); w.w = cvt_pk_bf16(v1[2], v1[3]);
                    *(u32x4*)(outb + off) = w; } }
    }
};
template <class Epi, class Sched, bool ALIGN_EPI = false, bool SP2 = false>
__device__ __forceinline__ void gemm_phase(PG8_LAS unsigned char* lds, const Gemm g, const Sched& S, const Epi& E) {
    const int tid = threadIdx.x, wid = __builtin_amdgcn_readfirstlane(tid >> 6), lane = tid & 63, wr = wid >> 2, wc = wid & 3, fr = lane & 15, fq = lane >> 4;
    const int K = g.K, nt = K / BK;
    unsigned voffA[2], voffB[2];
#pragma unroll
    for (int i = 0; i < 2; ++i) { int R, C; stage_rc(tid * 16 + i * 8192, R, C); const int Rb = Epi::PERM ? ((R & ~31) + perm32(R & 31)) : R;
        voffA[i] = (unsigned)(R * K + C) * 2u; voffB[i] = (unsigned)(Rb * K + C) * 2u; }
    constexpr bool GATHER = Sched::GATHER;
    int gR[2], gC[2];
#pragma unroll
    for (int i = 0; i < 2; ++i) stage_rc(tid * 16 + i * 8192, gR[i], gC[i]);
    unsigned offC[2][2] = {{0u, 0u}, {0u, 0u}}, offN[2][2] = {{0u, 0u}, {0u, 0u}};
#define PG8_GOFF(dst, ui_) do { _Pragma("unroll") for (int h_ = 0; h_ < 2; ++h_) _Pragma("unroll") for (int i_ = 0; i_ < 2; ++i_) dst[h_][i_] = (unsigned)(S.a_row((ui_), 128 * h_ + gR[i_]) * (unsigned)K + (unsigned)gC[i_]) * 2u; } while (0)
#define PG8_STAGE_A(bufoff, ptr, h, nx) do { if constexpr (GATHER) { unsigned o_[2] = {(nx) ? offN[h][0] : offC[h][0], (nx) ? offN[h][1] : offC[h][1]}; PG8_STAGE(bufoff, ptr, o_); } else { PG8_STAGE(bufoff, (ptr) + (h) * hstep, voffA); } } while (0)
    const size_t kstep = (size_t)(BK * 2);
    const size_t hstep = (size_t)HALF * K * 2;
    const size_t tstep = 2 * hstep;
    const unsigned ldsw = (unsigned)wid * 1024u;
    const int aoff = lds_byte(wr * 64 + fr, fq * 8), boff = lds_byte(wc * 32 + fr, fq * 8);
#define PG8_SA(b, h) (((b) * 2 + (h)) * HTB)
#define PG8_SB(b, h) ((4 + (b) * 2 + (h)) * HTB)
#define PG8_STAGE(bufoff, gbase, voff) do { _Pragma("unroll") for (int _i = 0; _i < 2; ++_i) \
        __builtin_amdgcn_global_load_lds((const unsigned*)((const char*)(gbase) + (voff)[_i]), (PG8_LAS unsigned*)(lds + (bufoff) + ldsw + _i * 8192), 16, 0, 0); } while (0)
#define PG8_LDA(dst, b, h) do { _Pragma("unroll") for (int m = 0; m < 4; ++m) _Pragma("unroll") for (int k = 0; k < 2; ++k) dst[m][k] = *(const PG8_LAS bf16x8*)(lds + PG8_SA(b, h) + aoff + m * 2048 + k * 1024); } while (0)
#define PG8_LDB(dst, b, h) do { _Pragma("unroll") for (int n = 0; n < 2; ++n) _Pragma("unroll") for (int k = 0; k < 2; ++k) dst[n][k] = *(const PG8_LAS bf16x8*)(lds + PG8_SB(b, h) + boff + n * 2048 + k * 1024); } while (0)
#define PG8_MMA(ai, bj, At, Bt) do { __builtin_amdgcn_s_setprio(1); _Pragma("unroll") for (int m = 0; m < 4; ++m) _Pragma("unroll") for (int n = 0; n < 2; ++n) _Pragma("unroll") for (int k = 0; k < 2; ++k) \
        acc[ai][bj][m][n] = __builtin_amdgcn_mfma_f32_16x16x32_bf16(Bt[n][k], At[m][k], acc[ai][bj][m][n], 0, 0, 0); __builtin_amdgcn_s_setprio(0); } while (0)
#define PG8_WAIT_V(n) asm volatile("s_waitcnt vmcnt(" #n ")" ::: "memory")
#define PG8_WAIT_L(n) asm volatile("s_waitcnt lgkmcnt(" #n ")" ::: "memory")
#define PG8_BAR __builtin_amdgcn_s_barrier()
#define PG8_SCHED __builtin_amdgcn_sched_barrier(0)
    Unit cur, nxt; int ui = 0;
    if (!S.next(0, cur)) return;
    f32x4 acc[2][2][4][2];
#pragma unroll
    for (int a = 0; a < 2; ++a)
#pragma unroll
        for (int b = 0; b < 2; ++b)
#pragma unroll
            for (int m = 0; m < 4; ++m)
#pragma unroll
                for (int n = 0; n < 2; ++n) acc[a][b][m][n] = (f32x4){0.f, 0.f, 0.f, 0.f};
    bf16x8 At[4][2], B0[2][2], B1[2][2];
    const char* cA = GATHER ? (const char*)g.A : (const char*)g.A + (size_t)cur.pm * tstep; const char* cB = (const char*)g.Bt + (size_t)cur.pn * tstep;
    if constexpr (GATHER) PG8_GOFF(offC, 0);
    S.a_ready(cur);
    if constexpr (SP2) {
        PG8_STAGE(PG8_SB(0, 0), cB, voffB); PG8_STAGE(PG8_SB(0, 1), cB + hstep, voffB); PG8_STAGE_A(PG8_SA(0, 0), cA, 0, false); PG8_STAGE_A(PG8_SA(0, 1), cA, 1, false);
        if (wr == 1) PG8_BAR;
        PG8_WAIT_V(2); PG8_BAR;
        PG8_STAGE(PG8_SB(1, 0), cB + kstep, voffB); PG8_STAGE_A(PG8_SA(1, 0), cA + kstep, 0, false); PG8_STAGE(PG8_SB(1, 1), cB + hstep + kstep, voffB);
        PG8_WAIT_V(6); PG8_BAR;
    } else {
        PG8_STAGE(PG8_SB(0, 0), cB, voffB); PG8_STAGE(PG8_SA(0, 0), cA, voffA); PG8_STAGE(PG8_SB(0, 1), cB + hstep, voffB); PG8_STAGE(PG8_SA(0, 1), cA + hstep, voffA);
        if (wr == 1) PG8_BAR;
        PG8_WAIT_V(4); PG8_BAR;
        PG8_STAGE(PG8_SB(1, 0), cB + kstep, voffB); PG8_STAGE(PG8_SA(1, 0), cA + kstep, voffA); PG8_STAGE(PG8_SB(1, 1), cB + hstep + kstep, voffB);
        PG8_WAIT_V(6); PG8_BAR;
    }
    for (;;) {
        const bool has_next = S.next(ui + 1, nxt);
        const char* nA = GATHER ? cA : (has_next ? (const char*)g.A + (size_t)nxt.pm * tstep : cA); const char* nB = has_next ? (const char*)g.Bt + (size_t)nxt.pn * tstep : cB;
        if constexpr (GATHER) { if (has_next) PG8_GOFF(offN, ui + 1); else { _Pragma("unroll") for (int h_ = 0; h_ < 2; ++h_) _Pragma("unroll") for (int i_ = 0; i_ < 2; ++i_) offN[h_][i_] = offC[h_][i_]; } }
        for (int t = 0; t < nt; t += 2) {
            const bool last = (t == nt - 2);
            const char* a1 = cA + (size_t)(t + 1) * kstep;
            const char* a2 = last ? nA : cA + (size_t)(t + 2) * kstep; const char* b2 = last ? nB : cB + (size_t)(t + 2) * kstep;
            const char* a3 = a2 + kstep; const char* b3 = b2 + kstep;
            if (last && has_next) S.a_ready(nxt);
            if constexpr (SP2) {
            PG8_LDB(B0, 0, 0); PG8_LDB(B1, 0, 1); PG8_SCHED; PG8_LDA(At, 0, 0); PG8_STAGE_A(PG8_SA(1, 1), a1, 1, false);
            PG8_WAIT_V(8); PG8_WAIT_L(0); PG8_BAR; PG8_MMA(0, 0, At, B0); PG8_MMA(0, 1, At, B1); PG8_BAR; PG8_SCHED;
            PG8_LDA(At, 0, 1); PG8_STAGE(PG8_SB(0, 0), b2, voffB); PG8_STAGE(PG8_SB(0, 1), b2 + hstep, voffB); PG8_STAGE_A(PG8_SA(0, 0), a2, 0, last);
            PG8_WAIT_V(8); PG8_WAIT_L(0); PG8_BAR; PG8_MMA(1, 0, At, B0); PG8_MMA(1, 1, At, B1); PG8_BAR; PG8_SCHED;
            PG8_LDB(B0, 1, 0); PG8_LDB(B1, 1, 1); PG8_SCHED; PG8_LDA(At, 1, 0); PG8_STAGE_A(PG8_SA(0, 1), a2, 1, last);
            PG8_WAIT_V(8); PG8_WAIT_L(0); PG8_BAR; PG8_MMA(0, 0, At, B0); PG8_MMA(0, 1, At, B1); PG8_BAR; PG8_SCHED;
            PG8_LDA(At, 1, 1); PG8_STAGE(PG8_SB(1, 0), b3, voffB); PG8_STAGE(PG8_SB(1, 1), b3 + hstep, voffB); PG8_STAGE_A(PG8_SA(1, 0), a3, 0, last);
            PG8_WAIT_V(8); PG8_WAIT_L(0); PG8_BAR; PG8_MMA(1, 0, At, B0); PG8_MMA(1, 1, At, B1); PG8_BAR; PG8_SCHED;
            } else {
            PG8_LDB(B0, 0, 0); PG8_SCHED; PG8_LDA(At, 0, 0); PG8_STAGE(PG8_SA(1, 1), a1 + hstep, voffA);
            PG8_WAIT_L(8); PG8_BAR; PG8_WAIT_L(0); PG8_MMA(0, 0, At, B0); PG8_BAR; PG8_SCHED;
            PG8_LDB(B1, 0, 1); PG8_STAGE(PG8_SB(0, 0), b2, voffB);
            PG8_BAR; PG8_WAIT_L(0); PG8_MMA(0, 1, At, B1); PG8_BAR;
            PG8_LDA(At, 0, 1); PG8_STAGE(PG8_SA(0, 0), a2, voffA);
            PG8_BAR; PG8_WAIT_L(0); PG8_MMA(1, 0, At, B0); PG8_BAR; PG8_SCHED;
            PG8_STAGE(PG8_SB(0, 1), b2 + hstep, voffB);
            PG8_WAIT_V(6); PG8_BAR; PG8_MMA(1, 1, At, B1); PG8_BAR;
            PG8_LDB(B0, 1, 0); PG8_SCHED; PG8_LDA(At, 1, 0); PG8_STAGE(PG8_SA(0, 1), a2 + hstep, voffA);
            PG8_WAIT_L(8); PG8_BAR; PG8_WAIT_L(0); PG8_MMA(0, 0, At, B0); PG8_BAR; PG8_SCHED;
            PG8_LDB(B1, 1, 1); PG8_STAGE(PG8_SB(1, 0), b3, voffB);
            PG8_BAR; PG8_WAIT_L(0); PG8_MMA(0, 1, At, B1); PG8_BAR;
            PG8_LDA(At, 1, 1); PG8_STAGE(PG8_SA(1, 0), a3, voffA);
            PG8_BAR; PG8_WAIT_L(0); PG8_MMA(1, 0, At, B0); PG8_BAR; PG8_SCHED;
            PG8_STAGE(PG8_SB(1, 1), b3 + hstep, voffB);
            PG8_WAIT_V(6); PG8_BAR; PG8_MMA(1, 1, At, B1); PG8_BAR;
            }
        }
        if constexpr (ALIGN_EPI) { if (wr == 0) PG8_BAR; }
#if defined(MK_EPI2)
        if constexpr (!Epi::AFTER_DRAIN) { E(acc, cur, wr, wc, fr, fq); asm volatile("" ::: "memory"); }
#endif
        if constexpr (!Epi::AFTER_DRAIN) { E(acc, cur, wr, wc, fr, fq); S.done(cur); }
        if (!has_next) break;
#pragma unroll
        for (int a = 0; a < 2; ++a)
#pragma unroll
            for (int b = 0; b < 2; ++b)
#pragma unroll
                for (int m = 0; m < 4; ++m)
#pragma unroll
                    for (int n = 0; n < 2; ++n) acc[a][b][m][n] = (f32x4){0.f, 0.f, 0.f, 0.f};
        cur = nxt; cA = nA; cB = nB; ++ui;
        if constexpr (GATHER) { _Pragma("unroll") for (int h_ = 0; h_ < 2; ++h_) _Pragma("unroll") for (int i_ = 0; i_ < 2; ++i_) offC[h_][i_] = offN[h_][i_]; }
        if constexpr (ALIGN_EPI) { if (wr == 1) PG8_BAR; }
    }
    PG8_WAIT_V(0);
    if constexpr (!ALIGN_EPI) { if (wr == 0) PG8_BAR; }
    PG8_BAR;
    if constexpr (Epi::AFTER_DRAIN) { E.fused(acc, cur, wr, wc, fr, fq, lds, wid, lane); S.done(cur); }
#undef PG8_SA
#undef PG8_SB
#undef PG8_STAGE
#undef PG8_STAGE_A
#undef PG8_GOFF
#undef PG8_LDA
#undef PG8_LDB
#undef PG8_MMA
#undef PG8_WAIT_V
#undef PG8_WAIT_L
#undef PG8_BAR
#undef PG8_SCHED
}
}

#ifndef PG8_SP2
#define PG8_SP2 true
#endif
#ifndef PG8_ALIGN
#define PG8_ALIGN true
#endif
namespace attn_body {
using bf16=__hip_bfloat16;
using bf16x8=__attribute__((ext_vector_type(8)))short;
using s16x4=__attribute__((ext_vector_type(4)))short;
using f32x16=__attribute__((ext_vector_type(16)))float;
using u32x4=__attribute__((ext_vector_type(4)))unsigned;
constexpr int BATCH=16,NHEAD=8,SEQ=4096,D=64,DMQ=1536,DMO=1024;
constexpr int NW=8,QBLK=32,QB=QBLK*NW,KVBLK=64,NQB=SEQ/QB;
constexpr int ATTN_UNIT_ROWS=QB;
__device__ __forceinline__ int crow(int r,int hi){return (r&3)+8*(r>>2)+4*hi;}
#define SBAR() __builtin_amdgcn_sched_barrier(0)
__device__ __forceinline__ void cmask(f32x16&p0,f32x16&p1,int jb,int qrel,int hi){
  const float NEG=-INFINITY; asm volatile("":"+v"(hi)); int kb=64*jb+4*hi;
  #pragma unroll
  for(int r=0;r<16;++r){int kv=kb+(r&3)+8*(r>>2); if(kv>qrel)p0[r]=NEG; if(kv+32>qrel)p1[r]=NEG;}
}

constexpr int NSLOT=3, SLOTB=8192;
constexpr int LDS_K=0, LDS_V=NSLOT*SLOTB, LDS_WS=2*NSLOT*SLOTB, LDS_OST=LDS_WS+NW*64*4, LDS_KX=LDS_OST+NW*4096, LDS_CB=LDS_KX+SEQ*16+16, LDS_BYTES=LDS_CB+1024;
constexpr float C2=0.125f*1.4426950408889634f;
__device__ __forceinline__ void glds16(const void*gsrc,unsigned lds_dst){unsigned keep;
  asm volatile("s_mov_b32 %0, m0\n\ts_mov_b32 m0, %2\n\ts_nop 0\n\tglobal_load_lds_dwordx4 %1, off\n\ts_mov_b32 m0, %0":"=&s"(keep):"v"(gsrc),"s"(lds_dst):"memory");}
__device__ __forceinline__ float max3f(float a,float b,float c){float r;asm("v_max3_f32 %0, %1, %2, %3":"=v"(r):"v"(a),"v"(b),"v"(c));return r;}
__device__ __forceinline__ float max2f(float a,float b){float r;asm("v_max_f32_e32 %0, %1, %2":"=v"(r):"v"(a),"v"(b));return r;}
__device__ __forceinline__ float fadd_s(float a,float b){float r;asm("v_add_f32_e32 %0, %1, %2":"=v"(r):"v"(a),"v"(b));return r;}
__device__ __forceinline__ float fsub_s(float a,float b){float r;asm("v_sub_f32_e32 %0, %1, %2":"=v"(r):"v"(a),"v"(b));return r;}
typedef float f32x2_t __attribute__((ext_vector_type(2))); typedef __bf16 bf16x2_t __attribute__((ext_vector_type(2)));
__device__ __forceinline__ unsigned cvtpk_s(float lo,float hi){f32x2_t v={lo,hi};bf16x2_t b=__builtin_convertvector(v,bf16x2_t);return __builtin_bit_cast(unsigned,b);}
#define WAIT_BAR(N) asm volatile("s_waitcnt vmcnt(" #N ") lgkmcnt(0)\n\ts_barrier":::"memory")

__device__ __forceinline__ void qkt(f32x16&p0,f32x16&p1,const char*Kslot,const bf16x8*qr,bf16x8 kx0,bf16x8 kx1,bf16x8 qx,int r32,int hi){
  const char*kb=Kslot+hi*1024+r32*16; const f32x16 z16=f32x16{};
  p0=__builtin_amdgcn_mfma_f32_32x32x16_bf16(kx0,qx,z16,0,0,0);p1=__builtin_amdgcn_mfma_f32_32x32x16_bf16(kx1,qx,z16,0,0,0);
  #pragma unroll
  for(int d0=0;d0<4;++d0){
    const bf16x8 b0=*reinterpret_cast<const bf16x8*>(kb+d0*2048);
    const bf16x8 b1=*reinterpret_cast<const bf16x8*>(kb+d0*2048+512);
    p0=__builtin_amdgcn_mfma_f32_32x32x16_bf16(b0,qr[d0],p0,0,0,0);p1=__builtin_amdgcn_mfma_f32_32x32x16_bf16(b1,qr[d0],p1,0,0,0);}
}
typedef __attribute__((address_space(3))) const char* lds_cptr;
typedef short v4i16_t __attribute__((ext_vector_type(4)));
__device__ __forceinline__ void kload8(bf16x8*kf,lds_cptr kp){
  kf[0]=*(const __attribute__((address_space(3))) bf16x8*)(kp);      kf[1]=*(const __attribute__((address_space(3))) bf16x8*)(kp+512);
  kf[2]=*(const __attribute__((address_space(3))) bf16x8*)(kp+2048); kf[3]=*(const __attribute__((address_space(3))) bf16x8*)(kp+2560);
  kf[4]=*(const __attribute__((address_space(3))) bf16x8*)(kp+4096); kf[5]=*(const __attribute__((address_space(3))) bf16x8*)(kp+4608);
  kf[6]=*(const __attribute__((address_space(3))) bf16x8*)(kp+6144); kf[7]=*(const __attribute__((address_space(3))) bf16x8*)(kp+6656);
}
__device__ __forceinline__ void kload2(bf16x8*kf,lds_cptr kp,int j){ kf[2*j]=*(const __attribute__((address_space(3))) bf16x8*)(kp+j*2048); kf[2*j+1]=*(const __attribute__((address_space(3))) bf16x8*)(kp+j*2048+512); }
__device__ __forceinline__ s16x4 vtr(lds_cptr p){ return __builtin_bit_cast(s16x4,__builtin_amdgcn_ds_read_tr16_b64_v4i16((__attribute__((address_space(3))) v4i16_t*)p)); }
__device__ __forceinline__ float rowmax(const f32x16&p0,const f32x16&p1){
  float a=max3f(p0[0],p0[1],p1[0]),b=max3f(p0[2],p0[3],p1[1]);a=max3f(a,p1[2],p1[3]);
  #pragma unroll
  for(int r=4;r<16;r+=4){a=max3f(a,p0[r],p0[r+1]);b=max3f(b,p0[r+2],p0[r+3]);a=max3f(a,p1[r],p1[r+1]);b=max3f(b,p1[r+2],p1[r+3]);}
  const float m=max2f(a,b);
  auto rr=__builtin_amdgcn_permlane32_swap(__float_as_uint(m),__float_as_uint(m),false,false);
  return max2f(__uint_as_float(rr[0]),__uint_as_float(rr[1]));
}
__device__ __forceinline__ void pv(f32x16*o,int vb,bf16x8 pa0,bf16x8 pa1,bf16x8 pa2,bf16x8 pa3){
  #pragma unroll
  for(int d0=0;d0<2;++d0){s16x4 lo[4],hi[4];
    #pragma unroll
    for(int ks=0;ks<4;++ks){
      asm volatile("ds_read_b64_tr_b16 %0,%1 offset:%c2":"=&v"(lo[ks]):"v"(vb),"i"(d0*4096+ks*1024):"memory");
      asm volatile("ds_read_b64_tr_b16 %0,%1 offset:%c2":"=&v"(hi[ks]):"v"(vb),"i"(d0*4096+ks*1024+512):"memory");}
    asm volatile("s_waitcnt lgkmcnt(0)":::"memory");SBAR();
    #define PK(k) (bf16x8){lo[k][0],lo[k][1],lo[k][2],lo[k][3],hi[k][0],hi[k][1],hi[k][2],hi[k][3]}
    o[d0]=__builtin_amdgcn_mfma_f32_32x32x16_bf16(pa0,PK(0),o[d0],0,0,0);
    o[d0]=__builtin_amdgcn_mfma_f32_32x32x16_bf16(pa1,PK(1),o[d0],0,0,0);
    o[d0]=__builtin_amdgcn_mfma_f32_32x32x16_bf16(pa2,PK(2),o[d0],0,0,0);
    o[d0]=__builtin_amdgcn_mfma_f32_32x32x16_bf16(pa3,PK(3),o[d0],0,0,0);
    #undef PK
  }
}

#ifndef ATTN_STORE16
#define ATTN_STORE16(p,v) (*(u32x4*)(p)=(v))
#endif
template<int THRL> __device__ __forceinline__ void attn_unit(int b,int h,int qb,int ts,const bf16*Q,const bf16*__restrict__ K,const bf16*__restrict__ V,bf16*O,char*shm){
#if defined(MK_TATT)
  const unsigned long long tu0_=__builtin_amdgcn_s_memrealtime();
#endif
  int tid_=threadIdx.x; asm volatile("":"+v"(tid_));
  const int tid=tid_,lane=tid&63,r32=lane&31,hi=lane>>5; const int wid=__builtin_amdgcn_readfirstlane(tid>>6);
  const long rowbase=(long)b*SEQ; const int q0=qb*QB;
  const bf16*Qw=Q+(rowbase+q0+wid*QBLK)*DMQ+h*D;
  const bf16*Kh=K+(rowbase+(long)ts*KVBLK)*DMQ+h*D,*Vh=V+(rowbase+(long)ts*KVBLK)*DMQ+h*D;
  const unsigned lds0=(unsigned)(uintptr_t)shm;
  float*wsf=(float*)(shm+LDS_WS)+wid*64;
  auto wsh_=[&]()->const float*{ int h_=hi; asm volatile("":"+v"(h_)); return wsf+4*h_; };
  const bf16*ksrc=Kh+(long)lane*DMQ+wid*8;
  const bf16*vsrc=Vh+(long)(16*(wid&3)+(lane>>2))*DMQ+(wid>>2)*32+(lane&3)*8;
  const unsigned kdst=lds0+LDS_K+wid*1024, vdst=lds0+LDS_V+wid*1024;
  #define DMA_K(t,slot) glds16(ksrc+(long)(t)*KVBLK*DMQ,(unsigned)__builtin_amdgcn_readfirstlane(kdst+(slot)))
  #define DMA_V(t,slot) glds16(vsrc+(long)(t)*KVBLK*DMQ,(unsigned)__builtin_amdgcn_readfirstlane(vdst+(slot)))
  const int vb0=(int)(lds0+LDS_V)+((lane>>4)&1)*32+(lane&3)*8+(4*hi+((lane&15)>>2))*64;
  const char*Kbase=shm+LDS_K; bf16x8 kf[8];
  const lds_cptr shm3=(lds_cptr)shm; const lds_cptr kp0=shm3+LDS_K+hi*1024+r32*16; const lds_cptr vp0=shm3+LDS_V+((lane>>4)&1)*32+(lane&3)*8+(4*hi+((lane&15)>>2))*64;
  const int NT=(q0+QB)/KVBLK-ts;
  DMA_K(0,0);DMA_V(0,0);DMA_K(1,SLOTB);
  bf16x8 qr[4];
  #pragma unroll
  for(int d0=0;d0<4;++d0)qr[d0]=*reinterpret_cast<const bf16x8*>(&Qw[(long)r32*DMQ+d0*16+hi*8]);
  float mhat=0.f,l_reg=0.f;f32x16 o[2];o[0]=f32x16{};o[1]=f32x16{};
  const lds_cptr kxp0=(lds_cptr)shm+LDS_KX+ts*1024+r32*16;
  u32x4 qxw; qxw[0]=hi?0u:0x3F803F80u; qxw[1]=hi?0u:0x00003F80u; qxw[2]=0u; qxw[3]=0u;
  #define SETQX() do{ const float m_=-mhat; const unsigned h1_=cvtpk_s(m_,0.f)&0xffffu; const float r1_=m_-__uint_as_float(h1_<<16); const unsigned h2_=cvtpk_s(r1_,0.f)&0xffffu; const float r2_=r1_-__uint_as_float(h2_<<16); \
      const unsigned h3_=cvtpk_s(r2_,0.f)&0xffffu; qxw[1]=hi?0u:(0x3F80u|(h1_<<16)); qxw[2]=hi?0u:(h2_|(h3_<<16)); asm volatile("":"+v"(qxw)); }while(0)
  #define QX __builtin_bit_cast(bf16x8,qxw)
  #define KXF(t,n) (*(const __attribute__((address_space(3))) bf16x8*)(kxp0+(t)*1024+(n)*512))
  const int qrel=wid*QBLK+r32;
  #define CMASK(P0,P1,t) do{int jb_=(t)-(NT-4); if(jb_>=0)cmask(P0,P1,jb_,qrel,hi);}while(0)
  bool resc=false;
  #define START(P0,P1) do{ const float rm=rowmax(P0,P1); resc=false; \
    { const float dl=rm; mhat=fadd_s(mhat,dl); \
      _Pragma("unroll") for(int r=0;r<16;++r){P0[r]=fsub_s(P0[r],dl);P1[r]=fsub_s(P1[r],dl);} \
      SETQX(); } \
    _Pragma("unroll") for(int r=0;r<16;++r)P0[r]=__builtin_amdgcn_exp2f(P0[r]); }while(0)
  #define RESC() do{ if(resc){ asm volatile("s_waitcnt lgkmcnt(0)":::"memory"); \
      _Pragma("unroll") for(int d_=0;d_<2;++d_) _Pragma("unroll") for(int r=0;r<16;++r)o[d_][r]*=wsh_()[(r&3)+8*(r>>2)]; } }while(0)
  f32x16 pA0,pA1,pB0,pB1;
  int sl_prev=0,sl_cur=0,sl_next=SLOTB;
  #define ROT() do{sl_prev=sl_cur;sl_cur=sl_next;sl_next=(sl_next==(NSLOT-1)*SLOTB)?0:sl_next+SLOTB;}while(0)
  DMA_K(2,2*SLOTB);
  WAIT_BAR(3);
  qkt(pA0,pA1,Kbase,qr,KXF(0,0),KXF(0,1),QX,r32,hi);asm volatile("s_nop 15\n\ts_nop 7":"+v"(pA0),"+v"(pA1));CMASK(pA0,pA1,0);
  START(pA0,pA1);
  _Pragma("unroll") for(int r=0;r<16;++r)pA1[r]=__builtin_amdgcn_exp2f(pA1[r]);
  WAIT_BAR(0);
  DMA_K(3,0);DMA_V(1,SLOTB);
  ROT();
  kload8(kf,kp0+sl_cur);
  WAIT_BAR(2);
  s16x4 vlo[8],vhi[8]; u32x4 pw0,pw1,pw2,pw3;
  #define PKW(P,B) cvtpk_s(P[B],P[B+1])
  #define PAF(k) __builtin_bit_cast(bf16x8,pw##k)
  #define VFR(i) (bf16x8){vlo[i][0],vlo[i][1],vlo[i][2],vlo[i][3],vhi[i][0],vhi[i][1],vhi[i][2],vhi[i][3]}
  #define PIN(x) asm volatile("":"+v"(x))
  #define MX3(a,b,c) __builtin_fmaxf(__builtin_fmaxf((a),(b)),(c))
  #define GAPA(MF,A0,A1,A2,A3,W0,W1,PW) do{ MF; sacc+=A0; sacc+=A1; sacc+=A2; sacc+=A3; PIN(sacc); W0; W1; PIN(PW); SBAR(); }while(0)
  #define EX(v) __builtin_amdgcn_exp2f(v)
  #define GAPB(MF,X,B) do{ MF; X[B]=EX(X[B]); X[B+1]=EX(X[B+1]); X[B+2]=EX(X[B+2]); X[B+3]=EX(X[B+3]); PIN(X); SBAR(); }while(0)
  #define VRD(i) do{ vlo[i]=vtr(vp_+(((i)>>2)*4096+((i)&3)*1024)); vhi[i]=vtr(vp_+(((i)>>2)*4096+((i)&3)*1024+512)); }while(0)
  #define KRD(G,j) do{ if(G){ kload2(kf,kp0+sl_next,j); SBAR(); } }while(0)
  #define STEP(C0,C1,P0,P1,t,GK,GV,GL) do{ SBAR(); \
    const lds_cptr vp_=vp0+sl_prev; const f32x16 z16_=f32x16{}; \
    const bf16x8 kx0_=KXF(t,0), kx1_=KXF(t,1); \
    VRD(0); SBAR(); float sacc=(P0[0]+P0[1]); \
    GAPA(C0=__builtin_amdgcn_mfma_f32_32x32x16_bf16(kf[0],qr[0],z16_,0,0,0), P0[2],P0[3],P0[4],P0[5],     pw0[0]=PKW(P0,0), pw0[1]=PKW(P0,2), pw0); \
    VRD(4); SBAR(); GAPA(C1=__builtin_amdgcn_mfma_f32_32x32x16_bf16(kf[1],qr[0],z16_,0,0,0), P0[6],P0[7],P0[8],P0[9],     pw0[2]=PKW(P0,4), pw0[3]=PKW(P0,6), pw0); \
    VRD(1); SBAR(); GAPA(C0=__builtin_amdgcn_mfma_f32_32x32x16_bf16(kf[2],qr[1],C0,0,0,0),   P0[10],P0[11],P0[12],P0[13], pw1[0]=PKW(P0,8), pw1[1]=PKW(P0,10), pw1); \
    VRD(5); SBAR(); GAPA(C1=__builtin_amdgcn_mfma_f32_32x32x16_bf16(kf[3],qr[1],C1,0,0,0),   P0[14],P0[15],P1[0],P1[1],   pw1[2]=PKW(P0,12),pw1[3]=PKW(P0,14), pw1); \
    VRD(2); SBAR(); GAPA(C0=__builtin_amdgcn_mfma_f32_32x32x16_bf16(kf[4],qr[2],C0,0,0,0),   P1[2],P1[3],P1[4],P1[5],     pw2[0]=PKW(P1,0), pw2[1]=PKW(P1,2), pw2); \
    VRD(6); SBAR(); GAPA(C1=__builtin_amdgcn_mfma_f32_32x32x16_bf16(kf[5],qr[2],C1,0,0,0),   P1[6],P1[7],P1[8],P1[9],     pw2[2]=PKW(P1,4), pw2[3]=PKW(P1,6), pw2); \
    VRD(3); SBAR(); GAPA(C0=__builtin_amdgcn_mfma_f32_32x32x16_bf16(kf[6],qr[3],C0,0,0,0),   P1[10],P1[11],P1[12],P1[13], pw3[0]=PKW(P1,8), pw3[1]=PKW(P1,10), pw3); \
    VRD(7); SBAR(); GAPA(C1=__builtin_amdgcn_mfma_f32_32x32x16_bf16(kf[7],qr[3],C1,0,0,0),   P1[14],P1[15],0.f,0.f,       pw3[2]=PKW(P1,12),pw3[3]=PKW(P1,14), pw3); \
    C0=__builtin_amdgcn_mfma_f32_32x32x16_bf16(kx0_,QX,C0,0,0,0); SBAR(); C1=__builtin_amdgcn_mfma_f32_32x32x16_bf16(kx1_,QX,C1,0,0,0); SBAR(); \
    l_reg+=sacc; \
    if(GK){DMA_K((t)+3,sl_cur);} if(GV){DMA_V((t)+1,sl_next);} \
    CMASK(C0,C1,t); \
    { float a=MX3(C0[0],C0[1],C1[0]),b=MX3(C0[2],C0[3],C1[1]); a=MX3(a,C1[2],C1[3]); \
      _Pragma("unroll") for(int r=4;r<16;r+=4){a=MX3(a,C0[r],C0[r+1]);b=MX3(b,C0[r+2],C0[r+3]);a=MX3(a,C1[r],C1[r+1]);b=MX3(b,C1[r+2],C1[r+3]);} \
      float rm=__builtin_fmaxf(a,b); { auto rr=__builtin_amdgcn_permlane32_swap(__float_as_uint(rm),__float_as_uint(rm),false,false); rm=__builtin_fmaxf(__uint_as_float(rr[0]),__uint_as_float(rr[1])); } \
      resc=false; \
      if(__builtin_expect(__any(rm>(float)THRL),0)){ const float dl=__builtin_fmaxf(rm,0.f); mhat+=dl; \
        _Pragma("unroll") for(int r=0;r<16;++r){C0[r]-=dl;C1[r]-=dl;} \
        SETQX(); \
        const float f=__builtin_amdgcn_exp2f(-dl); l_reg*=f; if(hi==0)wsf[r32]=f; resc=true; } } \
    SBAR(); \
    GAPB(o[0]=__builtin_amdgcn_mfma_f32_32x32x16_bf16(PAF(0),VFR(0),o[0],0,0,0), C0,0); \
    GAPB(o[1]=__builtin_amdgcn_mfma_f32_32x32x16_bf16(PAF(0),VFR(4),o[1],0,0,0), C0,4); \
    KRD(GL,0); GAPB(o[0]=__builtin_amdgcn_mfma_f32_32x32x16_bf16(PAF(1),VFR(1),o[0],0,0,0), C0,8); \
    KRD(GL,1); GAPB(o[1]=__builtin_amdgcn_mfma_f32_32x32x16_bf16(PAF(1),VFR(5),o[1],0,0,0), C0,12); \
    KRD(GL,2); GAPB(o[0]=__builtin_amdgcn_mfma_f32_32x32x16_bf16(PAF(2),VFR(2),o[0],0,0,0), C1,0); \
    KRD(GL,3); GAPB(o[1]=__builtin_amdgcn_mfma_f32_32x32x16_bf16(PAF(2),VFR(6),o[1],0,0,0), C1,4); \
    GAPB(o[0]=__builtin_amdgcn_mfma_f32_32x32x16_bf16(PAF(3),VFR(3),o[0],0,0,0), C1,8); \
    GAPB(o[1]=__builtin_amdgcn_mfma_f32_32x32x16_bf16(PAF(3),VFR(7),o[1],0,0,0), C1,12); \
    }while(0)
#if defined(MK_TATT)
  if(MK_TATT==1&&threadIdx.x==0)((unsigned long long*)(shm+LDS_CB))[90]+=__builtin_amdgcn_s_memrealtime()-tu0_;
#endif
  int t=1;
  #undef CMASK
  #define CMASK(P0,P1,t) do{}while(0)
  for(;t+5<NT;t+=2){
    STEP(pB0,pB1,pA0,pA1,t,true,true,true);     WAIT_BAR(2); RESC(); ROT();
    STEP(pA0,pA1,pB0,pB1,t+1,true,true,true);   WAIT_BAR(2); RESC(); ROT();
  }
  #undef CMASK
  #define CMASK(P0,P1,t) do{int jb_=(t)-(NT-4); if(jb_>=0)cmask(P0,P1,jb_,qrel,hi);}while(0)
  #define ENDW(tt) do{ if((tt)+3<NT){WAIT_BAR(2);} else if((tt)+2<NT){WAIT_BAR(1);} else {WAIT_BAR(0);} }while(0)
  for(;t+1<NT;t+=2){
    STEP(pB0,pB1,pA0,pA1,t,(t+3<NT),(t+1<NT),(t+1<NT));       ENDW(t);   RESC(); ROT();
    STEP(pA0,pA1,pB0,pB1,t+1,(t+4<NT),(t+2<NT),(t+2<NT));     ENDW(t+1); RESC(); ROT();
  }
  STEP(pB0,pB1,pA0,pA1,NT-1,false,false,false); RESC();
#if defined(MK_TATT)
  const unsigned long long tu1_=__builtin_amdgcn_s_memrealtime();
  if(MK_TATT==3&&threadIdx.x==0)((unsigned long long*)(shm+LDS_CB))[90]+=(unsigned long long)NT;
#endif
  { float sacc=pB0[0]+pB0[1]; _Pragma("unroll") for(int r=2;r<16;++r)sacc+=pB0[r]; _Pragma("unroll") for(int r=0;r<16;++r)sacc+=pB1[r]; l_reg+=sacc;
    pw0=(u32x4){PKW(pB0,0),PKW(pB0,2),PKW(pB0,4),PKW(pB0,6)};pw1=(u32x4){PKW(pB0,8),PKW(pB0,10),PKW(pB0,12),PKW(pB0,14)};pw2=(u32x4){PKW(pB1,0),PKW(pB1,2),PKW(pB1,4),PKW(pB1,6)};pw3=(u32x4){PKW(pB1,8),PKW(pB1,10),PKW(pB1,12),PKW(pB1,14)};
    SBAR(); pv(o,vb0+sl_cur,PAF(0),PAF(1),PAF(2),PAF(3)); }
  #undef PKW
  #undef PAF
  #undef VFR
  #undef PIN
  #undef MX3
  #undef GAPA
  #undef GAPB
  #undef EX
  #undef VRD
  #undef KRD
  #undef STEP
  #undef ENDW
  {auto rr=__builtin_amdgcn_permlane32_swap(__float_as_uint(l_reg),__float_as_uint(l_reg),false,false);l_reg=__uint_as_float(rr[0])+__uint_as_float(rr[1]);}
  if(hi==0)wsf[32+r32]=l_reg;asm volatile("s_waitcnt lgkmcnt(0)":::"memory");
  float rli[16];
  #pragma unroll
  for(int r=0;r<16;++r)rli[r]=__builtin_amdgcn_rcpf(wsh_()[32+(r&3)+8*(r>>2)]);
  bf16*Ow=O+(rowbase+q0+wid*QBLK)*DMO+h*D;
  { bf16*stg=(bf16*)(shm+LDS_OST)+wid*2048;
    #pragma unroll
    for(int r=0;r<16;++r){const int orow=crow(r,hi);
      #pragma unroll
      for(int d0=0;d0<2;++d0)stg[orow*64+d0*32+r32]=__float2bfloat16(o[d0][r]*rli[r]);}
    asm volatile("s_waitcnt lgkmcnt(0)":::"memory");
    #pragma unroll
    for(int i=0;i<4;++i){const int row=i*8+(lane>>3),ch=lane&7; const u32x4 v=*(const u32x4*)(stg+row*64+ch*8); ATTN_STORE16(Ow+(long)row*DMO+ch*8,v);} }
  asm volatile("s_waitcnt lgkmcnt(0)\n\ts_barrier":::"memory");
#if defined(MK_TATT)
  if(MK_TATT==2&&threadIdx.x==0)((unsigned long long*)(shm+LDS_CB))[90]+=__builtin_amdgcn_s_memrealtime()-tu1_;
#endif
  #undef DMA_K
  #undef DMA_V
  #undef SETQX
  #undef QX
  #undef KXF
  #undef CMASK
  #undef START
  #undef RESC
  #undef ROT
}
constexpr int ATTN_LDS_BYTES=LDS_BYTES;
__device__ __forceinline__ void fill_kx(char*shm,const float*FG,float fbias,int b,int h,const bf16*Q,const bf16*K,int tid){
  const int lane=tid&63,wid=tid>>6;
  double*wtot=(double*)(shm+LDS_WS);
  float ls[8]; double run=0.0;
  { float*stg=(float*)(shm+LDS_K);
    #pragma unroll
    for(int j=0;j<8;++j)stg[j*512+tid]=FG[((long)b*SEQ+j*512+tid)*8+h];
    __syncthreads();
    #pragma unroll
    for(int j=0;j<8;++j){ const float x=stg[8*tid+j]+fbias; const float e=__expf(-fabsf(x)); ls[j]=fminf(x,0.f)-log1pf(e); } }
  #pragma unroll
  for(int j=0;j<8;++j)run+=(double)ls[j];
  double inc=run;
  #pragma unroll
  for(int o=1;o<64;o<<=1){ const int src_=((lane>=o)?lane-o:lane)<<2; const long long bits=__builtin_bit_cast(long long,inc);
    const int lo_=__builtin_amdgcn_ds_bpermute(src_,(int)bits), hi_=__builtin_amdgcn_ds_bpermute(src_,(int)(bits>>32));
    const double v=__builtin_bit_cast(double,((long long)(unsigned)hi_<<32)|(unsigned)lo_); if(lane>=o)inc+=v; }
  if(lane==63)wtot[wid]=inc;
  __syncthreads();
  double base=inc-run;
  for(int w=0;w<wid;++w)base+=wtot[w];
  u32x4*dst=(u32x4*)(shm+LDS_KX)+8*tid;
  #pragma unroll
  for(int j=0;j<8;++j){ base+=(double)ls[j]; const float c=(float)(-base*1.4426950408889634);
    const unsigned h1=cvtpk_s(c,0.f)&0xffffu; const float r1=c-__uint_as_float(h1<<16); const unsigned h2=cvtpk_s(r1,0.f)&0xffffu; const float r2=r1-__uint_as_float(h2<<16); const unsigned h3=cvtpk_s(r2,0.f)&0xffffu;
    dst[j]=(u32x4){h1|(h2<<16),h3|0x3F800000u,0x3F803F80u,0u};
    if(j==0&&(tid&7)==0)((float*)(shm+LDS_CB))[tid>>3]=c; if(j==7&&(tid&7)==7)((float*)(shm+LDS_CB))[64+(tid>>3)]=c; }
  if(tid==0){ unsigned z_=0u; asm volatile("":"+v"(z_)); ((u32x4*)(shm+LDS_KX))[SEQ]=(u32x4){z_,z_,z_,z_}; }
  { float qm=0.f,km=0.f;
    const long row0=(long)b*SEQ+wid*512+(lane>>3); const int cho=h*D+(lane&7)*8;
    #pragma unroll
    for(int pass=0;pass<2;++pass){ const bf16*P=pass?K:Q;
      #pragma unroll 1
      for(int i0=0;i0<64;i0+=16){ u32x4 v[16];
        #pragma unroll
        for(int i=0;i<16;++i)v[i]=*(const u32x4*)(P+(row0+8*(i0+i))*DMQ+cho);
        #pragma unroll
        for(int i=0;i<16;++i){ float s=0.f;
          #pragma unroll
          for(int e=0;e<4;++e){ const float x0=__uint_as_float(v[i][e]<<16),x1=__uint_as_float(v[i][e]&0xffff0000u); s+=x0*x0+x1*x1; }
          s+=__int_as_float(__builtin_amdgcn_update_dpp(0,__float_as_int(s),0xB1,0xf,0xf,false)); s+=__int_as_float(__builtin_amdgcn_update_dpp(0,__float_as_int(s),0x4E,0xf,0xf,false));
          s+=__int_as_float(__builtin_amdgcn_update_dpp(0,__float_as_int(s),0x141,0xf,0xf,false));
          if(pass)km=fmaxf(km,s); else qm=fmaxf(qm,s); } } }
    #pragma unroll
    for(int o=1;o<64;o<<=1){ const int src_=(lane^o)<<2; qm=fmaxf(qm,__int_as_float(__builtin_amdgcn_ds_bpermute(src_,__float_as_int(qm)))); km=fmaxf(km,__int_as_float(__builtin_amdgcn_ds_bpermute(src_,__float_as_int(km)))); }
    if(lane==0){ ((float*)(shm+LDS_CB))[128+2*wid]=qm; ((float*)(shm+LDS_CB))[129+2*wid]=km; } }
  __syncthreads();
  if(tid==0){ float qm=0.f,km=0.f; for(int w=0;w<8;++w){ qm=fmaxf(qm,((float*)(shm+LDS_CB))[128+2*w]); km=fmaxf(km,((float*)(shm+LDS_CB))[129+2*w]); } ((float*)(shm+LDS_CB))[160]=2.0f*sqrtf(qm*km)*1.001f; }
  __syncthreads();
}
constexpr int KX_IMG_BYTES=SEQ*16+16+1024;
__device__ __forceinline__ void kx_store(const char*shm,char*g,int tid){
  for(int i=tid;i<KX_IMG_BYTES/16;i+=NW*64)((u32x4*)g)[i]=((const u32x4*)(shm+LDS_KX))[i];
}
__device__ __forceinline__ void kx_load(char*shm,const char*g,int tid){
  u32x4 v[9];
  #pragma unroll
  for(int j=0;j<9;++j){ const int i=tid+j*NW*64; if(i<KX_IMG_BYTES/16)v[j]=((const u32x4*)g)[i]; }
  #pragma unroll
  for(int j=0;j<9;++j){ const int i=tid+j*NW*64; if(i<KX_IMG_BYTES/16)((u32x4*)(shm+LDS_KX))[i]=v[j]; }
  __syncthreads();
}
__device__ __forceinline__ int tile_start(const char*shm,int qb,int lane){
  const float*cb=(const float*)(shm+LDS_CB); const float bound=cb[4*qb]-48.0f-cb[160];
  const int t=2*(lane+1); const bool ok=(t<=4*qb)&&(t<=64)&&(cb[64+((t-1)&63)]<=bound);
  return 2*__popcll(__ballot(ok));
}
struct AttnTensors { const bf16* Q; const bf16* K; const bf16* V; bf16* O; };
struct AttnUnit { int bh; int qb; };
struct StaticOrder {
  int vcu,bh_;
  __device__ __forceinline__ explicit StaticOrder(int vcu_,int bh):vcu(vcu_),bh_(bh){}
  __device__ __forceinline__ bool next(int i,AttnUnit&u)const{ if(i>=4)return false; const int s=vcu&3, j=4*(i>>1)+s; u.bh=bh_; u.qb=(i&1)?15-j:j; return true; }
  __device__ __forceinline__ void a_ready(const AttnUnit&)const{}
  __device__ __forceinline__ void done(const AttnUnit&)const{}
};
template<class Sched,int THRL=96> __device__ __forceinline__ void attn_phase(char*lds,const AttnTensors&T,const Sched&S){
  AttnUnit u;
  for(int i=0;S.next(i,u);++i){ S.a_ready(u); attn_unit<THRL>(u.bh/NHEAD,u.bh%NHEAD,u.qb,tile_start(lds,u.qb,threadIdx.x&63),T.Q,T.K,T.V,T.O,lds); S.done(u); }
}
#undef SBAR
#undef WAIT_BAR
}
#define GAS __attribute__((address_space(1)))
#define LAS __attribute__((address_space(3)))
typedef unsigned short bf16;
typedef unsigned v4u __attribute__((ext_vector_type(4)));
typedef float f32x4 __attribute__((ext_vector_type(4)));
typedef short bf16x8 __attribute__((ext_vector_type(8)));
typedef GAS unsigned gu32;
typedef GAS unsigned long long gu64;
#define RLX_AGENT __ATOMIC_RELAXED, __HIP_MEMORY_SCOPE_AGENT
#define LDS_WAIT() asm volatile("s_waitcnt lgkmcnt(0)" ::: "memory")
#define VM_WAIT() asm volatile("s_waitcnt vmcnt(0)" ::: "memory")
__device__ __forceinline__ unsigned long long rt() { return __builtin_amdgcn_s_memrealtime(); }
__device__ __forceinline__ unsigned f2bf(float f) { unsigned u = __builtin_bit_cast(unsigned, f); return (u + 0x7fffu + ((u >> 16) & 1u)) >> 16; }
__device__ __forceinline__ unsigned pk2(float lo, float hi) { return f2bf(lo) | (f2bf(hi) << 16); }

#define XB_TMO      128
#define XB_XCNT(j)  (256  + 64 * (j))
#define XB_XSUB(j)  (1280 + 64 * (j))
#define XB_XGEN(j)  (2304 + 64 * (j))
#define XB_TOP      3328
#define XB_TOPGEN   3392
#define XCD_BAR_WORDS 3456
#define XB_SPIN_CAP (1u << 20)

__device__ __forceinline__ unsigned xb_ld(unsigned* p)              { return __hip_atomic_load(p, __ATOMIC_RELAXED, __HIP_MEMORY_SCOPE_AGENT); }
__device__ __forceinline__ unsigned xb_add(unsigned* p, unsigned v) { return __hip_atomic_fetch_add(p, v, __ATOMIC_RELAXED, __HIP_MEMORY_SCOPE_AGENT); }
__device__ __forceinline__ unsigned xb_xcc_id() { return (unsigned)__builtin_amdgcn_s_getreg((3 << 11) | 20) & 0xFu; }
#define XB_SPIN(cond, bar) do { unsigned _sp = 0; while (cond) { __builtin_amdgcn_s_sleep(1); \
    if ((++_sp & 255u) == 0u) { if (xb_ld(&(bar)[XB_TMO])) break; if (_sp > XB_SPIN_CAP) { atomicAdd(&(bar)[XB_TMO], 1u); break; } } } } while (0)

struct XcdBarrier {
    unsigned* bar; unsigned x; unsigned gsz;
    volatile LAS unsigned* st;
};

__device__ __forceinline__ XcdBarrier xcd_barrier_post(unsigned* bar, volatile LAS unsigned* st, unsigned gsz) {
    XcdBarrier b; b.bar = bar; b.x = xb_xcc_id(); b.st = st; b.gsz = gsz;
    if (threadIdx.x == 0) (void)xb_add(&bar[XB_XCNT(b.x)], 1u);
    return b;
}
__device__ __forceinline__ void xcd_barrier_complete(unsigned* bar, unsigned x, unsigned& nloc, unsigned& nx, unsigned G) {
    unsigned sum, cnt, mine, sp = 0u;
    for (;;) {
        sum = 0u; cnt = 0u; mine = 0u;
#pragma unroll
        for (unsigned j = 0; j < 16; ++j) { const unsigned c = xb_ld(&bar[XB_XCNT(j)]); sum += c; cnt += (c > 0u) ? 1u : 0u; mine = (j == x) ? c : mine; }
        if (sum == G) break;
        __builtin_amdgcn_s_sleep(1);
        if ((++sp & 255u) == 0u) { if (xb_ld(&bar[XB_TMO])) break; if (sp > XB_SPIN_CAP) { atomicAdd(&bar[XB_TMO], 1u); break; } }
    }
    nloc = mine > 0u ? mine : 1u; nx = cnt > 0u ? cnt : 1u;
}

__device__ __forceinline__ void xcd_barrier(const XcdBarrier& b) {
    asm volatile("s_waitcnt vmcnt(0)" ::: "memory");
    __syncthreads();
    if (threadIdx.x == 0) {
        unsigned* bar = b.bar;
        __builtin_amdgcn_s_waitcnt(0);
        unsigned nloc = b.st[0], nx = b.st[1];
        if (nloc == 0u) { xcd_barrier_complete(bar, b.x, nloc, nx, b.gsz); b.st[0] = nloc; b.st[1] = nx; }
        const unsigned old = xb_add(&bar[XB_XSUB(b.x)], 1u);
        const unsigned gen = old / nloc;
        if (old + 1u == (gen + 1u) * nloc) {
            __builtin_amdgcn_fence(__ATOMIC_RELEASE, "agent");
            asm volatile("s_waitcnt vmcnt(0)" ::: "memory");
            const unsigned og = xb_add(&bar[XB_TOP], 1u);
            const unsigned tg = og / nx;
            if (og + 1u == (tg + 1u) * nx) xb_add(&bar[XB_TOPGEN], 1u);
            else XB_SPIN(xb_ld(&bar[XB_TOPGEN]) == tg, bar);
            __builtin_amdgcn_fence(__ATOMIC_ACQUIRE, "agent");
            xb_add(&bar[XB_XGEN(b.x)], 1u);
            asm volatile("s_waitcnt vmcnt(0)" ::: "memory");
        } else {
            XB_SPIN(xb_ld(&bar[XB_XGEN(b.x)]) == gen, bar);
            __builtin_amdgcn_fence(__ATOMIC_ACQUIRE, "agent");
            asm volatile("s_waitcnt vmcnt(0)" ::: "memory");
        }
    }
    __syncthreads();
}

constexpr int NWAVES = 8;
constexpr int NB = 16, SEQ = 4096, DMODEL = 1024, NTOK = NB * SEQ;
constexpr int RC = 1792, FQKV = 1536, NPROJ = 3328, ICOLS = 3336, NMOD = 6144;
constexpr int NEXP = 32, DEXP = 512;
constexpr size_t MiB = 1u << 20;
constexpr size_t WS_CTL = 0, CTL_ZERO_BYTES = 1 * MiB;
constexpr size_t WS_MOD = 1 * MiB, WS_FG = 2 * MiB, WS_WIN = 8 * MiB, WS_WOUT = 16 * MiB, WS_LORA = 18 * MiB, WS_TOKINFO = 19 * MiB;
constexpr size_t WS_SLOT_TOK = 24 * MiB, WS_SLOT_W = 32 * MiB, WS_W1 = 40 * MiB, WS_W2 = 104 * MiB;
constexpr size_t WS_H = 136 * MiB, WS_PR = 264 * MiB, WS_PF = 488 * MiB, WS_MIX = 680 * MiB, WS_END = 1024 * MiB;
constexpr int CW_TMO = 0, CW_CODE = 1, CW_BAR = 4096, CW_CNT = 16384, CW_BB = 32768;
constexpr int RING_OFF = 0, RING_BYTES = 131072, LDS_BYTES = 163840, LDSCTL_OFF = LDS_BYTES - 512, MISC_OFF = LDSCTL_OFF;
static_assert(attn_body::ATTN_LDS_BYTES <= LDSCTL_OFF, "attention LDS");

typedef decltype(__builtin_amdgcn_kernarg_segment_ptr()) kseg_t;
struct InTab { kseg_t k;
    __device__ __forceinline__ const float* operator[](int i) const { return (const float*)((const unsigned long long __attribute__((address_space(4)))*)k)[i]; } };
struct Frame {
    LAS unsigned char* lds;
    volatile LAS unsigned* MISC;
    gu32* ctl;
    int tid, lane, wave;
    int vcu, G;
    InTab in; float* out; unsigned char* ws;
};
#define IN_X 0
#define IN_C 1
#define IN_WADA 2
#define IN_BADA 3
#define IN_N1G 4
#define IN_WIN 5
#define IN_MU 6
#define IN_W0 7
#define IN_WUP 8
#define IN_A0 9
#define IN_AUP 10
#define IN_GUP 11
#define IN_KK 12
#define IN_KA 13
#define IN_RK 14
#define IN_LNG 15
#define IN_LNB 16
#define IN_FB 17
#define IN_WOUT 18
#define IN_N2G 19
#define IN_WGRP 20
#define IN_BGRP 21
#define IN_WRT 22
#define IN_BRT 23
#define IN_WGATE 24
#define IN_WUPM 25
#define IN_WDOWN 26
#define IN_NFG 27

template <int N> __device__ __forceinline__ float dpp_ror(float x) { return __int_as_float(__builtin_amdgcn_update_dpp(0, __float_as_int(x), 0x120 + N, 0xf, 0xf, false)); }
__device__ __forceinline__ float row_allsum(float x) { x += dpp_ror<8>(x); x += dpp_ror<4>(x); x += dpp_ror<2>(x); x += dpp_ror<1>(x); return x; }
__device__ __forceinline__ float rdl(float x, int l) { return __int_as_float(__builtin_amdgcn_readlane(__float_as_int(x), l)); }
__device__ __forceinline__ float wave_sum(float v) { v = row_allsum(v); return (rdl(v, 0) + rdl(v, 16)) + (rdl(v, 32) + rdl(v, 48)); }
__device__ __forceinline__ float xchg32(float s, bool upper) { auto rr = __builtin_amdgcn_permlane32_swap(__float_as_uint(s), __float_as_uint(s), false, false); return __uint_as_float(upper ? rr[0] : rr[1]); }
__device__ __forceinline__ void wave_reduce8(const float (&v)[8], float (&t)[8], int lane) {
    const bool up = lane & 32; float h[4];
#pragma unroll
    for (int j = 0; j < 4; ++j) { const float send = up ? v[j] : v[j + 4], keep = up ? v[j + 4] : v[j]; h[j] = row_allsum(keep + xchg32(send, up)); }
#pragma unroll
    for (int j = 0; j < 4; ++j) { t[j] = rdl(h[j], 0) + rdl(h[j], 16); t[j + 4] = rdl(h[j], 32) + rdl(h[j], 48); }
}
__device__ __forceinline__ void wave_reduce4(const float (&v)[4], float (&t)[4], int lane) {
    const bool up = lane & 32; float h[2];
#pragma unroll
    for (int j = 0; j < 2; ++j) { const float send = up ? v[j] : v[j + 2], keep = up ? v[j + 2] : v[j]; h[j] = row_allsum(keep + xchg32(send, up)); }
#pragma unroll
    for (int j = 0; j < 2; ++j) { t[j] = rdl(h[j], 0) + rdl(h[j], 16); t[j + 2] = rdl(h[j], 32) + rdl(h[j], 48); }
}

__device__ __forceinline__ void p0_transpose_item(const float* W, int ldw, bf16* WT, int ldt, int dst_row0, int k0, int n0, LAS float* scr, int lane) {
    float wv_[32];
#pragma unroll
    for (int i = 0; i < 32; ++i) wv_[i] = W[(size_t)(k0 + 2 * i + (lane >> 5)) * ldw + n0 + (lane & 31)];
#pragma unroll
    for (int i = 0; i < 32; ++i) scr[(2 * i + (lane >> 5)) * 33 + (lane & 31)] = wv_[i];
    LDS_WAIT(); asm volatile("" ::: "memory");
    const int c = lane & 7;
#pragma unroll
    for (int j = 0; j < 4; ++j) { const int n = (lane >> 3) + 8 * j; const LAS float* s = scr + (8 * c) * 33 + n;
        v4u o; o.x = pk2(s[0 * 33], s[1 * 33]); o.y = pk2(s[2 * 33], s[3 * 33]); o.z = pk2(s[4 * 33], s[5 * 33]); o.w = pk2(s[6 * 33], s[7 * 33]);
        *(GAS v4u*)(WT + (size_t)(dst_row0 + n) * ldt + k0 + 8 * c) = o; }
    LDS_WAIT(); asm volatile("" ::: "memory");
}
template <int PART> __device__ __forceinline__ void p0_prologue(Frame& F) {
  if (PART != 2)
    {
        LAS float* cond = (LAS float*)(F.lds);
        LAS float* red = (LAS float*)(F.lds + 65536);
        const float* c = F.in[IN_C]; const float* wada = F.in[IN_WADA]; const float* bada = F.in[IN_BADA]; float* mod = (float*)(F.ws + WS_MOD);
        for (int u = F.vcu; u < NMOD / 32; u += F.G) {
            for (int idx = F.tid; idx < 16384; idx += 512) { const int k = idx >> 4, b = idx & 15; const float v = c[b * 1024 + k]; cond[idx] = v / (1.f + __expf(-v)); }
            __syncthreads();
            const int ks = F.tid >> 5, cl = F.tid & 31, col = u * 32 + cl;
            float acc[16];
#pragma unroll
            for (int b = 0; b < 16; ++b) acc[b] = 0.f;
            for (int i0 = 0; i0 < 64; i0 += 16) { float wv[16];
#pragma unroll
                for (int i = 0; i < 16; ++i) wv[i] = wada[(size_t)(ks + 16 * (i0 + i)) * NMOD + col];
#pragma unroll
                for (int i = 0; i < 16; ++i) { const int k = ks + 16 * (i0 + i); const float w = wv[i];
                    const LAS f32x4* cv = (const LAS f32x4*)(cond + k * 16);
#pragma unroll
                    for (int q = 0; q < 4; ++q) { const f32x4 t = cv[q]; acc[4 * q] += t[0] * w; acc[4 * q + 1] += t[1] * w; acc[4 * q + 2] += t[2] * w; acc[4 * q + 3] += t[3] * w; } } }
#pragma unroll
            for (int b = 0; b < 16; ++b) red[(ks * 16 + b) * 32 + cl] = acc[b];
            __syncthreads();
            { const int b = F.tid >> 5; float s = bada[col];
#pragma unroll
              for (int k2 = 0; k2 < 16; ++k2) s += red[(k2 * 16 + b) * 32 + cl];
              mod[(size_t)b * NMOD + col] = s; }
            __syncthreads();
        }
    }
    {
        LAS float* scr = (LAS float*)(F.lds + F.wave * 16384);
        const int gw = F.vcu * NWAVES + F.wave, NGW = F.G * NWAVES;
        constexpr int I_IN = 16 * (NPROJ / 32), I_OUT = 16 * 32, I_E = 768, NITEMS = I_IN + I_OUT + NEXP * I_E;
        bf16* Win_t = (bf16*)(F.ws + WS_WIN); bf16* Wout_t = (bf16*)(F.ws + WS_WOUT); bf16* W1_t = (bf16*)(F.ws + WS_W1); bf16* W2_t = (bf16*)(F.ws + WS_W2);
        for (int it = gw + ((PART == 2) ? I_IN + I_OUT : 0); it < ((PART == 1) ? I_IN + I_OUT : NITEMS); it += NGW) {
            int r = it;
            if (r < I_IN) { const int nblk = NPROJ / 32, kb = r / nblk, nb = r % nblk; p0_transpose_item(F.in[IN_WIN], ICOLS, Win_t, 1024, 32 * nb, 64 * kb, 32 * nb, scr, F.lane); continue; } r -= I_IN;
            if (r < I_OUT) { const int kb = r / 32, nb = r % 32; p0_transpose_item(F.in[IN_WOUT], 1024, Wout_t, 1024, 32 * nb, 64 * kb, 32 * nb, scr, F.lane); continue; } r -= I_OUT;
            const int e = r / I_E; r -= e * I_E;
            if (r < 512) { const int up = r >> 8, q = r & 255, kb = q >> 4, nb = q & 15, n0 = 32 * nb;
                if (up) p0_transpose_item(F.in[IN_WUPM] + (size_t)e * 1024 * 512, 512, W1_t + (size_t)e * 1024 * 1024, 1024, 256 * (n0 >> 7) + 128 + (n0 & 127), 64 * kb, n0, scr, F.lane);
                else    p0_transpose_item(F.in[IN_WGATE] + (size_t)e * 1024 * 512, 512, W1_t + (size_t)e * 1024 * 1024, 1024, 256 * (n0 >> 7) + (n0 & 127), 64 * kb, n0, scr, F.lane); }
            else { const int q = r - 512, kb = q >> 5, nb = q & 31;
                p0_transpose_item(F.in[IN_WDOWN] + (size_t)e * 512 * 1024, 1024, W2_t + (size_t)e * 1024 * 512, 512, 32 * nb, 64 * kb, 32 * nb, scr, F.lane); }
        }
    }
}

__device__ __forceinline__ void p1_norm(Frame& F) {
    LAS f32x4* Wf4 = (LAS f32x4*)(F.lds);
    const float* win = F.in[IN_WIN];
    for (int idx = F.tid; idx < 8192; idx += 512) { const int c = idx >> 3, j = idx & 7; const float v = win[(size_t)c * ICOLS + NPROJ + j];
        const int l = (c & 255) >> 2, jq = c >> 8, i = c & 3, jj = jq * 4 + i; ((LAS float*)Wf4)[(((j >> 2) * 16 + jj) * 64 + l) * 4 + (j & 3)] = v; }
    __syncthreads();
    const float* x = F.in[IN_X]; const float* g1 = F.in[IN_N1G]; const float* mod = (const float*)(F.ws + WS_MOD);
    bf16* H = (bf16*)(F.ws + WS_H); float* FG = (float*)(F.ws + WS_FG);
    for (int rb = F.vcu; rb < NTOK / 256; rb += F.G) {
        const int b = (rb * 256) / SEQ;
        f32x4 A[4], Bc[4];
#pragma unroll
        for (int j = 0; j < 4; ++j) { const int c = 4 * F.lane + 256 * j; const f32x4 g = *(const f32x4*)(g1 + c), sc = *(const f32x4*)(mod + (size_t)b * NMOD + 1024 + c); A[j] = g * (sc + 1.0f); Bc[j] = *(const f32x4*)(mod + (size_t)b * NMOD + c); }
        f32x4 vn[4];
        { const GAS f32x4* xr0 = (const GAS f32x4*)(x + ((size_t)rb * 256 + F.wave) * 1024) + F.lane;
#pragma unroll
          for (int j = 0; j < 4; ++j) vn[j] = xr0[64 * j]; }
        for (int r = F.wave; r < 256; r += NWAVES) {
            const size_t m = (size_t)rb * 256 + r;
            f32x4 v[4]; float ss = 0.f;
#pragma unroll
            for (int j = 0; j < 4; ++j) v[j] = vn[j];
            if (r + NWAVES < 256) { const GAS f32x4* xr = (const GAS f32x4*)(x + (m + NWAVES) * 1024) + F.lane;
#pragma unroll
                for (int j = 0; j < 4; ++j) vn[j] = xr[64 * j]; }
#pragma unroll
            for (int j = 0; j < 4; ++j) ss += (v[j].x * v[j].x + v[j].y * v[j].y) + (v[j].z * v[j].z + v[j].w * v[j].w);
            const float rstd = 1.0f / sqrtf(wave_sum(ss) * (1.f / 1024.f) + 1e-6f);
            GAS unsigned long long* o8 = (GAS unsigned long long*)(H + m * 1024) + F.lane;
            float acc[8];
#pragma unroll
            for (int q = 0; q < 8; ++q) acc[q] = 0.f;
#pragma unroll
            for (int j = 0; j < 4; ++j) { v[j] = v[j] * rstd * A[j] + Bc[j];
                o8[64 * j] = (unsigned long long)attn_body::cvtpk_s(v[j].x, v[j].y) | ((unsigned long long)attn_body::cvtpk_s(v[j].z, v[j].w) << 32);
#pragma unroll
                for (int i = 0; i < 4; ++i) { const f32x4 w0 = Wf4[(j * 4 + i) * 64 + F.lane], w1 = Wf4[(16 + j * 4 + i) * 64 + F.lane]; const float hv = v[j][i];
                    acc[0] += hv * w0[0]; acc[1] += hv * w0[1]; acc[2] += hv * w0[2]; acc[3] += hv * w0[3]; acc[4] += hv * w1[0]; acc[5] += hv * w1[1]; acc[6] += hv * w1[2]; acc[7] += hv * w1[3]; } }
            float ft[8]; wave_reduce8(acc, ft, F.lane);
            if (F.lane == 0) { *(GAS f32x4*)(FG + m * 8) = (f32x4){ft[0], ft[1], ft[2], ft[3]}; *(GAS f32x4*)(FG + m * 8 + 4) = (f32x4){ft[4], ft[5], ft[6], ft[7]}; }
        }
    }
}

__device__ __forceinline__ void p_final_nomoe(Frame& F) {
    const float* gf = F.in[IN_NFG];
    f32x4 G4[4];
#pragma unroll
    for (int j = 0; j < 4; ++j) G4[j] = *(const f32x4*)(gf + 4 * F.lane + 256 * j);
    const int gw = F.vcu * NWAVES + F.wave, NGW = F.G * NWAVES;
    for (int m = gw; m < NTOK; m += NGW) {
        GAS f32x4* xr = (GAS f32x4*)(F.out + (size_t)m * 1024) + F.lane;
        f32x4 v[4]; float ss = 0.f;
#pragma unroll
        for (int j = 0; j < 4; ++j) { v[j] = xr[64 * j]; ss += (v[j].x * v[j].x + v[j].y * v[j].y) + (v[j].z * v[j].z + v[j].w * v[j].w); }
        const float rstd = 1.0f / sqrtf(wave_sum(ss) * (1.f / 1024.f) + 1e-6f);
#pragma unroll
        for (int j = 0; j < 4; ++j) xr[64 * j] = v[j] * rstd * G4[j];
    }
}


constexpr size_t WS_ALORA = 808 * MiB;
constexpr size_t OUT_Y = 0, OUT_GG = 128 * MiB, OUT_Z = 192 * MiB;
typedef unsigned v2u __attribute__((ext_vector_type(2)));
typedef float f32x2 __attribute__((ext_vector_type(2)));
__device__ __forceinline__ float bf2f(unsigned short u) { return __uint_as_float((unsigned)u << 16); }
__device__ __forceinline__ float sigmoidf_(float v) { return 1.0f / (1.0f + __expf(-v)); }

__device__ __forceinline__ void r0_lora_inputs(Frame& F) {
    const bf16* PR = (const bf16*)(F.ws + WS_PR); bf16* AL = (bf16*)(F.ws + WS_ALORA); const float* mu = F.in[IN_MU] + 1536;
    const int l = F.lane & 31, hwl = ((F.vcu & 15) * NWAVES + F.wave) * 2 + (F.lane >> 5);
    float m8[8];
#pragma unroll
    for (int i = 0; i < 8; ++i) m8[i] = mu[8 * l + i];
    for (int m0 = (F.vcu >> 4) * SEQ + hwl * 4, mend = ((F.vcu >> 4) + 1) * SEQ; m0 < mend; m0 += 1024) {
        v4u cur[4], prv[4];
#pragma unroll
        for (int u = 0; u < 4; ++u) { const int m = m0 + u; cur[u] = *(const GAS v4u*)(PR + (size_t)m * RC + 1536 + 8 * l);
            prv[u] = (v4u){0u, 0u, 0u, 0u}; if (u > 0) prv[u] = cur[u - 1]; else if ((m & (SEQ - 1)) != 0) prv[u] = *(const GAS v4u*)(PR + (size_t)(m - 1) * RC + 1536 + 8 * l); }
#pragma unroll
        for (int u = 0; u < 4; ++u) { float o[8];
#pragma unroll
            for (int i = 0; i < 4; ++i) { const unsigned cw = cur[u][i], pw = prv[u][i];
                const float c0 = __uint_as_float(cw << 16), c1 = __uint_as_float(cw & 0xffff0000u), p0 = __uint_as_float(pw << 16), p1 = __uint_as_float(pw & 0xffff0000u);
                o[2 * i] = c0 + (p0 - c0) * m8[2 * i]; o[2 * i + 1] = c1 + (p1 - c1) * m8[2 * i + 1]; }
            if (l < 8) {
#pragma unroll
                for (int i = 0; i < 8; ++i) { const float ex = __expf(2.0f * o[i]); o[i] = 1.0f - 2.0f * __builtin_amdgcn_rcpf(1.0f + ex); }
            } else if (l >= 16) {
#pragma unroll
                for (int i = 0; i < 8; ++i) o[i] = __builtin_amdgcn_rcpf(1.0f + __expf(-o[i]));
            }
            *(GAS v4u*)(AL + (size_t)(m0 + u) * 256 + 8 * l) = (v4u){pk2(o[0], o[1]), pk2(o[2], o[3]), pk2(o[4], o[5]), pk2(o[6], o[7])}; }
    }
}

namespace scan {
typedef _Float16 h16x4 __attribute__((ext_vector_type(4)));
constexpr int TC = 32;
constexpr int KSB = 80;
constexpr int RECB = 16 * KSB + 128;
constexpr int L_RAW = 0;
constexpr int L_AL = 13312;
constexpr int L_REC = L_AL + 16 * 1056;
constexpr int L_WL = L_REC + TC * RECB;
constexpr int L_AV = L_WL + 8192;
constexpr int L_GV = L_AV + 8192;
constexpr int L_YB = L_GV + 4096;
constexpr int L_BF = L_YB + 8192 + 256;
constexpr int L_END = L_BF + 24576;
template <int N> __device__ __forceinline__ float ror16(float x) { return __int_as_float(__builtin_amdgcn_update_dpp(0, __float_as_int(x), 0x120 + N, 0xf, 0xf, false)); }
__device__ __forceinline__ float allsum16(float x) { x += ror16<8>(x); x += ror16<4>(x); x += ror16<2>(x); x += ror16<1>(x); return x; }
typedef float f32x16 __attribute__((ext_vector_type(16)));
__device__ __forceinline__ float fmix_lo(float a, unsigned h2, float c) { float d; asm("v_fma_mix_f32 %0, %1, %2, %3 op_sel_hi:[0,1,0]" : "=v"(d) : "v"(a), "v"(h2), "v"(c)); return d; }
__device__ __forceinline__ float fmix_hi(float a, unsigned h2, float c) { float d; asm("v_fma_mix_f32 %0, %1, %2, %3 op_sel:[0,1,0] op_sel_hi:[0,1,0]" : "=v"(d) : "v"(a), "v"(h2), "v"(c)); return d; }
__device__ __forceinline__ float fmix_hi_nop(float a, unsigned h2, float c) { float d; asm("v_fma_mix_f32 %0, %1, %2, %3 op_sel:[0,1,0] op_sel_hi:[0,1,0]\n\ts_nop 1" : "=v"(d) : "v"(a), "v"(h2), "v"(c)); return d; }
__device__ __forceinline__ float fmix_lo0(float a, unsigned h2) { float d; asm("v_fma_mix_f32 %0, %1, %2, 0 op_sel_hi:[0,1,0]" : "=v"(d) : "v"(a), "v"(h2)); return d; }

__device__ __forceinline__ void phase(Frame& F) {
    const int tid = F.tid, lane = F.lane, wave = F.wave;
    const int half = F.vcu & 1, hd = (F.vcu >> 1) & 7, b = F.vcu >> 4;
    LAS unsigned char* L = F.lds;
    const unsigned lds0 = (unsigned)(uintptr_t)(unsigned char*)F.lds;
    const bf16* PR = (const bf16*)(F.ws + WS_PR); const bf16* AL = (const bf16*)(F.ws + WS_ALORA);
    float* Y = (float*)((unsigned char*)F.out + OUT_Y); bf16* GG = (bf16*)((unsigned char*)F.out + OUT_GG); bf16* Z = (bf16*)((unsigned char*)F.out + OUT_Z);
    const int et = tid >> 4, cg = tid & 15, chb = hd * 64 + 4 * cg;
    float mu_r[4], mu_k[4], mu_v[4], kkc[4], kac[4], rkc[4], lng[4], lnb[4], w0c[4], a0c[4];
#pragma unroll
    for (int i = 0; i < 4; ++i) { mu_r[i] = F.in[IN_MU][chb + i]; mu_k[i] = F.in[IN_MU][512 + chb + i]; kkc[i] = F.in[IN_KK][chb + i]; kac[i] = F.in[IN_KA][chb + i]; rkc[i] = F.in[IN_RK][chb + i]; w0c[i] = F.in[IN_W0][chb + i]; a0c[i] = F.in[IN_A0][chb + i]; }
    const int vch = hd * 64 + half * 32 + 4 * (cg & 7);
#pragma unroll
    for (int i = 0; i < 4; ++i) { mu_v[i] = F.in[IN_MU][1024 + vch + i]; lng[i] = F.in[IN_LNG][vch + i]; lnb[i] = F.in[IN_LNB][vch + i]; }
    if (wave < 5) {
        const int r32 = lane & 31, hi = lane >> 5;
        const int col = (wave < 4) ? hd * 64 + (wave & 1) * 32 + r32 : hd * 64 + half * 32 + r32;
        const int ns = (wave < 4) ? 4 : 8;
        const float* wup = F.in[IN_WUP]; const float* aup = F.in[IN_AUP]; const float* gup = F.in[IN_GUP];
        for (int s = 0; s < ns; ++s) { float f[8];
            if (wave < 2) {
#pragma unroll
                for (int jj = 0; jj < 8; ++jj) f[jj] = wup[(size_t)(16 * s + 8 * hi + jj) * 512 + col];
            } else if (wave < 4) {
#pragma unroll
                for (int jj = 0; jj < 8; ++jj) f[jj] = aup[(size_t)(16 * s + 8 * hi + jj) * 512 + col];
            } else {
#pragma unroll
                for (int jj = 0; jj < 8; ++jj) f[jj] = gup[(size_t)(16 * s + 8 * hi + jj) * 512 + col];
            }
            *(LAS v4u*)(L + L_BF + ((wave < 4 ? wave * 4 : 16) + s) * 1024 + lane * 16) = (v4u){pk2(f[0], f[1]), pk2(f[2], f[3]), pk2(f[4], f[5]), pk2(f[6], f[7])}; }
    }
    long raw_off[2];
#pragma unroll
    for (int i = 0; i < 2; ++i) { int q = 64 * (wave + 8 * i) + lane; if (q > 791) q = 791; const int row = q / 24, cc = q % 24; raw_off[i] = (long)(row - 1) * RC + (cc >> 3) * 512 + hd * 64 + (cc & 7) * 8; }
    const size_t mrow0 = (size_t)b * SEQ;
#define SCAN_DMA(c) do { const size_t m0_ = mrow0 + (size_t)(c) * TC; \
        _Pragma("unroll") for (int i_ = 0; i_ < 2; ++i_) { const int p_ = wave + 8 * i_; if (p_ < 13) { long o_ = raw_off[i_]; if ((c) == 0 && o_ < 0) o_ += RC; \
            attn_body::glds16(PR + m0_ * RC + o_, (unsigned)__builtin_amdgcn_readfirstlane(lds0 + L_RAW + p_ * 1024)); } } \
        _Pragma("unroll") for (int i_ = 0; i_ < 2; ++i_) { const int p_ = wave + 8 * i_; \
            attn_body::glds16(AL + (m0_ + 2 * p_) * 256 + lane * 8, (unsigned)__builtin_amdgcn_readfirstlane(lds0 + L_AL + p_ * 1056)); } } while (0)
#define STORE_Y(c) do { const int st_ = tid >> 4, v2_ = (tid & 15) * 2; const f32x2 y2_ = *(const LAS f32x2*)(L + L_YB + ((c) & 1) * 4096 + (st_ * 32 + v2_) * 4); \
        *(GAS f32x2*)(Y + (mrow0 + (size_t)(c) * TC + st_) * 512 + hd * 64 + half * 32 + v2_) = y2_; } while (0)
    f32x2 S01 = (f32x2){0.f, 0.f}, S23 = (f32x2){0.f, 0.f};
    const int vloc = 4 * wave + (lane >> 4), ks = lane & 15;
    SCAN_DMA(0);
    for (int c = 0; c < SEQ / TC; ++c) {
        asm volatile("s_waitcnt vmcnt(0)" ::: "memory"); __syncthreads();
        float rs[4], ksv[4], vs[4], rn;
#if defined(MK_PROBE_S2)
        for (int prep = 0; prep < 2; ++prep) {
#endif
        {
            const bool first = (c == 0 && et == 0);
            const LAS unsigned char* rowc = L + L_RAW + (et + 1) * 384; const LAS unsigned char* rowp = L + L_RAW + et * 384;
            const v2u rc = *(const LAS v2u*)(rowc + cg * 8), rp = *(const LAS v2u*)(rowp + cg * 8);
            const v2u kc = *(const LAS v2u*)(rowc + 128 + cg * 8), kp = *(const LAS v2u*)(rowp + 128 + cg * 8);
            const int vo = 256 + (half * 32 + 4 * (cg & 7)) * 2;
            const v2u vc = *(const LAS v2u*)(rowc + vo), vp = *(const LAS v2u*)(rowp + vo);
#define SH4(dst, cu, pr, mu) do { const float c0 = __uint_as_float(cu.x << 16), c1 = __uint_as_float(cu.x & 0xffff0000u), c2 = __uint_as_float(cu.y << 16), c3 = __uint_as_float(cu.y & 0xffff0000u); \
            const float p0 = first ? 0.f : __uint_as_float(pr.x << 16), p1 = first ? 0.f : __uint_as_float(pr.x & 0xffff0000u), p2 = first ? 0.f : __uint_as_float(pr.y << 16), p3 = first ? 0.f : __uint_as_float(pr.y & 0xffff0000u); \
            dst[0] = c0 + (p0 - c0) * mu[0]; dst[1] = c1 + (p1 - c1) * mu[1]; dst[2] = c2 + (p2 - c2) * mu[2]; dst[3] = c3 + (p3 - c3) * mu[3]; } while (0)
            SH4(rs, rc, rp, mu_r); SH4(ksv, kc, kp, mu_k); SH4(vs, vc, vp, mu_v);
#undef SH4
            float q = 0.f;
#pragma unroll
            for (int i = 0; i < 4; ++i) { const float u = ksv[i] * kkc[i]; q += u * u; }
            q = allsum16(q); rn = __builtin_amdgcn_rsqf(fmaxf(q, 1e-24f));
            LAS unsigned char* rec = L + L_REC + et * RECB;
            *(LAS h16x4*)(rec + cg * KSB) = (h16x4){(_Float16)rs[0], (_Float16)rs[1], (_Float16)rs[2], (_Float16)rs[3]};
            if (cg < 8) *(LAS f32x4*)(rec + 16 * KSB + cg * 16) = (f32x4){vs[0], vs[1], vs[2], vs[3]};
        }
        if (wave < 5) {
            const int r32 = lane & 31, hi = lane >> 5;
            const LAS unsigned char* arow = L + L_AL + (r32 >> 1) * 1056 + (r32 & 1) * 512 + hi * 16;
            const int colb = (wave < 2) ? 0 : (wave < 4) ? 128 : 256;
            const LAS unsigned char* bfr = L + L_BF + (wave < 4 ? wave * 4 : 16) * 1024 + lane * 16;
            f32x16 acc = f32x16{};
            if (wave < 4) {
#pragma unroll
                for (int s = 0; s < 4; ++s) acc = __builtin_amdgcn_mfma_f32_32x32x16_bf16(*(const LAS bf16x8*)(arow + colb + 32 * s), *(const LAS bf16x8*)(bfr + s * 1024), acc, 0, 0, 0);
            } else {
#pragma unroll
                for (int s = 0; s < 8; ++s) acc = __builtin_amdgcn_mfma_f32_32x32x16_bf16(*(const LAS bf16x8*)(arow + colb + 32 * s), *(const LAS bf16x8*)(bfr + s * 1024), acc, 0, 0, 0);
            }
            LAS float* dst = (wave < 2) ? (LAS float*)(L + L_WL) + (wave & 1) * 32 + r32 : (wave < 4) ? (LAS float*)(L + L_AV) + (wave & 1) * 32 + r32 : (LAS float*)(L + L_GV) + r32;
            const int pitch = (wave < 4) ? 64 : 32;
#pragma unroll
            for (int r = 0; r < 16; ++r) { const int t = (r & 3) + 8 * (r >> 2) + 4 * hi; dst[t * pitch] = acc[r]; }
        }
        __syncthreads();
        {
            const f32x4 wl = *(const LAS f32x4*)(L + L_WL + (et * 64 + 4 * cg) * 4), al = *(const LAS f32x4*)(L + L_AV + (et * 64 + 4 * cg) * 4);
            float kp[4], nk[4], bb[4], dec[4], rk = 0.f;
#pragma unroll
            for (int i = 0; i < 4; ++i) {
                const float z = -(wl[i] + w0c[i]); const float sp = fmaxf(z, 0.f) + __logf(1.0f + __expf(-fabsf(z)));
                dec[i] = __expf(-__expf(-sp - 0.5f));
                const float a = __builtin_amdgcn_rcpf(1.0f + __expf(-(al[i] + a0c[i])));
                const float kn = ksv[i] * kkc[i] * rn; nk[i] = -kn; bb[i] = kn * a; kp[i] = ksv[i] * (1.0f + (a - 1.0f) * kac[i]); rk += rs[i] * kp[i] * rkc[i]; }
            rk = allsum16(rk);
            LAS unsigned char* rec = L + L_REC + et * RECB + cg * KSB;
            *(LAS h16x4*)(rec + 8) = (h16x4){(_Float16)nk[0], (_Float16)nk[1], (_Float16)nk[2], (_Float16)nk[3]};
            *(LAS f32x4*)(rec + 16) = (f32x4){dec[0], dec[1], dec[2], dec[3]};
            *(LAS f32x4*)(rec + 32) = (f32x4){bb[0], bb[1], bb[2], bb[3]};
            *(LAS f32x4*)(rec + 48) = (f32x4){kp[0], kp[1], kp[2], kp[3]};
            if (cg < 8) {
                const f32x4 g4 = *(const LAS f32x4*)(L + L_GV + (et * 32 + 4 * cg) * 4);
                float zz[4], gg[4];
#pragma unroll
                for (int i = 0; i < 4; ++i) { zz[i] = (lnb[i] + rk * vs[i]) * g4[i]; gg[i] = g4[i] * lng[i]; }
                const size_t o = (mrow0 + (size_t)c * TC + et) * 512 + vch;
                *(GAS v2u*)(Z + o) = (v2u){pk2(zz[0], zz[1]), pk2(zz[2], zz[3])};
                *(GAS v2u*)(GG + o) = (v2u){pk2(gg[0], gg[1]), pk2(gg[2], gg[3])};
            }
        }
        if (c > 0) STORE_Y(c - 1);
        __syncthreads();
#if defined(MK_PROBE_S2)
        }
#endif
        if (c + 1 < SEQ / TC) SCAN_DMA(c + 1);
        {
            const LAS unsigned char* rec = L + L_REC + ks * KSB; const LAS unsigned char* vrow = L + L_REC + 16 * KSB + vloc * 4;
            const unsigned ybase = L_YB + (c & 1) * 4096, ydump = L_YB + 8192 + lane * 4;
            v4u ra[3]; f32x4 rw[3], rb[3], rk4[3]; float rv[3];
            const unsigned recA = (unsigned)(L_REC + ks * KSB), vrowA = (unsigned)(L_REC + 16 * KSB + vloc * 4);
#define LOADREC(q_, st_) asm volatile("ds_read_b128 %0, %5 offset:%c7\n\tds_read_b128 %1, %5 offset:%c8\n\tds_read_b128 %2, %5 offset:%c9\n\tds_read_b128 %3, %5 offset:%c10\n\tds_read_b32 %4, %6 offset:%c7" \
                : "=&v"(ra[q_]), "=&v"(rw[q_]), "=&v"(rb[q_]), "=&v"(rk4[q_]), "=&v"(rv[q_]) : "v"(recA), "v"(vrowA), "i"((st_) * RECB), "i"((st_) * RECB + 16), "i"((st_) * RECB + 32), "i"((st_) * RECB + 48) : "memory")
#define WAITREC(q_, n_) asm volatile("s_waitcnt lgkmcnt(" #n_ ")" : "+v"(ra[q_]), "+v"(rw[q_]), "+v"(rb[q_]), "+v"(rk4[q_]), "+v"(rv[q_]) :: "memory")
#if defined(MK_PROBE_S1)
            const f32x2 sv01 = S01, sv23 = S23;
            for (int prep = 0; prep < 2; ++prep) { if (prep == 1) { S01 = sv01; S23 = sv23; }
#endif
            asm volatile("s_waitcnt lgkmcnt(0)" ::: "memory");
            LOADREC(0, 0); LOADREC(1, 1); WAITREC(0, 5);
            float y4 = 0.f;
#define STEP(st) do { \
                if ((st) + 2 < TC) { LOADREC(((st) + 2) % 3, (st) + 2); WAITREC(((st) + 1) % 3, 5); } else if ((st) + 1 < TC) { WAITREC(((st) + 1) % 3, 0); } \
                const v4u ca = ra[(st) % 3]; const f32x4 cw = rw[(st) % 3], cb = rb[(st) % 3], ck = rk4[(st) % 3]; const float vv = rv[(st) % 3]; \
                float p1 = fmix_lo0(S01[0], ca[2]); p1 = fmix_hi(S01[1], ca[2], p1); p1 = fmix_lo(S23[0], ca[3], p1); p1 = fmix_hi_nop(S23[1], ca[3], p1); \
                const float sa = allsum16(p1); \
                { const f32x2 vv2 = (f32x2){vv, vv}, sa2 = (f32x2){sa, sa}; \
                  f32x2 t01 = vv2 * (f32x2){ck[0], ck[1]}, t23 = vv2 * (f32x2){ck[2], ck[3]}; \
                  t01 = __builtin_elementwise_fma(sa2, (f32x2){cb[0], cb[1]}, t01); t23 = __builtin_elementwise_fma(sa2, (f32x2){cb[2], cb[3]}, t23); \
                  S01 = __builtin_elementwise_fma(S01, (f32x2){cw[0], cw[1]}, t01); S23 = __builtin_elementwise_fma(S23, (f32x2){cw[2], cw[3]}, t23); } \
                float p2 = fmix_lo0(S01[0], ca[0]); p2 = fmix_hi(S01[1], ca[0], p2); p2 = fmix_lo(S23[0], ca[1], p2); p2 = fmix_hi_nop(S23[1], ca[1], p2); \
                const float yv = allsum16(p2); \
                y4 = (ks == ((st) & 3)) ? yv : y4; \
                if (((st) & 3) == 3) { const unsigned ya = (ks < 4) ? (unsigned)(ybase + ((((st) & ~3) + ks) * 32 + vloc) * 4) : ydump; *(LAS float*)(L + ya) = y4; } \
            } while (0)
#define STEP4(b_) STEP(b_); STEP((b_) + 1); STEP((b_) + 2); STEP((b_) + 3)
            STEP4(0); STEP4(4); STEP4(8); STEP4(12); STEP4(16); STEP4(20); STEP4(24); STEP4(28);
#undef STEP4
#undef STEP
#undef WAITREC
#if defined(MK_PROBE_S1)
            }
#endif
#undef LOADREC
        }
    }
    __syncthreads();
    STORE_Y(SEQ / TC - 1);
    asm volatile("s_waitcnt vmcnt(0)" ::: "memory"); __syncthreads();
#undef SCAN_DMA
#undef STORE_Y
}
}
static_assert(scan::L_END <= LDSCTL_OFF, "scan LDS");

__device__ __forceinline__ void r2_post(Frame& F) {
    const bf16* Y = (const bf16*)((unsigned char*)F.out + OUT_Y); const bf16* GG = (const bf16*)((unsigned char*)F.out + OUT_GG); const bf16* Z = (const bf16*)((unsigned char*)F.out + OUT_Z);
    bf16* MIX = (bf16*)(F.ws + WS_MIX);
    const int gw = (F.vcu >> 4) * SEQ + (F.vcu & 15) * NWAVES + F.wave, NGW = 16 * NWAVES, mend = ((F.vcu >> 4) + 1) * SEQ;
    v4u ny, ng, nz;
    { const size_t o = (size_t)gw * 512 + 8 * F.lane; ny = *(const GAS v4u*)(Y + o); ng = *(const GAS v4u*)(GG + o); nz = *(const GAS v4u*)(Z + o); }
    for (int m = gw; m < mend; m += NGW) {
        const v4u yq = ny, g = ng, z = nz;
        if (m + NGW < mend) { const size_t o = (size_t)(m + NGW) * 512 + 8 * F.lane; ny = *(const GAS v4u*)(Y + o); ng = *(const GAS v4u*)(GG + o); nz = *(const GAS v4u*)(Z + o); }
        float yv[8];
#pragma unroll
        for (int i = 0; i < 4; ++i) { yv[2 * i] = __uint_as_float(yq[i] << 16); yv[2 * i + 1] = __uint_as_float(yq[i] & 0xffff0000u); }
        float s = ((yv[0] + yv[1]) + (yv[2] + yv[3])) + ((yv[4] + yv[5]) + (yv[6] + yv[7]));
        s += __int_as_float(__builtin_amdgcn_update_dpp(0, __float_as_int(s), 0xB1, 0xf, 0xf, false));
        s += __int_as_float(__builtin_amdgcn_update_dpp(0, __float_as_int(s), 0x4E, 0xf, 0xf, false));
        s += __int_as_float(__builtin_amdgcn_update_dpp(0, __float_as_int(s), 0x141, 0xf, 0xf, false));
        const float mean = s * (1.f / 64.f);
        float q = 0.f;
#pragma unroll
        for (int i = 0; i < 8; ++i) { yv[i] -= mean; q += yv[i] * yv[i]; }
        q += __int_as_float(__builtin_amdgcn_update_dpp(0, __float_as_int(q), 0xB1, 0xf, 0xf, false));
        q += __int_as_float(__builtin_amdgcn_update_dpp(0, __float_as_int(q), 0x4E, 0xf, 0xf, false));
        q += __int_as_float(__builtin_amdgcn_update_dpp(0, __float_as_int(q), 0x141, 0xf, 0xf, false));
        const float rstd = __builtin_amdgcn_rsqf(q * (1.f / 64.f) + 64e-5f);
        unsigned ow[4];
#pragma unroll
        for (int i = 0; i < 4; ++i) ow[i] = attn_body::cvtpk_s(yv[2 * i] * rstd * __uint_as_float(g[i] << 16) + __uint_as_float(z[i] << 16), yv[2 * i + 1] * rstd * __uint_as_float(g[i] & 0xffff0000u) + __uint_as_float(z[i] & 0xffff0000u));
        *(GAS v4u*)(MIX + (size_t)m * 1024 + 8 * F.lane) = (v4u){ow[0], ow[1], ow[2], ow[3]};
    }
}

namespace scan2 {
using scan::allsum16; using scan::f32x16; using scan::TC;
typedef unsigned short u16;
constexpr size_t WS_QPH = 488 * MiB, WS_GT = 840 * MiB, WS_VT = 136 * MiB, WS_QPH_ODD = 984 * MiB, OUT_QPH_ODD = 64 * MiB;
constexpr int S64 = 144, S32 = 80;
constexpr int QPH_B = 12288, GT_B = 9216, VT_B = 6144, O_PM = 32 * S64, O_HT = O_PM + 32 * S32;
constexpr int B_RAW = 0, B_AL = 13312, B_BF = B_AL + 16 * 1056;
constexpr int B_WL = B_BF + 32768, B_AV = B_WL + 8192, B_GV = B_AV + 8192, B_EE = B_GV + 8192;
constexpr int B_OUT = B_WL, O_VT = 0, O_QPH = VT_B, O_GT = VT_B + QPH_B;
constexpr int B_ALP = B_EE + 8192, B_ALPT = B_ALP + 32 * S64, B_BET = B_ALPT + 64 * S32, B_BETT = B_BET + 32 * S64, B_KAP = B_BETT + 64 * S32, B_RHO = B_KAP + 32 * S64;
constexpr int B_GL = B_RHO + 32 * S64, B_PW0 = B_GL + 256, B_PW1 = B_PW0 + 2 * 32 * S32, B_PL = B_PW1 + 2 * 32 * S32, B_TL = B_PL + 32 * S32, B_AAKT = B_TL + 32 * S32;
constexpr int B_KAPT = B_AAKT + 32 * S32, B_VSL = B_KAPT + 64 * S32, B_ARB = B_VSL + 32 * S64, B_WMT = B_ARB + 32 * S32, B_UMT = B_WMT + 64 * S32, B_END = B_UMT + 32 * S32;
static_assert(B_END <= LDSCTL_OFF && VT_B + QPH_B + GT_B <= 32768, "scan2 build LDS");
__device__ __forceinline__ u16 f2h(float f) { return (u16)(attn_body::cvtpk_s(f, 0.f) & 0xffffu); }
__device__ __forceinline__ int crow(int r, int hi) { return (r & 3) + 8 * (r >> 2) + 4 * hi; }
__device__ __forceinline__ void tile_nt(f32x16& acc, const LAS unsigned char* A, int lda, int arow0, const LAS unsigned char* Bt, int ldb, int brow0, int ksteps, int lane) {
    const int r32 = lane & 31, hi = lane >> 5;
    const LAS unsigned char* ap = A + (arow0 + r32) * lda + hi * 16; const LAS unsigned char* bp = Bt + (brow0 + r32) * ldb + hi * 16;
    for (int s = 0; s < ksteps; ++s) acc = __builtin_amdgcn_mfma_f32_32x32x16_bf16(*(const LAS bf16x8*)(ap + 32 * s), *(const LAS bf16x8*)(bp + 32 * s), acc, 0, 0, 0);
}
#define LBAR() asm volatile("s_waitcnt lgkmcnt(0)\n\ts_barrier" ::: "memory")
#define ST16_(base, off, val) (*(LAS unsigned short*)((base) + (off)) = (unsigned short)(attn_body::cvtpk_s((val), 0.f) & 0xffffu))
__device__ __forceinline__ int crow_(int r, int hi) { return (r & 3) + 8 * (r >> 2) + 4 * hi; }
__device__ __forceinline__ void store_tr(LAS unsigned char* img, int stride, int ncol0, const f32x16& a, int lane) {
    LAS unsigned char* p = img + (ncol0 + (lane & 31)) * 2; const int hi = lane >> 5;
#pragma unroll
    for (int r = 0; r < 16; ++r) ST16_(p, crow_(r, hi) * stride, a[r]);
}
#define ST16(base, off, val) (*(LAS u16*)((base) + (off)) = f2h(val))
__device__ __forceinline__ void store_nat(LAS unsigned char* img, int stride, int nrow0, const f32x16& a, int lane, int mcol0 = 0) {
    LAS unsigned char* p = img + (nrow0 + (lane & 31)) * stride + (mcol0 + 4 * (lane >> 5)) * 2;
#pragma unroll
    for (int g = 0; g < 4; ++g) *(LAS v2u*)(p + 16 * g) = (v2u){attn_body::cvtpk_s(a[4 * g], a[4 * g + 1]), attn_body::cvtpk_s(a[4 * g + 2], a[4 * g + 3])};
}

__device__ __forceinline__ unsigned char* vt_home(const Frame& F, int b, int hd) { return F.ws + WS_VT + (size_t)b * (8 * MiB) + (size_t)hd * 128 * VT_B; }
__device__ __forceinline__ unsigned char* qph_home(const Frame& F, int b, int hd) {
    unsigned char* base = (b & 1) ? (((b >> 1) < 5) ? (unsigned char*)F.out + OUT_QPH_ODD + (size_t)(b >> 1) * (12 * MiB) : F.ws + WS_QPH_ODD + (size_t)((b >> 1) - 5) * (12 * MiB)) : F.ws + WS_QPH + (size_t)b * (12 * MiB);
    return base + (size_t)hd * 128 * QPH_B; }
__device__ __forceinline__ void build(Frame& F) {
    const int tid = F.tid, lane = F.lane, wave = F.wave;
    const int bh = F.vcu >> 1, hd = bh & 7, b = bh >> 3, c0 = (F.vcu & 1) * 64;
    LAS unsigned char* L = F.lds;
    const unsigned lds0 = (unsigned)(uintptr_t)(unsigned char*)F.lds;
    const bf16* PR = (const bf16*)(F.ws + WS_PR); const bf16* AL = (const bf16*)(F.ws + WS_ALORA);
    bf16* GG = (bf16*)((unsigned char*)F.out + OUT_GG); bf16* Z = (bf16*)((unsigned char*)F.out + OUT_Z);
    const int et = tid >> 4, cg = tid & 15, chb = hd * 64 + 4 * cg;
    float mu_r[4], mu_k[4], mu_v[4], kkc[4], kac[4], rkc[4], lng[4], lnb[4], w0c[4], a0c[4];
#pragma unroll
    for (int i = 0; i < 4; ++i) { mu_r[i] = F.in[IN_MU][chb + i]; mu_k[i] = F.in[IN_MU][512 + chb + i]; mu_v[i] = F.in[IN_MU][1024 + chb + i]; kkc[i] = F.in[IN_KK][chb + i]; kac[i] = F.in[IN_KA][chb + i]; rkc[i] = F.in[IN_RK][chb + i];
        w0c[i] = F.in[IN_W0][chb + i]; a0c[i] = F.in[IN_A0][chb + i]; lng[i] = F.in[IN_LNG][chb + i]; lnb[i] = F.in[IN_LNB][chb + i]; }
    if (wave < 6) {
        const int r32 = lane & 31, hi = lane >> 5, col = hd * 64 + (wave & 1) * 32 + r32, ns = (wave < 4) ? 4 : 8;
        const float* wup = F.in[IN_WUP]; const float* aup = F.in[IN_AUP]; const float* gup = F.in[IN_GUP];
        for (int s = 0; s < ns; ++s) { float f[8];
            if (wave < 2) {
#pragma unroll
                for (int jj = 0; jj < 8; ++jj) f[jj] = wup[(size_t)(16 * s + 8 * hi + jj) * 512 + col];
            } else if (wave < 4) {
#pragma unroll
                for (int jj = 0; jj < 8; ++jj) f[jj] = aup[(size_t)(16 * s + 8 * hi + jj) * 512 + col];
            } else {
#pragma unroll
                for (int jj = 0; jj < 8; ++jj) f[jj] = gup[(size_t)(16 * s + 8 * hi + jj) * 512 + col];
            }
            *(LAS v4u*)(L + B_BF + ((wave < 4 ? wave * 4 : 16 + (wave - 4) * 8) + s) * 1024 + lane * 16) = (v4u){pk2(f[0], f[1]), pk2(f[2], f[3]), pk2(f[4], f[5]), pk2(f[6], f[7])}; }
    }
    long raw_off[2];
#pragma unroll
    for (int i = 0; i < 2; ++i) { int q = 64 * (wave + 8 * i) + lane; if (q > 791) q = 791; const int row = q / 24, cc = q % 24; raw_off[i] = (long)(row - 1) * RC + (cc >> 3) * 512 + hd * 64 + (cc & 7) * 8; }
    const size_t mrow0 = (size_t)b * SEQ;
#define B_DMA(c) do { const size_t m0_ = mrow0 + (size_t)(c) * TC; \
        _Pragma("unroll") for (int i_ = 0; i_ < 2; ++i_) { const int p_ = wave + 8 * i_; if (p_ < 13) { long o_ = raw_off[i_]; if ((c) == 0 && o_ < 0) o_ += RC; \
            attn_body::glds16(PR + m0_ * RC + o_, (unsigned)__builtin_amdgcn_readfirstlane(lds0 + B_RAW + p_ * 1024)); } } \
        _Pragma("unroll") for (int i_ = 0; i_ < 2; ++i_) { const int p_ = wave + 8 * i_; \
            attn_body::glds16(AL + (m0_ + 2 * p_) * 256 + lane * 8, (unsigned)__builtin_amdgcn_readfirstlane(lds0 + B_AL + p_ * 1056)); } } while (0)
#define B_COPYOUT(cc) do { const size_t u_ = (size_t)bh * 128 + (cc); \
        for (int q_ = tid; q_ < 1728; q_ += 512) { const v4u v_ = *(const LAS v4u*)(L + B_OUT + q_ * 16); \
            unsigned char* d_ = (q_ < 384) ? vt_home(F, b, hd) + (size_t)(cc) * VT_B + (size_t)q_ * 16 : (q_ < 1152) ? qph_home(F, b, hd) + (size_t)(cc) * QPH_B + (size_t)(q_ - 384) * 16 : F.ws + WS_GT + u_ * GT_B + (size_t)(q_ - 1152) * 16; \
            *(GAS v4u*)d_ = v_; } } while (0)
#if defined(MK_TSTAGE)
    unsigned long long ts_acc = 0ull, ts_start = 0ull; bool ts_on = false;
#define TS(p) do { const unsigned long long now_ = __builtin_amdgcn_s_memrealtime(); if ((p) == (MK_TSTAGE + 1) % 8 && ts_on) { ts_acc += now_ - ts_start; ts_on = false; } if ((p) == MK_TSTAGE) { ts_start = now_; ts_on = true; } } while (0)
#else
#define TS(p) do {} while (0)
#endif
    B_DMA(c0);
    for (int ci = 0; ci < 64; ++ci) {
        const int c = c0 + ci;
        asm volatile("s_waitcnt vmcnt(0) lgkmcnt(0)\n\ts_barrier" ::: "memory"); TS(0);
        if (ci > 0) B_COPYOUT(c - 1);
        float rs[4], ksv[4], vs[4], rn;
        {
            const bool first = (c == 0 && et == 0);
            const LAS unsigned char* rowc = L + B_RAW + (et + 1) * 384; const LAS unsigned char* rowp = L + B_RAW + et * 384;
            const v2u rc = *(const LAS v2u*)(rowc + cg * 8), rp = *(const LAS v2u*)(rowp + cg * 8);
            const v2u kc = *(const LAS v2u*)(rowc + 128 + cg * 8), kp = *(const LAS v2u*)(rowp + 128 + cg * 8);
            const v2u vc = *(const LAS v2u*)(rowc + 256 + cg * 8), vp = *(const LAS v2u*)(rowp + 256 + cg * 8);
#define SH4(dst, cu, pr, mu) do { const float c0_ = __uint_as_float(cu.x << 16), c1_ = __uint_as_float(cu.x & 0xffff0000u), c2_ = __uint_as_float(cu.y << 16), c3_ = __uint_as_float(cu.y & 0xffff0000u); \
            const float p0_ = first ? 0.f : __uint_as_float(pr.x << 16), p1_ = first ? 0.f : __uint_as_float(pr.x & 0xffff0000u), p2_ = first ? 0.f : __uint_as_float(pr.y << 16), p3_ = first ? 0.f : __uint_as_float(pr.y & 0xffff0000u); \
            dst[0] = c0_ + (p0_ - c0_) * mu[0]; dst[1] = c1_ + (p1_ - c1_) * mu[1]; dst[2] = c2_ + (p2_ - c2_) * mu[2]; dst[3] = c3_ + (p3_ - c3_) * mu[3]; } while (0)
            SH4(rs, rc, rp, mu_r); SH4(ksv, kc, kp, mu_k); SH4(vs, vc, vp, mu_v);
#undef SH4
            float q = 0.f;
#pragma unroll
            for (int i = 0; i < 4; ++i) { const float u = ksv[i] * kkc[i]; q += u * u; }
            q = allsum16(q); rn = __builtin_amdgcn_rsqf(fmaxf(q, 1e-24f));
        }
        LBAR(); TS(1);
        if (wave < 6) {
            int l2 = lane; asm volatile("" : "+v"(l2)); const int r32 = l2 & 31, hi = l2 >> 5;
            const LAS unsigned char* arow = L + B_AL + (r32 >> 1) * 1056 + (r32 & 1) * 512 + hi * 16;
            const int colb = (wave < 2) ? 0 : (wave < 4) ? 128 : 256;
            const LAS unsigned char* bfr = L + B_BF + (wave < 4 ? wave * 4 : 16 + (wave - 4) * 8) * 1024 + lane * 16;
            f32x16 acc = f32x16{};
            if (wave < 4) {
#pragma unroll
                for (int s = 0; s < 4; ++s) acc = __builtin_amdgcn_mfma_f32_32x32x16_bf16(*(const LAS bf16x8*)(arow + colb + 32 * s), *(const LAS bf16x8*)(bfr + s * 1024), acc, 0, 0, 0);
            } else {
#pragma unroll
                for (int s = 0; s < 8; ++s) acc = __builtin_amdgcn_mfma_f32_32x32x16_bf16(*(const LAS bf16x8*)(arow + colb + 32 * s), *(const LAS bf16x8*)(bfr + s * 1024), acc, 0, 0, 0);
            }
            LAS float* dst = (LAS float*)(L + ((wave < 2) ? B_WL : (wave < 4) ? B_AV : B_GV)) + (wave & 1) * 32 + r32;
#pragma unroll
            for (int r = 0; r < 16; ++r) dst[crow(r, hi) * 64] = acc[r];
        }
        LBAR(); TS(2);
        if (ci + 1 < 64) B_DMA(c + 1);
        float ee[4], kn[4], bb[4], kp4[4];
        f32x4 E;
        {
            const f32x4 wl = *(const LAS f32x4*)(L + B_WL + (et * 64 + 4 * cg) * 4), al = *(const LAS f32x4*)(L + B_AV + (et * 64 + 4 * cg) * 4), g4 = *(const LAS f32x4*)(L + B_GV + (et * 64 + 4 * cg) * 4);
            float rk = 0.f;
#pragma unroll
            for (int i = 0; i < 4; ++i) {
                ee[i] = 0.6065306597f * __builtin_amdgcn_rcpf(1.0f + __expf(-(wl[i] + w0c[i])));
                const float a = __builtin_amdgcn_rcpf(1.0f + __expf(-(al[i] + a0c[i])));
                kn[i] = ksv[i] * kkc[i] * rn; bb[i] = kn[i] * a; kp4[i] = ksv[i] * (1.0f + (a - 1.0f) * kac[i]); rk += rs[i] * kp4[i] * rkc[i]; }
            rk = allsum16(rk);
            float zz[4], gg[4];
#pragma unroll
            for (int i = 0; i < 4; ++i) { zz[i] = (lnb[i] + rk * vs[i]) * g4[i]; gg[i] = g4[i] * lng[i]; }
            const size_t o = (mrow0 + (size_t)c * TC + et) * 512 + chb;
            *(GAS v2u*)(Z + o) = (v2u){attn_body::cvtpk_s(zz[0], zz[1]), attn_body::cvtpk_s(zz[2], zz[3])};
            *(GAS v2u*)(GG + o) = (v2u){attn_body::cvtpk_s(gg[0], gg[1]), attn_body::cvtpk_s(gg[2], gg[3])};
#pragma unroll
            for (int i = 0; i < 4; ++i) { float p = ee[i]; const float t1 = __shfl_up(p, 16); if (lane >= 16) p += t1;
                auto rr = __builtin_amdgcn_permlane32_swap(__float_as_uint(p), __float_as_uint(p), false, false); if (lane >= 32) p += __uint_as_float(rr[0]);
                E[i] = p; }
            if (lane >= 48) *(LAS f32x4*)(L + B_EE + (wave * 16 + cg) * 16) = E;
        }
        LBAR(); TS(3);
        {
#pragma unroll
            for (int w = 0; w < 7; ++w) { const f32x4 tw = *(const LAS f32x4*)(L + B_EE + (w * 16 + cg) * 16); if (w < wave) E += tw; }
            float al_[4], be_[4], ka_[4], rh_[4];
#pragma unroll
            for (int i = 0; i < 4; ++i) { const float gt = __expf(-E[i]), gp = __expf(-(E[i] - ee[i])), ig = __expf(E[i]);
                al_[i] = gp * kn[i]; be_[i] = bb[i] * ig; ka_[i] = kp4[i] * ig; rh_[i] = gt * rs[i];
                if (et == 31) *(LAS float*)(L + B_GL + (4 * cg + i) * 4) = gt; }
            *(LAS v2u*)(L + B_ALP + et * S64 + cg * 8) = (v2u){attn_body::cvtpk_s(al_[0], al_[1]), attn_body::cvtpk_s(al_[2], al_[3])};
            *(LAS v2u*)(L + B_BET + et * S64 + cg * 8) = (v2u){attn_body::cvtpk_s(be_[0], be_[1]), attn_body::cvtpk_s(be_[2], be_[3])};
            *(LAS v2u*)(L + B_KAP + et * S64 + cg * 8) = (v2u){attn_body::cvtpk_s(ka_[0], ka_[1]), attn_body::cvtpk_s(ka_[2], ka_[3])};
            *(LAS v2u*)(L + B_RHO + et * S64 + cg * 8) = (v2u){attn_body::cvtpk_s(rh_[0], rh_[1]), attn_body::cvtpk_s(rh_[2], rh_[3])};
            *(LAS v2u*)(L + B_VSL + et * S64 + cg * 8) = (v2u){attn_body::cvtpk_s(vs[0], vs[1]), attn_body::cvtpk_s(vs[2], vs[3])};
        }
        LBAR(); TS(4);
        {
            const int mtx = tid >> 7, cb = (tid >> 3) & 15, tb = tid & 7;
            const LAS unsigned char* src = L + ((mtx == 0) ? B_ALP : (mtx == 1) ? B_BET : (mtx == 2) ? B_KAP : B_VSL) + (4 * tb) * S64 + cb * 8;
            const v2u r0 = *(const LAS v2u*)(src), r1 = *(const LAS v2u*)(src + S64), r2 = *(const LAS v2u*)(src + 2 * S64), r3 = *(const LAS v2u*)(src + 3 * S64);
            LAS unsigned char* dst = (mtx == 3) ? L + B_OUT + O_VT + (cb >> 3) * 3072 + (4 * (cb & 7)) * S32 + tb * 8 : L + ((mtx == 0) ? B_ALPT : (mtx == 1) ? B_BETT : B_KAPT) + (4 * cb) * S32 + tb * 8;
            *(LAS v2u*)(dst)           = (v2u){(r0.x & 0xffffu) | (r1.x << 16), (r2.x & 0xffffu) | (r3.x << 16)};
            *(LAS v2u*)(dst + S32)     = (v2u){(r0.x >> 16) | (r1.x & 0xffff0000u), (r2.x >> 16) | (r3.x & 0xffff0000u)};
            *(LAS v2u*)(dst + 2 * S32) = (v2u){(r0.y & 0xffffu) | (r1.y << 16), (r2.y & 0xffffu) | (r3.y << 16)};
            *(LAS v2u*)(dst + 3 * S32) = (v2u){(r0.y >> 16) | (r1.y & 0xffff0000u), (r2.y >> 16) | (r3.y & 0xffff0000u)};
        }
        LBAR(); TS(5);
        int ln = lane; asm volatile("" : "+v"(ln));
        f32x16 X = f32x16{}, RK = f32x16{};
        {
            const int r32 = ln & 31, hi = ln >> 5;
            if (wave == 0) { f32x16 acc = f32x16{}; tile_nt(acc, L + B_ALP, S64, 0, L + B_BET, S64, 0, 4, ln);
#pragma unroll
                for (int r = 0; r < 16; ++r) acc[r] = (crow(r, hi) > r32) ? -acc[r] : 0.f;
                store_nat(L + B_PW0 + 32 * S32, S32, 0, acc, ln);
            } else if (wave == 4) { f32x16 acc = f32x16{}; tile_nt(acc, L + B_BET, S64, 0, L + B_ALP, S64, 0, 4, ln);
#pragma unroll
                for (int r = 0; r < 16; ++r) acc[r] = (r32 > crow(r, hi)) ? -acc[r] : 0.f;
                store_nat(L + B_PW0, S32, 0, acc, ln);
            } else if (wave == 1) { tile_nt(X, L + B_ALP, S64, 0, L + B_KAP, S64, 0, 4, ln);
#pragma unroll
                for (int r = 0; r < 16; ++r) X[r] = (crow(r, hi) > r32) ? X[r] : 0.f;
            } else if (wave == 2 || wave == 3) {
                const LAS unsigned char* ap = L + B_ALPT + ((wave - 2) * 32 + r32) * S32 + 8 * hi;
#pragma unroll
                for (int g4 = 0; g4 < 4; ++g4) { const v2u t2 = *(const LAS v2u*)(ap + 16 * g4);
                    X[4 * g4] = __uint_as_float(t2.x << 16); X[4 * g4 + 1] = __uint_as_float(t2.x & 0xffff0000u); X[4 * g4 + 2] = __uint_as_float(t2.y << 16); X[4 * g4 + 3] = __uint_as_float(t2.y & 0xffff0000u); }
            } else if (wave == 5) { f32x16 acc = f32x16{}; tile_nt(acc, L + B_BET, S64, 0, L + B_RHO, S64, 0, 4, ln);
#pragma unroll
                for (int r = 0; r < 16; ++r) acc[r] = (r32 >= crow(r, hi)) ? acc[r] : 0.f;
                store_nat(L + B_ARB, S32, 0, acc, ln);
            } else if (wave == 6) { tile_nt(RK, L + B_KAP, S64, 0, L + B_RHO, S64, 0, 4, ln);
#pragma unroll
                for (int r = 0; r < 16; ++r) RK[r] = (r32 >= crow(r, hi)) ? RK[r] : 0.f; }
        }
        LBAR(); TS(6);
#pragma unroll
        for (int j = 0; j < 5; ++j) {
            const LAS unsigned char* pw = L + ((j & 1) ? B_PW1 : B_PW0); LAS unsigned char* pn = L + ((j & 1) ? B_PW0 : B_PW1);
            asm volatile("" : "+v"(ln));
            if (wave >= 1 && wave <= 3) { LAS unsigned char* xt = (wave == 1) ? L + B_UMT : L + B_WMT + (wave - 2) * 32 * S32;
                store_nat(xt, S32, 0, X, ln);
                tile_nt(X, pw, S32, 0, xt, S32, 0, 2, ln);
                if (j == 4) store_nat(xt, S32, 0, X, ln);
            } else if (j < 4 && (wave == 0 || wave == 4)) { f32x16 sq = f32x16{};
                if (wave == 0) { tile_nt(sq, pw, S32, 0, pw + 32 * S32, S32, 0, 2, ln); store_nat(pn + 32 * S32, S32, 0, sq, ln); }
                else           { tile_nt(sq, pw + 32 * S32, S32, 0, pw, S32, 0, 2, ln); store_nat(pn, S32, 0, sq, ln); } }
            LBAR();
        }
        TS(7);
        {
            asm volatile("" : "+v"(ln)); const int r32 = ln & 31, hi = ln >> 5; LAS unsigned char* OQ = L + B_OUT + O_QPH; LAS unsigned char* OG = L + B_OUT + O_GT;
            if (wave < 2) { f32x16 acc = f32x16{}; tile_nt(acc, L + B_WMT, S32, wave * 32, L + B_ARB, S32, 0, 2, ln);
#pragma unroll
                for (int g4 = 0; g4 < 4; ++g4) { const v2u rr = *(const LAS v2u*)(L + B_RHO + r32 * S64 + (wave * 32 + 8 * g4 + 4 * hi) * 2);
                    acc[4 * g4] = __uint_as_float(rr.x << 16) - acc[4 * g4]; acc[4 * g4 + 1] = __uint_as_float(rr.x & 0xffff0000u) - acc[4 * g4 + 1]; acc[4 * g4 + 2] = __uint_as_float(rr.y << 16) - acc[4 * g4 + 2]; acc[4 * g4 + 3] = __uint_as_float(rr.y & 0xffff0000u) - acc[4 * g4 + 3]; }
                store_nat(OQ, S64, 0, acc, ln, wave * 32); }
            if (wave == 2 || wave == 3) { const int ni = wave - 2; f32x16 acc = f32x16{}; tile_nt(acc, L + B_UMT, S32, 0, L + B_BETT, S32, ni * 32, 2, ln);
                const int ch = ni * 32 + r32; const float gl = *(const LAS float*)(L + B_GL + ch * 4);
#pragma unroll
                for (int g4 = 0; g4 < 4; ++g4) { const v2u kk2 = *(const LAS v2u*)(L + B_KAPT + ch * S32 + (8 * g4 + 4 * hi) * 2);
                    acc[4 * g4] = (__uint_as_float(kk2.x << 16) - acc[4 * g4]) * gl; acc[4 * g4 + 1] = (__uint_as_float(kk2.x & 0xffff0000u) - acc[4 * g4 + 1]) * gl;
                    acc[4 * g4 + 2] = (__uint_as_float(kk2.y << 16) - acc[4 * g4 + 2]) * gl; acc[4 * g4 + 3] = (__uint_as_float(kk2.y & 0xffff0000u) - acc[4 * g4 + 3]) * gl; }
                store_nat(OQ + O_HT, S32, ni * 32, acc, ln); }
            if (wave == 6) { f32x16 acc = f32x16{}; tile_nt(acc, L + B_UMT, S32, 0, L + B_ARB, S32, 0, 2, ln);
#pragma unroll
                for (int r = 0; r < 16; ++r) acc[r] = RK[r] - acc[r];
                store_nat(OQ + O_PM, S32, 0, acc, ln); }
            if (wave >= 4) { const int gi = (wave == 4) ? 0 : (wave == 5) ? 1 : (wave == 7) ? 2 : 3, mi = gi >> 1, ni = gi & 1; f32x16 acc = f32x16{};
                tile_nt(acc, L + B_WMT, S32, mi * 32, L + B_BETT, S32, ni * 32, 2, ln);
                const int ch = ni * 32 + r32; const float gl = *(const LAS float*)(L + B_GL + ch * 4);
#pragma unroll
                for (int r = 0; r < 16; ++r) { const int chp = mi * 32 + crow(r, hi); acc[r] = (((chp == ch) ? 1.f : 0.f) - acc[r]) * gl; }
                store_nat(OG, S64, ni * 32, acc, ln, mi * 32); }
        }
    }
    __syncthreads();
#if defined(MK_TSTAGE)
    if (blockIdx.x == 0 && wave == 0) { const unsigned long long t0_ = __builtin_amdgcn_s_memrealtime(); while (__builtin_amdgcn_s_memrealtime() - t0_ < 4ull * ts_acc) __builtin_amdgcn_s_sleep(8); }
#endif
    B_COPYOUT(c0 + 63);
    asm volatile("s_waitcnt vmcnt(0)" ::: "memory"); __syncthreads();
#undef B_DMA
#undef B_COPYOUT
#undef TS
}

constexpr int A_IMG = 0, IMG_B = 3072 + QPH_B + GT_B;
constexpr int A_S = 3 * IMG_B, A_YB = A_S + 32 * S64, A_END = A_YB + 2 * 4096;
static_assert(A_END <= LDSCTL_OFF, "scan2 apply LDS");
__device__ __forceinline__ void apply(Frame& F) {
    const int tid = F.tid, lane = F.lane, wave = F.wave;
    const int half = F.vcu & 1, bh = F.vcu >> 1, hd = bh & 7, b = bh >> 3;
    LAS unsigned char* L = F.lds;
    const unsigned lds0 = (unsigned)(uintptr_t)(unsigned char*)F.lds;
    bf16* Y = (bf16*)((unsigned char*)F.out + OUT_Y);
    const size_t mrow0 = (size_t)b * SEQ;
    const int dw = (wave - 3) & 1;
#define A_DMA(c) do { const size_t u_ = (size_t)bh * 128 + (c); \
        _Pragma("unroll") for (int i_ = 0; i_ < 12; ++i_) { const int p_ = dw * 12 + i_; \
            const unsigned char* src_ = (p_ < 3) ? vt_home(F, b, hd) + (size_t)(c) * VT_B + half * 3072 + p_ * 1024 : (p_ < 15) ? qph_home(F, b, hd) + (size_t)(c) * QPH_B + (p_ - 3) * 1024 : F.ws + WS_GT + u_ * GT_B + (p_ - 15) * 1024; \
            attn_body::glds16(src_ + lane * 16, (unsigned)__builtin_amdgcn_readfirstlane(lds0 + A_IMG + ((c) % 3) * IMG_B + p_ * 1024)); } } while (0)
    for (int q = tid; q < 32 * S64 / 4; q += 512) ((LAS unsigned*)(L + A_S))[q] = 0u;
    if (wave == 3 || wave == 4) A_DMA(0);
    if (wave == 5 || wave == 6) A_DMA(1);
    for (int c = 0; c < SEQ / TC; ++c) {
        const bool mydma = (wave >= 3 && wave < 7) && ((((wave - 3) >> 1) & 1) == (c & 1));
        if (mydma) asm volatile("s_waitcnt vmcnt(0)" ::: "memory");
        LBAR();
        if (mydma && c + 2 < SEQ / TC) A_DMA(c + 2);
        const LAS unsigned char* I = L + A_IMG + (c % 3) * IMG_B; const LAS unsigned char* IVT = I; const LAS unsigned char* IQ = I + 3072; const LAS unsigned char* IG = I + 3072 + QPH_B;
        f32x16 acc = f32x16{};
        int ln = lane; asm volatile("" : "+v"(ln)); const int r32 = ln & 31, hi = ln >> 5;
        if (wave == 0) { tile_nt(acc, IQ, S64, 0, L + A_S, S64, 0, 4, ln); tile_nt(acc, IQ + O_PM, S32, 0, IVT, S32, 0, 2, ln); }
        else if (wave < 3) { const int ni = wave - 1; tile_nt(acc, IG, S64, ni * 32, L + A_S, S64, 0, 4, ln); tile_nt(acc, IQ + O_HT, S32, ni * 32, IVT, S32, 0, 2, ln); }
        if (wave == 7 && c > 0) {
#pragma unroll
            for (int i = 0; i < 2; ++i) { const int q = i * 64 + lane, st = q >> 2, v8 = (q & 3) * 8; const LAS f32x4* yp = (const LAS f32x4*)(L + A_YB + ((c - 1) & 1) * 4096 + (st * 32 + v8) * 4); const f32x4 ya = yp[0], yb = yp[1];
                *(GAS v4u*)(Y + (mrow0 + (size_t)(c - 1) * TC + st) * 512 + hd * 64 + half * 32 + v8) = (v4u){attn_body::cvtpk_s(ya[0], ya[1]), attn_body::cvtpk_s(ya[2], ya[3]), attn_body::cvtpk_s(yb[0], yb[1]), attn_body::cvtpk_s(yb[2], yb[3])}; } }
        LBAR();
        if (wave == 0) {
#pragma unroll
            for (int r = 0; r < 16; ++r) *(LAS float*)(L + A_YB + (c & 1) * 4096 + (crow(r, hi) * 32 + r32) * 4) = acc[r]; }
        else if (wave < 3) store_nat(L + A_S, S64, 0, acc, ln, (wave - 1) * 32);
    }
    __syncthreads();
    if (wave == 7) {
#pragma unroll
        for (int i = 0; i < 2; ++i) { const int q = i * 64 + lane, st = q >> 2, v8 = (q & 3) * 8; const LAS f32x4* yp = (const LAS f32x4*)(L + A_YB + ((SEQ / TC - 1) & 1) * 4096 + (st * 32 + v8) * 4); const f32x4 ya = yp[0], yb = yp[1];
            *(GAS v4u*)(Y + (mrow0 + (size_t)(SEQ / TC - 1) * TC + st) * 512 + hd * 64 + half * 32 + v8) = (v4u){attn_body::cvtpk_s(ya[0], ya[1]), attn_body::cvtpk_s(ya[2], ya[3]), attn_body::cvtpk_s(yb[0], yb[1]), attn_body::cvtpk_s(yb[2], yb[3])}; } }
    asm volatile("s_waitcnt vmcnt(0)" ::: "memory"); __syncthreads();
#undef A_DMA
}
constexpr int A2_IMG = 0, IMG2_B = VT_B + QPH_B + GT_B;
constexpr int A2_S = 3 * IMG2_B, A2_YB = A2_S + 64 * S64, A2_END = A2_YB + 2 * 8192;
static_assert(A2_END <= LDSCTL_OFF, "scan2 apply2 LDS");
__device__ __forceinline__ void a2_epilogue(const LAS float* yr, const v4u (&gq)[4], const v4u (&zq)[4], bf16* dst) {
    float y[32]; float s = 0.f;
#pragma unroll
    for (int i = 0; i < 8; ++i) { const f32x4 t4 = *(const LAS f32x4*)(yr + 4 * i); y[4 * i] = t4[0]; y[4 * i + 1] = t4[1]; y[4 * i + 2] = t4[2]; y[4 * i + 3] = t4[3]; s += (t4[0] + t4[1]) + (t4[2] + t4[3]); }
    s += __int_as_float(__builtin_amdgcn_update_dpp(0, __float_as_int(s), 0xB1, 0xf, 0xf, false));
    const float mean = s * (1.f / 64.f); float q = 0.f;
#pragma unroll
    for (int i = 0; i < 32; ++i) { y[i] -= mean; q += y[i] * y[i]; }
    q += __int_as_float(__builtin_amdgcn_update_dpp(0, __float_as_int(q), 0xB1, 0xf, 0xf, false));
    const float rstd = __builtin_amdgcn_rsqf(q * (1.f / 64.f) + 64e-5f);
#pragma unroll
    for (int h = 0; h < 4; ++h) { unsigned ow[4];
#pragma unroll
        for (int i = 0; i < 4; ++i) { const unsigned gw_ = gq[h][i], zw_ = zq[h][i]; const int k = 8 * h + 2 * i;
            const float o0 = y[k] * rstd * __uint_as_float(gw_ << 16) + __uint_as_float(zw_ << 16), o1 = y[k + 1] * rstd * __uint_as_float(gw_ & 0xffff0000u) + __uint_as_float(zw_ & 0xffff0000u);
            ow[i] = attn_body::cvtpk_s(o0, o1); }
        *(GAS v4u*)(dst + 8 * h) = (v4u){ow[0], ow[1], ow[2], ow[3]}; }
}
__device__ __forceinline__ void apply2(Frame& F) {
    if (F.vcu & 1) return;
    const int lane = F.lane, wave = F.wave;
    const int bh = F.vcu >> 1, hd = bh & 7, b = bh >> 3;
    LAS unsigned char* L = F.lds;
    const unsigned lds0 = (unsigned)(uintptr_t)(unsigned char*)F.lds;
    const bf16* GG = (const bf16*)((unsigned char*)F.out + OUT_GG); const bf16* Z = (const bf16*)((unsigned char*)F.out + OUT_Z); bf16* MIX = (bf16*)(F.ws + WS_MIX);
    const size_t mrow0 = (size_t)b * SEQ;
#define A2_DMA(c) do { const size_t u_ = (size_t)bh * 128 + (c); \
        _Pragma("unroll") for (int i_ = 0; i_ < 4; ++i_) { const int p_ = wave + 7 * i_; if (p_ < 27) { \
            const unsigned char* src_ = (p_ < 6) ? F.ws + WS_VT + u_ * VT_B + p_ * 1024 : (p_ < 18) ? F.ws + WS_QPH + u_ * QPH_B + (p_ - 6) * 1024 : F.ws + WS_GT + u_ * GT_B + (p_ - 18) * 1024; \
            attn_body::glds16(src_ + lane * 16, (unsigned)__builtin_amdgcn_readfirstlane(lds0 + A2_IMG + ((c) % 3) * IMG2_B + p_ * 1024)); } } } while (0)
    for (int q = F.tid; q < 64 * S64 / 4; q += 512) ((LAS unsigned*)(L + A2_S))[q] = 0u;
    if (wave < 7) { A2_DMA(0); A2_DMA(1); }
    const int est = lane >> 1, ev0 = 32 * (lane & 1);
    v4u gq[4], zq[4];
    for (int c = 0; c < SEQ / TC; ++c) {
        if (wave < 7) { if (c + 1 >= SEQ / TC) asm volatile("s_waitcnt vmcnt(0)" ::: "memory"); else if (wave < 6) asm volatile("s_waitcnt vmcnt(4)" ::: "memory"); else asm volatile("s_waitcnt vmcnt(3)" ::: "memory"); }
        LBAR();
        if (wave < 7 && c + 2 < SEQ / TC) A2_DMA(c + 2);
        const LAS unsigned char* I = L + A2_IMG + (c % 3) * IMG2_B; const LAS unsigned char* IVT = I; const LAS unsigned char* IQ = I + VT_B; const LAS unsigned char* IG = I + VT_B + QPH_B;
        f32x16 acc = f32x16{};
        int ln = lane; asm volatile("" : "+v"(ln)); const int r32 = ln & 31, hi = ln >> 5;
        if (wave < 2) { tile_nt(acc, IQ, S64, 0, L + A2_S, S64, wave * 32, 4, ln); tile_nt(acc, IQ + O_PM, S32, 0, IVT + wave * 3072, S32, 0, 2, ln); }
        else if (wave < 6) { const int ni = (wave - 2) & 1, vi = (wave - 2) >> 1;
            tile_nt(acc, IG, S64, ni * 32, L + A2_S, S64, vi * 32, 4, ln); tile_nt(acc, IQ + O_HT, S32, ni * 32, IVT + vi * 3072, S32, 0, 2, ln); }
        else if (wave == 7) {
            if (c > 0) a2_epilogue((const LAS float*)(L + A2_YB + ((c - 1) & 1) * 8192) + est * 64 + ev0, gq, zq, MIX + (mrow0 + (size_t)(c - 1) * TC + est) * 1024 + hd * 64 + ev0);
            const size_t o = (mrow0 + (size_t)c * TC + est) * 512 + hd * 64 + ev0;
#pragma unroll
            for (int i = 0; i < 4; ++i) { gq[i] = *(const GAS v4u*)(GG + o + 8 * i); zq[i] = *(const GAS v4u*)(Z + o + 8 * i); }
        }
        LBAR();
        if (wave < 2) {
#pragma unroll
            for (int r = 0; r < 16; ++r) *(LAS float*)(L + A2_YB + (c & 1) * 8192 + (crow(r, hi) * 64 + wave * 32 + r32) * 4) = acc[r]; }
        else if (wave < 6) store_nat(L + A2_S, S64, ((wave - 2) >> 1) * 32, acc, ln, ((wave - 2) & 1) * 32);
    }
    LBAR();
    if (wave == 7) a2_epilogue((const LAS float*)(L + A2_YB + ((SEQ / TC - 1) & 1) * 8192) + est * 64 + ev0, gq, zq, MIX + (mrow0 + (size_t)(SEQ / TC - 1) * TC + est) * 1024 + hd * 64 + ev0);
    asm volatile("s_waitcnt vmcnt(0)" ::: "memory");
#undef A2_DMA
}
#undef ST16
}

constexpr size_t WS_XS = 264 * MiB, WS_HID = 536 * MiB, WS_YB = 672 * MiB;
constexpr size_t WS_X1B = 264 * MiB, X1B_XTRA = 3 * 1024 * 1024;
constexpr int SLOT_CAP = 65536;
constexpr int L_TB = 131072;
__device__ __forceinline__ void moe_tile_table(Frame& F) {
    LAS int* cnt = (LAS int*)(F.lds + L_TB); LAS int* tb = cnt + 32;
    if (F.tid < 32) cnt[F.tid] = (int)__hip_atomic_load(F.ctl + CW_CNT + 64 * F.tid, RLX_AGENT);
    __syncthreads();
    if (F.tid == 0) { int s = 0; for (int e = 0; e < 32; ++e) { tb[e] = s; s += (cnt[e] + 255) >> 8; } tb[32] = s; }
    __syncthreads();
}
__device__ __forceinline__ void m0_route(Frame& F) {
    LAS f32x4* Wg4 = (LAS f32x4*)(F.lds);
    LAS f32x4* Wr4 = (LAS f32x4*)(F.lds + 16384);
    LAS int* tokE = (LAS int*)(F.lds + 147456);
    LAS float* tokW = (LAS float*)(F.lds + 147456 + 2048);
    LAS int* hist = (LAS int*)(F.lds + 147456 + 4096);
    const float* wgrp = F.in[IN_WGRP]; const float* wrt = F.in[IN_WRT];
    for (int idx = F.tid; idx < 1024 * 4; idx += 512) { const int c = idx >> 2, j = idx & 3; const int l = (c & 255) >> 2, jj = (c >> 8) * 4 + (c & 3); ((LAS float*)Wg4)[(jj * 64 + l) * 4 + j] = wgrp[idx]; }
    for (int i0 = 0; i0 < 64; i0 += 16) { float wv_[16];
#pragma unroll
        for (int i = 0; i < 16; ++i) wv_[i] = wrt[F.tid + 512 * (i0 + i)];
#pragma unroll
        for (int i = 0; i < 16; ++i) { const int idx = F.tid + 512 * (i0 + i); const int c = idx >> 5, e = idx & 31; const int l = (c & 255) >> 2, jj = (c >> 8) * 4 + (c & 3); ((LAS float*)Wr4)[(((e >> 2) * 16 + jj) * 64 + l) * 4 + (e & 3)] = wv_[i]; } }
    const float* g2 = F.in[IN_N2G]; const float* mod = (const float*)(F.ws + WS_MOD); const float* bgrp = F.in[IN_BGRP]; const float* brt = F.in[IN_BRT];
    bf16* H2 = (bf16*)(F.ws + WS_H); int* slot_tok = (int*)(F.ws + WS_SLOT_TOK); float* slot_w = (float*)(F.ws + WS_SLOT_W); unsigned* tokinfo = (unsigned*)(F.ws + WS_TOKINFO);
    const float bg0 = bgrp[0], bg1 = bgrp[1], bg2 = bgrp[2], bg3 = bgrp[3];
    for (int rb = F.vcu; rb < NTOK / 256; rb += F.G) {
        if (F.tid < 32) hist[F.tid] = 0;
        __syncthreads();
        const int b = (rb * 256) / SEQ;
        f32x4 A[4], Bc[4];
#pragma unroll
        for (int j = 0; j < 4; ++j) { const int c = 4 * F.lane + 256 * j; const f32x4 g = *(const f32x4*)(g2 + c), sc = *(const f32x4*)(mod + (size_t)b * NMOD + 4096 + c); A[j] = g * (sc + 1.0f); Bc[j] = *(const f32x4*)(mod + (size_t)b * NMOD + 3072 + c); }
        const bf16* X1B = (const bf16*)(F.ws + WS_X1B) + (size_t)b * X1B_XTRA;
        v2u vn[4];
        { const GAS v2u* xr0 = (const GAS v2u*)(X1B + ((size_t)rb * 256 + F.wave) * 1024) + F.lane;
#pragma unroll
          for (int j = 0; j < 4; ++j) vn[j] = xr0[64 * j]; }
        for (int r = F.wave; r < 256; r += NWAVES) {
            const size_t m = (size_t)rb * 256 + r;
            f32x4 v[4]; float ss = 0.f;
#pragma unroll
            for (int j = 0; j < 4; ++j) v[j] = (f32x4){__uint_as_float(vn[j][0] << 16), __uint_as_float(vn[j][0] & 0xffff0000u), __uint_as_float(vn[j][1] << 16), __uint_as_float(vn[j][1] & 0xffff0000u)};
            if (r + NWAVES < 256) { const GAS v2u* xr = (const GAS v2u*)(X1B + (m + NWAVES) * 1024) + F.lane;
#pragma unroll
                for (int j = 0; j < 4; ++j) vn[j] = xr[64 * j]; }
#pragma unroll
            for (int j = 0; j < 4; ++j) ss += (v[j].x * v[j].x + v[j].y * v[j].y) + (v[j].z * v[j].z + v[j].w * v[j].w);
            const float rstd = 1.0f / sqrtf(wave_sum(ss) * (1.f / 1024.f) + 1e-6f);
            GAS unsigned long long* o8 = (GAS unsigned long long*)(H2 + m * 1024) + F.lane;
            f32x4 ga = (f32x4){0.f, 0.f, 0.f, 0.f};
#pragma unroll
            for (int j = 0; j < 4; ++j) { v[j] = v[j] * rstd * A[j] + Bc[j];
                o8[64 * j] = (unsigned long long)attn_body::cvtpk_s(v[j].x, v[j].y) | ((unsigned long long)attn_body::cvtpk_s(v[j].z, v[j].w) << 32);
#pragma unroll
                for (int i = 0; i < 4; ++i) ga += Wg4[(j * 4 + i) * 64 + F.lane] * v[j][i]; }
            float gv_[4] = {ga[0], ga[1], ga[2], ga[3]}, gt_[4]; wave_reduce4(gv_, gt_, F.lane);
            const float l0 = gt_[0] + bg0, l1 = gt_[1] + bg1, l2 = gt_[2] + bg2, l3 = gt_[3] + bg3;
            int gs = 0; float lm = l0; if (l1 > lm) { lm = l1; gs = 1; } if (l2 > lm) { lm = l2; gs = 2; } if (l3 > lm) { lm = l3; gs = 3; }
            const float pg = 1.0f / (__expf(l0 - lm) + __expf(l1 - lm) + __expf(l2 - lm) + __expf(l3 - lm));
            gs = __builtin_amdgcn_readfirstlane(gs);
            f32x4 e0 = (f32x4){0.f, 0.f, 0.f, 0.f}, e1 = e0;
            const LAS f32x4* w0p = Wr4 + (gs * 2) * 1024 + F.lane; const LAS f32x4* w1p = w0p + 1024;
#pragma unroll
            for (int j = 0; j < 4; ++j)
#pragma unroll
                for (int i = 0; i < 4; ++i) { e0 += w0p[(j * 4 + i) * 64] * v[j][i]; e1 += w1p[(j * 4 + i) * 64] * v[j][i]; }
            float el[8], ev_[8] = {e0[0], e0[1], e0[2], e0[3], e1[0], e1[1], e1[2], e1[3]}; wave_reduce8(ev_, el, F.lane);
#pragma unroll
            for (int q = 0; q < 8; ++q) el[q] += brt[gs * 8 + q];
            int i1 = 0; float m1 = el[0];
#pragma unroll
            for (int q = 1; q < 8; ++q) if (el[q] > m1) { m1 = el[q]; i1 = q; }
            int i2 = -1; float m2 = -3.0e38f;
#pragma unroll
            for (int q = 0; q < 8; ++q) if (q != i1 && el[q] > m2) { m2 = el[q]; i2 = q; }
            const float t = __expf(m2 - m1), w1 = pg / (1.0f + t), w2 = pg * t / (1.0f + t);
            if (F.lane == 0) { tokE[2 * r] = gs * 8 + i1; tokE[2 * r + 1] = gs * 8 + i2; tokW[2 * r] = w1; tokW[2 * r + 1] = w2; }
        }
        __syncthreads();
        const int ar = F.tid >> 1, ak = F.tid & 1, ae = tokE[2 * ar + ak];
        const int lpos = __hip_atomic_fetch_add(hist + ae, 1, __ATOMIC_RELAXED, __HIP_MEMORY_SCOPE_WORKGROUP);
        __syncthreads();
        if (F.tid < 32) { const int n = hist[F.tid]; hist[32 + F.tid] = n ? (int)__hip_atomic_fetch_add(F.ctl + CW_CNT + 64 * F.tid, (unsigned)n, RLX_AGENT) : 0; }
        __syncthreads();
        { const int pos = hist[32 + ae] + lpos; const int tok = rb * 256 + ar;
          slot_tok[(size_t)ae * SLOT_CAP + pos] = tok; slot_w[(size_t)ae * SLOT_CAP + pos] = tokW[2 * ar + ak]; tokinfo[2 * tok + ak] = ((unsigned)ae << 20) | (unsigned)pos; }
        __syncthreads();
    }
}
__device__ __forceinline__ void m1_permute(Frame& F) {
    moe_tile_table(F);
    const LAS int* cnt = (const LAS int*)(F.lds + L_TB); const LAS int* tb = cnt + 32;
    const bf16* H2 = (const bf16*)(F.ws + WS_H); bf16* XS = (bf16*)(F.ws + WS_XS); const int* slot_tok = (const int*)(F.ws + WS_SLOT_TOK);
    const int nrows = tb[32] * 256, gw = F.vcu * NWAVES + F.wave, NGW = F.G * NWAVES;
    for (int R = gw; R < nrows; R += NGW) {
        const int rt = R >> 8; int e = 0;
        for (int q = 1; q < 32; ++q) if (tb[q] <= rt) e = q;
        const int slot = (rt - tb[e]) * 256 + (R & 255);
        v4u a = (v4u){0u, 0u, 0u, 0u}, c = a;
        if (slot < cnt[e]) { const int tok = slot_tok[(size_t)e * SLOT_CAP + slot]; const GAS v4u* src = (const GAS v4u*)(H2 + (size_t)tok * 1024) + F.lane; a = src[0]; c = src[64]; }
        GAS v4u* dst = (GAS v4u*)(XS + (size_t)R * 1024) + F.lane; dst[0] = a; dst[64] = c;
    }
}
constexpr int L_TOKL = L_TB + 1024;
template <bool GATHER_> struct MoeOrder {
    static constexpr bool GATHER = GATHER_;
    const LAS int* tb; const LAS int* tokl; int G, c, nwg;
    __device__ __forceinline__ bool next(int i, pg8::Unit& u) const {
        const int Lq = i * G + c; if (Lq >= nwg) return false;
        const int rt = Lq >> 2; int e = 0;
        for (int q = 1; q < 32; ++q) if (tb[q] <= rt) e = q;
        u.pm = rt; u.pn = 4 * e + (Lq & 3); u.e = e; u.j = GATHER_ ? rt - tb[e] : i; return true;
    }
    __device__ __forceinline__ unsigned a_row(int ui, int row) const { return (unsigned)tokl[ui * 256 + row]; }
    __device__ __forceinline__ void a_ready(const pg8::Unit&) const {}
    __device__ __forceinline__ void done(const pg8::Unit&) const {}
};
__device__ __forceinline__ void moe_fill_tokl(Frame& F) {
    const LAS int* cnt = (const LAS int*)(F.lds + L_TB); const LAS int* tb = cnt + 32; LAS int* tokl = (LAS int*)(F.lds + L_TOKL);
    const int* slot_tok = (const int*)(F.ws + WS_SLOT_TOK); const int nwg = tb[32] * 4;
    for (int i = 0; i < 12; ++i) { const int Lq = i * F.G + F.vcu; if (Lq >= nwg) break;
        const int rt = Lq >> 2; int e = 0;
        for (int q = 1; q < 32; ++q) if (tb[q] <= rt) e = q;
        if (F.tid < 256) { const int slot = (rt - tb[e]) * 256 + F.tid; tokl[i * 256 + F.tid] = slot < cnt[e] ? slot_tok[(size_t)e * SLOT_CAP + slot] : 0; } }
    __syncthreads();
}
__device__ __forceinline__ void moe_fill_wl(Frame& F) {
    const LAS int* cnt = (const LAS int*)(F.lds + L_TB); const LAS int* tb = cnt + 32; LAS float* wl = (LAS float*)(F.lds + L_TOKL);
    const float* slot_w = (const float*)(F.ws + WS_SLOT_W); const int nwg = tb[32] * 4;
    for (int i = 0; i < 12; ++i) { const int Lq = i * F.G + F.vcu; if (Lq >= nwg) break;
        const int rt = Lq >> 2; int e = 0;
        for (int q = 1; q < 32; ++q) if (tb[q] <= rt) e = q;
        if (F.tid < 256) { const int slot = (rt - tb[e]) * 256 + F.tid; wl[i * 256 + F.tid] = slot < cnt[e] ? slot_w[(size_t)e * SLOT_CAP + slot] : 0.f; } }
    __syncthreads();
}
namespace pg8 {
struct EpiSwiGLU {
    static constexpr bool PERM = true, AFTER_DRAIN = false;
    bf16_t* HID;
    __device__ __forceinline__ void operator()(const f32x4 (&acc)[2][2][4][2], const Unit& u, int wr, int wc, int fr, int fq) const {
        const int row0 = u.pm * BM + wr * 64 + fr, col0 = (u.pn & 3) * 128 + wc * 32 + 8 * fq;
#pragma unroll
        for (int ai = 0; ai < 2; ++ai)
#pragma unroll
            for (int m = 0; m < 4; ++m) { f32x4 h[2];
#pragma unroll
                for (int n = 0; n < 2; ++n) { const f32x4 g = acc[ai][0][m][n], up = acc[ai][1][m][n];
#pragma unroll
                    for (int i = 0; i < 4; ++i) h[n][i] = g[i] / (1.0f + __expf(-g[i])) * up[i]; }
                u32x4 w; w.x = cvt_pk_bf16(h[0][0], h[0][1]); w.y = cvt_pk_bf16(h[0][2], h[0][3]); w.z = cvt_pk_bf16(h[1][0], h[1][1]); w.w = cvt_pk_bf16(h[1][2], h[1][3]);
                *(u32x4*)(HID + (size_t)(row0 + ai * HALF + m * 16) * 512 + col0) = w; }
    }
};
struct EpiDown {
    static constexpr bool PERM = true, AFTER_DRAIN = false;
    bf16_t* YB; const PG8_LAS float* wl;
    __device__ __forceinline__ void operator()(const f32x4 (&acc)[2][2][4][2], const Unit& u, int wr, int wc, int fr, int fq) const {
        const int rloc0 = wr * 64 + fr, col0 = (u.pn & 3) * BM + wc * 32 + 8 * fq;
#pragma unroll
        for (int ai = 0; ai < 2; ++ai)
#pragma unroll
            for (int m = 0; m < 4; ++m) { const int rloc = rloc0 + ai * HALF + m * 16; const float sc = wl[u.j * BM + rloc];
                bf16_t* rowp = YB + (size_t)(u.pm * BM + rloc) * 1024 + col0;
#pragma unroll
                for (int bj = 0; bj < 2; ++bj) { const f32x4 v0 = acc[ai][bj][m][0] * sc, v1 = acc[ai][bj][m][1] * sc;
                    u32x4 w; w.x = cvt_pk_bf16(v0[0], v0[1]); w.y = cvt_pk_bf16(v0[2], v0[3]); w.z = cvt_pk_bf16(v1[0], v1[1]); w.w = cvt_pk_bf16(v1[2], v1[3]);
                    *(u32x4*)(rowp + bj * HALF) = w; } }
    }
};
}
__device__ __forceinline__ void p_final(Frame& F) {
    moe_tile_table(F);
    const LAS int* tb = (const LAS int*)(F.lds + L_TB) + 32;
    const float* gf = F.in[IN_NFG]; const float* mod = (const float*)(F.ws + WS_MOD); const bf16* YB = (const bf16*)(F.ws + WS_YB); const unsigned* tokinfo = (const unsigned*)(F.ws + WS_TOKINFO);
    f32x4 G4[4];
#pragma unroll
    for (int j = 0; j < 4; ++j) G4[j] = *(const f32x4*)(gf + 4 * F.lane + 256 * j);
    const int gw = F.vcu * NWAVES + F.wave, NGW = F.G * NWAVES;
    const bf16* X1B = (const bf16*)(F.ws + WS_X1B);
    v2u xn[4], an[4], cn[4];
#define FIN_LOAD(mm) do { const unsigned i0_ = tokinfo[2 * (mm)], i1_ = tokinfo[2 * (mm) + 1]; \
        const size_t r0_ = (size_t)tb[i0_ >> 20] * 256 + (i0_ & 0xfffffu), r1_ = (size_t)tb[i1_ >> 20] * 256 + (i1_ & 0xfffffu); \
        const GAS v2u* xr_ = (const GAS v2u*)(X1B + (size_t)(mm) * 1024 + (size_t)((mm) / SEQ) * X1B_XTRA) + F.lane; const GAS v2u* y0_ = (const GAS v2u*)(YB + r0_ * 1024) + F.lane; const GAS v2u* y1_ = (const GAS v2u*)(YB + r1_ * 1024) + F.lane; \
        _Pragma("unroll") for (int j_ = 0; j_ < 4; ++j_) { xn[j_] = xr_[64 * j_]; an[j_] = y0_[64 * j_]; cn[j_] = y1_[64 * j_]; } } while (0)
    if (gw < NTOK) FIN_LOAD(gw);
    for (int m = gw; m < NTOK; m += NGW) {
        const int b = m / SEQ;
        GAS f32x4* xr = (GAS f32x4*)(F.out + (size_t)m * 1024) + F.lane;
        v2u xc[4], ac[4], cc[4];
#pragma unroll
        for (int j = 0; j < 4; ++j) { xc[j] = xn[j]; ac[j] = an[j]; cc[j] = cn[j]; }
        if (m + NGW < NTOK) FIN_LOAD(m + NGW);
        f32x4 v[4]; float ss = 0.f;
#pragma unroll
        for (int j = 0; j < 4; ++j) { const f32x4 gt = *(const f32x4*)(mod + (size_t)b * NMOD + 5120 + 4 * F.lane + 256 * j); const v2u a = ac[j], c = cc[j];
            f32x4 ff; ff[0] = __uint_as_float(a[0] << 16) + __uint_as_float(c[0] << 16); ff[1] = __uint_as_float(a[0] & 0xffff0000u) + __uint_as_float(c[0] & 0xffff0000u);
            ff[2] = __uint_as_float(a[1] << 16) + __uint_as_float(c[1] << 16); ff[3] = __uint_as_float(a[1] & 0xffff0000u) + __uint_as_float(c[1] & 0xffff0000u);
            const f32x4 x1 = (f32x4){__uint_as_float(xc[j][0] << 16), __uint_as_float(xc[j][0] & 0xffff0000u), __uint_as_float(xc[j][1] << 16), __uint_as_float(xc[j][1] & 0xffff0000u)};
            v[j] = x1 + gt * ff; ss += (v[j].x * v[j].x + v[j].y * v[j].y) + (v[j].z * v[j].z + v[j].w * v[j].w); }
        const float rstd = 1.0f / sqrtf(wave_sum(ss) * (1.f / 1024.f) + 1e-6f);
#if defined(MK_PROBE_A)
        { const unsigned long long* st = (const unsigned long long*)(F.ws + WS_CTL + 32768);
          const float ta = (float)(st[MK_PROBE_A + 1] - st[MK_PROBE_A]) * 0.01f, tb_ = (float)(st[MK_PROBE_B + 1] - st[MK_PROBE_B]) * 0.01f;
          const float sc = 1.0f + ta * 1e-4f;
#pragma unroll
          for (int j = 0; j < 4; ++j) v[j] = v[j] * sc;
          if (m == 0 && F.lane == 0) v[0][0] += tb_ * 0.02f / (rstd * G4[0][0]); }
#endif
#pragma unroll
        for (int j = 0; j < 4; ++j) xr[64 * j] = v[j] * rstd * G4[j];
    }
#undef FIN_LOAD
}
#ifndef MK_ONE_LAUNCH
#define MK_ONE_LAUNCH 1
#endif
constexpr int CW_ATT = 131072;
constexpr size_t WS_KXG_A = 19 * MiB + 512 * 1024, WS_KXG_B = 4 * MiB; constexpr int KXG_NA = 70;
static_assert((size_t)KXG_NA * attn_body::KX_IMG_BYTES <= 4 * MiB + 512 * 1024 && (size_t)(128 - KXG_NA) * attn_body::KX_IMG_BYTES <= 4 * MiB, "kx images");
__device__ __forceinline__ char* kxg_home(const Frame& F, int bh) { return (char*)F.ws + (bh < KXG_NA ? WS_KXG_A + (size_t)bh * attn_body::KX_IMG_BYTES : WS_KXG_B + (size_t)(bh - KXG_NA) * attn_body::KX_IMG_BYTES); }
struct AttnDyn {
    gu32* cnt; volatile LAS int* box; int bh_;
    __device__ __forceinline__ bool next(int, attn_body::AttnUnit& u) const {
        if (threadIdx.x == 0) *box = (int)__hip_atomic_fetch_add(cnt, 1u, RLX_AGENT);
        __syncthreads(); const int v = __builtin_amdgcn_readfirstlane(*box); __syncthreads();
        if (v >= 16) return false;
        u.bh = bh_; u.qb = 15 - v; return true; }
    __device__ __forceinline__ void a_ready(const attn_body::AttnUnit&) const {}
    __device__ __forceinline__ void done(const attn_body::AttnUnit&) const {}
};
__device__ __forceinline__ int attn_pick(gu32* cntb, volatile LAS int* box) {
    if (threadIdx.x == 0) { int best = -1, bw = 0;
        for (int h = 0; h < 8; ++h) { const int c = (int)__hip_atomic_load(cntb + 16 * h, RLX_AGENT); const int w = (c < 16) ? (16 - c) * (h + 2) : 0; if (w > bw) { bw = w; best = h; } }
        *box = best; }
    __syncthreads(); const int v = __builtin_amdgcn_readfirstlane(*box); __syncthreads();
    return v; }
constexpr int N_PHASES = 12;
struct Args { const float* in[28]; float* out; unsigned char* ws; int ph_lo, ph_hi; };
__global__ void __launch_bounds__(NWAVES * 64, 2) mk_fwd(Args args) {
    extern __shared__ __attribute__((aligned(16))) unsigned char lds[];
    Frame F;
    F.lds = (LAS unsigned char*)lds;
    F.MISC = (volatile LAS unsigned*)(F.lds + MISC_OFF);
    F.tid = threadIdx.x; F.lane = F.tid & 63; F.wave = __builtin_amdgcn_readfirstlane(F.tid >> 6);
    F.G = gridDim.x; { const int bx = blockIdx.x; F.vcu = (F.G % 8 == 0) ? (bx % 8) * (F.G / 8) + bx / 8 : bx; }
    F.ws = args.ws; F.out = args.out; F.ctl = (gu32*)(args.ws + WS_CTL);
    F.in.k = __builtin_amdgcn_kernarg_segment_ptr();
#define RELOAD_IN() do { kseg_t kp_ = __builtin_amdgcn_kernarg_segment_ptr(); asm volatile("" : "+s"(kp_)); F.in.k = kp_; } while (0)
    for (int u = F.tid; u < (LDS_BYTES - LDSCTL_OFF) / 4; u += NWAVES * 64) ((LAS unsigned*)(F.lds + LDSCTL_OFF))[u] = 0u;
    __syncthreads();
    const int lo = args.ph_lo, hi = args.ph_hi;
    int multi_ = __builtin_amdgcn_readfirstlane(((hi - lo) > 1) ? 1 : 0); asm volatile("" : "+s"(multi_)); const bool multi = multi_ != 0;
    XcdBarrier bar; bar.bar = (unsigned*)(F.ctl + CW_BAR); bar.x = 0; bar.st = nullptr; bar.gsz = 0; XcdBarrier bb = bar;
    if (multi) { bar = xcd_barrier_post((unsigned*)(F.ctl + CW_BAR), F.MISC + 8, gridDim.x);
        bb = xcd_barrier_post((unsigned*)(F.ctl + CW_BB + (F.vcu >> 4) * 4096), F.MISC + 10, 16u); }
#ifndef MK_REP_MASK
#define MK_REP_MASK 0
#endif
#ifndef MK_BATCH_BAR
#define MK_BATCH_BAR 1
#endif
#ifndef MK_ODD_ORDER
#define MK_ODD_ORDER 0
#endif
#define IN(k) (lo <= (k) && (k) < hi)
#define BOTH(k) (IN(k) && IN((k) + 1))
#define GRID_BAR() xcd_barrier(bar)
#define BATCH_BAR() do { if (MK_BATCH_BAR && F.G == 256) xcd_barrier(bb); else xcd_barrier(bar); } while (0)
#define STAMP(k) do {} while (0)
#ifndef MK_STAGN
#define MK_STAGN 4
#endif
#ifndef MK_STAG2
#define MK_STAG2 0
#endif
#ifndef MK_STAG7
#define MK_STAG7 0
#endif
#ifndef MK_STAG9
#define MK_STAG9 0
#endif
#ifndef MK_STAG10
#define MK_STAG10 0
#endif
#define STAGGER(step_) do { if ((step_) > 0) { const unsigned long long t0_ = __builtin_amdgcn_s_memrealtime(), d_ = (unsigned long long)((blockIdx.x >> 3) % MK_STAGN) * (step_); while (__builtin_amdgcn_s_memrealtime() - t0_ < d_) __builtin_amdgcn_s_sleep(8); } } while (0)
#define REDERIVE() do { int t_ = threadIdx.x; asm volatile("" : "+v"(t_)); F.tid = t_; F.lane = t_ & 63; F.wave = __builtin_amdgcn_readfirstlane(t_ >> 6); } while (0)

#ifndef MK_SPLIT_P0
#define MK_SPLIT_P0 0
#endif
    if (IN(0)) { RELOAD_IN(); if (MK_SPLIT_P0 && multi) p0_prologue<1>(F); else p0_prologue<0>(F); if (BOTH(0)) GRID_BAR(); }
    if (MK_SPLIT_P0 && multi && !((F.vcu >> 4) & 1)) { RELOAD_IN(); p0_prologue<2>(F); __syncthreads(); REDERIVE(); }
    if (IN(1)) { RELOAD_IN(); p1_norm(F); if (BOTH(1)) BATCH_BAR(); }

    if (IN(2)) { RELOAD_IN();
        pg8::Gemm g{(const pg8::bf16_t*)(F.ws + WS_H), (const pg8::bf16_t*)(F.ws + WS_WIN), NTOK, NPROJ, DMODEL}; pg8::BatchOrder S; S.init(NPROJ, F.vcu);
        pg8::EpiProj E{(pg8::bf16_t*)(F.ws + WS_PR), (pg8::bf16_t*)(F.ws + WS_PF), attn_body::C2};
        STAGGER(MK_STAG2);
        pg8::gemm_phase<pg8::EpiProj, pg8::BatchOrder, PG8_ALIGN, PG8_SP2>(F.lds + RING_OFF, g, S, E);
        if (BOTH(2)) BATCH_BAR();
    }
    REDERIVE();
    if (IN(3)) { RELOAD_IN(); r0_lora_inputs(F);
        if (F.G == 256 && (F.vcu & 15) < 8) {
            REDERIVE(); RELOAD_IN(); int vc = F.vcu; asm volatile("" : "+s"(vc)); const int b = vc >> 4, h = vc & 7; const attn_body::bf16* PF = (const attn_body::bf16*)(F.ws + WS_PF);
            int tt = threadIdx.x; asm volatile("" : "+v"(tt));
            __syncthreads();
            attn_body::fill_kx((char*)lds, (const float*)(F.ws + WS_FG), F.in[IN_FB][h], b, h, PF, PF + 512, tt);
            attn_body::kx_store((const char*)lds, kxg_home(F, b * 8 + h), tt); }
        if (multi) BATCH_BAR(); }
    int odd = __builtin_amdgcn_readfirstlane(MK_ODD_ORDER ? (multi_ & (F.vcu >> 4) & 1) : 0); asm volatile("" : "+s"(odd));
#ifndef MK_ATT_DYN
#define MK_ATT_DYN 0
#endif
#if MK_ATT_DYN
#define ATTN_GROUP() do { if (IN(3) && F.G == 256) { RELOAD_IN(); int vc = F.vcu; asm volatile("" : "+s"(vc)); \
            const int b = vc >> 4; int h = (vc & 15) >> 1; \
            const attn_body::bf16* PF = (const attn_body::bf16*)(F.ws + WS_PF); \
            const attn_body::AttnTensors AT{PF, PF + 512, PF + 1024, (attn_body::bf16*)(F.ws + WS_MIX) + 512}; \
            gu32* cntb = F.ctl + CW_ATT + b * 128; \
            _Pragma("nounroll") for (;;) { int tt = threadIdx.x; asm volatile("" : "+v"(tt)); \
                attn_body::kx_load((char*)lds, kxg_home(F, b * 8 + h), tt); \
                const AttnDyn S{cntb + 16 * h, (volatile LAS int*)(F.MISC + 12), b * 8 + h}; \
                attn_body::attn_phase<AttnDyn>((char*)lds + RING_OFF, AT, S); \
                h = attn_pick(cntb, (volatile LAS int*)(F.MISC + 12)); if (h < 0) break; } \
            __syncthreads(); } REDERIVE(); } while (0)
#else
#define ATTN_PASS(pass_) do { int vc = F.vcu; asm volatile("" : "+s"(vc)); \
                const int g4 = vc >> 2, b = g4 >> 2, hp = g4 & 3, h = (pass_) ? 7 - hp : hp; \
                const attn_body::bf16* PF = (const attn_body::bf16*)(F.ws + WS_PF); \
                const attn_body::AttnTensors AT{PF, PF + 512, PF + 1024, (attn_body::bf16*)(F.ws + WS_MIX) + 512}; \
                int tt = threadIdx.x; asm volatile("" : "+v"(tt)); \
                attn_body::kx_load((char*)lds, kxg_home(F, b * 8 + h), tt); \
                const attn_body::StaticOrder S(vc, b * 8 + h); \
                attn_body::attn_phase<attn_body::StaticOrder>((char*)lds + RING_OFF, AT, S); \
                __syncthreads(); } while (0)
#define ATTN_GROUP() do { if (IN(3) && F.G == 256) { RELOAD_IN(); ATTN_PASS(0); ATTN_PASS(1); } REDERIVE(); } while (0)
#endif
#if defined(MK_TWAITV)
    if (!odd) { ATTN_GROUP(); const unsigned long long tw0_ = __builtin_amdgcn_s_memrealtime(); if (multi) BATCH_BAR();
        if (F.vcu == MK_TWAITV && threadIdx.x == 0) { const unsigned long long w_ = 4ull * (__builtin_amdgcn_s_memrealtime() - tw0_), t0_ = __builtin_amdgcn_s_memrealtime(); while (__builtin_amdgcn_s_memrealtime() - t0_ < w_) __builtin_amdgcn_s_sleep(8); }
        __syncthreads(); }
#else
    if (!odd) { ATTN_GROUP(); if (multi) BATCH_BAR(); }
#endif
    if (IN(4)) { RELOAD_IN(); if (F.G == 256) scan2::build(F); if (BOTH(4)) BATCH_BAR(); }
    REDERIVE();
    if (IN(5)) { RELOAD_IN(); if (F.G == 256) scan2::apply(F); if (BOTH(5)) BATCH_BAR(); }
    REDERIVE();
    if (IN(6)) { RELOAD_IN(); r2_post(F); }
    REDERIVE();
#if MK_ODD_ORDER
    asm volatile("" : "+s"(odd));
    if (odd) ATTN_GROUP();
#endif
#undef ATTN_GROUP
    if (multi) BATCH_BAR();
    if (IN(7)) { RELOAD_IN();
        pg8::Gemm g{(const pg8::bf16_t*)(F.ws + WS_MIX), (const pg8::bf16_t*)(F.ws + WS_WOUT), NTOK, DMODEL, DMODEL}; pg8::BatchOrder S; S.init(DMODEL, F.vcu);
        pg8::EpiResB E{F.in[IN_X], (pg8::bf16_t*)(F.ws + WS_X1B), (const float*)(F.ws + WS_MOD) + 2048, SEQ, X1B_XTRA};
        STAGGER(MK_STAG7);
        pg8::gemm_phase<pg8::EpiResB, pg8::BatchOrder, PG8_ALIGN, PG8_SP2>(F.lds + RING_OFF, g, S, E);
        if (BOTH(7)) BATCH_BAR();
    }
    REDERIVE();
    if (IN(8)) { RELOAD_IN(); m0_route(F); if (MK_SPLIT_P0 && multi && ((F.vcu >> 4) & 1)) { __syncthreads(); REDERIVE(); RELOAD_IN(); p0_prologue<2>(F); }
#if defined(MK_TWAIT8)
        { const unsigned long long tw0_ = __builtin_amdgcn_s_memrealtime(); if (BOTH(8)) GRID_BAR();
          if (F.vcu == MK_TWAIT8 && threadIdx.x == 0) { const unsigned long long w_ = 4ull * (__builtin_amdgcn_s_memrealtime() - tw0_), t0_ = __builtin_amdgcn_s_memrealtime(); while (__builtin_amdgcn_s_memrealtime() - t0_ < w_) __builtin_amdgcn_s_sleep(8); }
          __syncthreads(); } }
#else
        if (BOTH(8)) GRID_BAR(); }
#endif
    REDERIVE();
    if (IN(9)) { RELOAD_IN();
        moe_tile_table(F); moe_fill_tokl(F);
        const LAS int* tb = (const LAS int*)(F.lds + L_TB) + 32;
        pg8::Gemm g{(const pg8::bf16_t*)(F.ws + WS_H), (const pg8::bf16_t*)(F.ws + WS_W1), 0, 0, DMODEL}; MoeOrder<true> S{tb, (const LAS int*)(F.lds + L_TOKL), F.G, F.vcu, tb[32] * 4};
        pg8::EpiSwiGLU E{(pg8::bf16_t*)(F.ws + WS_HID)};
        STAGGER(MK_STAG9);
        pg8::gemm_phase<pg8::EpiSwiGLU, MoeOrder<true>, PG8_ALIGN, PG8_SP2>(F.lds + RING_OFF, g, S, E);
        if (BOTH(9)) GRID_BAR();
    }
    REDERIVE();
    if (IN(10)) { RELOAD_IN();
        moe_tile_table(F); moe_fill_wl(F);
        const LAS int* tb = (const LAS int*)(F.lds + L_TB) + 32;
        pg8::Gemm g{(const pg8::bf16_t*)(F.ws + WS_HID), (const pg8::bf16_t*)(F.ws + WS_W2), 0, 0, DEXP}; MoeOrder<false> S{tb, nullptr, F.G, F.vcu, tb[32] * 4};
        pg8::EpiDown E{(pg8::bf16_t*)(F.ws + WS_YB), (const LAS float*)(F.lds + L_TOKL)};
        STAGGER(MK_STAG10);
        pg8::gemm_phase<pg8::EpiDown, MoeOrder<false>, PG8_ALIGN, PG8_SP2>(F.lds + RING_OFF, g, S, E);
        if (BOTH(10)) GRID_BAR();
    }
    REDERIVE();
    if (IN(11)) { RELOAD_IN(); p_final(F); }
#undef IN
#undef BOTH
}

extern "C" void kernel_launch(void* const* d_in, const int* in_sizes, int n_in, void* d_out, int out_size, void* d_ws, size_t ws_size, hipStream_t stream) {
    static int grid = 0;
    if (grid == 0) {
        if (n_in != 28 || in_sizes[0] != NTOK * DMODEL || out_size != NTOK * DMODEL || ws_size < WS_END) {
            fprintf(stderr, "kernel_launch: unexpected shapes: n_in %d in0 %d out %d ws %zu (need %zu); nothing launched\n", n_in, n_in > 0 ? in_sizes[0] : -1, out_size, ws_size, (size_t)WS_END); grid = -1; return; }
        int dev = 0, cus = 0, per_cu = 0;
        if (hipGetDevice(&dev) != hipSuccess || hipDeviceGetAttribute(&cus, hipDeviceAttributeMultiprocessorCount, dev) != hipSuccess) { grid = -1; return; }
        if (hipFuncSetAttribute((const void*)mk_fwd, hipFuncAttributeMaxDynamicSharedMemorySize, LDS_BYTES) != hipSuccess) { fprintf(stderr, "kernel_launch: hipFuncSetAttribute failed\n"); grid = -1; return; }
        if (hipOccupancyMaxActiveBlocksPerMultiprocessor(&per_cu, (const void*)mk_fwd, NWAVES * 64, LDS_BYTES) != hipSuccess || per_cu < 1) { fprintf(stderr, "kernel_launch: occupancy query says %d blocks per CU\n", per_cu); per_cu = 1; }
        (void)hipGetLastError();
        grid = cus;
        if (grid != 256) fprintf(stderr, "kernel_launch: %d CUs; this kernel is tuned for 256\n", grid);
    }
    if (grid < 0) return;
    if (hipMemsetAsync((char*)d_ws + WS_CTL, 0, CTL_ZERO_BYTES, stream) != hipSuccess) return;
    Args a{};
    for (int i = 0; i < 28; ++i) a.in[i] = (const float*)d_in[i];
    a.out = (float*)d_out; a.ws = (unsigned char*)d_ws;
#if MK_ONE_LAUNCH
    a.ph_lo = 0; a.ph_hi = N_PHASES;
    hipLaunchKernelGGL(mk_fwd, dim3(grid), dim3(NWAVES * 64), LDS_BYTES, stream, a);
#else
    for (int p = 0; p < N_PHASES; ++p) for (int rep = 0; rep < 1 + ((MK_REP_MASK >> p) & 1); ++rep) { a.ph_lo = p; a.ph_hi = p + 1; hipLaunchKernelGGL(mk_fwd, dim3(grid), dim3(NWAVES * 64), LDS_BYTES, stream, a); }
#endif
}
```

```cpp
#include <hip/hip_runtime.h>
#include <hip/hip_bf16.h>
#include <hip/hip_fp16.h>
#include <cstdio>
#include <cstdint>
#include <cmath>
namespace pg8 {
#define PG8_LAS __attribute__((address_space(3)))
typedef unsigned short bf16_t;
typedef short bf16x8 __attribute__((ext_vector_type(8)));
typedef float f32x4 __attribute__((ext_vector_type(4)));
typedef unsigned u32x4 __attribute__((ext_vector_type(4)));
constexpr int BM = 256, BK = 64, HALF = 128, HTB = HALF * BK * 2  , STAGE_BYTES = 8 * HTB, NXCD = 8, WGM = 2;

__host__ __device__ __forceinline__ int lds_byte(int r, int c) { const int st = (r >> 4) * 2 + (c >> 5), rr = r & 15, cc = c & 31, ob = rr * 64 + cc * 2; return st * 1024 + (ob ^ (((ob >> 9) & 1) << 5)); }
__host__ __device__ __forceinline__ void stage_rc(int b, int& R, int& C) { const int st = b / 1024, sb = b % 1024, swz = sb ^ (((sb >> 9) & 1) << 5); R = (st >> 1) * 16 + swz / 64; C = (st & 1) * 32 + (swz % 64) / 2; }
__host__ __device__ __forceinline__ int perm32(int rho) { const int n = rho >> 4, i = rho & 15; return 8 * (i >> 2) + 4 * n + (i & 3); }

struct Unit { int pm, pn, e, j; };
struct Gemm { const bf16_t* A; const bf16_t* Bt; int M, N, K; };

#ifndef MK_BWGM
#define MK_BWGM 2
#endif
constexpr int BWGM = MK_BWGM;
struct BatchOrder {
    static constexpr bool GATHER = false;
    __device__ __forceinline__ unsigned a_row(int, int) const { return 0u; }
    int nN, nwb, vcu;
    __host__ __device__ void init(int N, int vcu_) { nN = N / BM; nwb = 16 * nN; vcu = vcu_; }
    __host__ __device__ bool next(int i, Unit& u) const {
        const int w = i * 16 + (vcu & 15); if (w >= nwb) return false;
        const int nig = BWGM * nN, gid = w / nig, r = w % nig;
        u.pm = (vcu >> 4) * 16 + gid * BWGM + r % BWGM; u.pn = r / BWGM; u.e = 0; u.j = 0; return true;
    }
    __device__ __forceinline__ void a_ready(const Unit&) const {}
    __device__ __forceinline__ void done(const Unit&) const {}
};
struct StaticOrder {
    static constexpr bool GATHER = false;
    __device__ __forceinline__ unsigned a_row(int, int) const { return 0u; }
    int nM, nN, nwg, G, c;
    __host__ __device__ void init(int M, int N, int G_, int c_) { nM = M / BM; nN = N / BM; nwg = nM * nN; G = G_; c = c_; }
    __host__ __device__ bool next(int i, Unit& u) const {
        const long L = (long)i * G + c; if (L >= nwg) return false;
        int wgid = (int)L; { const int q = nwg / NXCD, r = nwg % NXCD, xcd = wgid % NXCD, off = wgid / NXCD; wgid = (xcd < r ? xcd * (q + 1) : r * (q + 1) + (xcd - r) * q) + off; }
        const int nig = WGM * nN, gid = wgid / nig, fm = gid * WGM, gsz = (nM - fm) < WGM ? (nM - fm) : WGM;
        u.pm = fm + ((wgid % nig) % gsz); u.pn = (wgid % nig) / gsz; u.e = 0; u.j = 0; return true;
    }
    __device__ __forceinline__ void a_ready(const Unit&) const {}
    __device__ __forceinline__ void done(const Unit&) const {}
};


__device__ __forceinline__ unsigned cvt_pk_bf16(float lo, float hi) { unsigned r; asm volatile("v_cvt_pk_bf16_f32 %0, %1, %2" : "=v"(r) : "v"(lo), "v"(hi)); return r; }

struct EpiProj {
    static constexpr bool PERM = true, AFTER_DRAIN = false;
    bf16_t* PR; bf16_t* PF; float qscale;
    __device__ __forceinline__ void operator()(const f32x4 (&acc)[2][2][4][2], const Unit& u, int wr, int wc, int fr, int fq) const {
        const int row0 = u.pm * BM + wr * 64 + fr;
        bf16_t* base; int ldc, colt; float sc = 1.f;
        if (u.pn < 7) { base = PR; ldc = 1792; colt = u.pn * BM; } else { base = PF; ldc = 1536; colt = (u.pn - 7) * BM; if (u.pn < 9) sc = qscale; }
        const int col0 = colt + wc * 32 + 8 * fq;
#pragma unroll
        for (int ai = 0; ai < 2; ++ai)
#pragma unroll
            for (int m = 0; m < 4; ++m) { bf16_t* rowp = base + (size_t)(row0 + ai * HALF + m * 16) * ldc + col0;
#pragma unroll
                for (int bj = 0; bj < 2; ++bj) { const f32x4 v0 = acc[ai][bj][m][0] * sc, v1 = acc[ai][bj][m][1] * sc;
                    u32x4 w; w.x = cvt_pk_bf16(v0[0], v0[1]); w.y = cvt_pk_bf16(v0[2], v0[3]); w.z = cvt_pk_bf16(v1[0], v1[1]); w.w = cvt_pk_bf16(v1[2], v1[3]);
                    *(u32x4*)(rowp + bj * HALF) = w; } }
    }
};
struct EpiRes {
    static constexpr bool PERM = false, AFTER_DRAIN = false;
    const float* x; float* out; const float* gate; int rows_per_batch;
    __device__ __forceinline__ void operator()(const f32x4 (&acc)[2][2][4][2], const Unit& u, int wr, int wc, int fr, int fq) const {
        const int b = (u.pm * BM) / rows_per_batch; const float* g = gate + (size_t)b * 6144;
        const int col0 = u.pn * BM + wc * 32 + 4 * fq;
#pragma unroll
        for (int bj = 0; bj < 2; ++bj)
#pragma unroll
            for (int n = 0; n < 2; ++n) { const f32x4 gv = *(const f32x4*)(g + col0 + bj * HALF + n * 16);
#pragma unroll
                for (int ai = 0; ai < 2; ++ai)
#pragma unroll
                    for (int m = 0; m < 4; ++m) { const size_t off = (size_t)(u.pm * BM + ai * HALF + wr * 64 + m * 16 + fr) * 1024 + col0 + bj * HALF + n * 16;
                        const f32x4 xv = *(const f32x4*)(x + off); *(f32x4*)(out + off) = xv + gv * acc[ai][bj][m][n]; } }
    }
};

struct EpiResB {
    static constexpr bool PERM = true, AFTER_DRAIN = false;
    const float* x; bf16_t* out; const float* gate; int rows_per_batch; size_t out_xtra;
    __device__ __forceinline__ void operator()(const f32x4 (&acc)[2][2][4][2], const Unit& u, int wr, int wc, int fr, int fq) const {
        const int b = (u.pm * BM) / rows_per_batch; const float* g = gate + (size_t)b * 6144; bf16_t* outb = out + (size_t)b * out_xtra;
        const int col0 = u.pn * BM + wc * 32 + 8 * fq;
#pragma unroll
        for (int bj = 0; bj < 2; ++bj) { const f32x4 g0 = *(const f32x4*)(g + col0 + bj * HALF), g1 = *(const f32x4*)(g + col0 + bj * HALF + 4);
#pragma unroll
            for (int ai = 0; ai < 2; ++ai)
#pragma unroll
                for (int m = 0; m < 4; ++m) { const size_t off = (size_t)(u.pm * BM + ai * HALF + wr * 64 + m * 16 + fr) * 1024 + col0 + bj * HALF;
                    const f32x4 v0 = *(const f32x4*)(x + off) + g0 * acc[ai][bj][m][0], v1 = *(const f32x4*)(x + off + 4) + g1 * acc[ai][bj][m][1];
                    u32x4 w; w.x = cvt_pk_bf16(v0[0], v0[1]); w.y = cvt_pk_bf16(v0[2], v0[3]); w.z = cvt_pk_bf16(v1[0], v1[1]); w.w = cvt_pk_bf16(v1[2], v1[3]);
                    *(u32x4*)(outb + off) = w; } }
    }
};
template <class Epi, class Sched, bool ALIGN_EPI = false, bool SP2 = false>
__device__ __forceinline__ void gemm_phase(PG8_LAS unsigned char* lds, const Gemm g, const Sched& S, const Epi& E) {
    const int tid = threadIdx.x, wid = __builtin_amdgcn_readfirstlane(tid >> 6), lane = tid & 63, wr = wid >> 2, wc = wid & 3, fr = lane & 15, fq = lane >> 4;
    const int K = g.K, nt = K / BK;
    unsigned voffA[2], voffB[2];
#pragma unroll
    for (int i = 0; i < 2; ++i) { int R, C; stage_rc(tid * 16 + i * 8192, R, C); const int Rb = Epi::PERM ? ((R & ~31) + perm32(R & 31)) : R;
        voffA[i] = (unsigned)(R * K + C) * 2u; voffB[i] = (unsigned)(Rb * K + C) * 2u; }
    constexpr bool GATHER = Sched::GATHER;
    int gR[2], gC[2];
#pragma unroll
    for (int i = 0; i < 2; ++i) stage_rc(tid * 16 + i * 8192, gR[i], gC[i]);
    unsigned offC[2][2] = {{0u, 0u}, {0u, 0u}}, offN[2][2] = {{0u, 0u}, {0u, 0u}};
#define PG8_GOFF(dst, ui_) do { _Pragma("unroll") for (int h_ = 0; h_ < 2; ++h_) _Pragma("unroll") for (int i_ = 0; i_ < 2; ++i_) dst[h_][i_] = (unsigned)(S.a_row((ui_), 128 * h_ + gR[i_]) * (unsigned)K + (unsigned)gC[i_]) * 2u; } while (0)
#define PG8_STAGE_A(bufoff, ptr, h, nx) do { if constexpr (GATHER) { unsigned o_[2] = {(nx) ? offN[h][0] : offC[h][0], (nx) ? offN[h][1] : offC[h][1]}; PG8_STAGE(bufoff, ptr, o_); } else { PG8_STAGE(bufoff, (ptr) + (h) * hstep, voffA); } } while (0)
    const size_t kstep = (size_t)(BK * 2);
    const size_t hstep = (size_t)HALF * K * 2;
    const size_t tstep = 2 * hstep;
    const unsigned ldsw = (unsigned)wid * 1024u;
    const int aoff = lds_byte(wr * 64 + fr, fq * 8), boff = lds_byte(wc * 32 + fr, fq * 8);
#define PG8_SA(b, h) (((b) * 2 + (h)) * HTB)
#define PG8_SB(b, h) ((4 + (b) * 2 + (h)) * HTB)
#define PG8_STAGE(bufoff, gbase, voff) do { _Pragma("unroll") for (int _i = 0; _i < 2; ++_i) \
        __builtin_amdgcn_global_load_lds((const unsigned*)((const char*)(gbase) + (voff)[_i]), (PG8_LAS unsigned*)(lds + (bufoff) + ldsw + _i * 8192), 16, 0, 0); } while (0)
#define PG8_LDA(dst, b, h) do { _Pragma("unroll") for (int m = 0; m < 4; ++m) _Pragma("unroll") for (int k = 0; k < 2; ++k) dst[m][k] = *(const PG8_LAS bf16x8*)(lds + PG8_SA(b, h) + aoff + m * 2048 + k * 1024); } while (0)
#define PG8_LDB(dst, b, h) do { _Pragma("unroll") for (int n = 0; n < 2; ++n) _Pragma("unroll") for (int k = 0; k < 2; ++k) dst[n][k] = *(const PG8_LAS bf16x8*)(lds + PG8_SB(b, h) + boff + n * 2048 + k * 1024); } while (0)
#define PG8_MMA(ai, bj, At, Bt) do { __builtin_amdgcn_s_setprio(1); _Pragma("unroll") for (int m = 0; m < 4; ++m) _Pragma("unroll") for (int n = 0; n < 2; ++n) _Pragma("unroll") for (int k = 0; k < 2; ++k) \
        acc[ai][bj][m][n] = __builtin_amdgcn_mfma_f32_16x16x32_bf16(Bt[n][k], At[m][k], acc[ai][bj][m][n], 0, 0, 0); __builtin_amdgcn_s_setprio(0); } while (0)
#define PG8_WAIT_V(n) asm volatile("s_waitcnt vmcnt(" #n ")" ::: "memory")
#define PG8_WAIT_L(n) asm volatile("s_waitcnt lgkmcnt(" #n ")" ::: "memory")
#define PG8_BAR __builtin_amdgcn_s_barrier()
#define PG8_SCHED __builtin_amdgcn_sched_barrier(0)
    Unit cur, nxt; int ui = 0;
    if (!S.next(0, cur)) return;
    f32x4 acc[2][2][4][2];
#pragma unroll
    for (int a = 0; a < 2; ++a)
#pragma unroll
        for (int b = 0; b < 2; ++b)
#pragma unroll
            for (int m = 0; m < 4; ++m)
#pragma unroll
                for (int n = 0; n < 2; ++n) acc[a][b][m][n] = (f32x4){0.f, 0.f, 0.f, 0.f};
    bf16x8 At[4][2], B0[2][2], B1[2][2];
    const char* cA = GATHER ? (const char*)g.A : (const char*)g.A + (size_t)cur.pm * tstep; const char* cB = (const char*)g.Bt + (size_t)cur.pn * tstep;
    if constexpr (GATHER) PG8_GOFF(offC, 0);
    S.a_ready(cur);
    if constexpr (SP2) {
        PG8_STAGE(PG8_SB(0, 0), cB, voffB); PG8_STAGE(PG8_SB(0, 1), cB + hstep, voffB); PG8_STAGE_A(PG8_SA(0, 0), cA, 0, false); PG8_STAGE_A(PG8_SA(0, 1), cA, 1, false);
        if (wr == 1) PG8_BAR;
        PG8_WAIT_V(2); PG8_BAR;
        PG8_STAGE(PG8_SB(1, 0), cB + kstep, voffB); PG8_STAGE_A(PG8_SA(1, 0), cA + kstep, 0, false); PG8_STAGE(PG8_SB(1, 1), cB + hstep + kstep, voffB);
        PG8_WAIT_V(6); PG8_BAR;
    } else {
        PG8_STAGE(PG8_SB(0, 0), cB, voffB); PG8_STAGE(PG8_SA(0, 0), cA, voffA); PG8_STAGE(PG8_SB(0, 1), cB + hstep, voffB); PG8_STAGE(PG8_SA(0, 1), cA + hstep, voffA);
        if (wr == 1) PG8_BAR;
        PG8_WAIT_V(4); PG8_BAR;
        PG8_STAGE(PG8_SB(1, 0), cB + kstep, voffB); PG8_STAGE(PG8_SA(1, 0), cA + kstep, voffA); PG8_STAGE(PG8_SB(1, 1), cB + hstep + kstep, voffB);
        PG8_WAIT_V(6); PG8_BAR;
    }
    for (;;) {
        const bool has_next = S.next(ui + 1, nxt);
        const char* nA = GATHER ? cA : (has_next ? (const char*)g.A + (size_t)nxt.pm * tstep : cA); const char* nB = has_next ? (const char*)g.Bt + (size_t)nxt.pn * tstep : cB;
        if constexpr (GATHER) { if (has_next) PG8_GOFF(offN, ui + 1); else { _Pragma("unroll") for (int h_ = 0; h_ < 2; ++h_) _Pragma("unroll") for (int i_ = 0; i_ < 2; ++i_) offN[h_][i_] = offC[h_][i_]; } }
        for (int t = 0; t < nt; t += 2) {
            const bool last = (t == nt - 2);
            const char* a1 = cA + (size_t)(t + 1) * kstep;
            const char* a2 = last ? nA : cA + (size_t)(t + 2) * kstep; const char* b2 = last ? nB : cB + (size_t)(t + 2) * kstep;
            const char* a3 = a2 + kstep; const char* b3 = b2 + kstep;
            if (last && has_next) S.a_ready(nxt);
            if constexpr (SP2) {
            PG8_LDB(B0, 0, 0); PG8_LDB(B1, 0, 1); PG8_SCHED; PG8_LDA(At, 0, 0); PG8_STAGE_A(PG8_SA(1, 1), a1, 1, false);
            PG8_WAIT_V(8); PG8_WAIT_L(0); PG8_BAR; PG8_MMA(0, 0, At, B0); PG8_MMA(0, 1, At, B1); PG8_BAR; PG8_SCHED;
            PG8_LDA(At, 0, 1); PG8_STAGE(PG8_SB(0, 0), b2, voffB); PG8_STAGE(PG8_SB(0, 1), b2 + hstep, voffB); PG8_STAGE_A(PG8_SA(0, 0), a2, 0, last);
            PG8_WAIT_V(8); PG8_WAIT_L(0); PG8_BAR; PG8_MMA(1, 0, At, B0); PG8_MMA(1, 1, At, B1); PG8_BAR; PG8_SCHED;
            PG8_LDB(B0, 1, 0); PG8_LDB(B1, 1, 1); PG8_SCHED; PG8_LDA(At, 1, 0); PG8_STAGE_A(PG8_SA(0, 1), a2, 1, last);
            PG8_WAIT_V(8); PG8_WAIT_L(0); PG8_BAR; PG8_MMA(0, 0, At, B0); PG8_MMA(0, 1, At, B1); PG8_BAR; PG8_SCHED;
            PG8_LDA(At, 1, 1); PG8_STAGE(PG8_SB(1, 0), b3, voffB); PG8_STAGE(PG8_SB(1, 1), b3 + hstep, voffB); PG8_STAGE_A(PG8_SA(1, 0), a3, 0, last);
            PG8_WAIT_V(8); PG8_WAIT_L(0); PG8_BAR; PG8_MMA(1, 0, At, B0); PG8_MMA(1, 1, At, B1); PG8_BAR; PG8_SCHED;
            } else {
            PG8_LDB(B0, 0, 0); PG8_SCHED; PG8_LDA(At, 0, 0); PG8_STAGE(PG8_SA(1, 1), a1 + hstep, voffA);
            PG8_WAIT_L(8); PG8_BAR; PG8_WAIT_L(0); PG8_MMA(0, 0, At, B0); PG8_BAR; PG8_SCHED;
            PG8_LDB(B1, 0, 1); PG8_STAGE(PG8_SB(0, 0), b2, voffB);
            PG8_BAR; PG8_WAIT_L(0); PG8_MMA(0, 1, At, B1); PG8_BAR;
            PG8_LDA(At, 0, 1); PG8_STAGE(PG8_SA(0, 0), a2, voffA);
            PG8_BAR; PG8_WAIT_L(0); PG8_MMA(1, 0, At, B0); PG8_BAR; PG8_SCHED;
            PG8_STAGE(PG8_SB(0, 1), b2 + hstep, voffB);
            PG8_WAIT_V(6); PG8_BAR; PG8_MMA(1, 1, At, B1); PG8_BAR;
            PG8_LDB(B0, 1, 0); PG8_SCHED; PG8_LDA(At, 1, 0); PG8_STAGE(PG8_SA(0, 1), a2 + hstep, voffA);
            PG8_WAIT_L(8); PG8_BAR; PG8_WAIT_L(0); PG8_MMA(0, 0, At, B0); PG8_BAR; PG8_SCHED;
            PG8_LDB(B1, 1, 1); PG8_STAGE(PG8_SB(1, 0), b3, voffB);
            PG8_BAR; PG8_WAIT_L(0); PG8_MMA(0, 1, At, B1); PG8_BAR;
            PG8_LDA(At, 1, 1); PG8_STAGE(PG8_SA(1, 0), a3, voffA);
            PG8_BAR; PG8_WAIT_L(0); PG8_MMA(1, 0, At, B0); PG8_BAR; PG8_SCHED;
            PG8_STAGE(PG8_SB(1, 1), b3 + hstep, voffB);
            PG8_WAIT_V(6); PG8_BAR; PG8_MMA(1, 1, At, B1); PG8_BAR;
            }
        }
        if constexpr (ALIGN_EPI) { if (wr == 0) PG8_BAR; }
#if defined(MK_EPI2)
        if constexpr (!Epi::AFTER_DRAIN) { E(acc, cur, wr, wc, fr, fq); asm volatile("" ::: "memory"); }
#endif
        if constexpr (!Epi::AFTER_DRAIN) { E(acc, cur, wr, wc, fr, fq); S.done(cur); }
        if (!has_next) break;
#pragma unroll
        for (int a = 0; a < 2; ++a)
#pragma unroll
            for (int b = 0; b < 2; ++b)
#pragma unroll
                for (int m = 0; m < 4; ++m)
#pragma unroll
                    for (int n = 0; n < 2; ++n) acc[a][b][m][n] = (f32x4){0.f, 0.f, 0.f, 0.f};
        cur = nxt; cA = nA; cB = nB; ++ui;
        if constexpr (GATHER) { _Pragma("unroll") for (int h_ = 0; h_ < 2; ++h_) _Pragma("unroll") for (int i_ = 0; i_ < 2; ++i_) offC[h_][i_] = offN[h_][i_]; }
        if constexpr (ALIGN_EPI) { if (wr == 1) PG8_BAR; }
    }
    PG8_WAIT_V(0);
    if constexpr (!ALIGN_EPI) { if (wr == 0) PG8_BAR; }
    PG8_BAR;
    if constexpr (Epi::AFTER_DRAIN) { E.fused(acc, cur, wr, wc, fr, fq, lds, wid, lane); S.done(cur); }
#undef PG8_SA
#undef PG8_SB
#undef PG8_STAGE
#undef PG8_STAGE_A
#undef PG8_GOFF
#undef PG8_LDA
#undef PG8_LDB
#undef PG8_MMA
#undef PG8_WAIT_V
#undef PG8_WAIT_L
#undef PG8_BAR
#undef PG8_SCHED
}
}

#ifndef PG8_SP2
#define PG8_SP2 true
#endif
#ifndef PG8_ALIGN
#define PG8_ALIGN true
#endif
namespace attn_body {
using bf16=__hip_bfloat16;
using bf16x8=__attribute__((ext_vector_type(8)))short;
using s16x4=__attribute__((ext_vector_type(4)))short;
using f32x16=__attribute__((ext_vector_type(16)))float;
using u32x4=__attribute__((ext_vector_type(4)))unsigned;
constexpr int BATCH=16,NHEAD=8,SEQ=4096,D=64,DMQ=1536,DMO=1024;
constexpr int NW=8,QBLK=32,QB=QBLK*NW,KVBLK=64,NQB=SEQ/QB;
constexpr int ATTN_UNIT_ROWS=QB;
__device__ __forceinline__ int crow(int r,int hi){return (r&3)+8*(r>>2)+4*hi;}
#define SBAR() __builtin_amdgcn_sched_barrier(0)
__device__ __forceinline__ void cmask(f32x16&p0,f32x16&p1,int jb,int qrel,int hi){
  const float NEG=-INFINITY; asm volatile("":"+v"(hi)); int kb=64*jb+4*hi;
  #pragma unroll
  for(int r=0;r<16;++r){int kv=kb+(r&3)+8*(r>>2); if(kv>qrel)p0[r]=NEG; if(kv+32>qrel)p1[r]=NEG;}
}

constexpr int NSLOT=3, SLOTB=8192;
constexpr int LDS_K=0, LDS_V=NSLOT*SLOTB, LDS_WS=2*NSLOT*SLOTB, LDS_OST=LDS_WS+NW*64*4, LDS_KX=LDS_OST+NW*4096, LDS_CB=LDS_KX+SEQ*16+16, LDS_BYTES=LDS_CB+1024;
constexpr float C2=0.125f*1.4426950408889634f;
__device__ __forceinline__ void glds16(const void*gsrc,unsigned lds_dst){unsigned keep;
  asm volatile("s_mov_b32 %0, m0\n\ts_mov_b32 m0, %2\n\ts_nop 0\n\tglobal_load_lds_dwordx4 %1, off\n\ts_mov_b32 m0, %0":"=&s"(keep):"v"(gsrc),"s"(lds_dst):"memory");}
__device__ __forceinline__ float max3f(float a,float b,float c){float r;asm("v_max3_f32 %0, %1, %2, %3":"=v"(r):"v"(a),"v"(b),"v"(c));return r;}
__device__ __forceinline__ float max2f(float a,float b){float r;asm("v_max_f32_e32 %0, %1, %2":"=v"(r):"v"(a),"v"(b));return r;}
__device__ __forceinline__ float fadd_s(float a,float b){float r;asm("v_add_f32_e32 %0, %1, %2":"=v"(r):"v"(a),"v"(b));return r;}
__device__ __forceinline__ float fsub_s(float a,float b){float r;asm("v_sub_f32_e32 %0, %1, %2":"=v"(r):"v"(a),"v"(b));return r;}
typedef float f32x2_t __attribute__((ext_vector_type(2))); typedef __bf16 bf16x2_t __attribute__((ext_vector_type(2)));
__device__ __forceinline__ unsigned cvtpk_s(float lo,float hi){f32x2_t v={lo,hi};bf16x2_t b=__builtin_convertvector(v,bf16x2_t);return __builtin_bit_cast(unsigned,b);}
#define WAIT_BAR(N) asm volatile("s_waitcnt vmcnt(" #N ") lgkmcnt(0)\n\ts_barrier":::"memory")

__device__ __forceinline__ void qkt(f32x16&p0,f32x16&p1,const char*Kslot,const bf16x8*qr,bf16x8 kx0,bf16x8 kx1,bf16x8 qx,int r32,int hi){
  const char*kb=Kslot+hi*1024+r32*16; const f32x16 z16=f32x16{};
  p0=__builtin_amdgcn_mfma_f32_32x32x16_bf16(kx0,qx,z16,0,0,0);p1=__builtin_amdgcn_mfma_f32_32x32x16_bf16(kx1,qx,z16,0,0,0);
  #pragma unroll
  for(int d0=0;d0<4;++d0){
    const bf16x8 b0=*reinterpret_cast<const bf16x8*>(kb+d0*2048);
    const bf16x8 b1=*reinterpret_cast<const bf16x8*>(kb+d0*2048+512);
    p0=__builtin_amdgcn_mfma_f32_32x32x16_bf16(b0,qr[d0],p0,0,0,0);p1=__builtin_amdgcn_mfma_f32_32x32x16_bf16(b1,qr[d0],p1,0,0,0);}
}
typedef __attribute__((address_space(3))) const char* lds_cptr;
typedef short v4i16_t __attribute__((ext_vector_type(4)));
__device__ __forceinline__ void kload8(bf16x8*kf,lds_cptr kp){
  kf[0]=*(const __attribute__((address_space(3))) bf16x8*)(kp);      kf[1]=*(const __attribute__((address_space(3))) bf16x8*)(kp+512);
  kf[2]=*(const __attribute__((address_space(3))) bf16x8*)(kp+2048); kf[3]=*(const __attribute__((address_space(3))) bf16x8*)(kp+2560);
  kf[4]=*(const __attribute__((address_space(3))) bf16x8*)(kp+4096); kf[5]=*(const __attribute__((address_space(3))) bf16x8*)(kp+4608);
  kf[6]=*(const __attribute__((address_space(3))) bf16x8*)(kp+6144); kf[7]=*(const __attribute__((address_space(3))) bf16x8*)(kp+6656);
}
__device__ __forceinline__ void kload2(bf16x8*kf,lds_cptr kp,int j){ kf[2*j]=*(const __attribute__((address_space(3))) bf16x8*)(kp+j*2048); kf[2*j+1]=*(const __attribute__((address_space(3))) bf16x8*)(kp+j*2048+512); }
__device__ __forceinline__ s16x4 vtr(lds_cptr p){ return __builtin_bit_cast(s16x4,__builtin_amdgcn_ds_read_tr16_b64_v4i16((__attribute__((address_space(3))) v4i16_t*)p)); }
__device__ __forceinline__ float rowmax(const f32x16&p0,const f32x16&p1){
  float a=max3f(p0[0],p0[1],p1[0]),b=max3f(p0[2],p0[3],p1[1]);a=max3f(a,p1[2],p1[3]);
  #pragma unroll
  for(int r=4;r<16;r+=4){a=max3f(a,p0[r],p0[r+1]);b=max3f(b,p0[r+2],p0[r+3]);a=max3f(a,p1[r],p1[r+1]);b=max3f(b,p1[r+2],p1[r+3]);}
  const float m=max2f(a,b);
  auto rr=__builtin_amdgcn_permlane32_swap(__float_as_uint(m),__float_as_uint(m),false,false);
  return max2f(__uint_as_float(rr[0]),__uint_as_float(rr[1]));
}
__device__ __forceinline__ void pv(f32x16*o,int vb,bf16x8 pa0,bf16x8 pa1,bf16x8 pa2,bf16x8 pa3){
  #pragma unroll
  for(int d0=0;d0<2;++d0){s16x4 lo[4],hi[4];
    #pragma unroll
    for(int ks=0;ks<4;++ks){
      asm volatile("ds_read_b64_tr_b16 %0,%1 offset:%c2":"=&v"(lo[ks]):"v"(vb),"i"(d0*4096+ks*1024):"memory");
      asm volatile("ds_read_b64_tr_b16 %0,%1 offset:%c2":"=&v"(hi[ks]):"v"(vb),"i"(d0*4096+ks*1024+512):"memory");}
    asm volatile("s_waitcnt lgkmcnt(0)":::"memory");SBAR();
    #define PK(k) (bf16x8){lo[k][0],lo[k][1],lo[k][2],lo[k][3],hi[k][0],hi[k][1],hi[k][2],hi[k][3]}
    o[d0]=__builtin_amdgcn_mfma_f32_32x32x16_bf16(pa0,PK(0),o[d0],0,0,0);
    o[d0]=__builtin_amdgcn_mfma_f32_32x32x16_bf16(pa1,PK(1),o[d0],0,0,0);
    o[d0]=__builtin_amdgcn_mfma_f32_32x32x16_bf16(pa2,PK(2),o[d0],0,0,0);
    o[d0]=__builtin_amdgcn_mfma_f32_32x32x16_bf16(pa3,PK(3),o[d0],0,0,0);
    #undef PK
  }
}

#ifndef ATTN_STORE16
#define ATTN_STORE16(p,v) (*(u32x4*)(p)=(v))
#endif
template<int THRL> __device__ __forceinline__ void attn_unit(int b,int h,int qb,int ts,const bf16*Q,const bf16*__restrict__ K,const bf16*__restrict__ V,bf16*O,char*shm){
#if defined(MK_TATT)
  const unsigned long long tu0_=__builtin_amdgcn_s_memrealtime();
#endif
  int tid_=threadIdx.x; asm volatile("":"+v"(tid_));
  const int tid=tid_,lane=tid&63,r32=lane&31,hi=lane>>5; const int wid=__builtin_amdgcn_readfirstlane(tid>>6);
  const long rowbase=(long)b*SEQ; const int q0=qb*QB;
  const bf16*Qw=Q+(rowbase+q0+wid*QBLK)*DMQ+h*D;
  const bf16*Kh=K+(rowbase+(long)ts*KVBLK)*DMQ+h*D,*Vh=V+(rowbase+(long)ts*KVBLK)*DMQ+h*D;
  const unsigned lds0=(unsigned)(uintptr_t)shm;
  float*wsf=(float*)(shm+LDS_WS)+wid*64;
  auto wsh_=[&]()->const float*{ int h_=hi; asm volatile("":"+v"(h_)); return wsf+4*h_; };
  const bf16*ksrc=Kh+(long)lane*DMQ+wid*8;
  const bf16*vsrc=Vh+(long)(16*(wid&3)+(lane>>2))*DMQ+(wid>>2)*32+(lane&3)*8;
  const unsigned kdst=lds0+LDS_K+wid*1024, vdst=lds0+LDS_V+wid*1024;
  #define DMA_K(t,slot) glds16(ksrc+(long)(t)*KVBLK*DMQ,(unsigned)__builtin_amdgcn_readfirstlane(kdst+(slot)))
  #define DMA_V(t,slot) glds16(vsrc+(long)(t)*KVBLK*DMQ,(unsigned)__builtin_amdgcn_readfirstlane(vdst+(slot)))
  const int vb0=(int)(lds0+LDS_V)+((lane>>4)&1)*32+(lane&3)*8+(4*hi+((lane&15)>>2))*64;
  const char*Kbase=shm+LDS_K; bf16x8 kf[8];
  const lds_cptr shm3=(lds_cptr)shm; const lds_cptr kp0=shm3+LDS_K+hi*1024+r32*16; const lds_cptr vp0=shm3+LDS_V+((lane>>4)&1)*32+(lane&3)*8+(4*hi+((lane&15)>>2))*64;
  const int NT=(q0+QB)/KVBLK-ts;
  DMA_K(0,0);DMA_V(0,0);DMA_K(1,SLOTB);
  bf16x8 qr[4];
  #pragma unroll
  for(int d0=0;d0<4;++d0)qr[d0]=*reinterpret_cast<const bf16x8*>(&Qw[(long)r32*DMQ+d0*16+hi*8]);
  float mhat=0.f,l_reg=0.f;f32x16 o[2];o[0]=f32x16{};o[1]=f32x16{};
  const lds_cptr kxp0=(lds_cptr)shm+LDS_KX+ts*1024+r32*16;
  u32x4 qxw; qxw[0]=hi?0u:0x3F803F80u; qxw[1]=hi?0u:0x00003F80u; qxw[2]=0u; qxw[3]=0u;
  #define SETQX() do{ const float m_=-mhat; const unsigned h1_=cvtpk_s(m_,0.f)&0xffffu; const float r1_=m_-__uint_as_float(h1_<<16); const unsigned h2_=cvtpk_s(r1_,0.f)&0xffffu; const float r2_=r1_-__uint_as_float(h2_<<16); \
      const unsigned h3_=cvtpk_s(r2_,0.f)&0xffffu; qxw[1]=hi?0u:(0x3F80u|(h1_<<16)); qxw[2]=hi?0u:(h2_|(h3_<<16)); asm volatile("":"+v"(qxw)); }while(0)
  #define QX __builtin_bit_cast(bf16x8,qxw)
  #define KXF(t,n) (*(const __attribute__((address_space(3))) bf16x8*)(kxp0+(t)*1024+(n)*512))
  const int qrel=wid*QBLK+r32;
  #define CMASK(P0,P1,t) do{int jb_=(t)-(NT-4); if(jb_>=0)cmask(P0,P1,jb_,qrel,hi);}while(0)
  bool resc=false;
  #define START(P0,P1) do{ const float rm=rowmax(P0,P1); resc=false; \
    { const float dl=rm; mhat=fadd_s(mhat,dl); \
      _Pragma("unroll") for(int r=0;r<16;++r){P0[r]=fsub_s(P0[r],dl);P1[r]=fsub_s(P1[r],dl);} \
      SETQX(); } \
    _Pragma("unroll") for(int r=0;r<16;++r)P0[r]=__builtin_amdgcn_exp2f(P0[r]); }while(0)
  #define RESC() do{ if(resc){ asm volatile("s_waitcnt lgkmcnt(0)":::"memory"); \
      _Pragma("unroll") for(int d_=0;d_<2;++d_) _Pragma("unroll") for(int r=0;r<16;++r)o[d_][r]*=wsh_()[(r&3)+8*(r>>2)]; } }while(0)
  f32x16 pA0,pA1,pB0,pB1;
  int sl_prev=0,sl_cur=0,sl_next=SLOTB;
  #define ROT() do{sl_prev=sl_cur;sl_cur=sl_next;sl_next=(sl_next==(NSLOT-1)*SLOTB)?0:sl_next+SLOTB;}while(0)
  DMA_K(2,2*SLOTB);
  WAIT_BAR(3);
  qkt(pA0,pA1,Kbase,qr,KXF(0,0),KXF(0,1),QX,r32,hi);asm volatile("s_nop 15\n\ts_nop 7":"+v"(pA0),"+v"(pA1));CMASK(pA0,pA1,0);
  START(pA0,pA1);
  _Pragma("unroll") for(int r=0;r<16;++r)pA1[r]=__builtin_amdgcn_exp2f(pA1[r]);
  WAIT_BAR(0);
  DMA_K(3,0);DMA_V(1,SLOTB);
  ROT();
  kload8(kf,kp0+sl_cur);
  WAIT_BAR(2);
  s16x4 vlo[8],vhi[8]; u32x4 pw0,pw1,pw2,pw3;
  #define PKW(P,B) cvtpk_s(P[B],P[B+1])
  #define PAF(k) __builtin_bit_cast(bf16x8,pw##k)
  #define VFR(i) (bf16x8){vlo[i][0],vlo[i][1],vlo[i][2],vlo[i][3],vhi[i][0],vhi[i][1],vhi[i][2],vhi[i][3]}
  #define PIN(x) asm volatile("":"+v"(x))
  #define MX3(a,b,c) __builtin_fmaxf(__builtin_fmaxf((a),(b)),(c))
  #define GAPA(MF,A0,A1,A2,A3,W0,W1,PW) do{ MF; sacc+=A0; sacc+=A1; sacc+=A2; sacc+=A3; PIN(sacc); W0; W1; PIN(PW); SBAR(); }while(0)
  #define EX(v) __builtin_amdgcn_exp2f(v)
  #define GAPB(MF,X,B) do{ MF; X[B]=EX(X[B]); X[B+1]=EX(X[B+1]); X[B+2]=EX(X[B+2]); X[B+3]=EX(X[B+3]); PIN(X); SBAR(); }while(0)
  #define VRD(i) do{ vlo[i]=vtr(vp_+(((i)>>2)*4096+((i)&3)*1024)); vhi[i]=vtr(vp_+(((i)>>2)*4096+((i)&3)*1024+512)); }while(0)
  #define KRD(G,j) do{ if(G){ kload2(kf,kp0+sl_next,j); SBAR(); } }while(0)
  #define STEP(C0,C1,P0,P1,t,GK,GV,GL) do{ SBAR(); \
    const lds_cptr vp_=vp0+sl_prev; const f32x16 z16_=f32x16{}; \
    const bf16x8 kx0_=KXF(t,0), kx1_=KXF(t,1); \
    VRD(0); SBAR(); float sacc=(P0[0]+P0[1]); \
    GAPA(C0=__builtin_amdgcn_mfma_f32_32x32x16_bf16(kf[0],qr[0],z16_,0,0,0), P0[2],P0[3],P0[4],P0[5],     pw0[0]=PKW(P0,0), pw0[1]=PKW(P0,2), pw0); \
    VRD(4); SBAR(); GAPA(C1=__builtin_amdgcn_mfma_f32_32x32x16_bf16(kf[1],qr[0],z16_,0,0,0), P0[6],P0[7],P0[8],P0[9],     pw0[2]=PKW(P0,4), pw0[3]=PKW(P0,6), pw0); \
    VRD(1); SBAR(); GAPA(C0=__builtin_amdgcn_mfma_f32_32x32x16_bf16(kf[2],qr[1],C0,0,0,0),   P0[10],P0[11],P0[12],P0[13], pw1[0]=PKW(P0,8), pw1[1]=PKW(P0,10), pw1); \
    VRD(5); SBAR(); GAPA(C1=__builtin_amdgcn_mfma_f32_32x32x16_bf16(kf[3],qr[1],C1,0,0,0),   P0[14],P0[15],P1[0],P1[1],   pw1[2]=PKW(P0,12),pw1[3]=PKW(P0,14), pw1); \
    VRD(2); SBAR(); GAPA(C0=__builtin_amdgcn_mfma_f32_32x32x16_bf16(kf[4],qr[2],C0,0,0,0),   P1[2],P1[3],P1[4],P1[5],     pw2[0]=PKW(P1,0), pw2[1]=PKW(P1,2), pw2); \
    VRD(6); SBAR(); GAPA(C1=__builtin_amdgcn_mfma_f32_32x32x16_bf16(kf[5],qr[2],C1,0,0,0),   P1[6],P1[7],P1[8],P1[9],     pw2[2]=PKW(P1,4), pw2[3]=PKW(P1,6), pw2); \
    VRD(3); SBAR(); GAPA(C0=__builtin_amdgcn_mfma_f32_32x32x16_bf16(kf[6],qr[3],C0,0,0,0),   P1[10],P1[11],P1[12],P1[13], pw3[0]=PKW(P1,8), pw3[1]=PKW(P1,10), pw3); \
    VRD(7); SBAR(); GAPA(C1=__builtin_amdgcn_mfma_f32_32x32x16_bf16(kf[7],qr[3],C1,0,0,0),   P1[14],P1[15],0.f,0.f,       pw3[2]=PKW(P1,12),pw3[3]=PKW(P1,14), pw3); \
    C0=__builtin_amdgcn_mfma_f32_32x32x16_bf16(kx0_,QX,C0,0,0,0); SBAR(); C1=__builtin_amdgcn_mfma_f32_32x32x16_bf16(kx1_,QX,C1,0,0,0); SBAR(); \
    l_reg+=sacc; \
    if(GK){DMA_K((t)+3,sl_cur);} if(GV){DMA_V((t)+1,sl_next);} \
    CMASK(C0,C1,t); \
    { float a=MX3(C0[0],C0[1],C1[0]),b=MX3(C0[2],C0[3],C1[1]); a=MX3(a,C1[2],C1[3]); \
      _Pragma("unroll") for(int r=4;r<16;r+=4){a=MX3(a,C0[r],C0[r+1]);b=MX3(b,C0[r+2],C0[r+3]);a=MX3(a,C1[r],C1[r+1]);b=MX3(b,C1[r+2],C1[r+3]);} \
      float rm=__builtin_fmaxf(a,b); { auto rr=__builtin_amdgcn_permlane32_swap(__float_as_uint(rm),__float_as_uint(rm),false,false); rm=__builtin_fmaxf(__uint_as_float(rr[0]),__uint_as_float(rr[1])); } \
      resc=false; \
      if(__builtin_expect(__any(rm>(float)THRL),0)){ const float dl=__builtin_fmaxf(rm,0.f); mhat+=dl; \
        _Pragma("unroll") for(int r=0;r<16;++r){C0[r]-=dl;C1[r]-=dl;} \
        SETQX(); \
        const float f=__builtin_amdgcn_exp2f(-dl); l_reg*=f; if(hi==0)wsf[r32]=f; resc=true; } } \
    SBAR(); \
    GAPB(o[0]=__builtin_amdgcn_mfma_f32_32x32x16_bf16(PAF(0),VFR(0),o[0],0,0,0), C0,0); \
    GAPB(o[1]=__builtin_amdgcn_mfma_f32_32x32x16_bf16(PAF(0),VFR(4),o[1],0,0,0), C0,4); \
    KRD(GL,0); GAPB(o[0]=__builtin_amdgcn_mfma_f32_32x32x16_bf16(PAF(1),VFR(1),o[0],0,0,0), C0,8); \
    KRD(GL,1); GAPB(o[1]=__builtin_amdgcn_mfma_f32_32x32x16_bf16(PAF(1),VFR(5),o[1],0,0,0), C0,12); \
    KRD(GL,2); GAPB(o[0]=__builtin_amdgcn_mfma_f32_32x32x16_bf16(PAF(2),VFR(2),o[0],0,0,0), C1,0); \
    KRD(GL,3); GAPB(o[1]=__builtin_amdgcn_mfma_f32_32x32x16_bf16(PAF(2),VFR(6),o[1],0,0,0), C1,4); \
    GAPB(o[0]=__builtin_amdgcn_mfma_f32_32x32x16_bf16(PAF(3),VFR(3),o[0],0,0,0), C1,8); \
    GAPB(o[1]=__builtin_amdgcn_mfma_f32_32x32x16_bf16(PAF(3),VFR(7),o[1],0,0,0), C1,12); \
    }while(0)
#if defined(MK_TATT)
  if(MK_TATT==1&&threadIdx.x==0)((unsigned long long*)(shm+LDS_CB))[90]+=__builtin_amdgcn_s_memrealtime()-tu0_;
#endif
  int t=1;
  #undef CMASK
  #define CMASK(P0,P1,t) do{}while(0)
  for(;t+5<NT;t+=2){
    STEP(pB0,pB1,pA0,pA1,t,true,true,true);     WAIT_BAR(2); RESC(); ROT();
    STEP(pA0,pA1,pB0,pB1,t+1,true,true,true);   WAIT_BAR(2); RESC(); ROT();
  }
  #undef CMASK
  #define CMASK(P0,P1,t) do{int jb_=(t)-(NT-4); if(jb_>=0)cmask(P0,P1,jb_,qrel,hi);}while(0)
  #define ENDW(tt) do{ if((tt)+3<NT){WAIT_BAR(2);} else if((tt)+2<NT){WAIT_BAR(1);} else {WAIT_BAR(0);} }while(0)
  for(;t+1<NT;t+=2){
    STEP(pB0,pB1,pA0,pA1,t,(t+3<NT),(t+1<NT),(t+1<NT));       ENDW(t);   RESC(); ROT();
    STEP(pA0,pA1,pB0,pB1,t+1,(t+4<NT),(t+2<NT),(t+2<NT));     ENDW(t+1); RESC(); ROT();
  }
  STEP(pB0,pB1,pA0,pA1,NT-1,false,false,false); RESC();
#if defined(MK_TATT)
  const unsigned long long tu1_=__builtin_amdgcn_s_memrealtime();
  if(MK_TATT==3&&threadIdx.x==0)((unsigned long long*)(shm+LDS_CB))[90]+=(unsigned long long)NT;
#endif
  { float sacc=pB0[0]+pB0[1]; _Pragma("unroll") for(int r=2;r<16;++r)sacc+=pB0[r]; _Pragma("unroll") for(int r=0;r<16;++r)sacc+=pB1[r]; l_reg+=sacc;
    pw0=(u32x4){PKW(pB0,0),PKW(pB0,2),PKW(pB0,4),PKW(pB0,6)};pw1=(u32x4){PKW(pB0,8),PKW(pB0,10),PKW(pB0,12),PKW(pB0,14)};pw2=(u32x4){PKW(pB1,0),PKW(pB1,2),PKW(pB1,4),PKW(pB1,6)};pw3=(u32x4){PKW(pB1,8),PKW(pB1,10),PKW(pB1,12),PKW(pB1,14)};
    SBAR(); pv(o,vb0+sl_cur,PAF(0),PAF(1),PAF(2),PAF(3)); }
  #undef PKW
  #undef PAF
  #undef VFR
  #undef PIN
  #undef MX3
  #undef GAPA
  #undef GAPB
  #undef EX
  #undef VRD
  #undef KRD
  #undef STEP
  #undef ENDW
  {auto rr=__builtin_amdgcn_permlane32_swap(__float_as_uint(l_reg),__float_as_uint(l_reg),false,false);l_reg=__uint_as_float(rr[0])+__uint_as_float(rr[1]);}
  if(hi==0)wsf[32+r32]=l_reg;asm volatile("s_waitcnt lgkmcnt(0)":::"memory");
  float rli[16];
  #pragma unroll
  for(int r=0;r<16;++r)rli[r]=__builtin_amdgcn_rcpf(wsh_()[32+(r&3)+8*(r>>2)]);
  bf16*Ow=O+(rowbase+q0+wid*QBLK)*DMO+h*D;
  { bf16*stg=(bf16*)(shm+LDS_OST)+wid*2048;
    #pragma unroll
    for(int r=0;r<16;++r){const int orow=crow(r,hi);
      #pragma unroll
      for(int d0=0;d0<2;++d0)stg[orow*64+d0*32+r32]=__float2bfloat16(o[d0][r]*rli[r]);}
    asm volatile("s_waitcnt lgkmcnt(0)":::"memory");
    #pragma unroll
    for(int i=0;i<4;++i){const int row=i*8+(lane>>3),ch=lane&7; const u32x4 v=*(const u32x4*)(stg+row*64+ch*8); ATTN_STORE16(Ow+(long)row*DMO+ch*8,v);} }
  asm volatile("s_waitcnt lgkmcnt(0)\n\ts_barrier":::"memory");
#if defined(MK_TATT)
  if(MK_TATT==2&&threadIdx.x==0)((unsigned long long*)(shm+LDS_CB))[90]+=__builtin_amdgcn_s_memrealtime()-tu1_;
#endif
  #undef DMA_K
  #undef DMA_V
  #undef SETQX
  #undef QX
  #undef KXF
  #undef CMASK
  #undef START
  #undef RESC
  #undef ROT
}
constexpr int ATTN_LDS_BYTES=LDS_BYTES;
__device__ __forceinline__ void fill_kx(char*shm,const float*FG,float fbias,int b,int h,const bf16*Q,const bf16*K,int tid){
  const int lane=tid&63,wid=tid>>6;
  double*wtot=(double*)(shm+LDS_WS);
  float ls[8]; double run=0.0;
  { float*stg=(float*)(shm+LDS_K);
    #pragma unroll
    for(int j=0;j<8;++j)stg[j*512+tid]=FG[((long)b*SEQ+j*512+tid)*8+h];
    __syncthreads();
    #pragma unroll
    for(int j=0;j<8;++j){ const float x=stg[8*tid+j]+fbias; const float e=__expf(-fabsf(x)); ls[j]=fminf(x,0.f)-log1pf(e); } }
  #pragma unroll
  for(int j=0;j<8;++j)run+=(double)ls[j];
  double inc=run;
  #pragma unroll
  for(int o=1;o<64;o<<=1){ const int src_=((lane>=o)?lane-o:lane)<<2; const long long bits=__builtin_bit_cast(long long,inc);
    const int lo_=__builtin_amdgcn_ds_bpermute(src_,(int)bits), hi_=__builtin_amdgcn_ds_bpermute(src_,(int)(bits>>32));
    const double v=__builtin_bit_cast(double,((long long)(unsigned)hi_<<32)|(unsigned)lo_); if(lane>=o)inc+=v; }
  if(lane==63)wtot[wid]=inc;
  __syncthreads();
  double base=inc-run;
  for(int w=0;w<wid;++w)base+=wtot[w];
  u32x4*dst=(u32x4*)(shm+LDS_KX)+8*tid;
  #pragma unroll
  for(int j=0;j<8;++j){ base+=(double)ls[j]; const float c=(float)(-base*1.4426950408889634);
    const unsigned h1=cvtpk_s(c,0.f)&0xffffu; const float r1=c-__uint_as_float(h1<<16); const unsigned h2=cvtpk_s(r1,0.f)&0xffffu; const float r2=r1-__uint_as_float(h2<<16); const unsigned h3=cvtpk_s(r2,0.f)&0xffffu;
    dst[j]=(u32x4){h1|(h2<<16),h3|0x3F800000u,0x3F803F80u,0u};
    if(j==0&&(tid&7)==0)((float*)(shm+LDS_CB))[tid>>3]=c; if(j==7&&(tid&7)==7)((float*)(shm+LDS_CB))[64+(tid>>3)]=c; }
  if(tid==0){ unsigned z_=0u; asm volatile("":"+v"(z_)); ((u32x4*)(shm+LDS_KX))[SEQ]=(u32x4){z_,z_,z_,z_}; }
  { float qm=0.f,km=0.f;
    const long row0=(long)b*SEQ+wid*512+(lane>>3); const int cho=h*D+(lane&7)*8;
    #pragma unroll
    for(int pass=0;pass<2;++pass){ const bf16*P=pass?K:Q;
      #pragma unroll 1
      for(int i0=0;i0<64;i0+=16){ u32x4 v[16];
        #pragma unroll
        for(int i=0;i<16;++i)v[i]=*(const u32x4*)(P+(row0+8*(i0+i))*DMQ+cho);
        #pragma unroll
        for(int i=0;i<16;++i){ float s=0.f;
          #pragma unroll
          for(int e=0;e<4;++e){ const float x0=__uint_as_float(v[i][e]<<16),x1=__uint_as_float(v[i][e]&0xffff0000u); s+=x0*x0+x1*x1; }
          s+=__int_as_float(__builtin_amdgcn_update_dpp(0,__float_as_int(s),0xB1,0xf,0xf,false)); s+=__int_as_float(__builtin_amdgcn_update_dpp(0,__float_as_int(s),0x4E,0xf,0xf,false));
          s+=__int_as_float(__builtin_amdgcn_update_dpp(0,__float_as_int(s),0x141,0xf,0xf,false));
          if(pass)km=fmaxf(km,s); else qm=fmaxf(qm,s); } } }
    #pragma unroll
    for(int o=1;o<64;o<<=1){ const int src_=(lane^o)<<2; qm=fmaxf(qm,__int_as_float(__builtin_amdgcn_ds_bpermute(src_,__float_as_int(qm)))); km=fmaxf(km,__int_as_float(__builtin_amdgcn_ds_bpermute(src_,__float_as_int(km)))); }
    if(lane==0){ ((float*)(shm+LDS_CB))[128+2*wid]=qm; ((float*)(shm+LDS_CB))[129+2*wid]=km; } }
  __syncthreads();
  if(tid==0){ float qm=0.f,km=0.f; for(int w=0;w<8;++w){ qm=fmaxf(qm,((float*)(shm+LDS_CB))[128+2*w]); km=fmaxf(km,((float*)(shm+LDS_CB))[129+2*w]); } ((float*)(shm+LDS_CB))[160]=2.0f*sqrtf(qm*km)*1.001f; }
  __syncthreads();
}
constexpr int KX_IMG_BYTES=SEQ*16+16+1024;
__device__ __forceinline__ void kx_store(const char*shm,char*g,int tid){
  for(int i=tid;i<KX_IMG_BYTES/16;i+=NW*64)((u32x4*)g)[i]=((const u32x4*)(shm+LDS_KX))[i];
}
__device__ __forceinline__ void kx_load(char*shm,const char*g,int tid){
  u32x4 v[9];
  #pragma unroll
  for(int j=0;j<9;++j){ const int i=tid+j*NW*64; if(i<KX_IMG_BYTES/16)v[j]=((const u32x4*)g)[i]; }
  #pragma unroll
  for(int j=0;j<9;++j){ const int i=tid+j*NW*64; if(i<KX_IMG_BYTES/16)((u32x4*)(shm+LDS_KX))[i]=v[j]; }
  __syncthreads();
}
__device__ __forceinline__ int tile_start(const char*shm,int qb,int lane){
  const float*cb=(const float*)(shm+LDS_CB); const float bound=cb[4*qb]-48.0f-cb[160];
  const int t=2*(lane+1); const bool ok=(t<=4*qb)&&(t<=64)&&(cb[64+((t-1)&63)]<=bound);
  return 2*__popcll(__ballot(ok));
}
struct AttnTensors { const bf16* Q; const bf16* K; const bf16* V; bf16* O; };
struct AttnUnit { int bh; int qb; };
struct StaticOrder {
  int vcu,bh_;
  __device__ __forceinline__ explicit StaticOrder(int vcu_,int bh):vcu(vcu_),bh_(bh){}
  __device__ __forceinline__ bool next(int i,AttnUnit&u)const{ if(i>=4)return false; const int s=vcu&3, j=4*(i>>1)+s; u.bh=bh_; u.qb=(i&1)?15-j:j; return true; }
  __device__ __forceinline__ void a_ready(const AttnUnit&)const{}
  __device__ __forceinline__ void done(const AttnUnit&)const{}
};
template<class Sched,int THRL=96> __device__ __forceinline__ void attn_phase(char*lds,const AttnTensors&T,const Sched&S){
  AttnUnit u;
  for(int i=0;S.next(i,u);++i){ S.a_ready(u); attn_unit<THRL>(u.bh/NHEAD,u.bh%NHEAD,u.qb,tile_start(lds,u.qb,threadIdx.x&63),T.Q,T.K,T.V,T.O,lds); S.done(u); }
}
#undef SBAR
#undef WAIT_BAR
}
#define GAS __attribute__((address_space(1)))
#define LAS __attribute__((address_space(3)))
typedef unsigned short bf16;
typedef unsigned v4u __attribute__((ext_vector_type(4)));
typedef float f32x4 __attribute__((ext_vector_type(4)));
typedef short bf16x8 __attribute__((ext_vector_type(8)));
typedef GAS unsigned gu32;
typedef GAS unsigned long long gu64;
#define RLX_AGENT __ATOMIC_RELAXED, __HIP_MEMORY_SCOPE_AGENT
#define LDS_WAIT() asm volatile("s_waitcnt lgkmcnt(0)" ::: "memory")
#define VM_WAIT() asm volatile("s_waitcnt vmcnt(0)" ::: "memory")
__device__ __forceinline__ unsigned long long rt() { return __builtin_amdgcn_s_memrealtime(); }
__device__ __forceinline__ unsigned f2bf(float f) { unsigned u = __builtin_bit_cast(unsigned, f); return (u + 0x7fffu + ((u >> 16) & 1u)) >> 16; }
__device__ __forceinline__ unsigned pk2(float lo, float hi) { return f2bf(lo) | (f2bf(hi) << 16); }

#define XB_TMO      128
#define XB_XCNT(j)  (256  + 64 * (j))
#define XB_XSUB(j)  (1280 + 64 * (j))
#define XB_XGEN(j)  (2304 + 64 * (j))
#define XB_TOP      3328
#define XB_TOPGEN   3392
#define XCD_BAR_WORDS 3456
#define XB_SPIN_CAP (1u << 20)

__device__ __forceinline__ unsigned xb_ld(unsigned* p)              { return __hip_atomic_load(p, __ATOMIC_RELAXED, __HIP_MEMORY_SCOPE_AGENT); }
__device__ __forceinline__ unsigned xb_add(unsigned* p, unsigned v) { return __hip_atomic_fetch_add(p, v, __ATOMIC_RELAXED, __HIP_MEMORY_SCOPE_AGENT); }
__device__ __forceinline__ unsigned xb_xcc_id() { return (unsigned)__builtin_amdgcn_s_getreg((3 << 11) | 20) & 0xFu; }
#define XB_SPIN(cond, bar) do { unsigned _sp = 0; while (cond) { __builtin_amdgcn_s_sleep(1); \
    if ((++_sp & 255u) == 0u) { if (xb_ld(&(bar)[XB_TMO])) break; if (_sp > XB_SPIN_CAP) { atomicAdd(&(bar)[XB_TMO], 1u); break; } } } } while (0)

struct XcdBarrier {
    unsigned* bar; unsigned x; unsigned gsz;
    volatile LAS unsigned* st;
};

__device__ __forceinline__ XcdBarrier xcd_barrier_post(unsigned* bar, volatile LAS unsigned* st, unsigned gsz) {
    XcdBarrier b; b.bar = bar; b.x = xb_xcc_id(); b.st = st; b.gsz = gsz;
    if (threadIdx.x == 0) (void)xb_add(&bar[XB_XCNT(b.x)], 1u);
    return b;
}
__device__ __forceinline__ void xcd_barrier_complete(unsigned* bar, unsigned x, unsigned& nloc, unsigned& nx, unsigned G) {
    unsigned sum, cnt, mine, sp = 0u;
    for (;;) {
        sum = 0u; cnt = 0u; mine = 0u;
#pragma unroll
        for (unsigned j = 0; j < 16; ++j) { const unsigned c = xb_ld(&bar[XB_XCNT(j)]); sum += c; cnt += (c > 0u) ? 1u : 0u; mine = (j == x) ? c : mine; }
        if (sum == G) break;
        __builtin_amdgcn_s_sleep(1);
        if ((++sp & 255u) == 0u) { if (xb_ld(&bar[XB_TMO])) break; if (sp > XB_SPIN_CAP) { atomicAdd(&bar[XB_TMO], 1u); break; } }
    }
    nloc = mine > 0u ? mine : 1u; nx = cnt > 0u ? cnt : 1u;
}

__device__ __forceinline__ void xcd_barrier(const XcdBarrier& b) {
    asm volatile("s_waitcnt vmcnt(0)" ::: "memory");
    __syncthreads();
    if (threadIdx.x == 0) {
        unsigned* bar = b.bar;
        __builtin_amdgcn_s_waitcnt(0);
        unsigned nloc = b.st[0], nx = b.st[1];
        if (nloc == 0u) { xcd_barrier_complete(bar, b.x, nloc, nx, b.gsz); b.st[0] = nloc; b.st[1] = nx; }
        const unsigned old = xb_add(&bar[XB_XSUB(b.x)], 1u);
        const unsigned gen = old / nloc;
        if (old + 1u == (gen + 1u) * nloc) {
            __builtin_amdgcn_fence(__ATOMIC_RELEASE, "agent");
            asm volatile("s_waitcnt vmcnt(0)" ::: "memory");
            const unsigned og = xb_add(&bar[XB_TOP], 1u);
            const unsigned tg = og / nx;
            if (og + 1u == (tg + 1u) * nx) xb_add(&bar[XB_TOPGEN], 1u);
            else XB_SPIN(xb_ld(&bar[XB_TOPGEN]) == tg, bar);
            __builtin_amdgcn_fence(__ATOMIC_ACQUIRE, "agent");
            xb_add(&bar[XB_XGEN(b.x)], 1u);
            asm volatile("s_waitcnt vmcnt(0)" ::: "memory");
        } else {
            XB_SPIN(xb_ld(&bar[XB_XGEN(b.x)]) == gen, bar);
            __builtin_amdgcn_fence(__ATOMIC_ACQUIRE, "agent");
            asm volatile("s_waitcnt vmcnt(0)" ::: "memory");
        }
    }
    __syncthreads();
}

constexpr int NWAVES = 8;
constexpr int NB = 16, SEQ = 4096, DMODEL = 1024, NTOK = NB * SEQ;
constexpr int RC = 1792, FQKV = 1536, NPROJ = 3328, ICOLS = 3336, NMOD = 6144;
constexpr int NEXP = 32, DEXP = 512;
constexpr size_t MiB = 1u << 20;
constexpr size_t WS_CTL = 0, CTL_ZERO_BYTES = 1 * MiB;
constexpr size_t WS_MOD = 1 * MiB, WS_FG = 2 * MiB, WS_WIN = 8 * MiB, WS_WOUT = 16 * MiB, WS_LORA = 18 * MiB, WS_TOKINFO = 19 * MiB;
constexpr size_t WS_SLOT_TOK = 24 * MiB, WS_SLOT_W = 32 * MiB, WS_W1 = 40 * MiB, WS_W2 = 104 * MiB;
constexpr size_t WS_H = 136 * MiB, WS_PR = 264 * MiB, WS_PF = 488 * MiB, WS_MIX = 680 * MiB, WS_END = 1024 * MiB;
constexpr int CW_TMO = 0, CW_CODE = 1, CW_BAR = 4096, CW_CNT = 16384, CW_BB = 32768;
constexpr int RING_OFF = 0, RING_BYTES = 131072, LDS_BYTES = 163840, LDSCTL_OFF = LDS_BYTES - 512, MISC_OFF = LDSCTL_OFF;
static_assert(attn_body::ATTN_LDS_BYTES <= LDSCTL_OFF, "attention LDS");

typedef decltype(__builtin_amdgcn_kernarg_segment_ptr()) kseg_t;
struct InTab { kseg_t k;
    __device__ __forceinline__ const float* operator[](int i) const { return (const float*)((const unsigned long long __attribute__((address_space(4)))*)k)[i]; } };
struct Frame {
    LAS unsigned char* lds;
    volatile LAS unsigned* MISC;
    gu32* ctl;
    int tid, lane, wave;
    int vcu, G;
    InTab in; float* out; unsigned char* ws;
};
#define IN_X 0
#define IN_C 1
#define IN_WADA 2
#define IN_BADA 3
#define IN_N1G 4
#define IN_WIN 5
#define IN_MU 6
#define IN_W0 7
#define IN_WUP 8
#define IN_A0 9
#define IN_AUP 10
#define IN_GUP 11
#define IN_KK 12
#define IN_KA 13
#define IN_RK 14
#define IN_LNG 15
#define IN_LNB 16
#define IN_FB 17
#define IN_WOUT 18
#define IN_N2G 19
#define IN_WGRP 20
#define IN_BGRP 21
#define IN_WRT 22
#define IN_BRT 23
#define IN_WGATE 24
#define IN_WUPM 25
#define IN_WDOWN 26
#define IN_NFG 27

template <int N> __device__ __forceinline__ float dpp_ror(float x) { return __int_as_float(__builtin_amdgcn_update_dpp(0, __float_as_int(x), 0x120 + N, 0xf, 0xf, false)); }
__device__ __forceinline__ float row_allsum(float x) { x += dpp_ror<8>(x); x += dpp_ror<4>(x); x += dpp_ror<2>(x); x += dpp_ror<1>(x); return x; }
__device__ __forceinline__ float rdl(float x, int l) { return __int_as_float(__builtin_amdgcn_readlane(__float_as_int(x), l)); }
__device__ __forceinline__ float wave_sum(float v) { v = row_allsum(v); return (rdl(v, 0) + rdl(v, 16)) + (rdl(v, 32) + rdl(v, 48)); }
__device__ __forceinline__ float xchg32(float s, bool upper) { auto rr = __builtin_amdgcn_permlane32_swap(__float_as_uint(s), __float_as_uint(s), false, false); return __uint_as_float(upper ? rr[0] : rr[1]); }
__device__ __forceinline__ void wave_reduce8(const float (&v)[8], float (&t)[8], int lane) {
    const bool up = lane & 32; float h[4];
#pragma unroll
    for (int j = 0; j < 4; ++j) { const float send = up ? v[j] : v[j + 4], keep = up ? v[j + 4] : v[j]; h[j] = row_allsum(keep + xchg32(send, up)); }
#pragma unroll
    for (int j = 0; j < 4; ++j) { t[j] = rdl(h[j], 0) + rdl(h[j], 16); t[j + 4] = rdl(h[j], 32) + rdl(h[j], 48); }
}
__device__ __forceinline__ void wave_reduce4(const float (&v)[4], float (&t)[4], int lane) {
    const bool up = lane & 32; float h[2];
#pragma unroll
    for (int j = 0; j < 2; ++j) { const float send = up ? v[j] : v[j + 2], keep = up ? v[j + 2] : v[j]; h[j] = row_allsum(keep + xchg32(send, up)); }
#pragma unroll
    for (int j = 0; j < 2; ++j) { t[j] = rdl(h[j], 0) + rdl(h[j], 16); t[j + 2] = rdl(h[j], 32) + rdl(h[j], 48); }
}

__device__ __forceinline__ void p0_transpose_item(const float* W, int ldw, bf16* WT, int ldt, int dst_row0, int k0, int n0, LAS float* scr, int lane) {
    float wv_[32];
#pragma unroll
    for (int i = 0; i < 32; ++i) wv_[i] = W[(size_t)(k0 + 2 * i + (lane >> 5)) * ldw + n0 + (lane & 31)];
#pragma unroll
    for (int i = 0; i < 32; ++i) scr[(2 * i + (lane >> 5)) * 33 + (lane & 31)] = wv_[i];
    LDS_WAIT(); asm volatile("" ::: "memory");
    const int c = lane & 7;
#pragma unroll
    for (int j = 0; j < 4; ++j) { const int n = (lane >> 3) + 8 * j; const LAS float* s = scr + (8 * c) * 33 + n;
        v4u o; o.x = pk2(s[0 * 33], s[1 * 33]); o.y = pk2(s[2 * 33], s[3 * 33]); o.z = pk2(s[4 * 33], s[5 * 33]); o.w = pk2(s[6 * 33], s[7 * 33]);
        *(GAS v4u*)(WT + (size_t)(dst_row0 + n) * ldt + k0 + 8 * c) = o; }
    LDS_WAIT(); asm volatile("" ::: "memory");
}
template <int PART> __device__ __forceinline__ void p0_prologue(Frame& F) {
  if (PART != 2)
    {
        LAS float* cond = (LAS float*)(F.lds);
        LAS float* red = (LAS float*)(F.lds + 65536);
        const float* c = F.in[IN_C]; const float* wada = F.in[IN_WADA]; const float* bada = F.in[IN_BADA]; float* mod = (float*)(F.ws + WS_MOD);
        for (int u = F.vcu; u < NMOD / 32; u += F.G) {
            for (int idx = F.tid; idx < 16384; idx += 512) { const int k = idx >> 4, b = idx & 15; const float v = c[b * 1024 + k]; cond[idx] = v / (1.f + __expf(-v)); }
            __syncthreads();
            const int ks = F.tid >> 5, cl = F.tid & 31, col = u * 32 + cl;
            float acc[16];
#pragma unroll
            for (int b = 0; b < 16; ++b) acc[b] = 0.f;
            for (int i0 = 0; i0 < 64; i0 += 16) { float wv[16];
#pragma unroll
                for (int i = 0; i < 16; ++i) wv[i] = wada[(size_t)(ks + 16 * (i0 + i)) * NMOD + col];
#pragma unroll
                for (int i = 0; i < 16; ++i) { const int k = ks + 16 * (i0 + i); const float w = wv[i];
                    const LAS f32x4* cv = (const LAS f32x4*)(cond + k * 16);
#pragma unroll
                    for (int q = 0; q < 4; ++q) { const f32x4 t = cv[q]; acc[4 * q] += t[0] * w; acc[4 * q + 1] += t[1] * w; acc[4 * q + 2] += t[2] * w; acc[4 * q + 3] += t[3] * w; } } }
#pragma unroll
            for (int b = 0; b < 16; ++b) red[(ks * 16 + b) * 32 + cl] = acc[b];
            __syncthreads();
            { const int b = F.tid >> 5; float s = bada[col];
#pragma unroll
              for (int k2 = 0; k2 < 16; ++k2) s += red[(k2 * 16 + b) * 32 + cl];
              mod[(size_t)b * NMOD + col] = s; }
            __syncthreads();
        }
    }
    {
        LAS float* scr = (LAS float*)(F.lds + F.wave * 16384);
        const int gw = F.vcu * NWAVES + F.wave, NGW = F.G * NWAVES;
        constexpr int I_IN = 16 * (NPROJ / 32), I_OUT = 16 * 32, I_E = 768, NITEMS = I_IN + I_OUT + NEXP * I_E;
        bf16* Win_t = (bf16*)(F.ws + WS_WIN); bf16* Wout_t = (bf16*)(F.ws + WS_WOUT); bf16* W1_t = (bf16*)(F.ws + WS_W1); bf16* W2_t = (bf16*)(F.ws + WS_W2);
        for (int it = gw + ((PART == 2) ? I_IN + I_OUT : 0); it < ((PART == 1) ? I_IN + I_OUT : NITEMS); it += NGW) {
            int r = it;
            if (r < I_IN) { const int nblk = NPROJ / 32, kb = r / nblk, nb = r % nblk; p0_transpose_item(F.in[IN_WIN], ICOLS, Win_t, 1024, 32 * nb, 64 * kb, 32 * nb, scr, F.lane); continue; } r -= I_IN;
            if (r < I_OUT) { const int kb = r / 32, nb = r % 32; p0_transpose_item(F.in[IN_WOUT], 1024, Wout_t, 1024, 32 * nb, 64 * kb, 32 * nb, scr, F.lane); continue; } r -= I_OUT;
            const int e = r / I_E; r -= e * I_E;
            if (r < 512) { const int up = r >> 8, q = r & 255, kb = q >> 4, nb = q & 15, n0 = 32 * nb;
                if (up) p0_transpose_item(F.in[IN_WUPM] + (size_t)e * 1024 * 512, 512, W1_t + (size_t)e * 1024 * 1024, 1024, 256 * (n0 >> 7) + 128 + (n0 & 127), 64 * kb, n0, scr, F.lane);
                else    p0_transpose_item(F.in[IN_WGATE] + (size_t)e * 1024 * 512, 512, W1_t + (size_t)e * 1024 * 1024, 1024, 256 * (n0 >> 7) + (n0 & 127), 64 * kb, n0, scr, F.lane); }
            else { const int q = r - 512, kb = q >> 5, nb = q & 31;
                p0_transpose_item(F.in[IN_WDOWN] + (size_t)e * 512 * 1024, 1024, W2_t + (size_t)e * 1024 * 512, 512, 32 * nb, 64 * kb, 32 * nb, scr, F.lane); }
        }
    }
}

__device__ __forceinline__ void p1_norm(Frame& F) {
    LAS f32x4* Wf4 = (LAS f32x4*)(F.lds);
    const float* win = F.in[IN_WIN];
    for (int idx = F.tid; idx < 8192; idx += 512) { const int c = idx >> 3, j = idx & 7; const float v = win[(size_t)c * ICOLS + NPROJ + j];
        const int l = (c & 255) >> 2, jq = c >> 8, i = c & 3, jj = jq * 4 + i; ((LAS float*)Wf4)[(((j >> 2) * 16 + jj) * 64 + l) * 4 + (j & 3)] = v; }
    __syncthreads();
    const float* x = F.in[IN_X]; const float* g1 = F.in[IN_N1G]; const float* mod = (const float*)(F.ws + WS_MOD);
    bf16* H = (bf16*)(F.ws + WS_H); float* FG = (float*)(F.ws + WS_FG);
    for (int rb = F.vcu; rb < NTOK / 256; rb += F.G) {
        const int b = (rb * 256) / SEQ;
        f32x4 A[4], Bc[4];
#pragma unroll
        for (int j = 0; j < 4; ++j) { const int c = 4 * F.lane + 256 * j; const f32x4 g = *(const f32x4*)(g1 + c), sc = *(const f32x4*)(mod + (size_t)b * NMOD + 1024 + c); A[j] = g * (sc + 1.0f); Bc[j] = *(const f32x4*)(mod + (size_t)b * NMOD + c); }
        f32x4 vn[4];
        { const GAS f32x4* xr0 = (const GAS f32x4*)(x + ((size_t)rb * 256 + F.wave) * 1024) + F.lane;
#pragma unroll
          for (int j = 0; j < 4; ++j) vn[j] = xr0[64 * j]; }
        for (int r = F.wave; r < 256; r += NWAVES) {
            const size_t m = (size_t)rb * 256 + r;
            f32x4 v[4]; float ss = 0.f;
#pragma unroll
            for (int j = 0; j < 4; ++j) v[j] = vn[j];
            if (r + NWAVES < 256) { const GAS f32x4* xr = (const GAS f32x4*)(x + (m + NWAVES) * 1024) + F.lane;
#pragma unroll
                for (int j = 0; j < 4; ++j) vn[j] = xr[64 * j]; }
#pragma unroll
            for (int j = 0; j < 4; ++j) ss += (v[j].x * v[j].x + v[j].y * v[j].y) + (v[j].z * v[j].z + v[j].w * v[j].w);
            const float rstd = 1.0f / sqrtf(wave_sum(ss) * (1.f / 1024.f) + 1e-6f);
            GAS unsigned long long* o8 = (GAS unsigned long long*)(H + m * 1024) + F.lane;
            float acc[8];
#pragma unroll
            for (int q = 0; q < 8; ++q) acc[q] = 0.f;
#pragma unroll
            for (int j = 0; j < 4; ++j) { v[j] = v[j] * rstd * A[j] + Bc[j];
                o8[64 * j] = (unsigned long long)attn_body::cvtpk_s(v[j].x, v[j].y) | ((unsigned long long)attn_body::cvtpk_s(v[j].z, v[j].w) << 32);
#pragma unroll
                for (int i = 0; i < 4; ++i) { const f32x4 w0 = Wf4[(j * 4 + i) * 64 + F.lane], w1 = Wf4[(16 + j * 4 + i) * 64 + F.lane]; const float hv = v[j][i];
                    acc[0] += hv * w0[0]; acc[1] += hv * w0[1]; acc[2] += hv * w0[2]; acc[3] += hv * w0[3]; acc[4] += hv * w1[0]; acc[5] += hv * w1[1]; acc[6] += hv * w1[2]; acc[7] += hv * w1[3]; } }
            float ft[8]; wave_reduce8(acc, ft, F.lane);
            if (F.lane == 0) { *(GAS f32x4*)(FG + m * 8) = (f32x4){ft[0], ft[1], ft[2], ft[3]}; *(GAS f32x4*)(FG + m * 8 + 4) = (f32x4){ft[4], ft[5], ft[6], ft[7]}; }
        }
    }
}

__device__ __forceinline__ void p_final_nomoe(Frame& F) {
    const float* gf = F.in[IN_NFG];
    f32x4 G4[4];
#pragma unroll
    for (int j = 0; j < 4; ++j) G4[j] = *(const f32x4*)(gf + 4 * F.lane + 256 * j);
    const int gw = F.vcu * NWAVES + F.wave, NGW = F.G * NWAVES;
    for (int m = gw; m < NTOK; m += NGW) {
        GAS f32x4* xr = (GAS f32x4*)(F.out + (size_t)m * 1024) + F.lane;
        f32x4 v[4]; float ss = 0.f;
#pragma unroll
        for (int j = 0; j < 4; ++j) { v[j] = xr[64 * j]; ss += (v[j].x * v[j].x + v[j].y * v[j].y) + (v[j].z * v[j].z + v[j].w * v[j].w); }
        const float rstd = 1.0f / sqrtf(wave_sum(ss) * (1.f / 1024.f) + 1e-6f);
#pragma unroll
        for (int j = 0; j < 4; ++j) xr[64 * j] = v[j] * rstd * G4[j];
    }
}


constexpr size_t WS_ALORA = 808 * MiB;
constexpr size_t OUT_Y = 0, OUT_GG = 128 * MiB, OUT_Z = 192 * MiB;
typedef unsigned v2u __attribute__((ext_vector_type(2)));
typedef float f32x2 __attribute__((ext_vector_type(2)));
__device__ __forceinline__ float bf2f(unsigned short u) { return __uint_as_float((unsigned)u << 16); }
__device__ __forceinline__ float sigmoidf_(float v) { return 1.0f / (1.0f + __expf(-v)); }

__device__ __forceinline__ void r0_lora_inputs(Frame& F) {
    const bf16* PR = (const bf16*)(F.ws + WS_PR); bf16* AL = (bf16*)(F.ws + WS_ALORA); const float* mu = F.in[IN_MU] + 1536;
    const int l = F.lane & 31, hwl = ((F.vcu & 15) * NWAVES + F.wave) * 2 + (F.lane >> 5);
    float m8[8];
#pragma unroll
    for (int i = 0; i < 8; ++i) m8[i] = mu[8 * l + i];
    for (int m0 = (F.vcu >> 4) * SEQ + hwl * 4, mend = ((F.vcu >> 4) + 1) * SEQ; m0 < mend; m0 += 1024) {
        v4u cur[4], prv[4];
#pragma unroll
        for (int u = 0; u < 4; ++u) { const int m = m0 + u; cur[u] = *(const GAS v4u*)(PR + (size_t)m * RC + 1536 + 8 * l);
            prv[u] = (v4u){0u, 0u, 0u, 0u}; if (u > 0) prv[u] = cur[u - 1]; else if ((m & (SEQ - 1)) != 0) prv[u] = *(const GAS v4u*)(PR + (size_t)(m - 1) * RC + 1536 + 8 * l); }
#pragma unroll
        for (int u = 0; u < 4; ++u) { float o[8];
#pragma unroll
            for (int i = 0; i < 4; ++i) { const unsigned cw = cur[u][i], pw = prv[u][i];
                const float c0 = __uint_as_float(cw << 16), c1 = __uint_as_float(cw & 0xffff0000u), p0 = __uint_as_float(pw << 16), p1 = __uint_as_float(pw & 0xffff0000u);
                o[2 * i] = c0 + (p0 - c0) * m8[2 * i]; o[2 * i + 1] = c1 + (p1 - c1) * m8[2 * i + 1]; }
            if (l < 8) {
#pragma unroll
                for (int i = 0; i < 8; ++i) { const float ex = __expf(2.0f * o[i]); o[i] = 1.0f - 2.0f * __builtin_amdgcn_rcpf(1.0f + ex); }
            } else if (l >= 16) {
#pragma unroll
                for (int i = 0; i < 8; ++i) o[i] = __builtin_amdgcn_rcpf(1.0f + __expf(-o[i]));
            }
            *(GAS v4u*)(AL + (size_t)(m0 + u) * 256 + 8 * l) = (v4u){pk2(o[0], o[1]), pk2(o[2], o[3]), pk2(o[4], o[5]), pk2(o[6], o[7])}; }
    }
}

namespace scan {
typedef _Float16 h16x4 __attribute__((ext_vector_type(4)));
constexpr int TC = 32;
constexpr int KSB = 80;
constexpr int RECB = 16 * KSB + 128;
constexpr int L_RAW = 0;
constexpr int L_AL = 13312;
constexpr int L_REC = L_AL + 16 * 1056;
constexpr int L_WL = L_REC + TC * RECB;
constexpr int L_AV = L_WL + 8192;
constexpr int L_GV = L_AV + 8192;
constexpr int L_YB = L_GV + 4096;
constexpr int L_BF = L_YB + 8192 + 256;
constexpr int L_END = L_BF + 24576;
template <int N> __device__ __forceinline__ float ror16(float x) { return __int_as_float(__builtin_amdgcn_update_dpp(0, __float_as_int(x), 0x120 + N, 0xf, 0xf, false)); }
__device__ __forceinline__ float allsum16(float x) { x += ror16<8>(x); x += ror16<4>(x); x += ror16<2>(x); x += ror16<1>(x); return x; }
typedef float f32x16 __attribute__((ext_vector_type(16)));
__device__ __forceinline__ float fmix_lo(float a, unsigned h2, float c) { float d; asm("v_fma_mix_f32 %0, %1, %2, %3 op_sel_hi:[0,1,0]" : "=v"(d) : "v"(a), "v"(h2), "v"(c)); return d; }
__device__ __forceinline__ float fmix_hi(float a, unsigned h2, float c) { float d; asm("v_fma_mix_f32 %0, %1, %2, %3 op_sel:[0,1,0] op_sel_hi:[0,1,0]" : "=v"(d) : "v"(a), "v"(h2), "v"(c)); return d; }
__device__ __forceinline__ float fmix_hi_nop(float a, unsigned h2, float c) { float d; asm("v_fma_mix_f32 %0, %1, %2, %3 op_sel:[0,1,0] op_sel_hi:[0,1,0]\n\ts_nop 1" : "=v"(d) : "v"(a), "v"(h2), "v"(c)); return d; }
__device__ __forceinline__ float fmix_lo0(float a, unsigned h2) { float d; asm("v_fma_mix_f32 %0, %1, %2, 0 op_sel_hi:[0,1,0]" : "=v"(d) : "v"(a), "v"(h2)); return d; }

__device__ __forceinline__ void phase(Frame& F) {
    const int tid = F.tid, lane = F.lane, wave = F.wave;
    const int half = F.vcu & 1, hd = (F.vcu >> 1) & 7, b = F.vcu >> 4;
    LAS unsigned char* L = F.lds;
    const unsigned lds0 = (unsigned)(uintptr_t)(unsigned char*)F.lds;
    const bf16* PR = (const bf16*)(F.ws + WS_PR); const bf16* AL = (const bf16*)(F.ws + WS_ALORA);
    float* Y = (float*)((unsigned char*)F.out + OUT_Y); bf16* GG = (bf16*)((unsigned char*)F.out + OUT_GG); bf16* Z = (bf16*)((unsigned char*)F.out + OUT_Z);
    const int et = tid >> 4, cg = tid & 15, chb = hd * 64 + 4 * cg;
    float mu_r[4], mu_k[4], mu_v[4], kkc[4], kac[4], rkc[4], lng[4], lnb[4], w0c[4], a0c[4];
#pragma unroll
    for (int i = 0; i < 4; ++i) { mu_r[i] = F.in[IN_MU][chb + i]; mu_k[i] = F.in[IN_MU][512 + chb + i]; kkc[i] = F.in[IN_KK][chb + i]; kac[i] = F.in[IN_KA][chb + i]; rkc[i] = F.in[IN_RK][chb + i]; w0c[i] = F.in[IN_W0][chb + i]; a0c[i] = F.in[IN_A0][chb + i]; }
    const int vch = hd * 64 + half * 32 + 4 * (cg & 7);
#pragma unroll
    for (int i = 0; i < 4; ++i) { mu_v[i] = F.in[IN_MU][1024 + vch + i]; lng[i] = F.in[IN_LNG][vch + i]; lnb[i] = F.in[IN_LNB][vch + i]; }
    if (wave < 5) {
        const int r32 = lane & 31, hi = lane >> 5;
        const int col = (wave < 4) ? hd * 64 + (wave & 1) * 32 + r32 : hd * 64 + half * 32 + r32;
        const int ns = (wave < 4) ? 4 : 8;
        const float* wup = F.in[IN_WUP]; const float* aup = F.in[IN_AUP]; const float* gup = F.in[IN_GUP];
        for (int s = 0; s < ns; ++s) { float f[8];
            if (wave < 2) {
#pragma unroll
                for (int jj = 0; jj < 8; ++jj) f[jj] = wup[(size_t)(16 * s + 8 * hi + jj) * 512 + col];
            } else if (wave < 4) {
#pragma unroll
                for (int jj = 0; jj < 8; ++jj) f[jj] = aup[(size_t)(16 * s + 8 * hi + jj) * 512 + col];
            } else {
#pragma unroll
                for (int jj = 0; jj < 8; ++jj) f[jj] = gup[(size_t)(16 * s + 8 * hi + jj) * 512 + col];
            }
            *(LAS v4u*)(L + L_BF + ((wave < 4 ? wave * 4 : 16) + s) * 1024 + lane * 16) = (v4u){pk2(f[0], f[1]), pk2(f[2], f[3]), pk2(f[4], f[5]), pk2(f[6], f[7])}; }
    }
    long raw_off[2];
#pragma unroll
    for (int i = 0; i < 2; ++i) { int q = 64 * (wave + 8 * i) + lane; if (q > 791) q = 791; const int row = q / 24, cc = q % 24; raw_off[i] = (long)(row - 1) * RC + (cc >> 3) * 512 + hd * 64 + (cc & 7) * 8; }
    const size_t mrow0 = (size_t)b * SEQ;
#define SCAN_DMA(c) do { const size_t m0_ = mrow0 + (size_t)(c) * TC; \
        _Pragma("unroll") for (int i_ = 0; i_ < 2; ++i_) { const int p_ = wave + 8 * i_; if (p_ < 13) { long o_ = raw_off[i_]; if ((c) == 0 && o_ < 0) o_ += RC; \
            attn_body::glds16(PR + m0_ * RC + o_, (unsigned)__builtin_amdgcn_readfirstlane(lds0 + L_RAW + p_ * 1024)); } } \
        _Pragma("unroll") for (int i_ = 0; i_ < 2; ++i_) { const int p_ = wave + 8 * i_; \
            attn_body::glds16(AL + (m0_ + 2 * p_) * 256 + lane * 8, (unsigned)__builtin_amdgcn_readfirstlane(lds0 + L_AL + p_ * 1056)); } } while (0)
#define STORE_Y(c) do { const int st_ = tid >> 4, v2_ = (tid & 15) * 2; const f32x2 y2_ = *(const LAS f32x2*)(L + L_YB + ((c) & 1) * 4096 + (st_ * 32 + v2_) * 4); \
        *(GAS f32x2*)(Y + (mrow0 + (size_t)(c) * TC + st_) * 512 + hd * 64 + half * 32 + v2_) = y2_; } while (0)
    f32x2 S01 = (f32x2){0.f, 0.f}, S23 = (f32x2){0.f, 0.f};
    const int vloc = 4 * wave + (lane >> 4), ks = lane & 15;
    SCAN_DMA(0);
    for (int c = 0; c < SEQ / TC; ++c) {
        asm volatile("s_waitcnt vmcnt(0)" ::: "memory"); __syncthreads();
        float rs[4], ksv[4], vs[4], rn;
#if defined(MK_PROBE_S2)
        for (int prep = 0; prep < 2; ++prep) {
#endif
        {
            const bool first = (c == 0 && et == 0);
            const LAS unsigned char* rowc = L + L_RAW + (et + 1) * 384; const LAS unsigned char* rowp = L + L_RAW + et * 384;
            const v2u rc = *(const LAS v2u*)(rowc + cg * 8), rp = *(const LAS v2u*)(rowp + cg * 8);
            const v2u kc = *(const LAS v2u*)(rowc + 128 + cg * 8), kp = *(const LAS v2u*)(rowp + 128 + cg * 8);
            const int vo = 256 + (half * 32 + 4 * (cg & 7)) * 2;
            const v2u vc = *(const LAS v2u*)(rowc + vo), vp = *(const LAS v2u*)(rowp + vo);
#define SH4(dst, cu, pr, mu) do { const float c0 = __uint_as_float(cu.x << 16), c1 = __uint_as_float(cu.x & 0xffff0000u), c2 = __uint_as_float(cu.y << 16), c3 = __uint_as_float(cu.y & 0xffff0000u); \
            const float p0 = first ? 0.f : __uint_as_float(pr.x << 16), p1 = first ? 0.f : __uint_as_float(pr.x & 0xffff0000u), p2 = first ? 0.f : __uint_as_float(pr.y << 16), p3 = first ? 0.f : __uint_as_float(pr.y & 0xffff0000u); \
            dst[0] = c0 + (p0 - c0) * mu[0]; dst[1] = c1 + (p1 - c1) * mu[1]; dst[2] = c2 + (p2 - c2) * mu[2]; dst[3] = c3 + (p3 - c3) * mu[3]; } while (0)
            SH4(rs, rc, rp, mu_r); SH4(ksv, kc, kp, mu_k); SH4(vs, vc, vp, mu_v);
#undef SH4
            float q = 0.f;
#pragma unroll
            for (int i = 0; i < 4; ++i) { const float u = ksv[i] * kkc[i]; q += u * u; }
            q = allsum16(q); rn = __builtin_amdgcn_rsqf(fmaxf(q, 1e-24f));
            LAS unsigned char* rec = L + L_REC + et * RECB;
            *(LAS h16x4*)(rec + cg * KSB) = (h16x4){(_Float16)rs[0], (_Float16)rs[1], (_Float16)rs[2], (_Float16)rs[3]};
            if (cg < 8) *(LAS f32x4*)(rec + 16 * KSB + cg * 16) = (f32x4){vs[0], vs[1], vs[2], vs[3]};
        }
        if (wave < 5) {
            const int r32 = lane & 31, hi = lane >> 5;
            const LAS unsigned char* arow = L + L_AL + (r32 >> 1) * 1056 + (r32 & 1) * 512 + hi * 16;
            const int colb = (wave < 2) ? 0 : (wave < 4) ? 128 : 256;
            const LAS unsigned char* bfr = L + L_BF + (wave < 4 ? wave * 4 : 16) * 1024 + lane * 16;
            f32x16 acc = f32x16{};
            if (wave < 4) {
#pragma unroll
                for (int s = 0; s < 4; ++s) acc = __builtin_amdgcn_mfma_f32_32x32x16_bf16(*(const LAS bf16x8*)(arow + colb + 32 * s), *(const LAS bf16x8*)(bfr + s * 1024), acc, 0, 0, 0);
            } else {
#pragma unroll
                for (int s = 0; s < 8; ++s) acc = __builtin_amdgcn_mfma_f32_32x32x16_bf16(*(const LAS bf16x8*)(arow + colb + 32 * s), *(const LAS bf16x8*)(bfr + s * 1024), acc, 0, 0, 0);
            }
            LAS float* dst = (wave < 2) ? (LAS float*)(L + L_WL) + (wave & 1) * 32 + r32 : (wave < 4) ? (LAS float*)(L + L_AV) + (wave & 1) * 32 + r32 : (LAS float*)(L + L_GV) + r32;
            const int pitch = (wave < 4) ? 64 : 32;
#pragma unroll
            for (int r = 0; r < 16; ++r) { const int t = (r & 3) + 8 * (r >> 2) + 4 * hi; dst[t * pitch] = acc[r]; }
        }
        __syncthreads();
        {
            const f32x4 wl = *(const LAS f32x4*)(L + L_WL + (et * 64 + 4 * cg) * 4), al = *(const LAS f32x4*)(L + L_AV + (et * 64 + 4 * cg) * 4);
            float kp[4], nk[4], bb[4], dec[4], rk = 0.f;
#pragma unroll
            for (int i = 0; i < 4; ++i) {
                const float z = -(wl[i] + w0c[i]); const float sp = fmaxf(z, 0.f) + __logf(1.0f + __expf(-fabsf(z)));
                dec[i] = __expf(-__expf(-sp - 0.5f));
                const float a = __builtin_amdgcn_rcpf(1.0f + __expf(-(al[i] + a0c[i])));
                const float kn = ksv[i] * kkc[i] * rn; nk[i] = -kn; bb[i] = kn * a; kp[i] = ksv[i] * (1.0f + (a - 1.0f) * kac[i]); rk += rs[i] * kp[i] * rkc[i]; }
            rk = allsum16(rk);
            LAS unsigned char* rec = L + L_REC + et * RECB + cg * KSB;
            *(LAS h16x4*)(rec + 8) = (h16x4){(_Float16)nk[0], (_Float16)nk[1], (_Float16)nk[2], (_Float16)nk[3]};
            *(LAS f32x4*)(rec + 16) = (f32x4){dec[0], dec[1], dec[2], dec[3]};
            *(LAS f32x4*)(rec + 32) = (f32x4){bb[0], bb[1], bb[2], bb[3]};
            *(LAS f32x4*)(rec + 48) = (f32x4){kp[0], kp[1], kp[2], kp[3]};
            if (cg < 8) {
                const f32x4 g4 = *(const LAS f32x4*)(L + L_GV + (et * 32 + 4 * cg) * 4);
                float zz[4], gg[4];
#pragma unroll
                for (int i = 0; i < 4; ++i) { zz[i] = (lnb[i] + rk * vs[i]) * g4[i]; gg[i] = g4[i] * lng[i]; }
                const size_t o = (mrow0 + (size_t)c * TC + et) * 512 + vch;
                *(GAS v2u*)(Z + o) = (v2u){pk2(zz[0], zz[1]), pk2(zz[2], zz[3])};
                *(GAS v2u*)(GG + o) = (v2u){pk2(gg[0], gg[1]), pk2(gg[2], gg[3])};
            }
        }
        if (c > 0) STORE_Y(c - 1);
        __syncthreads();
#if defined(MK_PROBE_S2)
        }
#endif
        if (c + 1 < SEQ / TC) SCAN_DMA(c + 1);
        {
            const LAS unsigned char* rec = L + L_REC + ks * KSB; const LAS unsigned char* vrow = L + L_REC + 16 * KSB + vloc * 4;
            const unsigned ybase = L_YB + (c & 1) * 4096, ydump = L_YB + 8192 + lane * 4;
            v4u ra[3]; f32x4 rw[3], rb[3], rk4[3]; float rv[3];
            const unsigned recA = (unsigned)(L_REC + ks * KSB), vrowA = (unsigned)(L_REC + 16 * KSB + vloc * 4);
#define LOADREC(q_, st_) asm volatile("ds_read_b128 %0, %5 offset:%c7\n\tds_read_b128 %1, %5 offset:%c8\n\tds_read_b128 %2, %5 offset:%c9\n\tds_read_b128 %3, %5 offset:%c10\n\tds_read_b32 %4, %6 offset:%c7" \
                : "=&v"(ra[q_]), "=&v"(rw[q_]), "=&v"(rb[q_]), "=&v"(rk4[q_]), "=&v"(rv[q_]) : "v"(recA), "v"(vrowA), "i"((st_) * RECB), "i"((st_) * RECB + 16), "i"((st_) * RECB + 32), "i"((st_) * RECB + 48) : "memory")
#define WAITREC(q_, n_) asm volatile("s_waitcnt lgkmcnt(" #n_ ")" : "+v"(ra[q_]), "+v"(rw[q_]), "+v"(rb[q_]), "+v"(rk4[q_]), "+v"(rv[q_]) :: "memory")
#if defined(MK_PROBE_S1)
            const f32x2 sv01 = S01, sv23 = S23;
            for (int prep = 0; prep < 2; ++prep) { if (prep == 1) { S01 = sv01; S23 = sv23; }
#endif
            asm volatile("s_waitcnt lgkmcnt(0)" ::: "memory");
            LOADREC(0, 0); LOADREC(1, 1); WAITREC(0, 5);
            float y4 = 0.f;
#define STEP(st) do { \
                if ((st) + 2 < TC) { LOADREC(((st) + 2) % 3, (st) + 2); WAITREC(((st) + 1) % 3, 5); } else if ((st) + 1 < TC) { WAITREC(((st) + 1) % 3, 0); } \
                const v4u ca = ra[(st) % 3]; const f32x4 cw = rw[(st) % 3], cb = rb[(st) % 3], ck = rk4[(st) % 3]; const float vv = rv[(st) % 3]; \
                float p1 = fmix_lo0(S01[0], ca[2]); p1 = fmix_hi(S01[1], ca[2], p1); p1 = fmix_lo(S23[0], ca[3], p1); p1 = fmix_hi_nop(S23[1], ca[3], p1); \
                const float sa = allsum16(p1); \
                { const f32x2 vv2 = (f32x2){vv, vv}, sa2 = (f32x2){sa, sa}; \
                  f32x2 t01 = vv2 * (f32x2){ck[0], ck[1]}, t23 = vv2 * (f32x2){ck[2], ck[3]}; \
                  t01 = __builtin_elementwise_fma(sa2, (f32x2){cb[0], cb[1]}, t01); t23 = __builtin_elementwise_fma(sa2, (f32x2){cb[2], cb[3]}, t23); \
                  S01 = __builtin_elementwise_fma(S01, (f32x2){cw[0], cw[1]}, t01); S23 = __builtin_elementwise_fma(S23, (f32x2){cw[2], cw[3]}, t23); } \
                float p2 = fmix_lo0(S01[0], ca[0]); p2 = fmix_hi(S01[1], ca[0], p2); p2 = fmix_lo(S23[0], ca[1], p2); p2 = fmix_hi_nop(S23[1], ca[1], p2); \
                const float yv = allsum16(p2); \
                y4 = (ks == ((st) & 3)) ? yv : y4; \
                if (((st) & 3) == 3) { const unsigned ya = (ks < 4) ? (unsigned)(ybase + ((((st) & ~3) + ks) * 32 + vloc) * 4) : ydump; *(LAS float*)(L + ya) = y4; } \
            } while (0)
#define STEP4(b_) STEP(b_); STEP((b_) + 1); STEP((b_) + 2); STEP((b_) + 3)
            STEP4(0); STEP4(4); STEP4(8); STEP4(12); STEP4(16); STEP4(20); STEP4(24); STEP4(28);
#undef STEP4
#undef STEP
#undef WAITREC
#if defined(MK_PROBE_S1)
            }
#endif
#undef LOADREC
        }
    }
    __syncthreads();
    STORE_Y(SEQ / TC - 1);
    asm volatile("s_waitcnt vmcnt(0)" ::: "memory"); __syncthreads();
#undef SCAN_DMA
#undef STORE_Y
}
}
static_assert(scan::L_END <= LDSCTL_OFF, "scan LDS");

__device__ __forceinline__ void r2_post(Frame& F) {
    const bf16* Y = (const bf16*)((unsigned char*)F.out + OUT_Y); const bf16* GG = (const bf16*)((unsigned char*)F.out + OUT_GG); const bf16* Z = (const bf16*)((unsigned char*)F.out + OUT_Z);
    bf16* MIX = (bf16*)(F.ws + WS_MIX);
    const int gw = (F.vcu >> 4) * SEQ + (F.vcu & 15) * NWAVES + F.wave, NGW = 16 * NWAVES, mend = ((F.vcu >> 4) + 1) * SEQ;
    v4u ny, ng, nz;
    { const size_t o = (size_t)gw * 512 + 8 * F.lane; ny = *(const GAS v4u*)(Y + o); ng = *(const GAS v4u*)(GG + o); nz = *(const GAS v4u*)(Z + o); }
    for (int m = gw; m < mend; m += NGW) {
        const v4u yq = ny, g = ng, z = nz;
        if (m + NGW < mend) { const size_t o = (size_t)(m + NGW) * 512 + 8 * F.lane; ny = *(const GAS v4u*)(Y + o); ng = *(const GAS v4u*)(GG + o); nz = *(const GAS v4u*)(Z + o); }
        float yv[8];
#pragma unroll
        for (int i = 0; i < 4; ++i) { yv[2 * i] = __uint_as_float(yq[i] << 16); yv[2 * i + 1] = __uint_as_float(yq[i] & 0xffff0000u); }
        float s = ((yv[0] + yv[1]) + (yv[2] + yv[3])) + ((yv[4] + yv[5]) + (yv[6] + yv[7]));
        s += __int_as_float(__builtin_amdgcn_update_dpp(0, __float_as_int(s), 0xB1, 0xf, 0xf, false));
        s += __int_as_float(__builtin_amdgcn_update_dpp(0, __float_as_int(s), 0x4E, 0xf, 0xf, false));
        s += __int_as_float(__builtin_amdgcn_update_dpp(0, __float_as_int(s), 0x141, 0xf, 0xf, false));
        const float mean = s * (1.f / 64.f);
        float q = 0.f;
#pragma unroll
        for (int i = 0; i < 8; ++i) { yv[i] -= mean; q += yv[i] * yv[i]; }
        q += __int_as_float(__builtin_amdgcn_update_dpp(0, __float_as_int(q), 0xB1, 0xf, 0xf, false));
        q += __int_as_float(__builtin_amdgcn_update_dpp(0, __float_as_int(q), 0x4E, 0xf, 0xf, false));
        q += __int_as_float(__builtin_amdgcn_update_dpp(0, __float_as_int(q), 0x141, 0xf, 0xf, false));
        const float rstd = __builtin_amdgcn_rsqf(q * (1.f / 64.f) + 64e-5f);
        unsigned ow[4];
#pragma unroll
        for (int i = 0; i < 4; ++i) ow[i] = attn_body::cvtpk_s(yv[2 * i] * rstd * __uint_as_float(g[i] << 16) + __uint_as_float(z[i] << 16), yv[2 * i + 1] * rstd * __uint_as_float(g[i] & 0xffff0000u) + __uint_as_float(z[i] & 0xffff0000u));
        *(GAS v4u*)(MIX + (size_t)m * 1024 + 8 * F.lane) = (v4u){ow[0], ow[1], ow[2], ow[3]};
    }
}

namespace scan2 {
using scan::allsum16; using scan::f32x16; using scan::TC;
typedef unsigned short u16;
constexpr size_t WS_QPH = 488 * MiB, WS_GT = 840 * MiB, WS_VT = 136 * MiB, WS_QPH_ODD = 984 * MiB, OUT_QPH_ODD = 64 * MiB;
constexpr int S64 = 144, S32 = 80;
constexpr int QPH_B = 12288, GT_B = 9216, VT_B = 6144, O_PM = 32 * S64, O_HT = O_PM + 32 * S32;
constexpr int B_RAW = 0, B_AL = 13312, B_BF = B_AL + 16 * 1056;
constexpr int B_WL = B_BF + 32768, B_AV = B_WL + 8192, B_GV = B_AV + 8192, B_EE = B_GV + 8192;
constexpr int B_OUT = B_WL, O_VT = 0, O_QPH = VT_B, O_GT = VT_B + QPH_B;
constexpr int B_ALP = B_EE + 8192, B_ALPT = B_ALP + 32 * S64, B_BET = B_ALPT + 64 * S32, B_BETT = B_BET + 32 * S64, B_KAP = B_BETT + 64 * S32, B_RHO = B_KAP + 32 * S64;
constexpr int B_GL = B_RHO + 32 * S64, B_PW0 = B_GL + 256, B_PW1 = B_PW0 + 2 * 32 * S32, B_PL = B_PW1 + 2 * 32 * S32, B_TL = B_PL + 32 * S32, B_AAKT = B_TL + 32 * S32;
constexpr int B_KAPT = B_AAKT + 32 * S32, B_VSL = B_KAPT + 64 * S32, B_ARB = B_VSL + 32 * S64, B_WMT = B_ARB + 32 * S32, B_UMT = B_WMT + 64 * S32, B_END = B_UMT + 32 * S32;
static_assert(B_END <= LDSCTL_OFF && VT_B + QPH_B + GT_B <= 32768, "scan2 build LDS");
__device__ __forceinline__ u16 f2h(float f) { return (u16)(attn_body::cvtpk_s(f, 0.f) & 0xffffu); }
__device__ __forceinline__ int crow(int r, int hi) { return (r & 3) + 8 * (r >> 2) + 4 * hi; }
__device__ __forceinline__ void tile_nt(f32x16& acc, const LAS unsigned char* A, int lda, int arow0, const LAS unsigned char* Bt, int ldb, int brow0, int ksteps, int lane) {
    const int r32 = lane & 31, hi = lane >> 5;
    const LAS unsigned char* ap = A + (arow0 + r32) * lda + hi * 16; const LAS unsigned char* bp = Bt + (brow0 + r32) * ldb + hi * 16;
    for (int s = 0; s < ksteps; ++s) acc = __builtin_amdgcn_mfma_f32_32x32x16_bf16(*(const LAS bf16x8*)(ap + 32 * s), *(const LAS bf16x8*)(bp + 32 * s), acc, 0, 0, 0);
}
#define LBAR() asm volatile("s_waitcnt lgkmcnt(0)\n\ts_barrier" ::: "memory")
#define ST16_(base, off, val) (*(LAS unsigned short*)((base) + (off)) = (unsigned short)(attn_body::cvtpk_s((val), 0.f) & 0xffffu))
__device__ __forceinline__ int crow_(int r, int hi) { return (r & 3) + 8 * (r >> 2) + 4 * hi; }
__device__ __forceinline__ void store_tr(LAS unsigned char* img, int stride, int ncol0, const f32x16& a, int lane) {
    LAS unsigned char* p = img + (ncol0 + (lane & 31)) * 2; const int hi = lane >> 5;
#pragma unroll
    for (int r = 0; r < 16; ++r) ST16_(p, crow_(r, hi) * stride, a[r]);
}
#define ST16(base, off, val) (*(LAS u16*)((base) + (off)) = f2h(val))
__device__ __forceinline__ void store_nat(LAS unsigned char* img, int stride, int nrow0, const f32x16& a, int lane, int mcol0 = 0) {
    LAS unsigned char* p = img + (nrow0 + (lane & 31)) * stride + (mcol0 + 4 * (lane >> 5)) * 2;
#pragma unroll
    for (int g = 0; g < 4; ++g) *(LAS v2u*)(p + 16 * g) = (v2u){attn_body::cvtpk_s(a[4 * g], a[4 * g + 1]), attn_body::cvtpk_s(a[4 * g + 2], a[4 * g + 3])};
}

__device__ __forceinline__ unsigned char* vt_home(const Frame& F, int b, int hd) { return F.ws + WS_VT + (size_t)b * (8 * MiB) + (size_t)hd * 128 * VT_B; }
__device__ __forceinline__ unsigned char* qph_home(const Frame& F, int b, int hd) {
    unsigned char* base = (b & 1) ? (((b >> 1) < 5) ? (unsigned char*)F.out + OUT_QPH_ODD + (size_t)(b >> 1) * (12 * MiB) : F.ws + WS_QPH_ODD + (size_t)((b >> 1) - 5) * (12 * MiB)) : F.ws + WS_QPH + (size_t)b * (12 * MiB);
    return base + (size_t)hd * 128 * QPH_B; }
__device__ __forceinline__ void build(Frame& F) {
    const int tid = F.tid, lane = F.lane, wave = F.wave;
    const int bh = F.vcu >> 1, hd = bh & 7, b = bh >> 3, c0 = (F.vcu & 1) * 64;
    LAS unsigned char* L = F.lds;
    const unsigned lds0 = (unsigned)(uintptr_t)(unsigned char*)F.lds;
    const bf16* PR = (const bf16*)(F.ws + WS_PR); const bf16* AL = (const bf16*)(F.ws + WS_ALORA);
    bf16* GG = (bf16*)((unsigned char*)F.out + OUT_GG); bf16* Z = (bf16*)((unsigned char*)F.out + OUT_Z);
    const int et = tid >> 4, cg = tid & 15, chb = hd * 64 + 4 * cg;
    float mu_r[4], mu_k[4], mu_v[4], kkc[4], kac[4], rkc[4], lng[4], lnb[4], w0c[4], a0c[4];
#pragma unroll
    for (int i = 0; i < 4; ++i) { mu_r[i] = F.in[IN_MU][chb + i]; mu_k[i] = F.in[IN_MU][512 + chb + i]; mu_v[i] = F.in[IN_MU][1024 + chb + i]; kkc[i] = F.in[IN_KK][chb + i]; kac[i] = F.in[IN_KA][chb + i]; rkc[i] = F.in[IN_RK][chb + i];
        w0c[i] = F.in[IN_W0][chb + i]; a0c[i] = F.in[IN_A0][chb + i]; lng[i] = F.in[IN_LNG][chb + i]; lnb[i] = F.in[IN_LNB][chb + i]; }
    if (wave < 6) {
        const int r32 = lane & 31, hi = lane >> 5, col = hd * 64 + (wave & 1) * 32 + r32, ns = (wave < 4) ? 4 : 8;
        const float* wup = F.in[IN_WUP]; const float* aup = F.in[IN_AUP]; const float* gup = F.in[IN_GUP];
        for (int s = 0; s < ns; ++s) { float f[8];
            if (wave < 2) {
#pragma unroll
                for (int jj = 0; jj < 8; ++jj) f[jj] = wup[(size_t)(16 * s + 8 * hi + jj) * 512 + col];
            } else if (wave < 4) {
#pragma unroll
                for (int jj = 0; jj < 8; ++jj) f[jj] = aup[(size_t)(16 * s + 8 * hi + jj) * 512 + col];
            } else {
#pragma unroll
                for (int jj = 0; jj < 8; ++jj) f[jj] = gup[(size_t)(16 * s + 8 * hi + jj) * 512 + col];
            }
            *(LAS v4u*)(L + B_BF + ((wave < 4 ? wave * 4 : 16 + (wave - 4) * 8) + s) * 1024 + lane * 16) = (v4u){pk2(f[0], f[1]), pk2(f[2], f[3]), pk2(f[4], f[5]), pk2(f[6], f[7])}; }
    }
    long raw_off[2];
#pragma unroll
    for (int i = 0; i < 2; ++i) { int q = 64 * (wave + 8 * i) + lane; if (q > 791) q = 791; const int row = q / 24, cc = q % 24; raw_off[i] = (long)(row - 1) * RC + (cc >> 3) * 512 + hd * 64 + (cc & 7) * 8; }
    const size_t mrow0 = (size_t)b * SEQ;
#define B_DMA(c) do { const size_t m0_ = mrow0 + (size_t)(c) * TC; \
        _Pragma("unroll") for (int i_ = 0; i_ < 2; ++i_) { const int p_ = wave + 8 * i_; if (p_ < 13) { long o_ = raw_off[i_]; if ((c) == 0 && o_ < 0) o_ += RC; \
            attn_body::glds16(PR + m0_ * RC + o_, (unsigned)__builtin_amdgcn_readfirstlane(lds0 + B_RAW + p_ * 1024)); } } \
        _Pragma("unroll") for (int i_ = 0; i_ < 2; ++i_) { const int p_ = wave + 8 * i_; \
            attn_body::glds16(AL + (m0_ + 2 * p_) * 256 + lane * 8, (unsigned)__builtin_amdgcn_readfirstlane(lds0 + B_AL + p_ * 1056)); } } while (0)
#define B_COPYOUT(cc) do { const size_t u_ = (size_t)bh * 128 + (cc); \
        for (int q_ = tid; q_ < 1728; q_ += 512) { const v4u v_ = *(const LAS v4u*)(L + B_OUT + q_ * 16); \
            unsigned char* d_ = (q_ < 384) ? vt_home(F, b, hd) + (size_t)(cc) * VT_B + (size_t)q_ * 16 : (q_ < 1152) ? qph_home(F, b, hd) + (size_t)(cc) * QPH_B + (size_t)(q_ - 384) * 16 : F.ws + WS_GT + u_ * GT_B + (size_t)(q_ - 1152) * 16; \
            *(GAS v4u*)d_ = v_; } } while (0)
#if defined(MK_TSTAGE)
    unsigned long long ts_acc = 0ull, ts_start = 0ull; bool ts_on = false;
#define TS(p) do { const unsigned long long now_ = __builtin_amdgcn_s_memrealtime(); if ((p) == (MK_TSTAGE + 1) % 8 && ts_on) { ts_acc += now_ - ts_start; ts_on = false; } if ((p) == MK_TSTAGE) { ts_start = now_; ts_on = true; } } while (0)
#else
#define TS(p) do {} while (0)
#endif
    B_DMA(c0);
    for (int ci = 0; ci < 64; ++ci) {
        const int c = c0 + ci;
        asm volatile("s_waitcnt vmcnt(0) lgkmcnt(0)\n\ts_barrier" ::: "memory"); TS(0);
        if (ci > 0) B_COPYOUT(c - 1);
        float rs[4], ksv[4], vs[4], rn;
        {
            const bool first = (c == 0 && et == 0);
            const LAS unsigned char* rowc = L + B_RAW + (et + 1) * 384; const LAS unsigned char* rowp = L + B_RAW + et * 384;
            const v2u rc = *(const LAS v2u*)(rowc + cg * 8), rp = *(const LAS v2u*)(rowp + cg * 8);
            const v2u kc = *(const LAS v2u*)(rowc + 128 + cg * 8), kp = *(const LAS v2u*)(rowp + 128 + cg * 8);
            const v2u vc = *(const LAS v2u*)(rowc + 256 + cg * 8), vp = *(const LAS v2u*)(rowp + 256 + cg * 8);
#define SH4(dst, cu, pr, mu) do { const float c0_ = __uint_as_float(cu.x << 16), c1_ = __uint_as_float(cu.x & 0xffff0000u), c2_ = __uint_as_float(cu.y << 16), c3_ = __uint_as_float(cu.y & 0xffff0000u); \
            const float p0_ = first ? 0.f : __uint_as_float(pr.x << 16), p1_ = first ? 0.f : __uint_as_float(pr.x & 0xffff0000u), p2_ = first ? 0.f : __uint_as_float(pr.y << 16), p3_ = first ? 0.f : __uint_as_float(pr.y & 0xffff0000u); \
            dst[0] = c0_ + (p0_ - c0_) * mu[0]; dst[1] = c1_ + (p1_ - c1_) * mu[1]; dst[2] = c2_ + (p2_ - c2_) * mu[2]; dst[3] = c3_ + (p3_ - c3_) * mu[3]; } while (0)
            SH4(rs, rc, rp, mu_r); SH4(ksv, kc, kp, mu_k); SH4(vs, vc, vp, mu_v);
#undef SH4
            float q = 0.f;
#pragma unroll
            for (int i = 0; i < 4; ++i) { const float u = ksv[i] * kkc[i]; q += u * u; }
            q = allsum16(q); rn = __builtin_amdgcn_rsqf(fmaxf(q, 1e-24f));
        }
        LBAR(); TS(1);
        if (wave < 6) {
            int l2 = lane; asm volatile("" : "+v"(l2)); const int r32 = l2 & 31, hi = l2 >> 5;
            const LAS unsigned char* arow = L + B_AL + (r32 >> 1) * 1056 + (r32 & 1) * 512 + hi * 16;
            const int colb = (wave < 2) ? 0 : (wave < 4) ? 128 : 256;
            const LAS unsigned char* bfr = L + B_BF + (wave < 4 ? wave * 4 : 16 + (wave - 4) * 8) * 1024 + lane * 16;
            f32x16 acc = f32x16{};
            if (wave < 4) {
#pragma unroll
                for (int s = 0; s < 4; ++s) acc = __builtin_amdgcn_mfma_f32_32x32x16_bf16(*(const LAS bf16x8*)(arow + colb + 32 * s), *(const LAS bf16x8*)(bfr + s * 1024), acc, 0, 0, 0);
            } else {
#pragma unroll
                for (int s = 0; s < 8; ++s) acc = __builtin_amdgcn_mfma_f32_32x32x16_bf16(*(const LAS bf16x8*)(arow + colb + 32 * s), *(const LAS bf16x8*)(bfr + s * 1024), acc, 0, 0, 0);
            }
            LAS float* dst = (LAS float*)(L + ((wave < 2) ? B_WL : (wave < 4) ? B_AV : B_GV)) + (wave & 1) * 32 + r32;
#pragma unroll
            for (int r = 0; r < 16; ++r) dst[crow(r, hi) * 64] = acc[r];
        }
        LBAR(); TS(2);
        if (ci + 1 < 64) B_DMA(c + 1);
        float ee[4], kn[4], bb[4], kp4[4];
        f32x4 E;
        {
            const f32x4 wl = *(const LAS f32x4*)(L + B_WL + (et * 64 + 4 * cg) * 4), al = *(const LAS f32x4*)(L + B_AV + (et * 64 + 4 * cg) * 4), g4 = *(const LAS f32x4*)(L + B_GV + (et * 64 + 4 * cg) * 4);
            float rk = 0.f;
#pragma unroll
            for (int i = 0; i < 4; ++i) {
                ee[i] = 0.6065306597f * __builtin_amdgcn_rcpf(1.0f + __expf(-(wl[i] + w0c[i])));
                const float a = __builtin_amdgcn_rcpf(1.0f + __expf(-(al[i] + a0c[i])));
                kn[i] = ksv[i] * kkc[i] * rn; bb[i] = kn[i] * a; kp4[i] = ksv[i] * (1.0f + (a - 1.0f) * kac[i]); rk += rs[i] * kp4[i] * rkc[i]; }
            rk = allsum16(rk);
            float zz[4], gg[4];
#pragma unroll
            for (int i = 0; i < 4; ++i) { zz[i] = (lnb[i] + rk * vs[i]) * g4[i]; gg[i] = g4[i] * lng[i]; }
            const size_t o = (mrow0 + (size_t)c * TC + et) * 512 + chb;
            *(GAS v2u*)(Z + o) = (v2u){attn_body::cvtpk_s(zz[0], zz[1]), attn_body::cvtpk_s(zz[2], zz[3])};
            *(GAS v2u*)(GG + o) = (v2u){attn_body::cvtpk_s(gg[0], gg[1]), attn_body::cvtpk_s(gg[2], gg[3])};
#pragma unroll
            for (int i = 0; i < 4; ++i) { float p = ee[i]; const float t1 = __shfl_up(p, 16); if (lane >= 16) p += t1;
                auto rr = __builtin_amdgcn_permlane32_swap(__float_as_uint(p), __float_as_uint(p), false, false); if (lane >= 32) p += __uint_as_float(rr[0]);
                E[i] = p; }
            if (lane >= 48) *(LAS f32x4*)(L + B_EE + (wave * 16 + cg) * 16) = E;
        }
        LBAR(); TS(3);
        {
#pragma unroll
            for (int w = 0; w < 7; ++w) { const f32x4 tw = *(const LAS f32x4*)(L + B_EE + (w * 16 + cg) * 16); if (w < wave) E += tw; }
            float al_[4], be_[4], ka_[4], rh_[4];
#pragma unroll
            for (int i = 0; i < 4; ++i) { const float gt = __expf(-E[i]), gp = __expf(-(E[i] - ee[i])), ig = __expf(E[i]);
                al_[i] = gp * kn[i]; be_[i] = bb[i] * ig; ka_[i] = kp4[i] * ig; rh_[i] = gt * rs[i];
                if (et == 31) *(LAS float*)(L + B_GL + (4 * cg + i) * 4) = gt; }
            *(LAS v2u*)(L + B_ALP + et * S64 + cg * 8) = (v2u){attn_body::cvtpk_s(al_[0], al_[1]), attn_body::cvtpk_s(al_[2], al_[3])};
            *(LAS v2u*)(L + B_BET + et * S64 + cg * 8) = (v2u){attn_body::cvtpk_s(be_[0], be_[1]), attn_body::cvtpk_s(be_[2], be_[3])};
            *(LAS v2u*)(L + B_KAP + et * S64 + cg * 8) = (v2u){attn_body::cvtpk_s(ka_[0], ka_[1]), attn_body::cvtpk_s(ka_[2], ka_[3])};
            *(LAS v2u*)(L + B_RHO + et * S64 + cg * 8) = (v2u){attn_body::cvtpk_s(rh_[0], rh_[1]), attn_body::cvtpk_s(rh_[2], rh_[3])};
            *(LAS v2u*)(L + B_VSL + et * S64 + cg * 8) = (v2u){attn_body::cvtpk_s(vs[0], vs[1]), attn_body::cvtpk_s(vs[2], vs[3])};
        }
        LBAR(); TS(4);
        {
            const int mtx = tid >> 7, cb = (tid >> 3) & 15, tb = tid & 7;
            const LAS unsigned char* src = L + ((mtx == 0) ? B_ALP : (mtx == 1) ? B_BET : (mtx == 2) ? B_KAP : B_VSL) + (4 * tb) * S64 + cb * 8;
            const v2u r0 = *(const LAS v2u*)(src), r1 = *(const LAS v2u*)(src + S64), r2 = *(const LAS v2u*)(src + 2 * S64), r3 = *(const LAS v2u*)(src + 3 * S64);
            LAS unsigned char* dst = (mtx == 3) ? L + B_OUT + O_VT + (cb >> 3) * 3072 + (4 * (cb & 7)) * S32 + tb * 8 : L + ((mtx == 0) ? B_ALPT : (mtx == 1) ? B_BETT : B_KAPT) + (4 * cb) * S32 + tb * 8;
            *(LAS v2u*)(dst)           = (v2u){(r0.x & 0xffffu) | (r1.x << 16), (r2.x & 0xffffu) | (r3.x << 16)};
            *(LAS v2u*)(dst + S32)     = (v2u){(r0.x >> 16) | (r1.x & 0xffff0000u), (r2.x >> 16) | (r3.x & 0xffff0000u)};
            *(LAS v2u*)(dst + 2 * S32) = (v2u){(r0.y & 0xffffu) | (r1.y << 16), (r2.y & 0xffffu) | (r3.y << 16)};
            *(LAS v2u*)(dst + 3 * S32) = (v2u){(r0.y >> 16) | (r1.y & 0xffff0000u), (r2.y >> 16) | (r3.y & 0xffff0000u)};
        }
        LBAR(); TS(5);
        int ln = lane; asm volatile("" : "+v"(ln));
        f32x16 X = f32x16{}, RK = f32x16{};
        {
            const int r32 = ln & 31, hi = ln >> 5;
            if (wave == 0) { f32x16 acc = f32x16{}; tile_nt(acc, L + B_ALP, S64, 0, L + B_BET, S64, 0, 4, ln);
#pragma unroll
                for (int r = 0; r < 16; ++r) acc[r] = (crow(r, hi) > r32) ? -acc[r] : 0.f;
                store_nat(L + B_PW0 + 32 * S32, S32, 0, acc, ln);
            } else if (wave == 4) { f32x16 acc = f32x16{}; tile_nt(acc, L + B_BET, S64, 0, L + B_ALP, S64, 0, 4, ln);
#pragma unroll
                for (int r = 0; r < 16; ++r) acc[r] = (r32 > crow(r, hi)) ? -acc[r] : 0.f;
                store_nat(L + B_PW0, S32, 0, acc, ln);
            } else if (wave == 1) { tile_nt(X, L + B_ALP, S64, 0, L + B_KAP, S64, 0, 4, ln);
#pragma unroll
                for (int r = 0; r < 16; ++r) X[r] = (crow(r, hi) > r32) ? X[r] : 0.f;
            } else if (wave == 2 || wave == 3) {
                const LAS unsigned char* ap = L + B_ALPT + ((wave - 2) * 32 + r32) * S32 + 8 * hi;
#pragma unroll
                for (int g4 = 0; g4 < 4; ++g4) { const v2u t2 = *(const LAS v2u*)(ap + 16 * g4);
                    X[4 * g4] = __uint_as_float(t2.x << 16); X[4 * g4 + 1] = __uint_as_float(t2.x & 0xffff0000u); X[4 * g4 + 2] = __uint_as_float(t2.y << 16); X[4 * g4 + 3] = __uint_as_float(t2.y & 0xffff0000u); }
            } else if (wave == 5) { f32x16 acc = f32x16{}; tile_nt(acc, L + B_BET, S64, 0, L + B_RHO, S64, 0, 4, ln);
#pragma unroll
                for (int r = 0; r < 16; ++r) acc[r] = (r32 >= crow(r, hi)) ? acc[r] : 0.f;
                store_nat(L + B_ARB, S32, 0, acc, ln);
            } else if (wave == 6) { tile_nt(RK, L + B_KAP, S64, 0, L + B_RHO, S64, 0, 4, ln);
#pragma unroll
                for (int r = 0; r < 16; ++r) RK[r] = (r32 >= crow(r, hi)) ? RK[r] : 0.f; }
        }
        LBAR(); TS(6);
#pragma unroll
        for (int j = 0; j < 5; ++j) {
            const LAS unsigned char* pw = L + ((j & 1) ? B_PW1 : B_PW0); LAS unsigned char* pn = L + ((j & 1) ? B_PW0 : B_PW1);
            asm volatile("" : "+v"(ln));
            if (wave >= 1 && wave <= 3) { LAS unsigned char* xt = (wave == 1) ? L + B_UMT : L + B_WMT + (wave - 2) * 32 * S32;
                store_nat(xt, S32, 0, X, ln);
                tile_nt(X, pw, S32, 0, xt, S32, 0, 2, ln);
                if (j == 4) store_nat(xt, S32, 0, X, ln);
            } else if (j < 4 && (wave == 0 || wave == 4)) { f32x16 sq = f32x16{};
                if (wave == 0) { tile_nt(sq, pw, S32, 0, pw + 32 * S32, S32, 0, 2, ln); store_nat(pn + 32 * S32, S32, 0, sq, ln); }
                else           { tile_nt(sq, pw + 32 * S32, S32, 0, pw, S32, 0, 2, ln); store_nat(pn, S32, 0, sq, ln); } }
            LBAR();
        }
        TS(7);
        {
            asm volatile("" : "+v"(ln)); const int r32 = ln & 31, hi = ln >> 5; LAS unsigned char* OQ = L + B_OUT + O_QPH; LAS unsigned char* OG = L + B_OUT + O_GT;
            if (wave < 2) { f32x16 acc = f32x16{}; tile_nt(acc, L + B_WMT, S32, wave * 32, L + B_ARB, S32, 0, 2, ln);
#pragma unroll
                for (int g4 = 0; g4 < 4; ++g4) { const v2u rr = *(const LAS v2u*)(L + B_RHO + r32 * S64 + (wave * 32 + 8 * g4 + 4 * hi) * 2);
                    acc[4 * g4] = __uint_as_float(rr.x << 16) - acc[4 * g4]; acc[4 * g4 + 1] = __uint_as_float(rr.x & 0xffff0000u) - acc[4 * g4 + 1]; acc[4 * g4 + 2] = __uint_as_float(rr.y << 16) - acc[4 * g4 + 2]; acc[4 * g4 + 3] = __uint_as_float(rr.y & 0xffff0000u) - acc[4 * g4 + 3]; }
                store_nat(OQ, S64, 0, acc, ln, wave * 32); }
            if (wave == 2 || wave == 3) { const int ni = wave - 2; f32x16 acc = f32x16{}; tile_nt(acc, L + B_UMT, S32, 0, L + B_BETT, S32, ni * 32, 2, ln);
                const int ch = ni * 32 + r32; const float gl = *(const LAS float*)(L + B_GL + ch * 4);
#pragma unroll
                for (int g4 = 0; g4 < 4; ++g4) { const v2u kk2 = *(const LAS v2u*)(L + B_KAPT + ch * S32 + (8 * g4 + 4 * hi) * 2);
                    acc[4 * g4] = (__uint_as_float(kk2.x << 16) - acc[4 * g4]) * gl; acc[4 * g4 + 1] = (__uint_as_float(kk2.x & 0xffff0000u) - acc[4 * g4 + 1]) * gl;
                    acc[4 * g4 + 2] = (__uint_as_float(kk2.y << 16) - acc[4 * g4 + 2]) * gl; acc[4 * g4 + 3] = (__uint_as_float(kk2.y & 0xffff0000u) - acc[4 * g4 + 3]) * gl; }
                store_nat(OQ + O_HT, S32, ni * 32, acc, ln); }
            if (wave == 6) { f32x16 acc = f32x16{}; tile_nt(acc, L + B_UMT, S32, 0, L + B_ARB, S32, 0, 2, ln);
#pragma unroll
                for (int r = 0; r < 16; ++r) acc[r] = RK[r] - acc[r];
                store_nat(OQ + O_PM, S32, 0, acc, ln); }
            if (wave >= 4) { const int gi = (wave == 4) ? 0 : (wave == 5) ? 1 : (wave == 7) ? 2 : 3, mi = gi >> 1, ni = gi & 1; f32x16 acc = f32x16{};
                tile_nt(acc, L + B_WMT, S32, mi * 32, L + B_BETT, S32, ni * 32, 2, ln);
                const int ch = ni * 32 + r32; const float gl = *(const LAS float*)(L + B_GL + ch * 4);
#pragma unroll
                for (int r = 0; r < 16; ++r) { const int chp = mi * 32 + crow(r, hi); acc[r] = (((chp == ch) ? 1.f : 0.f) - acc[r]) * gl; }
                store_nat(OG, S64, ni * 32, acc, ln, mi * 32); }
        }
    }
    __syncthreads();
#if defined(MK_TSTAGE)
    if (blockIdx.x == 0 && wave == 0) { const unsigned long long t0_ = __builtin_amdgcn_s_memrealtime(); while (__builtin_amdgcn_s_memrealtime() - t0_ < 4ull * ts_acc) __builtin_amdgcn_s_sleep(8); }
#endif
    B_COPYOUT(c0 + 63);
    asm volatile("s_waitcnt vmcnt(0)" ::: "memory"); __syncthreads();
#undef B_DMA
#undef B_COPYOUT
#undef TS
}

constexpr int A_IMG = 0, IMG_B = 3072 + QPH_B + GT_B;
constexpr int A_S = 3 * IMG_B, A_YB = A_S + 32 * S64, A_END = A_YB + 2 * 4096;
static_assert(A_END <= LDSCTL_OFF, "scan2 apply LDS");
__device__ __forceinline__ void apply(Frame& F) {
    const int tid = F.tid, lane = F.lane, wave = F.wave;
    const int half = F.vcu & 1, bh = F.vcu >> 1, hd = bh & 7, b = bh >> 3;
    LAS unsigned char* L = F.lds;
    const unsigned lds0 = (unsigned)(uintptr_t)(unsigned char*)F.lds;
    bf16* Y = (bf16*)((unsigned char*)F.out + OUT_Y);
    const size_t mrow0 = (size_t)b * SEQ;
    const int dw = (wave - 3) & 1;
#define A_DMA(c) do { const size_t u_ = (size_t)bh * 128 + (c); \
        _Pragma("unroll") for (int i_ = 0; i_ < 12; ++i_) { const int p_ = dw * 12 + i_; \
            const unsigned char* src_ = (p_ < 3) ? vt_home(F, b, hd) + (size_t)(c) * VT_B + half * 3072 + p_ * 1024 : (p_ < 15) ? qph_home(F, b, hd) + (size_t)(c) * QPH_B + (p_ - 3) * 1024 : F.ws + WS_GT + u_ * GT_B + (p_ - 15) * 1024; \
            attn_body::glds16(src_ + lane * 16, (unsigned)__builtin_amdgcn_readfirstlane(lds0 + A_IMG + ((c) % 3) * IMG_B + p_ * 1024)); } } while (0)
    for (int q = tid; q < 32 * S64 / 4; q += 512) ((LAS unsigned*)(L + A_S))[q] = 0u;
    if (wave == 3 || wave == 4) A_DMA(0);
    if (wave == 5 || wave == 6) A_DMA(1);
    for (int c = 0; c < SEQ / TC; ++c) {
        const bool mydma = (wave >= 3 && wave < 7) && ((((wave - 3) >> 1) & 1) == (c & 1));
        if (mydma) asm volatile("s_waitcnt vmcnt(0)" ::: "memory");
        LBAR();
        if (mydma && c + 2 < SEQ / TC) A_DMA(c + 2);
        const LAS unsigned char* I = L + A_IMG + (c % 3) * IMG_B; const LAS unsigned char* IVT = I; const LAS unsigned char* IQ = I + 3072; const LAS unsigned char* IG = I + 3072 + QPH_B;
        f32x16 acc = f32x16{};
        int ln = lane; asm volatile("" : "+v"(ln)); const int r32 = ln & 31, hi = ln >> 5;
        if (wave == 0) { tile_nt(acc, IQ, S64, 0, L + A_S, S64, 0, 4, ln); tile_nt(acc, IQ + O_PM, S32, 0, IVT, S32, 0, 2, ln); }
        else if (wave < 3) { const int ni = wave - 1; tile_nt(acc, IG, S64, ni * 32, L + A_S, S64, 0, 4, ln); tile_nt(acc, IQ + O_HT, S32, ni * 32, IVT, S32, 0, 2, ln); }
        if (wave == 7 && c > 0) {
#pragma unroll
            for (int i = 0; i < 2; ++i) { const int q = i * 64 + lane, st = q >> 2, v8 = (q & 3) * 8; const LAS f32x4* yp = (const LAS f32x4*)(L + A_YB + ((c - 1) & 1) * 4096 + (st * 32 + v8) * 4); const f32x4 ya = yp[0], yb = yp[1];
                *(GAS v4u*)(Y + (mrow0 + (size_t)(c - 1) * TC + st) * 512 + hd * 64 + half * 32 + v8) = (v4u){attn_body::cvtpk_s(ya[0], ya[1]), attn_body::cvtpk_s(ya[2], ya[3]), attn_body::cvtpk_s(yb[0], yb[1]), attn_body::cvtpk_s(yb[2], yb[3])}; } }
        LBAR();
        if (wave == 0) {
#pragma unroll
            for (int r = 0; r < 16; ++r) *(LAS float*)(L + A_YB + (c & 1) * 4096 + (crow(r, hi) * 32 + r32) * 4) = acc[r]; }
        else if (wave < 3) store_nat(L + A_S, S64, 0, acc, ln, (wave - 1) * 32);
    }
    __syncthreads();
    if (wave == 7) {
#pragma unroll
        for (int i = 0; i < 2; ++i) { const int q = i * 64 + lane, st = q >> 2, v8 = (q & 3) * 8; const LAS f32x4* yp = (const LAS f32x4*)(L + A_YB + ((SEQ / TC - 1) & 1) * 4096 + (st * 32 + v8) * 4); const f32x4 ya = yp[0], yb = yp[1];
            *(GAS v4u*)(Y + (mrow0 + (size_t)(SEQ / TC - 1) * TC + st) * 512 + hd * 64 + half * 32 + v8) = (v4u){attn_body::cvtpk_s(ya[0], ya[1]), attn_body::cvtpk_s(ya[2], ya[3]), attn_body::cvtpk_s(yb[0], yb[1]), attn_body::cvtpk_s(yb[2], yb[3])}; } }
    asm volatile("s_waitcnt vmcnt(0)" ::: "memory"); __syncthreads();
#undef A_DMA
}
constexpr int A2_IMG = 0, IMG2_B = VT_B + QPH_B + GT_B;
constexpr int A2_S = 3 * IMG2_B, A2_YB = A2_S + 64 * S64, A2_END = A2_YB + 2 * 8192;
static_assert(A2_END <= LDSCTL_OFF, "scan2 apply2 LDS");
__device__ __forceinline__ void a2_epilogue(const LAS float* yr, const v4u (&gq)[4], const v4u (&zq)[4], bf16* dst) {
    float y[32]; float s = 0.f;
#pragma unroll
    for (int i = 0; i < 8; ++i) { const f32x4 t4 = *(const LAS f32x4*)(yr + 4 * i); y[4 * i] = t4[0]; y[4 * i + 1] = t4[1]; y[4 * i + 2] = t4[2]; y[4 * i + 3] = t4[3]; s += (t4[0] + t4[1]) + (t4[2] + t4[3]); }
    s += __int_as_float(__builtin_amdgcn_update_dpp(0, __float_as_int(s), 0xB1, 0xf, 0xf, false));
    const float mean = s * (1.f / 64.f); float q = 0.f;
#pragma unroll
    for (int i = 0; i < 32; ++i) { y[i] -= mean; q += y[i] * y[i]; }
    q += __int_as_float(__builtin_amdgcn_update_dpp(0, __float_as_int(q), 0xB1, 0xf, 0xf, false));
    const float rstd = __builtin_amdgcn_rsqf(q * (1.f / 64.f) + 64e-5f);
#pragma unroll
    for (int h = 0; h < 4; ++h) { unsigned ow[4];
#pragma unroll
        for (int i = 0; i < 4; ++i) { const unsigned gw_ = gq[h][i], zw_ = zq[h][i]; const int k = 8 * h + 2 * i;
            const float o0 = y[k] * rstd * __uint_as_float(gw_ << 16) + __uint_as_float(zw_ << 16), o1 = y[k + 1] * rstd * __uint_as_float(gw_ & 0xffff0000u) + __uint_as_float(zw_ & 0xffff0000u);
            ow[i] = attn_body::cvtpk_s(o0, o1); }
        *(GAS v4u*)(dst + 8 * h) = (v4u){ow[0], ow[1], ow[2], ow[3]}; }
}
__device__ __forceinline__ void apply2(Frame& F) {
    if (F.vcu & 1) return;
    const int lane = F.lane, wave = F.wave;
    const int bh = F.vcu >> 1, hd = bh & 7, b = bh >> 3;
    LAS unsigned char* L = F.lds;
    const unsigned lds0 = (unsigned)(uintptr_t)(unsigned char*)F.lds;
    const bf16* GG = (const bf16*)((unsigned char*)F.out + OUT_GG); const bf16* Z = (const bf16*)((unsigned char*)F.out + OUT_Z); bf16* MIX = (bf16*)(F.ws + WS_MIX);
    const size_t mrow0 = (size_t)b * SEQ;
#define A2_DMA(c) do { const size_t u_ = (size_t)bh * 128 + (c); \
        _Pragma("unroll") for (int i_ = 0; i_ < 4; ++i_) { const int p_ = wave + 7 * i_; if (p_ < 27) { \
            const unsigned char* src_ = (p_ < 6) ? F.ws + WS_VT + u_ * VT_B + p_ * 1024 : (p_ < 18) ? F.ws + WS_QPH + u_ * QPH_B + (p_ - 6) * 1024 : F.ws + WS_GT + u_ * GT_B + (p_ - 18) * 1024; \
            attn_body::glds16(src_ + lane * 16, (unsigned)__builtin_amdgcn_readfirstlane(lds0 + A2_IMG + ((c) % 3) * IMG2_B + p_ * 1024)); } } } while (0)
    for (int q = F.tid; q < 64 * S64 / 4; q += 512) ((LAS unsigned*)(L + A2_S))[q] = 0u;
    if (wave < 7) { A2_DMA(0); A2_DMA(1); }
    const int est = lane >> 1, ev0 = 32 * (lane & 1);
    v4u gq[4], zq[4];
    for (int c = 0; c < SEQ / TC; ++c) {
        if (wave < 7) { if (c + 1 >= SEQ / TC) asm volatile("s_waitcnt vmcnt(0)" ::: "memory"); else if (wave < 6) asm volatile("s_waitcnt vmcnt(4)" ::: "memory"); else asm volatile("s_waitcnt vmcnt(3)" ::: "memory"); }
        LBAR();
        if (wave < 7 && c + 2 < SEQ / TC) A2_DMA(c + 2);
        const LAS unsigned char* I = L + A2_IMG + (c % 3) * IMG2_B; const LAS unsigned char* IVT = I; const LAS unsigned char* IQ = I + VT_B; const LAS unsigned char* IG = I + VT_B + QPH_B;
        f32x16 acc = f32x16{};
        int ln = lane; asm volatile("" : "+v"(ln)); const int r32 = ln & 31, hi = ln >> 5;
        if (wave < 2) { tile_nt(acc, IQ, S64, 0, L + A2_S, S64, wave * 32, 4, ln); tile_nt(acc, IQ + O_PM, S32, 0, IVT + wave * 3072, S32, 0, 2, ln); }
        else if (wave < 6) { const int ni = (wave - 2) & 1, vi = (wave - 2) >> 1;
            tile_nt(acc, IG, S64, ni * 32, L + A2_S, S64, vi * 32, 4, ln); tile_nt(acc, IQ + O_HT, S32, ni * 32, IVT + vi * 3072, S32, 0, 2, ln); }
        else if (wave == 7) {
            if (c > 0) a2_epilogue((const LAS float*)(L + A2_YB + ((c - 1) & 1) * 8192) + est * 64 + ev0, gq, zq, MIX + (mrow0 + (size_t)(c - 1) * TC + est) * 1024 + hd * 64 + ev0);
            const size_t o = (mrow0 + (size_t)c * TC + est) * 512 + hd * 64 + ev0;
#pragma unroll
            for (int i = 0; i < 4; ++i) { gq[i] = *(const GAS v4u*)(GG + o + 8 * i); zq[i] = *(const GAS v4u*)(Z + o + 8 * i); }
        }
        LBAR();
        if (wave < 2) {
#pragma unroll
            for (int r = 0; r < 16; ++r) *(LAS float*)(L + A2_YB + (c & 1) * 8192 + (crow(r, hi) * 64 + wave * 32 + r32) * 4) = acc[r]; }
        else if (wave < 6) store_nat(L + A2_S, S64, ((wave - 2) >> 1) * 32, acc, ln, ((wave - 2) & 1) * 32);
    }
    LBAR();
    if (wave == 7) a2_epilogue((const LAS float*)(L + A2_YB + ((SEQ / TC - 1) & 1) * 8192) + est * 64 + ev0, gq, zq, MIX + (mrow0 + (size_t)(SEQ / TC - 1) * TC + est) * 1024 + hd * 64 + ev0);
    asm volatile("s_waitcnt vmcnt(0)" ::: "memory");
#undef A2_DMA
}
#undef ST16
}

constexpr size_t WS_XS = 264 * MiB, WS_HID = 536 * MiB, WS_YB = 672 * MiB;
constexpr size_t WS_X1B = 264 * MiB, X1B_XTRA = 3 * 1024 * 1024;
constexpr int SLOT_CAP = 65536;
constexpr int L_TB = 131072;
__device__ __forceinline__ void moe_tile_table(Frame& F) {
    LAS int* cnt = (LAS int*)(F.lds + L_TB); LAS int* tb = cnt + 32;
    if (F.tid < 32) cnt[F.tid] = (int)__hip_atomic_load(F.ctl + CW_CNT + 64 * F.tid, RLX_AGENT);
    __syncthreads();
    if (F.tid == 0) { int s = 0; for (int e = 0; e < 32; ++e) { tb[e] = s; s += (cnt[e] + 255) >> 8; } tb[32] = s; }
    __syncthreads();
}
__device__ __forceinline__ void m0_route(Frame& F) {
    LAS f32x4* Wg4 = (LAS f32x4*)(F.lds);
    LAS f32x4* Wr4 = (LAS f32x4*)(F.lds + 16384);
    LAS int* tokE = (LAS int*)(F.lds + 147456);
    LAS float* tokW = (LAS float*)(F.lds + 147456 + 2048);
    LAS int* hist = (LAS int*)(F.lds + 147456 + 4096);
    const float* wgrp = F.in[IN_WGRP]; const float* wrt = F.in[IN_WRT];
    for (int idx = F.tid; idx < 1024 * 4; idx += 512) { const int c = idx >> 2, j = idx & 3; const int l = (c & 255) >> 2, jj = (c >> 8) * 4 + (c & 3); ((LAS float*)Wg4)[(jj * 64 + l) * 4 + j] = wgrp[idx]; }
    for (int i0 = 0; i0 < 64; i0 += 16) { float wv_[16];
#pragma unroll
        for (int i = 0; i < 16; ++i) wv_[i] = wrt[F.tid + 512 * (i0 + i)];
#pragma unroll
        for (int i = 0; i < 16; ++i) { const int idx = F.tid + 512 * (i0 + i); const int c = idx >> 5, e = idx & 31; const int l = (c & 255) >> 2, jj = (c >> 8) * 4 + (c & 3); ((LAS float*)Wr4)[(((e >> 2) * 16 + jj) * 64 + l) * 4 + (e & 3)] = wv_[i]; } }
    const float* g2 = F.in[IN_N2G]; const float* mod = (const float*)(F.ws + WS_MOD); const float* bgrp = F.in[IN_BGRP]; const float* brt = F.in[IN_BRT];
    bf16* H2 = (bf16*)(F.ws + WS_H); int* slot_tok = (int*)(F.ws + WS_SLOT_TOK); float* slot_w = (float*)(F.ws + WS_SLOT_W); unsigned* tokinfo = (unsigned*)(F.ws + WS_TOKINFO);
    const float bg0 = bgrp[0], bg1 = bgrp[1], bg2 = bgrp[2], bg3 = bgrp[3];
    for (int rb = F.vcu; rb < NTOK / 256; rb += F.G) {
        if (F.tid < 32) hist[F.tid] = 0;
        __syncthreads();
        const int b = (rb * 256) / SEQ;
        f32x4 A[4], Bc[4];
#pragma unroll
        for (int j = 0; j < 4; ++j) { const int c = 4 * F.lane + 256 * j; const f32x4 g = *(const f32x4*)(g2 + c), sc = *(const f32x4*)(mod + (size_t)b * NMOD + 4096 + c); A[j] = g * (sc + 1.0f); Bc[j] = *(const f32x4*)(mod + (size_t)b * NMOD + 3072 + c); }
        const bf16* X1B = (const bf16*)(F.ws + WS_X1B) + (size_t)b * X1B_XTRA;
        v2u vn[4];
        { const GAS v2u* xr0 = (const GAS v2u*)(X1B + ((size_t)rb * 256 + F.wave) * 1024) + F.lane;
#pragma unroll
          for (int j = 0; j < 4; ++j) vn[j] = xr0[64 * j]; }
        for (int r = F.wave; r < 256; r += NWAVES) {
            const size_t m = (size_t)rb * 256 + r;
            f32x4 v[4]; float ss = 0.f;
#pragma unroll
            for (int j = 0; j < 4; ++j) v[j] = (f32x4){__uint_as_float(vn[j][0] << 16), __uint_as_float(vn[j][0] & 0xffff0000u), __uint_as_float(vn[j][1] << 16), __uint_as_float(vn[j][1] & 0xffff0000u)};
            if (r + NWAVES < 256) { const GAS v2u* xr = (const GAS v2u*)(X1B + (m + NWAVES) * 1024) + F.lane;
#pragma unroll
                for (int j = 0; j < 4; ++j) vn[j] = xr[64 * j]; }
#pragma unroll
            for (int j = 0; j < 4; ++j) ss += (v[j].x * v[j].x + v[j].y * v[j].y) + (v[j].z * v[j].z + v[j].w * v[j].w);
            const float rstd = 1.0f / sqrtf(wave_sum(ss) * (1.f / 1024.f) + 1e-6f);
            GAS unsigned long long* o8 = (GAS unsigned long long*)(H2 + m * 1024) + F.lane;
            f32x4 ga = (f32x4){0.f, 0.f, 0.f, 0.f};
#pragma unroll
            for (int j = 0; j < 4; ++j) { v[j] = v[j] * rstd * A[j] + Bc[j];
                o8[64 * j] = (unsigned long long)attn_body::cvtpk_s(v[j].x, v[j].y) | ((unsigned long long)attn_body::cvtpk_s(v[j].z, v[j].w) << 32);
#pragma unroll
                for (int i = 0; i < 4; ++i) ga += Wg4[(j * 4 + i) * 64 + F.lane] * v[j][i]; }
            float gv_[4] = {ga[0], ga[1], ga[2], ga[3]}, gt_[4]; wave_reduce4(gv_, gt_, F.lane);
            const float l0 = gt_[0] + bg0, l1 = gt_[1] + bg1, l2 = gt_[2] + bg2, l3 = gt_[3] + bg3;
            int gs = 0; float lm = l0; if (l1 > lm) { lm = l1; gs = 1; } if (l2 > lm) { lm = l2; gs = 2; } if (l3 > lm) { lm = l3; gs = 3; }
            const float pg = 1.0f / (__expf(l0 - lm) + __expf(l1 - lm) + __expf(l2 - lm) + __expf(l3 - lm));
            gs = __builtin_amdgcn_readfirstlane(gs);
            f32x4 e0 = (f32x4){0.f, 0.f, 0.f, 0.f}, e1 = e0;
            const LAS f32x4* w0p = Wr4 + (gs * 2) * 1024 + F.lane; const LAS f32x4* w1p = w0p + 1024;
#pragma unroll
            for (int j = 0; j < 4; ++j)
#pragma unroll
                for (int i = 0; i < 4; ++i) { e0 += w0p[(j * 4 + i) * 64] * v[j][i]; e1 += w1p[(j * 4 + i) * 64] * v[j][i]; }
            float el[8], ev_[8] = {e0[0], e0[1], e0[2], e0[3], e1[0], e1[1], e1[2], e1[3]}; wave_reduce8(ev_, el, F.lane);
#pragma unroll
            for (int q = 0; q < 8; ++q) el[q] += brt[gs * 8 + q];
            int i1 = 0; float m1 = el[0];
#pragma unroll
            for (int q = 1; q < 8; ++q) if (el[q] > m1) { m1 = el[q]; i1 = q; }
            int i2 = -1; float m2 = -3.0e38f;
#pragma unroll
            for (int q = 0; q < 8; ++q) if (q != i1 && el[q] > m2) { m2 = el[q]; i2 = q; }
            const float t = __expf(m2 - m1), w1 = pg / (1.0f + t), w2 = pg * t / (1.0f + t);
            if (F.lane == 0) { tokE[2 * r] = gs * 8 + i1; tokE[2 * r + 1] = gs * 8 + i2; tokW[2 * r] = w1; tokW[2 * r + 1] = w2; }
        }
        __syncthreads();
        const int ar = F.tid >> 1, ak = F.tid & 1, ae = tokE[2 * ar + ak];
        const int lpos = __hip_atomic_fetch_add(hist + ae, 1, __ATOMIC_RELAXED, __HIP_MEMORY_SCOPE_WORKGROUP);
        __syncthreads();
        if (F.tid < 32) { const int n = hist[F.tid]; hist[32 + F.tid] = n ? (int)__hip_atomic_fetch_add(F.ctl + CW_CNT + 64 * F.tid, (unsigned)n, RLX_AGENT) : 0; }
        __syncthreads();
        { const int pos = hist[32 + ae] + lpos; const int tok = rb * 256 + ar;
          slot_tok[(size_t)ae * SLOT_CAP + pos] = tok; slot_w[(size_t)ae * SLOT_CAP + pos] = tokW[2 * ar + ak]; tokinfo[2 * tok + ak] = ((unsigned)ae << 20) | (unsigned)pos; }
        __syncthreads();
    }
}
__device__ __forceinline__ void m1_permute(Frame& F) {
    moe_tile_table(F);
    const LAS int* cnt = (const LAS int*)(F.lds + L_TB); const LAS int* tb = cnt + 32;
    const bf16* H2 = (const bf16*)(F.ws + WS_H); bf16* XS = (bf16*)(F.ws + WS_XS); const int* slot_tok = (const int*)(F.ws + WS_SLOT_TOK);
    const int nrows = tb[32] * 256, gw = F.vcu * NWAVES + F.wave, NGW = F.G * NWAVES;
    for (int R = gw; R < nrows; R += NGW) {
        const int rt = R >> 8; int e = 0;
        for (int q = 1; q < 32; ++q) if (tb[q] <= rt) e = q;
        const int slot = (rt - tb[e]) * 256 + (R & 255);
        v4u a = (v4u){0u, 0u, 0u, 0u}, c = a;
        if (slot < cnt[e]) { const int tok = slot_tok[(size_t)e * SLOT_CAP + slot]; const GAS v4u* src = (const GAS v4u*)(H2 + (size_t)tok * 1024) + F.lane; a = src[0]; c = src[64]; }
        GAS v4u* dst = (GAS v4u*)(XS + (size_t)R * 1024) + F.lane; dst[0] = a; dst[64] = c;
    }
}
constexpr int L_TOKL = L_TB + 1024;
template <bool GATHER_> struct MoeOrder {
    static constexpr bool GATHER = GATHER_;
    const LAS int* tb; const LAS int* tokl; int G, c, nwg;
    __device__ __forceinline__ bool next(int i, pg8::Unit& u) const {
        const int Lq = i * G + c; if (Lq >= nwg) return false;
        const int rt = Lq >> 2; int e = 0;
        for (int q = 1; q < 32; ++q) if (tb[q] <= rt) e = q;
        u.pm = rt; u.pn = 4 * e + (Lq & 3); u.e = e; u.j = GATHER_ ? rt - tb[e] : i; return true;
    }
    __device__ __forceinline__ unsigned a_row(int ui, int row) const { return (unsigned)tokl[ui * 256 + row]; }
    __device__ __forceinline__ void a_ready(const pg8::Unit&) const {}
    __device__ __forceinline__ void done(const pg8::Unit&) const {}
};
__device__ __forceinline__ void moe_fill_tokl(Frame& F) {
    const LAS int* cnt = (const LAS int*)(F.lds + L_TB); const LAS int* tb = cnt + 32; LAS int* tokl = (LAS int*)(F.lds + L_TOKL);
    const int* slot_tok = (const int*)(F.ws + WS_SLOT_TOK); const int nwg = tb[32] * 4;
    for (int i = 0; i < 12; ++i) { const int Lq = i * F.G + F.vcu; if (Lq >= nwg) break;
        const int rt = Lq >> 2; int e = 0;
        for (int q = 1; q < 32; ++q) if (tb[q] <= rt) e = q;
        if (F.tid < 256) { const int slot = (rt - tb[e]) * 256 + F.tid; tokl[i * 256 + F.tid] = slot < cnt[e] ? slot_tok[(size_t)e * SLOT_CAP + slot] : 0; } }
    __syncthreads();
}
__device__ __forceinline__ void moe_fill_wl(Frame& F) {
    const LAS int* cnt = (const LAS int*)(F.lds + L_TB); const LAS int* tb = cnt + 32; LAS float* wl = (LAS float*)(F.lds + L_TOKL);
    const float* slot_w = (const float*)(F.ws + WS_SLOT_W); const int nwg = tb[32] * 4;
    for (int i = 0; i < 12; ++i) { const int Lq = i * F.G + F.vcu; if (Lq >= nwg) break;
        const int rt = Lq >> 2; int e = 0;
        for (int q = 1; q < 32; ++q) if (tb[q] <= rt) e = q;
        if (F.tid < 256) { const int slot = (rt - tb[e]) * 256 + F.tid; wl[i * 256 + F.tid] = slot < cnt[e] ? slot_w[(size_t)e * SLOT_CAP + slot] : 0.f; } }
    __syncthreads();
}
namespace pg8 {
struct EpiSwiGLU {
    static constexpr bool PERM = true, AFTER_DRAIN = false;
    bf16_t* HID;
    __device__ __forceinline__ void operator()(const f32x4 (&acc)[2][2][4][2], const Unit& u, int wr, int wc, int fr, int fq) const {
        const int row0 = u.pm * BM + wr * 64 + fr, col0 = (u.pn & 3) * 128 + wc * 32 + 8 * fq;
#pragma unroll
        for (int ai = 0; ai < 2; ++ai)
#pragma unroll
            for (int m = 0; m < 4; ++m) { f32x4 h[2];
#pragma unroll
                for (int n = 0; n < 2; ++n) { const f32x4 g = acc[ai][0][m][n], up = acc[ai][1][m][n];
#pragma unroll
                    for (int i = 0; i < 4; ++i) h[n][i] = g[i] / (1.0f + __expf(-g[i])) * up[i]; }
                u32x4 w; w.x = cvt_pk_bf16(h[0][0], h[0][1]); w.y = cvt_pk_bf16(h[0][2], h[0][3]); w.z = cvt_pk_bf16(h[1][0], h[1][1]); w.w = cvt_pk_bf16(h[1][2], h[1][3]);
                *(u32x4*)(HID + (size_t)(row0 + ai * HALF + m * 16) * 512 + col0) = w; }
    }
};
struct EpiDown {
    static constexpr bool PERM = true, AFTER_DRAIN = false;
    bf16_t* YB; const PG8_LAS float* wl;
    __device__ __forceinline__ void operator()(const f32x4 (&acc)[2][2][4][2], const Unit& u, int wr, int wc, int fr, int fq) const {
        const int rloc0 = wr * 64 + fr, col0 = (u.pn & 3) * BM + wc * 32 + 8 * fq;
#pragma unroll
        for (int ai = 0; ai < 2; ++ai)
#pragma unroll
            for (int m = 0; m < 4; ++m) { const int rloc = rloc0 + ai * HALF + m * 16; const float sc = wl[u.j * BM + rloc];
                bf16_t* rowp = YB + (size_t)(u.pm * BM + rloc) * 1024 + col0;
#pragma unroll
                for (int bj = 0; bj < 2; ++bj) { const f32x4 v0 = acc[ai][bj][m][0] * sc, v1 = acc[ai][bj][m][1] * sc;
                    u32x4 w; w.x = cvt_pk_bf16(v0[0], v0[1]); w.y = cvt_pk_bf16(v0[2], v0[3]); w.z = cvt_pk_bf16(v1[0], v1[1]); w.w = cvt_pk_bf16(v1[2], v1[3]);
                    *(u32x4*)(rowp + bj * HALF) = w; } }
    }
};
}
__device__ __forceinline__ void p_final(Frame& F) {
    moe_tile_table(F);
    const LAS int* tb = (const LAS int*)(F.lds + L_TB) + 32;
    const float* gf = F.in[IN_NFG]; const float* mod = (const float*)(F.ws + WS_MOD); const bf16* YB = (const bf16*)(F.ws + WS_YB); const unsigned* tokinfo = (const unsigned*)(F.ws + WS_TOKINFO);
    f32x4 G4[4];
#pragma unroll
    for (int j = 0; j < 4; ++j) G4[j] = *(const f32x4*)(gf + 4 * F.lane + 256 * j);
    const int gw = F.vcu * NWAVES + F.wave, NGW = F.G * NWAVES;
    const bf16* X1B = (const bf16*)(F.ws + WS_X1B);
    v2u xn[4], an[4], cn[4];
#define FIN_LOAD(mm) do { const unsigned i0_ = tokinfo[2 * (mm)], i1_ = tokinfo[2 * (mm) + 1]; \
        const size_t r0_ = (size_t)tb[i0_ >> 20] * 256 + (i0_ & 0xfffffu), r1_ = (size_t)tb[i1_ >> 20] * 256 + (i1_ & 0xfffffu); \
        const GAS v2u* xr_ = (const GAS v2u*)(X1B + (size_t)(mm) * 1024 + (size_t)((mm) / SEQ) * X1B_XTRA) + F.lane; const GAS v2u* y0_ = (const GAS v2u*)(YB + r0_ * 1024) + F.lane; const GAS v2u* y1_ = (const GAS v2u*)(YB + r1_ * 1024) + F.lane; \
        _Pragma("unroll") for (int j_ = 0; j_ < 4; ++j_) { xn[j_] = xr_[64 * j_]; an[j_] = y0_[64 * j_]; cn[j_] = y1_[64 * j_]; } } while (0)
    if (gw < NTOK) FIN_LOAD(gw);
    for (int m = gw; m < NTOK; m += NGW) {
        const int b = m / SEQ;
        GAS f32x4* xr = (GAS f32x4*)(F.out + (size_t)m * 1024) + F.lane;
        v2u xc[4], ac[4], cc[4];
#pragma unroll
        for (int j = 0; j < 4; ++j) { xc[j] = xn[j]; ac[j] = an[j]; cc[j] = cn[j]; }
        if (m + NGW < NTOK) FIN_LOAD(m + NGW);
        f32x4 v[4]; float ss = 0.f;
#pragma unroll
        for (int j = 0; j < 4; ++j) { const f32x4 gt = *(const f32x4*)(mod + (size_t)b * NMOD + 5120 + 4 * F.lane + 256 * j); const v2u a = ac[j], c = cc[j];
            f32x4 ff; ff[0] = __uint_as_float(a[0] << 16) + __uint_as_float(c[0] << 16); ff[1] = __uint_as_float(a[0] & 0xffff0000u) + __uint_as_float(c[0] & 0xffff0000u);
            ff[2] = __uint_as_float(a[1] << 16) + __uint_as_float(c[1] << 16); ff[3] = __uint_as_float(a[1] & 0xffff0000u) + __uint_as_float(c[1] & 0xffff0000u);
            const f32x4 x1 = (f32x4){__uint_as_float(xc[j][0] << 16), __uint_as_float(xc[j][0] & 0xffff0000u), __uint_as_float(xc[j][1] << 16), __uint_as_float(xc[j][1] & 0xffff0000u)};
            v[j] = x1 + gt * ff; ss += (v[j].x * v[j].x + v[j].y * v[j].y) + (v[j].z * v[j].z + v[j].w * v[j].w); }
        const float rstd = 1.0f / sqrtf(wave_sum(ss) * (1.f / 1024.f) + 1e-6f);
#if defined(MK_PROBE_A)
        { const unsigned long long* st = (const unsigned long long*)(F.ws + WS_CTL + 32768);
          const float ta = (float)(st[MK_PROBE_A + 1] - st[MK_PROBE_A]) * 0.01f, tb_ = (float)(st[MK_PROBE_B + 1] - st[MK_PROBE_B]) * 0.01f;
          const float sc = 1.0f + ta * 1e-4f;
#pragma unroll
          for (int j = 0; j < 4; ++j) v[j] = v[j] * sc;
          if (m == 0 && F.lane == 0) v[0][0] += tb_ * 0.02f / (rstd * G4[0][0]); }
#endif
#pragma unroll
        for (int j = 0; j < 4; ++j) xr[64 * j] = v[j] * rstd * G4[j];
    }
#undef FIN_LOAD
}
#ifndef MK_ONE_LAUNCH
#define MK_ONE_LAUNCH 1
#endif
constexpr int CW_ATT = 131072;
constexpr size_t WS_KXG_A = 19 * MiB + 512 * 1024, WS_KXG_B = 4 * MiB; constexpr int KXG_NA = 70;
static_assert((size_t)KXG_NA * attn_body::KX_IMG_BYTES <= 4 * MiB + 512 * 1024 && (size_t)(128 - KXG_NA) * attn_body::KX_IMG_BYTES <= 4 * MiB, "kx images");
__device__ __forceinline__ char* kxg_home(const Frame& F, int bh) { return (char*)F.ws + (bh < KXG_NA ? WS_KXG_A + (size_t)bh * attn_body::KX_IMG_BYTES : WS_KXG_B + (size_t)(bh - KXG_NA) * attn_body::KX_IMG_BYTES); }
struct AttnDyn {
    gu32* cnt; volatile LAS int* box; int bh_;
    __device__ __forceinline__ bool next(int, attn_body::AttnUnit& u) const {
        if (threadIdx.x == 0) *box = (int)__hip_atomic_fetch_add(cnt, 1u, RLX_AGENT);
        __syncthreads(); const int v = __builtin_amdgcn_readfirstlane(*box); __syncthreads();
        if (v >= 16) return false;
        u.bh = bh_; u.qb = 15 - v; return true; }
    __device__ __forceinline__ void a_ready(const attn_body::AttnUnit&) const {}
    __device__ __forceinline__ void done(const attn_body::AttnUnit&) const {}
};
__device__ __forceinline__ int attn_pick(gu32* cntb, volatile LAS int* box) {
    if (threadIdx.x == 0) { int best = -1, bw = 0;
        for (int h = 0; h < 8; ++h) { const int c = (int)__hip_atomic_load(cntb + 16 * h, RLX_AGENT); const int w = (c < 16) ? (16 - c) * (h + 2) : 0; if (w > bw) { bw = w; best = h; } }
        *box = best; }
    __syncthreads(); const int v = __builtin_amdgcn_readfirstlane(*box); __syncthreads();
    return v; }
constexpr int N_PHASES = 12;
struct Args { const float* in[28]; float* out; unsigned char* ws; int ph_lo, ph_hi; };
__global__ void __launch_bounds__(NWAVES * 64, 2) mk_fwd(Args args) {
    extern __shared__ __attribute__((aligned(16))) unsigned char lds[];
    Frame F;
    F.lds = (LAS unsigned char*)lds;
    F.MISC = (volatile LAS unsigned*)(F.lds + MISC_OFF);
    F.tid = threadIdx.x; F.lane = F.tid & 63; F.wave = __builtin_amdgcn_readfirstlane(F.tid >> 6);
    F.G = gridDim.x; { const int bx = blockIdx.x; F.vcu = (F.G % 8 == 0) ? (bx % 8) * (F.G / 8) + bx / 8 : bx; }
    F.ws = args.ws; F.out = args.out; F.ctl = (gu32*)(args.ws + WS_CTL);
    F.in.k = __builtin_amdgcn_kernarg_segment_ptr();
#define RELOAD_IN() do { kseg_t kp_ = __builtin_amdgcn_kernarg_segment_ptr(); asm volatile("" : "+s"(kp_)); F.in.k = kp_; } while (0)
    for (int u = F.tid; u < (LDS_BYTES - LDSCTL_OFF) / 4; u += NWAVES * 64) ((LAS unsigned*)(F.lds + LDSCTL_OFF))[u] = 0u;
    __syncthreads();
    const int lo = args.ph_lo, hi = args.ph_hi;
    int multi_ = __builtin_amdgcn_readfirstlane(((hi - lo) > 1) ? 1 : 0); asm volatile("" : "+s"(multi_)); const bool multi = multi_ != 0;
    XcdBarrier bar; bar.bar = (unsigned*)(F.ctl + CW_BAR); bar.x = 0; bar.st = nullptr; bar.gsz = 0; XcdBarrier bb = bar;
    if (multi) { bar = xcd_barrier_post((unsigned*)(F.ctl + CW_BAR), F.MISC + 8, gridDim.x);
        bb = xcd_barrier_post((unsigned*)(F.ctl + CW_BB + (F.vcu >> 4) * 4096), F.MISC + 10, 16u); }
#ifndef MK_REP_MASK
#define MK_REP_MASK 0
#endif
#ifndef MK_BATCH_BAR
#define MK_BATCH_BAR 1
#endif
#ifndef MK_ODD_ORDER
#define MK_ODD_ORDER 1
#endif
#define IN(k) (lo <= (k) && (k) < hi)
#define BOTH(k) (IN(k) && IN((k) + 1))
#define GRID_BAR() xcd_barrier(bar)
#define BATCH_BAR() do { if (MK_BATCH_BAR && F.G == 256) xcd_barrier(bb); else xcd_barrier(bar); } while (0)
#define STAMP(k) do {} while (0)
#ifndef MK_STAGN
#define MK_STAGN 4
#endif
#ifndef MK_STAG2
#define MK_STAG2 0
#endif
#ifndef MK_STAG7
#define MK_STAG7 0
#endif
#ifndef MK_STAG9
#define MK_STAG9 0
#endif
#ifndef MK_STAG10
#define MK_STAG10 0
#endif
#define STAGGER(step_) do { if ((step_) > 0) { const unsigned long long t0_ = __builtin_amdgcn_s_memrealtime(), d_ = (unsigned long long)((blockIdx.x >> 3) % MK_STAGN) * (step_); while (__builtin_amdgcn_s_memrealtime() - t0_ < d_) __builtin_amdgcn_s_sleep(8); } } while (0)
#define REDERIVE() do { int t_ = threadIdx.x; asm volatile("" : "+v"(t_)); F.tid = t_; F.lane = t_ & 63; F.wave = __builtin_amdgcn_readfirstlane(t_ >> 6); } while (0)

#ifndef MK_SPLIT_P0
#define MK_SPLIT_P0 0
#endif
    if (IN(0)) { RELOAD_IN(); if (MK_SPLIT_P0 && multi) p0_prologue<1>(F); else p0_prologue<0>(F); if (BOTH(0)) GRID_BAR(); }
    if (MK_SPLIT_P0 && multi && !((F.vcu >> 4) & 1)) { RELOAD_IN(); p0_prologue<2>(F); __syncthreads(); REDERIVE(); }
    if (IN(1)) { RELOAD_IN(); p1_norm(F); if (BOTH(1)) BATCH_BAR(); }

    if (IN(2)) { RELOAD_IN();
        pg8::Gemm g{(const pg8::bf16_t*)(F.ws + WS_H), (const pg8::bf16_t*)(F.ws + WS_WIN), NTOK, NPROJ, DMODEL}; pg8::BatchOrder S; S.init(NPROJ, F.vcu);
        pg8::EpiProj E{(pg8::bf16_t*)(F.ws + WS_PR), (pg8::bf16_t*)(F.ws + WS_PF), attn_body::C2};
        STAGGER(MK_STAG2);
        pg8::gemm_phase<pg8::EpiProj, pg8::BatchOrder, PG8_ALIGN, PG8_SP2>(F.lds + RING_OFF, g, S, E);
        if (BOTH(2)) BATCH_BAR();
    }
    REDERIVE();
    if (IN(3)) { RELOAD_IN(); r0_lora_inputs(F);
        if (F.G == 256 && (F.vcu & 15) < 8) {
            REDERIVE(); RELOAD_IN(); int vc = F.vcu; asm volatile("" : "+s"(vc)); const int b = vc >> 4, h = vc & 7; const attn_body::bf16* PF = (const attn_body::bf16*)(F.ws + WS_PF);
            int tt = threadIdx.x; asm volatile("" : "+v"(tt));
            __syncthreads();
            attn_body::fill_kx((char*)lds, (const float*)(F.ws + WS_FG), F.in[IN_FB][h], b, h, PF, PF + 512, tt);
            attn_body::kx_store((const char*)lds, kxg_home(F, b * 8 + h), tt); }
        if (multi) BATCH_BAR(); }
    int odd = __builtin_amdgcn_readfirstlane(MK_ODD_ORDER ? (multi_ & (F.vcu >> 4) & 1) : 0); asm volatile("" : "+s"(odd));
#ifndef MK_ATT_DYN
#define MK_ATT_DYN 0
#endif
#if MK_ATT_DYN
#define ATTN_GROUP() do { if (IN(3) && F.G == 256) { RELOAD_IN(); int vc = F.vcu; asm volatile("" : "+s"(vc)); \
            const int b = vc >> 4; int h = (vc & 15) >> 1; \
            const attn_body::bf16* PF = (const attn_body::bf16*)(F.ws + WS_PF); \
            const attn_body::AttnTensors AT{PF, PF + 512, PF + 1024, (attn_body::bf16*)(F.ws + WS_MIX) + 512}; \
            gu32* cntb = F.ctl + CW_ATT + b * 128; \
            _Pragma("nounroll") for (;;) { int tt = threadIdx.x; asm volatile("" : "+v"(tt)); \
                attn_body::kx_load((char*)lds, kxg_home(F, b * 8 + h), tt); \
                const AttnDyn S{cntb + 16 * h, (volatile LAS int*)(F.MISC + 12), b * 8 + h}; \
                attn_body::attn_phase<AttnDyn>((char*)lds + RING_OFF, AT, S); \
                h = attn_pick(cntb, (volatile LAS int*)(F.MISC + 12)); if (h < 0) break; } \
            __syncthreads(); } REDERIVE(); } while (0)
#else
#define ATTN_PASS(pass_) do { int vc = F.vcu; asm volatile("" : "+s"(vc)); \
                const int g4 = vc >> 2, b = g4 >> 2, hp = g4 & 3, h = (pass_) ? 7 - hp : hp; \
                const attn_body::bf16* PF = (const attn_body::bf16*)(F.ws + WS_PF); \
                const attn_body::AttnTensors AT{PF, PF + 512, PF + 1024, (attn_body::bf16*)(F.ws + WS_MIX) + 512}; \
                int tt = threadIdx.x; asm volatile("" : "+v"(tt)); \
                attn_body::kx_load((char*)lds, kxg_home(F, b * 8 + h), tt); \
                const attn_body::StaticOrder S(vc, b * 8 + h); \
                attn_body::attn_phase<attn_body::StaticOrder>((char*)lds + RING_OFF, AT, S); \
                __syncthreads(); } while (0)
#define ATTN_GROUP() do { if (IN(3) && F.G == 256) { RELOAD_IN(); ATTN_PASS(0); ATTN_PASS(1); } REDERIVE(); } while (0)
#endif
#if defined(MK_TWAITV)
    if (!odd) { ATTN_GROUP(); const unsigned long long tw0_ = __builtin_amdgcn_s_memrealtime(); if (multi) BATCH_BAR();
        if (F.vcu == MK_TWAITV && threadIdx.x == 0) { const unsigned long long w_ = 4ull * (__builtin_amdgcn_s_memrealtime() - tw0_), t0_ = __builtin_amdgcn_s_memrealtime(); while (__builtin_amdgcn_s_memrealtime() - t0_ < w_) __builtin_amdgcn_s_sleep(8); }
        __syncthreads(); }
#else
    if (!odd) { ATTN_GROUP(); if (multi) BATCH_BAR(); }
#endif
    if (IN(4)) { RELOAD_IN(); if (F.G == 256) scan2::build(F); if (BOTH(4)) BATCH_BAR(); }
    REDERIVE();
    if (IN(5)) { RELOAD_IN(); if (F.G == 256) scan2::apply(F); if (BOTH(5)) BATCH_BAR(); }
    REDERIVE();
    if (IN(6)) { RELOAD_IN(); r2_post(F); }
    REDERIVE();
#if MK_ODD_ORDER
    asm volatile("" : "+s"(odd));
    if (odd) ATTN_GROUP();
#endif
#undef ATTN_GROUP
    if (multi) BATCH_BAR();
    if (IN(7)) { RELOAD_IN();
        pg8::Gemm g{(const pg8::bf16_t*)(F.ws + WS_MIX), (const pg8::bf16_t*)(F.ws + WS_WOUT), NTOK, DMODEL, DMODEL}; pg8::BatchOrder S; S.init(DMODEL, F.vcu);
        pg8::EpiResB E{F.in[IN_X], (pg8::bf16_t*)(F.ws + WS_X1B), (const float*)(F.ws + WS_MOD) + 2048, SEQ, X1B_XTRA};
        STAGGER(MK_STAG7);
        pg8::gemm_phase<pg8::EpiResB, pg8::BatchOrder, PG8_ALIGN, PG8_SP2>(F.lds + RING_OFF, g, S, E);
        if (BOTH(7)) BATCH_BAR();
    }
    REDERIVE();
    if (IN(8)) { RELOAD_IN(); m0_route(F); if (MK_SPLIT_P0 && multi && ((F.vcu >> 4) & 1)) { __syncthreads(); REDERIVE(); RELOAD_IN(); p0_prologue<2>(F); }
#if defined(MK_TWAIT8)
        { const unsigned long long tw0_ = __builtin_amdgcn_s_memrealtime(); if (BOTH(8)) GRID_BAR();
          if (F.vcu == MK_TWAIT8 && threadIdx.x == 0) { const unsigned long long w_ = 4ull * (__builtin_amdgcn_s_memrealtime() - tw0_), t0_ = __builtin_amdgcn_s_memrealtime(); while (__builtin_amdgcn_s_memrealtime() - t0_ < w_) __builtin_amdgcn_s_sleep(8); }
          __syncthreads(); } }
#else
        if (BOTH(8)) GRID_BAR(); }
#endif
    REDERIVE();
    if (IN(9)) { RELOAD_IN();
        moe_tile_table(F); moe_fill_tokl(F);
        const LAS int* tb = (const LAS int*)(F.lds + L_TB) + 32;
        pg8::Gemm g{(const pg8::bf16_t*)(F.ws + WS_H), (const pg8::bf16_t*)(F.ws + WS_W1), 0, 0, DMODEL}; MoeOrder<true> S{tb, (const LAS int*)(F.lds + L_TOKL), F.G, F.vcu, tb[32] * 4};
        pg8::EpiSwiGLU E{(pg8::bf16_t*)(F.ws + WS_HID)};
        STAGGER(MK_STAG9);
        pg8::gemm_phase<pg8::EpiSwiGLU, MoeOrder<true>, PG8_ALIGN, PG8_SP2>(F.lds + RING_OFF, g, S, E);
        if (BOTH(9)) GRID_BAR();
    }
    REDERIVE();
    if (IN(10)) { RELOAD_IN();
        moe_tile_table(F); moe_fill_wl(F);
        const LAS int* tb = (const LAS int*)(F.lds + L_TB) + 32;
        pg8::Gemm g{(const pg8::bf16_t*)(F.ws + WS_HID), (const pg8::bf16_t*)(F.ws + WS_W2), 0, 0, DEXP}; MoeOrder<false> S{tb, nullptr, F.G, F.vcu, tb[32] * 4};
        pg8::EpiDown E{(pg8::bf16_t*)(F.ws + WS_YB), (const LAS float*)(F.lds + L_TOKL)};
        STAGGER(MK_STAG10);
        pg8::gemm_phase<pg8::EpiDown, MoeOrder<false>, PG8_ALIGN, PG8_SP2>(F.lds + RING_OFF, g, S, E);
        if (BOTH(10)) GRID_BAR();
    }
    REDERIVE();
    if (IN(11)) { RELOAD_IN(); p_final(F); }
#undef IN
#undef BOTH
}

extern "C" void kernel_launch(void* const* d_in, const int* in_sizes, int n_in, void* d_out, int out_size, void* d_ws, size_t ws_size, hipStream_t stream) {
    static int grid = 0;
    if (grid == 0) {
        if (n_in != 28 || in_sizes[0] != NTOK * DMODEL || out_size != NTOK * DMODEL || ws_size < WS_END) {
            fprintf(stderr, "kernel_launch: unexpected shapes: n_in %d in0 %d out %d ws %zu (need %zu); nothing launched\n", n_in, n_in > 0 ? in_sizes[0] : -1, out_size, ws_size, (size_t)WS_END); grid = -1; return; }
        int dev = 0, cus = 0, per_cu = 0;
        if (hipGetDevice(&dev) != hipSuccess || hipDeviceGetAttribute(&cus, hipDeviceAttributeMultiprocessorCount, dev) != hipSuccess) { grid = -1; return; }
        if (hipFuncSetAttribute((const void*)mk_fwd, hipFuncAttributeMaxDynamicSharedMemorySize, LDS_BYTES) != hipSuccess) { fprintf(stderr, "kernel_launch: hipFuncSetAttribute failed\n"); grid = -1; return; }
        if (hipOccupancyMaxActiveBlocksPerMultiprocessor(&per_cu, (const void*)mk_fwd, NWAVES * 64, LDS_BYTES) != hipSuccess || per_cu < 1) { fprintf(stderr, "kernel_launch: occupancy query says %d blocks per CU\n", per_cu); per_cu = 1; }
        (void)hipGetLastError();
        grid = cus;
        if (grid != 256) fprintf(stderr, "kernel_launch: %d CUs; this kernel is tuned for 256\n", grid);
    }
    if (grid < 0) return;
    if (hipMemsetAsync((char*)d_ws + WS_CTL, 0, CTL_ZERO_BYTES, stream) != hipSuccess) return;
    Args a{};
    for (int i = 0; i < 28; ++i) a.in[i] = (const float*)d_in[i];
    a.out = (float*)d_out; a.ws = (unsigned char*)d_ws;
#if MK_ONE_LAUNCH
    a.ph_lo = 0; a.ph_hi = N_PHASES;
    hipLaunchKernelGGL(mk_fwd, dim3(grid), dim3(NWAVES * 64), LDS_BYTES, stream, a);
#else
    for (int p = 0; p < N_PHASES; ++p) for (int rep = 0; rep < 1 + ((MK_REP_MASK >> p) & 1); ++rep) { a.ph_lo = p; a.ph_hi = p + 1; hipLaunchKernelGGL(mk_fwd, dim3(grid), dim3(NWAVES * 64), LDS_BYTES, stream, a); }
#endif
}
```

```cpp
#include <hip/hip_runtime.h>
#include <hip/hip_bf16.h>
#include <hip/hip_fp16.h>
#include <cstdio>
#include <cstdint>
#include <cmath>
namespace pg8 {
#define PG8_LAS __attribute__((address_space(3)))
typedef unsigned short bf16_t;
typedef short bf16x8 __attribute__((ext_vector_type(8)));
typedef float f32x4 __attribute__((ext_vector_type(4)));
typedef unsigned u32x4 __attribute__((ext_vector_type(4)));
constexpr int BM = 256, BK = 64, HALF = 128, HTB = HALF * BK * 2  , STAGE_BYTES = 8 * HTB, NXCD = 8, WGM = 2;

__host__ __device__ __forceinline__ int lds_byte(int r, int c) { const int st = (r >> 4) * 2 + (c >> 5), rr = r & 15, cc = c & 31, ob = rr * 64 + cc * 2; return st * 1024 + (ob ^ (((ob >> 9) & 1) << 5)); }
__host__ __device__ __forceinline__ void stage_rc(int b, int& R, int& C) { const int st = b / 1024, sb = b % 1024, swz = sb ^ (((sb >> 9) & 1) << 5); R = (st >> 1) * 16 + swz / 64; C = (st & 1) * 32 + (swz % 64) / 2; }
__host__ __device__ __forceinline__ int perm32(int rho) { const int n = rho >> 4, i = rho & 15; return 8 * (i >> 2) + 4 * n + (i & 3); }

struct Unit { int pm, pn, e, j; };
struct Gemm { const bf16_t* A; const bf16_t* Bt; int M, N, K; };

#ifndef MK_BWGM
#define MK_BWGM 2
#endif
constexpr int BWGM = MK_BWGM;
struct BatchOrder {
    static constexpr bool GATHER = false;
    __device__ __forceinline__ unsigned a_row(int, int) const { return 0u; }
    int nN, nwb, vcu;
    __host__ __device__ void init(int N, int vcu_) { nN = N / BM; nwb = 16 * nN; vcu = vcu_; }
    __host__ __device__ bool next(int i, Unit& u) const {
        const int w = i * 16 + (vcu & 15); if (w >= nwb) return false;
        const int nig = BWGM * nN, gid = w / nig, r = w % nig;
        u.pm = (vcu >> 4) * 16 + gid * BWGM + r % BWGM; u.pn = r / BWGM; u.e = 0; u.j = 0; return true;
    }
    __device__ __forceinline__ void a_ready(const Unit&) const {}
    __device__ __forceinline__ void done(const Unit&) const {}
};
struct StaticOrder {
    static constexpr bool GATHER = false;
    __device__ __forceinline__ unsigned a_row(int, int) const { return 0u; }
    int nM, nN, nwg, G, c;
    __host__ __device__ void init(int M, int N, int G_, int c_) { nM = M / BM; nN = N / BM; nwg = nM * nN; G = G_; c = c_; }
    __host__ __device__ bool next(int i, Unit& u) const {
        const long L = (long)i * G + c; if (L >= nwg) return false;
        int wgid = (int)L; { const int q = nwg / NXCD, r = nwg % NXCD, xcd = wgid % NXCD, off = wgid / NXCD; wgid = (xcd < r ? xcd * (q + 1) : r * (q + 1) + (xcd - r) * q) + off; }
        const int nig = WGM * nN, gid = wgid / nig, fm = gid * WGM, gsz = (nM - fm) < WGM ? (nM - fm) : WGM;
        u.pm = fm + ((wgid % nig) % gsz); u.pn = (wgid % nig) / gsz; u.e = 0; u.j = 0; return true;
    }
    __device__ __forceinline__ void a_ready(const Unit&) const {}
    __device__ __forceinline__ void done(const Unit&) const {}
};


__device__ __forceinline__ unsigned cvt_pk_bf16(float lo, float hi) { unsigned r; asm volatile("v_cvt_pk_bf16_f32 %0, %1, %2" : "=v"(r) : "v"(lo), "v"(hi)); return r; }

struct EpiProj {
    static constexpr bool PERM = true, AFTER_DRAIN = false;
    bf16_t* PR; bf16_t* PF; float qscale;
    __device__ __forceinline__ void operator()(const f32x4 (&acc)[2][2][4][2], const Unit& u, int wr, int wc, int fr, int fq) const {
        const int row0 = u.pm * BM + wr * 64 + fr;
        bf16_t* base; int ldc, colt; float sc = 1.f;
        if (u.pn < 7) { base = PR; ldc = 1792; colt = u.pn * BM; } else { base = PF; ldc = 1536; colt = (u.pn - 7) * BM; if (u.pn < 9) sc = qscale; }
        const int col0 = colt + wc * 32 + 8 * fq;
#pragma unroll
        for (int ai = 0; ai < 2; ++ai)
#pragma unroll
            for (int m = 0; m < 4; ++m) { bf16_t* rowp = base + (size_t)(row0 + ai * HALF + m * 16) * ldc + col0;
#pragma unroll
                for (int bj = 0; bj < 2; ++bj) { const f32x4 v0 = acc[ai][bj][m][0] * sc, v1 = acc[ai][bj][m][1] * sc;
                    u32x4 w; w.x = cvt_pk_bf16(v0[0], v0[1]); w.y = cvt_pk_bf16(v0[2], v0[3]); w.z = cvt_pk_bf16(v1[0], v1[1]); w.w = cvt_pk_bf16(v1[2], v1[3]);
                    *(u32x4*)(rowp + bj * HALF) = w; } }
    }
};
struct EpiRes {
    static constexpr bool PERM = false, AFTER_DRAIN = false;
    const float* x; float* out; const float* gate; int rows_per_batch;
    __device__ __forceinline__ void operator()(const f32x4 (&acc)[2][2][4][2], const Unit& u, int wr, int wc, int fr, int fq) const {
        const int b = (u.pm * BM) / rows_per_batch; const float* g = gate + (size_t)b * 6144;
        const int col0 = u.pn * BM + wc * 32 + 4 * fq;
#pragma unroll
        for (int bj = 0; bj < 2; ++bj)
#pragma unroll
            for (int n = 0; n < 2; ++n) { const f32x4 gv = *(const f32x4*)(g + col0 + bj * HALF + n * 16);
#pragma unroll
                for (int ai = 0; ai < 2; ++ai)
#pragma unroll
                    for (int m = 0; m < 4; ++m) { const size_t off = (size_t)(u.pm * BM + ai * HALF + wr * 64 + m * 16 + fr) * 1024 + col0 + bj * HALF + n * 16;
                        const f32x4 xv = *(const f32x4*)(x + off); *(f32x4*)(out + off) = xv + gv * acc[ai][bj][m][n]; } }
    }
};

struct EpiResB {
    static constexpr bool PERM = true, AFTER_DRAIN = false;
    const float* x; bf16_t* out; const float* gate; int rows_per_batch; size_t out_xtra;
    __device__ __forceinline__ void operator()(const f32x4 (&acc)[2][2][4][2], const Unit& u, int wr, int wc, int fr, int fq) const {
        const int b = (u.pm * BM) / rows_per_batch; const float* g = gate + (size_t)b * 6144; bf16_t* outb = out + (size_t)b * out_xtra;
        const int col0 = u.pn * BM + wc * 32 + 8 * fq;
#pragma unroll
        for (int bj = 0; bj < 2; ++bj) { const f32x4 g0 = *(const f32x4*)(g + col0 + bj * HALF), g1 = *(const f32x4*)(g + col0 + bj * HALF + 4);
#pragma unroll
            for (int ai = 0; ai < 2; ++ai)
#pragma unroll
                for (int m = 0; m < 4; ++m) { const size_t off = (size_t)(u.pm * BM + ai * HALF + wr * 64 + m * 16 + fr) * 1024 + col0 + bj * HALF;
                    const f32x4 v0 = *(const f32x4*)(x + off) + g0 * acc[ai][bj][m][0], v1 = *(const f32x4*)(x + off + 4) + g1 * acc[ai][bj][m][1];
                    u32x4 w; w.x = cvt_pk_bf16(v0[0], v0[1]); w.y = cvt_pk_bf16(v0[2], v0[3]); w.z = cvt_pk_bf16(v1[0], v1[1]); w.w = cvt_pk_bf16(v1[2], v1[3]);
                    *(u32x4*)(outb + off) = w; } }
    }
};
template <class Epi, class Sched, bool ALIGN_EPI = false, bool SP2 = false>
__device__ __forceinline__ void gemm_phase(PG8_LAS unsigned char* lds, const Gemm g, const Sched& S, const Epi& E) {
    const int tid = threadIdx.x, wid = __builtin_amdgcn_readfirstlane(tid >> 6), lane = tid & 63, wr = wid >> 2, wc = wid & 3, fr = lane & 15, fq = lane >> 4;
    const int K = g.K, nt = K / BK;
    unsigned voffA[2], voffB[2];
#pragma unroll
    for (int i = 0; i < 2; ++i) { int R, C; stage_rc(tid * 16 + i * 8192, R, C); const int Rb = Epi::PERM ? ((R & ~31) + perm32(R & 31)) : R;
        voffA[i] = (unsigned)(R * K + C) * 2u; voffB[i] = (unsigned)(Rb * K + C) * 2u; }
    constexpr bool GATHER = Sched::GATHER;
    int gR[2], gC[2];
#pragma unroll
    for (int i = 0; i < 2; ++i) stage_rc(tid * 16 + i * 8192, gR[i], gC[i]);
    unsigned offC[2][2] = {{0u, 0u}, {0u, 0u}}, offN[2][2] = {{0u, 0u}, {0u, 0u}};
#define PG8_GOFF(dst, ui_) do { _Pragma("unroll") for (int h_ = 0; h_ < 2; ++h_) _Pragma("unroll") for (int i_ = 0; i_ < 2; ++i_) dst[h_][i_] = (unsigned)(S.a_row((ui_), 128 * h_ + gR[i_]) * (unsigned)K + (unsigned)gC[i_]) * 2u; } while (0)
#define PG8_STAGE_A(bufoff, ptr, h, nx) do { if constexpr (GATHER) { unsigned o_[2] = {(nx) ? offN[h][0] : offC[h][0], (nx) ? offN[h][1] : offC[h][1]}; PG8_STAGE(bufoff, ptr, o_); } else { PG8_STAGE(bufoff, (ptr) + (h) * hstep, voffA); } } while (0)
    const size_t kstep = (size_t)(BK * 2);
    const size_t hstep = (size_t)HALF * K * 2;
    const size_t tstep = 2 * hstep;
    const unsigned ldsw = (unsigned)wid * 1024u;
    const int aoff = lds_byte(wr * 64 + fr, fq * 8), boff = lds_byte(wc * 32 + fr, fq * 8);
#define PG8_SA(b, h) (((b) * 2 + (h)) * HTB)
#define PG8_SB(b, h) ((4 + (b) * 2 + (h)) * HTB)
#define PG8_STAGE(bufoff, gbase, voff) do { _Pragma("unroll") for (int _i = 0; _i < 2; ++_i) \
        __builtin_amdgcn_global_load_lds((const unsigned*)((const char*)(gbase) + (voff)[_i]), (PG8_LAS unsigned*)(lds + (bufoff) + ldsw + _i * 8192), 16, 0, 0); } while (0)
#define PG8_LDA(dst, b, h) do { _Pragma("unroll") for (int m = 0; m < 4; ++m) _Pragma("unroll") for (int k = 0; k < 2; ++k) dst[m][k] = *(const PG8_LAS bf16x8*)(lds + PG8_SA(b, h) + aoff + m * 2048 + k * 1024); } while (0)
#define PG8_LDB(dst, b, h) do { _Pragma("unroll") for (int n = 0; n < 2; ++n) _Pragma("unroll") for (int k = 0; k < 2; ++k) dst[n][k] = *(const PG8_LAS bf16x8*)(lds + PG8_SB(b, h) + boff + n * 2048 + k * 1024); } while (0)
#define PG8_MMA(ai, bj, At, Bt) do { __builtin_amdgcn_s_setprio(1); _Pragma("unroll") for (int m = 0; m < 4; ++m) _Pragma("unroll") for (int n = 0; n < 2; ++n) _Pragma("unroll") for (int k = 0; k < 2; ++k) \
        acc[ai][bj][m][n] = __builtin_amdgcn_mfma_f32_16x16x32_bf16(Bt[n][k], At[m][k], acc[ai][bj][m][n], 0, 0, 0); __builtin_amdgcn_s_setprio(0); } while (0)
#define PG8_WAIT_V(n) asm volatile("s_waitcnt vmcnt(" #n ")" ::: "memory")
#define PG8_WAIT_L(n) asm volatile("s_waitcnt lgkmcnt(" #n ")" ::: "memory")
#define PG8_BAR __builtin_amdgcn_s_barrier()
#define PG8_SCHED __builtin_amdgcn_sched_barrier(0)
    Unit cur, nxt; int ui = 0;
    if (!S.next(0, cur)) return;
    f32x4 acc[2][2][4][2];
#pragma unroll
    for (int a = 0; a < 2; ++a)
#pragma unroll
        for (int b = 0; b < 2; ++b)
#pragma unroll
            for (int m = 0; m < 4; ++m)
#pragma unroll
                for (int n = 0; n < 2; ++n) acc[a][b][m][n] = (f32x4){0.f, 0.f, 0.f, 0.f};
    bf16x8 At[4][2], B0[2][2], B1[2][2];
    const char* cA = GATHER ? (const char*)g.A : (const char*)g.A + (size_t)cur.pm * tstep; const char* cB = (const char*)g.Bt + (size_t)cur.pn * tstep;
    if constexpr (GATHER) PG8_GOFF(offC, 0);
    S.a_ready(cur);
    if constexpr (SP2) {
        PG8_STAGE(PG8_SB(0, 0), cB, voffB); PG8_STAGE(PG8_SB(0, 1), cB + hstep, voffB); PG8_STAGE_A(PG8_SA(0, 0), cA, 0, false); PG8_STAGE_A(PG8_SA(0, 1), cA, 1, false);
        if (wr == 1) PG8_BAR;
        PG8_WAIT_V(2); PG8_BAR;
        PG8_STAGE(PG8_SB(1, 0), cB + kstep, voffB); PG8_STAGE_A(PG8_SA(1, 0), cA + kstep, 0, false); PG8_STAGE(PG8_SB(1, 1), cB + hstep + kstep, voffB);
        PG8_WAIT_V(6); PG8_BAR;
    } else {
        PG8_STAGE(PG8_SB(0, 0), cB, voffB); PG8_STAGE(PG8_SA(0, 0), cA, voffA); PG8_STAGE(PG8_SB(0, 1), cB + hstep, voffB); PG8_STAGE(PG8_SA(0, 1), cA + hstep, voffA);
        if (wr == 1) PG8_BAR;
        PG8_WAIT_V(4); PG8_BAR;
        PG8_STAGE(PG8_SB(1, 0), cB + kstep, voffB); PG8_STAGE(PG8_SA(1, 0), cA + kstep, voffA); PG8_STAGE(PG8_SB(1, 1), cB + hstep + kstep, voffB);
        PG8_WAIT_V(6); PG8_BAR;
    }
    for (;;) {
        const bool has_next = S.next(ui + 1, nxt);
        const char* nA = GATHER ? cA : (has_next ? (const char*)g.A + (size_t)nxt.pm * tstep : cA); const char* nB = has_next ? (const char*)g.Bt + (size_t)nxt.pn * tstep : cB;
        if constexpr (GATHER) { if (has_next) PG8_GOFF(offN, ui + 1); else { _Pragma("unroll") for (int h_ = 0; h_ < 2; ++h_) _Pragma("unroll") for (int i_ = 0; i_ < 2; ++i_) offN[h_][i_] = offC[h_][i_]; } }
        for (int t = 0; t < nt; t += 2) {
            const bool last = (t == nt - 2);
            const char* a1 = cA + (size_t)(t + 1) * kstep;
            const char* a2 = last ? nA : cA + (size_t)(t + 2) * kstep; const char* b2 = last ? nB : cB + (size_t)(t + 2) * kstep;
            const char* a3 = a2 + kstep; const char* b3 = b2 + kstep;
            if (last && has_next) S.a_ready(nxt);
            if constexpr (SP2) {
            PG8_LDB(B0, 0, 0); PG8_LDB(B1, 0, 1); PG8_SCHED; PG8_LDA(At, 0, 0); PG8_STAGE_A(PG8_SA(1, 1), a1, 1, false);
            PG8_WAIT_V(8); PG8_WAIT_L(0); PG8_BAR; PG8_MMA(0, 0, At, B0); PG8_MMA(0, 1, At, B1); PG8_BAR; PG8_SCHED;
            PG8_LDA(At, 0, 1); PG8_STAGE(PG8_SB(0, 0), b2, voffB); PG8_STAGE(PG8_SB(0, 1), b2 + hstep, voffB); PG8_STAGE_A(PG8_SA(0, 0), a2, 0, last);
            PG8_WAIT_V(8); PG8_WAIT_L(0); PG8_BAR; PG8_MMA(1, 0, At, B0); PG8_MMA(1, 1, At, B1); PG8_BAR; PG8_SCHED;
            PG8_LDB(B0, 1, 0); PG8_LDB(B1, 1, 1); PG8_SCHED; PG8_LDA(At, 1, 0); PG8_STAGE_A(PG8_SA(0, 1), a2, 1, last);
            PG8_WAIT_V(8); PG8_WAIT_L(0); PG8_BAR; PG8_MMA(0, 0, At, B0); PG8_MMA(0, 1, At, B1); PG8_BAR; PG8_SCHED;
            PG8_LDA(At, 1, 1); PG8_STAGE(PG8_SB(1, 0), b3, voffB); PG8_STAGE(PG8_SB(1, 1), b3 + hstep, voffB); PG8_STAGE_A(PG8_SA(1, 0), a3, 0, last);
            PG8_WAIT_V(8); PG8_WAIT_L(0); PG8_BAR; PG8_MMA(1, 0, At, B0); PG8_MMA(1, 1, At, B1); PG8_BAR; PG8_SCHED;
            } else {
            PG8_LDB(B0, 0, 0); PG8_SCHED; PG8_LDA(At, 0, 0); PG8_STAGE(PG8_SA(1, 1), a1 + hstep, voffA);
            PG8_WAIT_L(8); PG8_BAR; PG8_WAIT_L(0); PG8_MMA(0, 0, At, B0); PG8_BAR; PG8_SCHED;
            PG8_LDB(B1, 0, 1); PG8_STAGE(PG8_SB(0, 0), b2, voffB);
            PG8_BAR; PG8_WAIT_L(0); PG8_MMA(0, 1, At, B1); PG8_BAR;
            PG8_LDA(At, 0, 1); PG8_STAGE(PG8_SA(0, 0), a2, voffA);
            PG8_BAR; PG8_WAIT_L(0); PG8_MMA(1, 0, At, B0); PG8_BAR; PG8_SCHED;
            PG8_STAGE(PG8_SB(0, 1), b2 + hstep, voffB);
            PG8_WAIT_V(6); PG8_BAR; PG8_MMA(1, 1, At, B1); PG8_BAR;
            PG8_LDB(B0, 1, 0); PG8_SCHED; PG8_LDA(At, 1, 0); PG8_STAGE(PG8_SA(0, 1), a2 + hstep, voffA);
            PG8_WAIT_L(8); PG8_BAR; PG8_WAIT_L(0); PG8_MMA(0, 0, At, B0); PG8_BAR; PG8_SCHED;
            PG8_LDB(B1, 1, 1); PG8_STAGE(PG8_SB(1, 0), b3, voffB);
            PG8_BAR; PG8_WAIT_L(0); PG8_MMA(0, 1, At, B1); PG8_BAR;
            PG8_LDA(At, 1, 1); PG8_STAGE(PG8_SA(1, 0), a3, voffA);
            PG8_BAR; PG8_WAIT_L(0); PG8_MMA(1, 0, At, B0); PG8_BAR; PG8_SCHED;
            PG8_STAGE(PG8_SB(1, 1), b3 + hstep, voffB);
            PG8_WAIT_V(6); PG8_BAR; PG8_MMA(1, 1, At, B1); PG8_BAR;
            }
        }
        if constexpr (ALIGN_EPI) { if (wr == 0) PG8_BAR; }
#if defined(MK_EPI2)
        if constexpr (!Epi::AFTER_DRAIN) { E(acc, cur, wr, wc, fr, fq); asm volatile("" ::: "memory"); }
#endif
        if constexpr (!Epi::AFTER_DRAIN) { E(acc, cur, wr, wc, fr, fq); S.done(cur); }
        if (!has_next) break;
#pragma unroll
        for (int a = 0; a < 2; ++a)
#pragma unroll
            for (int b = 0; b < 2; ++b)
#pragma unroll
                for (int m = 0; m < 4; ++m)
#pragma unroll
                    for (int n = 0; n < 2; ++n) acc[a][b][m][n] = (f32x4){0.f, 0.f, 0.f, 0.f};
        cur = nxt; cA = nA; cB = nB; ++ui;
        if constexpr (GATHER) { _Pragma("unroll") for (int h_ = 0; h_ < 2; ++h_) _Pragma("unroll") for (int i_ = 0; i_ < 2; ++i_) offC[h_][i_] = offN[h_][i_]; }
        if constexpr (ALIGN_EPI) { if (wr == 1) PG8_BAR; }
    }
    PG8_WAIT_V(0);
    if constexpr (!ALIGN_EPI) { if (wr == 0) PG8_BAR; }
    PG8_BAR;
    if constexpr (Epi::AFTER_DRAIN) { E.fused(acc, cur, wr, wc, fr, fq, lds, wid, lane); S.done(cur); }
#undef PG8_SA
#undef PG8_SB
#undef PG8_STAGE
#undef PG8_STAGE_A
#undef PG8_GOFF
#undef PG8_LDA
#undef PG8_LDB
#undef PG8_MMA
#undef PG8_WAIT_V
#undef PG8_WAIT_L
#undef PG8_BAR
#undef PG8_SCHED
}
}

#ifndef PG8_SP2
#define PG8_SP2 true
#endif
#ifndef PG8_ALIGN
#define PG8_ALIGN true
#endif
namespace attn_body {
using bf16=__hip_bfloat16;
using bf16x8=__attribute__((ext_vector_type(8)))short;
using s16x4=__attribute__((ext_vector_type(4)))short;
using f32x16=__attribute__((ext_vector_type(16)))float;
using u32x4=__attribute__((ext_vector_type(4)))unsigned;
constexpr int BATCH=16,NHEAD=8,SEQ=4096,D=64,DMQ=1536,DMO=1024;
constexpr int NW=8,QBLK=32,QB=QBLK*NW,KVBLK=64,NQB=SEQ/QB;
constexpr int ATTN_UNIT_ROWS=QB;
__device__ __forceinline__ int crow(int r,int hi){return (r&3)+8*(r>>2)+4*hi;}
#define SBAR() __builtin_amdgcn_sched_barrier(0)
__device__ __forceinline__ void cmask(f32x16&p0,f32x16&p1,int jb,int qrel,int hi){
  const float NEG=-INFINITY; asm volatile("":"+v"(hi)); int kb=64*jb+4*hi;
  #pragma unroll
  for(int r=0;r<16;++r){int kv=kb+(r&3)+8*(r>>2); if(kv>qrel)p0[r]=NEG; if(kv+32>qrel)p1[r]=NEG;}
}

constexpr int NSLOT=3, SLOTB=8192;
constexpr int LDS_K=0, LDS_V=NSLOT*SLOTB, LDS_WS=2*NSLOT*SLOTB, LDS_OST=LDS_WS+NW*64*4, LDS_KX=LDS_OST+NW*4096, LDS_CB=LDS_KX+SEQ*16+16, LDS_BYTES=LDS_CB+1024;
constexpr float C2=0.125f*1.4426950408889634f;
__device__ __forceinline__ void glds16(const void*gsrc,unsigned lds_dst){unsigned keep;
  asm volatile("s_mov_b32 %0, m0\n\ts_mov_b32 m0, %2\n\ts_nop 0\n\tglobal_load_lds_dwordx4 %1, off\n\ts_mov_b32 m0, %0":"=&s"(keep):"v"(gsrc),"s"(lds_dst):"memory");}
__device__ __forceinline__ float max3f(float a,float b,float c){float r;asm("v_max3_f32 %0, %1, %2, %3":"=v"(r):"v"(a),"v"(b),"v"(c));return r;}
__device__ __forceinline__ float max2f(float a,float b){float r;asm("v_max_f32_e32 %0, %1, %2":"=v"(r):"v"(a),"v"(b));return r;}
__device__ __forceinline__ float fadd_s(float a,float b){float r;asm("v_add_f32_e32 %0, %1, %2":"=v"(r):"v"(a),"v"(b));return r;}
__device__ __forceinline__ float fsub_s(float a,float b){float r;asm("v_sub_f32_e32 %0, %1, %2":"=v"(r):"v"(a),"v"(b));return r;}
typedef float f32x2_t __attribute__((ext_vector_type(2))); typedef __bf16 bf16x2_t __attribute__((ext_vector_type(2)));
__device__ __forceinline__ unsigned cvtpk_s(float lo,float hi){f32x2_t v={lo,hi};bf16x2_t b=__builtin_convertvector(v,bf16x2_t);return __builtin_bit_cast(unsigned,b);}
#define WAIT_BAR(N) asm volatile("s_waitcnt vmcnt(" #N ") lgkmcnt(0)\n\ts_barrier":::"memory")

__device__ __forceinline__ void qkt(f32x16&p0,f32x16&p1,const char*Kslot,const bf16x8*qr,bf16x8 kx0,bf16x8 kx1,bf16x8 qx,int r32,int hi){
  const char*kb=Kslot+hi*1024+r32*16; const f32x16 z16=f32x16{};
  p0=__builtin_amdgcn_mfma_f32_32x32x16_bf16(kx0,qx,z16,0,0,0);p1=__builtin_amdgcn_mfma_f32_32x32x16_bf16(kx1,qx,z16,0,0,0);
  #pragma unroll
  for(int d0=0;d0<4;++d0){
    const bf16x8 b0=*reinterpret_cast<const bf16x8*>(kb+d0*2048);
    const bf16x8 b1=*reinterpret_cast<const bf16x8*>(kb+d0*2048+512);
    p0=__builtin_amdgcn_mfma_f32_32x32x16_bf16(b0,qr[d0],p0,0,0,0);p1=__builtin_amdgcn_mfma_f32_32x32x16_bf16(b1,qr[d0],p1,0,0,0);}
}
typedef __attribute__((address_space(3))) const char* lds_cptr;
typedef short v4i16_t __attribute__((ext_vector_type(4)));
__device__ __forceinline__ void kload8(bf16x8*kf,lds_cptr kp){
  kf[0]=*(const __attribute__((address_space(3))) bf16x8*)(kp);      kf[1]=*(const __attribute__((address_space(3))) bf16x8*)(kp+512);
  kf[2]=*(const __attribute__((address_space(3))) bf16x8*)(kp+2048); kf[3]=*(const __attribute__((address_space(3))) bf16x8*)(kp+2560);
  kf[4]=*(const __attribute__((address_space(3))) bf16x8*)(kp+4096); kf[5]=*(const __attribute__((address_space(3))) bf16x8*)(kp+4608);
  kf[6]=*(const __attribute__((address_space(3))) bf16x8*)(kp+6144); kf[7]=*(const __attribute__((address_space(3))) bf16x8*)(kp+6656);
}
__device__ __forceinline__ void kload2(bf16x8*kf,lds_cptr kp,int j){ kf[2*j]=*(const __attribute__((address_space(3))) bf16x8*)(kp+j*2048); kf[2*j+1]=*(const __attribute__((address_space(3))) bf16x8*)(kp+j*2048+512); }
__device__ __forceinline__ s16x4 vtr(lds_cptr p){ return __builtin_bit_cast(s16x4,__builtin_amdgcn_ds_read_tr16_b64_v4i16((__attribute__((address_space(3))) v4i16_t*)p)); }
__device__ __forceinline__ float rowmax(const f32x16&p0,const f32x16&p1){
  float a=max3f(p0[0],p0[1],p1[0]),b=max3f(p0[2],p0[3],p1[1]);a=max3f(a,p1[2],p1[3]);
  #pragma unroll
  for(int r=4;r<16;r+=4){a=max3f(a,p0[r],p0[r+1]);b=max3f(b,p0[r+2],p0[r+3]);a=max3f(a,p1[r],p1[r+1]);b=max3f(b,p1[r+2],p1[r+3]);}
  const float m=max2f(a,b);
  auto rr=__builtin_amdgcn_permlane32_swap(__float_as_uint(m),__float_as_uint(m),false,false);
  return max2f(__uint_as_float(rr[0]),__uint_as_float(rr[1]));
}
__device__ __forceinline__ void pv(f32x16*o,int vb,bf16x8 pa0,bf16x8 pa1,bf16x8 pa2,bf16x8 pa3){
  #pragma unroll
  for(int d0=0;d0<2;++d0){s16x4 lo[4],hi[4];
    #pragma unroll
    for(int ks=0;ks<4;++ks){
      asm volatile("ds_read_b64_tr_b16 %0,%1 offset:%c2":"=&v"(lo[ks]):"v"(vb),"i"(d0*4096+ks*1024):"memory");
      asm volatile("ds_read_b64_tr_b16 %0,%1 offset:%c2":"=&v"(hi[ks]):"v"(vb),"i"(d0*4096+ks*1024+512):"memory");}
    asm volatile("s_waitcnt lgkmcnt(0)":::"memory");SBAR();
    #define PK(k) (bf16x8){lo[k][0],lo[k][1],lo[k][2],lo[k][3],hi[k][0],hi[k][1],hi[k][2],hi[k][3]}
    o[d0]=__builtin_amdgcn_mfma_f32_32x32x16_bf16(pa0,PK(0),o[d0],0,0,0);
    o[d0]=__builtin_amdgcn_mfma_f32_32x32x16_bf16(pa1,PK(1),o[d0],0,0,0);
    o[d0]=__builtin_amdgcn_mfma_f32_32x32x16_bf16(pa2,PK(2),o[d0],0,0,0);
    o[d0]=__builtin_amdgcn_mfma_f32_32x32x16_bf16(pa3,PK(3),o[d0],0,0,0);
    #undef PK
  }
}

#ifndef ATTN_STORE16
#define ATTN_STORE16(p,v) (*(u32x4*)(p)=(v))
#endif
template<int THRL> __device__ __forceinline__ void attn_unit(int b,int h,int qb,int ts,const bf16*Q,const bf16*__restrict__ K,const bf16*__restrict__ V,bf16*O,char*shm){
#if defined(MK_TATT)
  const unsigned long long tu0_=__builtin_amdgcn_s_memrealtime();
#endif
  int tid_=threadIdx.x; asm volatile("":"+v"(tid_));
  const int tid=tid_,lane=tid&63,r32=lane&31,hi=lane>>5; const int wid=__builtin_amdgcn_readfirstlane(tid>>6);
  const long rowbase=(long)b*SEQ; const int q0=qb*QB;
  const bf16*Qw=Q+(rowbase+q0+wid*QBLK)*DMQ+h*D;
  const bf16*Kh=K+(rowbase+(long)ts*KVBLK)*DMQ+h*D,*Vh=V+(rowbase+(long)ts*KVBLK)*DMQ+h*D;
  const unsigned lds0=(unsigned)(uintptr_t)shm;
  float*wsf=(float*)(shm+LDS_WS)+wid*64;
  auto wsh_=[&]()->const float*{ int h_=hi; asm volatile("":"+v"(h_)); return wsf+4*h_; };
  const bf16*ksrc=Kh+(long)lane*DMQ+wid*8;
  const bf16*vsrc=Vh+(long)(16*(wid&3)+(lane>>2))*DMQ+(wid>>2)*32+(lane&3)*8;
  const unsigned kdst=lds0+LDS_K+wid*1024, vdst=lds0+LDS_V+wid*1024;
  #define DMA_K(t,slot) glds16(ksrc+(long)(t)*KVBLK*DMQ,(unsigned)__builtin_amdgcn_readfirstlane(kdst+(slot)))
  #define DMA_V(t,slot) glds16(vsrc+(long)(t)*KVBLK*DMQ,(unsigned)__builtin_amdgcn_readfirstlane(vdst+(slot)))
  const int vb0=(int)(lds0+LDS_V)+((lane>>4)&1)*32+(lane&3)*8+(4*hi+((lane&15)>>2))*64;
  const char*Kbase=shm+LDS_K; bf16x8 kf[8];
  const lds_cptr shm3=(lds_cptr)shm; const lds_cptr kp0=shm3+LDS_K+hi*1024+r32*16; const lds_cptr vp0=shm3+LDS_V+((lane>>4)&1)*32+(lane&3)*8+(4*hi+((lane&15)>>2))*64;
  const int NT=(q0+QB)/KVBLK-ts;
  DMA_K(0,0);DMA_V(0,0);DMA_K(1,SLOTB);
  bf16x8 qr[4];
  #pragma unroll
  for(int d0=0;d0<4;++d0)qr[d0]=*reinterpret_cast<const bf16x8*>(&Qw[(long)r32*DMQ+d0*16+hi*8]);
  float mhat=0.f,l_reg=0.f;f32x16 o[2];o[0]=f32x16{};o[1]=f32x16{};
  const lds_cptr kxp0=(lds_cptr)shm+LDS_KX+ts*1024+r32*16;
  u32x4 qxw; qxw[0]=hi?0u:0x3F803F80u; qxw[1]=hi?0u:0x00003F80u; qxw[2]=0u; qxw[3]=0u;
  #define SETQX() do{ const float m_=-mhat; const unsigned h1_=cvtpk_s(m_,0.f)&0xffffu; const float r1_=m_-__uint_as_float(h1_<<16); const unsigned h2_=cvtpk_s(r1_,0.f)&0xffffu; const float r2_=r1_-__uint_as_float(h2_<<16); \
      const unsigned h3_=cvtpk_s(r2_,0.f)&0xffffu; qxw[1]=hi?0u:(0x3F80u|(h1_<<16)); qxw[2]=hi?0u:(h2_|(h3_<<16)); asm volatile("":"+v"(qxw)); }while(0)
  #define QX __builtin_bit_cast(bf16x8,qxw)
  #define KXF(t,n) (*(const __attribute__((address_space(3))) bf16x8*)(kxp0+(t)*1024+(n)*512))
  const int qrel=wid*QBLK+r32;
  #define CMASK(P0,P1,t) do{int jb_=(t)-(NT-4); if(jb_>=0)cmask(P0,P1,jb_,qrel,hi);}while(0)
  bool resc=false;
  #define START(P0,P1) do{ const float rm=rowmax(P0,P1); resc=false; \
    { const float dl=rm; mhat=fadd_s(mhat,dl); \
      _Pragma("unroll") for(int r=0;r<16;++r){P0[r]=fsub_s(P0[r],dl);P1[r]=fsub_s(P1[r],dl);} \
      SETQX(); } \
    _Pragma("unroll") for(int r=0;r<16;++r)P0[r]=__builtin_amdgcn_exp2f(P0[r]); }while(0)
  #define RESC() do{ if(resc){ asm volatile("s_waitcnt lgkmcnt(0)":::"memory"); \
      _Pragma("unroll") for(int d_=0;d_<2;++d_) _Pragma("unroll") for(int r=0;r<16;++r)o[d_][r]*=wsh_()[(r&3)+8*(r>>2)]; } }while(0)
  f32x16 pA0,pA1,pB0,pB1;
  int sl_prev=0,sl_cur=0,sl_next=SLOTB;
  #define ROT() do{sl_prev=sl_cur;sl_cur=sl_next;sl_next=(sl_next==(NSLOT-1)*SLOTB)?0:sl_next+SLOTB;}while(0)
  DMA_K(2,2*SLOTB);
  WAIT_BAR(3);
  qkt(pA0,pA1,Kbase,qr,KXF(0,0),KXF(0,1),QX,r32,hi);asm volatile("s_nop 15\n\ts_nop 7":"+v"(pA0),"+v"(pA1));CMASK(pA0,pA1,0);
  START(pA0,pA1);
  _Pragma("unroll") for(int r=0;r<16;++r)pA1[r]=__builtin_amdgcn_exp2f(pA1[r]);
  WAIT_BAR(0);
  DMA_K(3,0);DMA_V(1,SLOTB);
  ROT();
  kload8(kf,kp0+sl_cur);
  WAIT_BAR(2);
  s16x4 vlo[8],vhi[8]; u32x4 pw0,pw1,pw2,pw3;
  #define PKW(P,B) cvtpk_s(P[B],P[B+1])
  #define PAF(k) __builtin_bit_cast(bf16x8,pw##k)
  #define VFR(i) (bf16x8){vlo[i][0],vlo[i][1],vlo[i][2],vlo[i][3],vhi[i][0],vhi[i][1],vhi[i][2],vhi[i][3]}
  #define PIN(x) asm volatile("":"+v"(x))
  #define MX3(a,b,c) __builtin_fmaxf(__builtin_fmaxf((a),(b)),(c))
  #define GAPA(MF,A0,A1,A2,A3,W0,W1,PW) do{ MF; sacc+=A0; sacc+=A1; sacc+=A2; sacc+=A3; PIN(sacc); W0; W1; PIN(PW); SBAR(); }while(0)
  #define EX(v) __builtin_amdgcn_exp2f(v)
  #define GAPB(MF,X,B) do{ MF; X[B]=EX(X[B]); X[B+1]=EX(X[B+1]); X[B+2]=EX(X[B+2]); X[B+3]=EX(X[B+3]); PIN(X); SBAR(); }while(0)
  #define VRD(i) do{ vlo[i]=vtr(vp_+(((i)>>2)*4096+((i)&3)*1024)); vhi[i]=vtr(vp_+(((i)>>2)*4096+((i)&3)*1024+512)); }while(0)
  #define KRD(G,j) do{ if(G){ kload2(kf,kp0+sl_next,j); SBAR(); } }while(0)
  #define STEP(C0,C1,P0,P1,t,GK,GV,GL) do{ SBAR(); \
    const lds_cptr vp_=vp0+sl_prev; const f32x16 z16_=f32x16{}; \
    const bf16x8 kx0_=KXF(t,0), kx1_=KXF(t,1); \
    VRD(0); SBAR(); float sacc=(P0[0]+P0[1]); \
    GAPA(C0=__builtin_amdgcn_mfma_f32_32x32x16_bf16(kf[0],qr[0],z16_,0,0,0), P0[2],P0[3],P0[4],P0[5],     pw0[0]=PKW(P0,0), pw0[1]=PKW(P0,2), pw0); \
    VRD(4); SBAR(); GAPA(C1=__builtin_amdgcn_mfma_f32_32x32x16_bf16(kf[1],qr[0],z16_,0,0,0), P0[6],P0[7],P0[8],P0[9],     pw0[2]=PKW(P0,4), pw0[3]=PKW(P0,6), pw0); \
    VRD(1); SBAR(); GAPA(C0=__builtin_amdgcn_mfma_f32_32x32x16_bf16(kf[2],qr[1],C0,0,0,0),   P0[10],P0[11],P0[12],P0[13], pw1[0]=PKW(P0,8), pw1[1]=PKW(P0,10), pw1); \
    VRD(5); SBAR(); GAPA(C1=__builtin_amdgcn_mfma_f32_32x32x16_bf16(kf[3],qr[1],C1,0,0,0),   P0[14],P0[15],P1[0],P1[1],   pw1[2]=PKW(P0,12),pw1[3]=PKW(P0,14), pw1); \
    VRD(2); SBAR(); GAPA(C0=__builtin_amdgcn_mfma_f32_32x32x16_bf16(kf[4],qr[2],C0,0,0,0),   P1[2],P1[3],P1[4],P1[5],     pw2[0]=PKW(P1,0), pw2[1]=PKW(P1,2), pw2); \
    VRD(6); SBAR(); GAPA(C1=__builtin_amdgcn_mfma_f32_32x32x16_bf16(kf[5],qr[2],C1,0,0,0),   P1[6],P1[7],P1[8],P1[9],     pw2[2]=PKW(P1,4), pw2[3]=PKW(P1,6), pw2); \
    VRD(3); SBAR(); GAPA(C0=__builtin_amdgcn_mfma_f32_32x32x16_bf16(kf[6],qr[3],C0,0,0,0),   P1[10],P1[11],P1[12],P1[13], pw3[0]=PKW(P1,8), pw3[1]=PKW(P1,10), pw3); \
    VRD(7); SBAR(); GAPA(C1=__builtin_amdgcn_mfma_f32_32x32x16_bf16(kf[7],qr[3],C1,0,0,0),   P1[14],P1[15],0.f,0.f,       pw3[2]=PKW(P1,12),pw3[3]=PKW(P1,14), pw3); \
    C0=__builtin_amdgcn_mfma_f32_32x32x16_bf16(kx0_,QX,C0,0,0,0); SBAR(); C1=__builtin_amdgcn_mfma_f32_32x32x16_bf16(kx1_,QX,C1,0,0,0); SBAR(); \
    l_reg+=sacc; \
    if(GK){DMA_K((t)+3,sl_cur);} if(GV){DMA_V((t)+1,sl_next);} \
    CMASK(C0,C1,t); \
    { float a=MX3(C0[0],C0[1],C1[0]),b=MX3(C0[2],C0[3],C1[1]); a=MX3(a,C1[2],C1[3]); \
      _Pragma("unroll") for(int r=4;r<16;r+=4){a=MX3(a,C0[r],C0[r+1]);b=MX3(b,C0[r+2],C0[r+3]);a=MX3(a,C1[r],C1[r+1]);b=MX3(b,C1[r+2],C1[r+3]);} \
      float rm=__builtin_fmaxf(a,b); { auto rr=__builtin_amdgcn_permlane32_swap(__float_as_uint(rm),__float_as_uint(rm),false,false); rm=__builtin_fmaxf(__uint_as_float(rr[0]),__uint_as_float(rr[1])); } \
      resc=false; \
      if(__builtin_expect(__any(rm>(float)THRL),0)){ const float dl=__builtin_fmaxf(rm,0.f); mhat+=dl; \
        _Pragma("unroll") for(int r=0;r<16;++r){C0[r]-=dl;C1[r]-=dl;} \
        SETQX(); \
        const float f=__builtin_amdgcn_exp2f(-dl); l_reg*=f; if(hi==0)wsf[r32]=f; resc=true; } } \
    SBAR(); \
    GAPB(o[0]=__builtin_amdgcn_mfma_f32_32x32x16_bf16(PAF(0),VFR(0),o[0],0,0,0), C0,0); \
    GAPB(o[1]=__builtin_amdgcn_mfma_f32_32x32x16_bf16(PAF(0),VFR(4),o[1],0,0,0), C0,4); \
    KRD(GL,0); GAPB(o[0]=__builtin_amdgcn_mfma_f32_32x32x16_bf16(PAF(1),VFR(1),o[0],0,0,0), C0,8); \
    KRD(GL,1); GAPB(o[1]=__builtin_amdgcn_mfma_f32_32x32x16_bf16(PAF(1),VFR(5),o[1],0,0,0), C0,12); \
    KRD(GL,2); GAPB(o[0]=__builtin_amdgcn_mfma_f32_32x32x16_bf16(PAF(2),VFR(2),o[0],0,0,0), C1,0); \
    KRD(GL,3); GAPB(o[1]=__builtin_amdgcn_mfma_f32_32x32x16_bf16(PAF(2),VFR(6),o[1],0,0,0), C1,4); \
    GAPB(o[0]=__builtin_amdgcn_mfma_f32_32x32x16_bf16(PAF(3),VFR(3),o[0],0,0,0), C1,8); \
    GAPB(o[1]=__builtin_amdgcn_mfma_f32_32x32x16_bf16(PAF(3),VFR(7),o[1],0,0,0), C1,12); \
    }while(0)
#if defined(MK_TATT)
  if(MK_TATT==1&&threadIdx.x==0)((unsigned long long*)(shm+LDS_CB))[90]+=__builtin_amdgcn_s_memrealtime()-tu0_;
#endif
  int t=1;
  #undef CMASK
  #define CMASK(P0,P1,t) do{}while(0)
  for(;t+5<NT;t+=2){
    STEP(pB0,pB1,pA0,pA1,t,true,true,true);     WAIT_BAR(2); RESC(); ROT();
    STEP(pA0,pA1,pB0,pB1,t+1,true,true,true);   WAIT_BAR(2); RESC(); ROT();
  }
  #undef CMASK
  #define CMASK(P0,P1,t) do{int jb_=(t)-(NT-4); if(jb_>=0)cmask(P0,P1,jb_,qrel,hi);}while(0)
  #define ENDW(tt) do{ if((tt)+3<NT){WAIT_BAR(2);} else if((tt)+2<NT){WAIT_BAR(1);} else {WAIT_BAR(0);} }while(0)
  for(;t+1<NT;t+=2){
    STEP(pB0,pB1,pA0,pA1,t,(t+3<NT),(t+1<NT),(t+1<NT));       ENDW(t);   RESC(); ROT();
    STEP(pA0,pA1,pB0,pB1,t+1,(t+4<NT),(t+2<NT),(t+2<NT));     ENDW(t+1); RESC(); ROT();
  }
  STEP(pB0,pB1,pA0,pA1,NT-1,false,false,false); RESC();
#if defined(MK_TATT)
  const unsigned long long tu1_=__builtin_amdgcn_s_memrealtime();
  if(MK_TATT==3&&threadIdx.x==0)((unsigned long long*)(shm+LDS_CB))[90]+=(unsigned long long)NT;
#endif
  { float sacc=pB0[0]+pB0[1]; _Pragma("unroll") for(int r=2;r<16;++r)sacc+=pB0[r]; _Pragma("unroll") for(int r=0;r<16;++r)sacc+=pB1[r]; l_reg+=sacc;
    pw0=(u32x4){PKW(pB0,0),PKW(pB0,2),PKW(pB0,4),PKW(pB0,6)};pw1=(u32x4){PKW(pB0,8),PKW(pB0,10),PKW(pB0,12),PKW(pB0,14)};pw2=(u32x4){PKW(pB1,0),PKW(pB1,2),PKW(pB1,4),PKW(pB1,6)};pw3=(u32x4){PKW(pB1,8),PKW(pB1,10),PKW(pB1,12),PKW(pB1,14)};
    SBAR(); pv(o,vb0+sl_cur,PAF(0),PAF(1),PAF(2),PAF(3)); }
  #undef PKW
  #undef PAF
  #undef VFR
  #undef PIN
  #undef MX3
  #undef GAPA
  #undef GAPB
  #undef EX
  #undef VRD
  #undef KRD
  #undef STEP
  #undef ENDW
  {auto rr=__builtin_amdgcn_permlane32_swap(__float_as_uint(l_reg),__float_as_uint(l_reg),false,false);l_reg=__uint_as_float(rr[0])+__uint_as_float(rr[1]);}
  if(hi==0)wsf[32+r32]=l_reg;asm volatile("s_waitcnt lgkmcnt(0)":::"memory");
  float rli[16];
  #pragma unroll
  for(int r=0;r<16;++r)rli[r]=__builtin_amdgcn_rcpf(wsh_()[32+(r&3)+8*(r>>2)]);
  bf16*Ow=O+(rowbase+q0+wid*QBLK)*DMO+h*D;
  { bf16*stg=(bf16*)(shm+LDS_OST)+wid*2048;
    #pragma unroll
    for(int r=0;r<16;++r){const int orow=crow(r,hi);
      #pragma unroll
      for(int d0=0;d0<2;++d0)stg[orow*64+d0*32+r32]=__float2bfloat16(o[d0][r]*rli[r]);}
    asm volatile("s_waitcnt lgkmcnt(0)":::"memory");
    #pragma unroll
    for(int i=0;i<4;++i){const int row=i*8+(lane>>3),ch=lane&7; const u32x4 v=*(const u32x4*)(stg+row*64+ch*8); ATTN_STORE16(Ow+(long)row*DMO+ch*8,v);} }
  asm volatile("s_waitcnt lgkmcnt(0)\n\ts_barrier":::"memory");
#if defined(MK_TATT)
  if(MK_TATT==2&&threadIdx.x==0)((unsigned long long*)(shm+LDS_CB))[90]+=__builtin_amdgcn_s_memrealtime()-tu1_;
#endif
  #undef DMA_K
  #undef DMA_V
  #undef SETQX
  #undef QX
  #undef KXF
  #undef CMASK
  #undef START
  #undef RESC
  #undef ROT
}
constexpr int ATTN_LDS_BYTES=LDS_BYTES;
__device__ __forceinline__ void fill_kx(char*shm,const float*FG,float fbias,int b,int h,const bf16*Q,const bf16*K,int tid){
  const int lane=tid&63,wid=tid>>6;
  double*wtot=(double*)(shm+LDS_WS);
  float ls[8]; double run=0.0;
  { float*stg=(float*)(shm+LDS_K);
    #pragma unroll
    for(int j=0;j<8;++j)stg[j*512+tid]=FG[((long)b*SEQ+j*512+tid)*8+h];
    __syncthreads();
    #pragma unroll
    for(int j=0;j<8;++j){ const float x=stg[8*tid+j]+fbias; const float e=__expf(-fabsf(x)); ls[j]=fminf(x,0.f)-log1pf(e); } }
  #pragma unroll
  for(int j=0;j<8;++j)run+=(double)ls[j];
  double inc=run;
  #pragma unroll
  for(int o=1;o<64;o<<=1){ const int src_=((lane>=o)?lane-o:lane)<<2; const long long bits=__builtin_bit_cast(long long,inc);
    const int lo_=__builtin_amdgcn_ds_bpermute(src_,(int)bits), hi_=__builtin_amdgcn_ds_bpermute(src_,(int)(bits>>32));
    const double v=__builtin_bit_cast(double,((long long)(unsigned)hi_<<32)|(unsigned)lo_); if(lane>=o)inc+=v; }
  if(lane==63)wtot[wid]=inc;
  __syncthreads();
  double base=inc-run;
  for(int w=0;w<wid;++w)base+=wtot[w];
  u32x4*dst=(u32x4*)(shm+LDS_KX)+8*tid;
  #pragma unroll
  for(int j=0;j<8;++j){ base+=(double)ls[j]; const float c=(float)(-base*1.4426950408889634);
    const unsigned h1=cvtpk_s(c,0.f)&0xffffu; const float r1=c-__uint_as_float(h1<<16); const unsigned h2=cvtpk_s(r1,0.f)&0xffffu; const float r2=r1-__uint_as_float(h2<<16); const unsigned h3=cvtpk_s(r2,0.f)&0xffffu;
    dst[j]=(u32x4){h1|(h2<<16),h3|0x3F800000u,0x3F803F80u,0u};
    if(j==0&&(tid&7)==0)((float*)(shm+LDS_CB))[tid>>3]=c; if(j==7&&(tid&7)==7)((float*)(shm+LDS_CB))[64+(tid>>3)]=c; }
  if(tid==0){ unsigned z_=0u; asm volatile("":"+v"(z_)); ((u32x4*)(shm+LDS_KX))[SEQ]=(u32x4){z_,z_,z_,z_}; }
  { float qm=0.f,km=0.f;
    const long row0=(long)b*SEQ+wid*512+(lane>>3); const int cho=h*D+(lane&7)*8;
    #pragma unroll
    for(int pass=0;pass<2;++pass){ const bf16*P=pass?K:Q;
      #pragma unroll 1
      for(int i0=0;i0<64;i0+=16){ u32x4 v[16];
        #pragma unroll
        for(int i=0;i<16;++i)v[i]=*(const u32x4*)(P+(row0+8*(i0+i))*DMQ+cho);
        #pragma unroll
        for(int i=0;i<16;++i){ float s=0.f;
          #pragma unroll
          for(int e=0;e<4;++e){ const float x0=__uint_as_float(v[i][e]<<16),x1=__uint_as_float(v[i][e]&0xffff0000u); s+=x0*x0+x1*x1; }
          s+=__int_as_float(__builtin_amdgcn_update_dpp(0,__float_as_int(s),0xB1,0xf,0xf,false)); s+=__int_as_float(__builtin_amdgcn_update_dpp(0,__float_as_int(s),0x4E,0xf,0xf,false));
          s+=__int_as_float(__builtin_amdgcn_update_dpp(0,__float_as_int(s),0x141,0xf,0xf,false));
          if(pass)km=fmaxf(km,s); else qm=fmaxf(qm,s); } } }
    #pragma unroll
    for(int o=1;o<64;o<<=1){ const int src_=(lane^o)<<2; qm=fmaxf(qm,__int_as_float(__builtin_amdgcn_ds_bpermute(src_,__float_as_int(qm)))); km=fmaxf(km,__int_as_float(__builtin_amdgcn_ds_bpermute(src_,__float_as_int(km)))); }
    if(lane==0){ ((float*)(shm+LDS_CB))[128+2*wid]=qm; ((float*)(shm+LDS_CB))[129+2*wid]=km; } }
  __syncthreads();
  if(tid==0){ float qm=0.f,km=0.f; for(int w=0;w<8;++w){ qm=fmaxf(qm,((float*)(shm+LDS_CB))[128+2*w]); km=fmaxf(km,((float*)(shm+LDS_CB))[129+2*w]); } ((float*)(shm+LDS_CB))[160]=2.0f*sqrtf(qm*km)*1.001f; }
  __syncthreads();
}
constexpr int KX_IMG_BYTES=SEQ*16+16+1024;
__device__ __forceinline__ void kx_store(const char*shm,char*g,int tid){
  for(int i=tid;i<KX_IMG_BYTES/16;i+=NW*64)((u32x4*)g)[i]=((const u32x4*)(shm+LDS_KX))[i];
}
__device__ __forceinline__ void kx_load(char*shm,const char*g,int tid){
  u32x4 v[9];
  #pragma unroll
  for(int j=0;j<9;++j){ const int i=tid+j*NW*64; if(i<KX_IMG_BYTES/16)v[j]=((const u32x4*)g)[i]; }
  #pragma unroll
  for(int j=0;j<9;++j){ const int i=tid+j*NW*64; if(i<KX_IMG_BYTES/16)((u32x4*)(shm+LDS_KX))[i]=v[j]; }
  __syncthreads();
}
__device__ __forceinline__ int tile_start(const char*shm,int qb,int lane){
  const float*cb=(const float*)(shm+LDS_CB); const float bound=cb[4*qb]-48.0f-cb[160];
  const int t=2*(lane+1); const bool ok=(t<=4*qb)&&(t<=64)&&(cb[64+((t-1)&63)]<=bound);
  return 2*__popcll(__ballot(ok));
}
struct AttnTensors { const bf16* Q; const bf16* K; const bf16* V; bf16* O; };
struct AttnUnit { int bh; int qb; };
struct StaticOrder {
  int vcu,bh_;
  __device__ __forceinline__ explicit StaticOrder(int vcu_,int bh):vcu(vcu_),bh_(bh){}
  __device__ __forceinline__ bool next(int i,AttnUnit&u)const{ if(i>=4)return false; const int s=vcu&3, j=4*(i>>1)+s; u.bh=bh_; u.qb=(i&1)?15-j:j; return true; }
  __device__ __forceinline__ void a_ready(const AttnUnit&)const{}
  __device__ __forceinline__ void done(const AttnUnit&)const{}
};
template<class Sched,int THRL=96> __device__ __forceinline__ void attn_phase(char*lds,const AttnTensors&T,const Sched&S){
  AttnUnit u;
  for(int i=0;S.next(i,u);++i){ S.a_ready(u); attn_unit<THRL>(u.bh/NHEAD,u.bh%NHEAD,u.qb,tile_start(lds,u.qb,threadIdx.x&63),T.Q,T.K,T.V,T.O,lds); S.done(u); }
}
#undef SBAR
#undef WAIT_BAR
}
#define GAS __attribute__((address_space(1)))
#define LAS __attribute__((address_space(3)))
typedef unsigned short bf16;
typedef unsigned v4u __attribute__((ext_vector_type(4)));
typedef float f32x4 __attribute__((ext_vector_type(4)));
typedef short bf16x8 __attribute__((ext_vector_type(8)));
typedef GAS unsigned gu32;
typedef GAS unsigned long long gu64;
#define RLX_AGENT __ATOMIC_RELAXED, __HIP_MEMORY_SCOPE_AGENT
#define LDS_WAIT() asm volatile("s_waitcnt lgkmcnt(0)" ::: "memory")
#define VM_WAIT() asm volatile("s_waitcnt vmcnt(0)" ::: "memory")
__device__ __forceinline__ unsigned long long rt() { return __builtin_amdgcn_s_memrealtime(); }
__device__ __forceinline__ unsigned f2bf(float f) { unsigned u = __builtin_bit_cast(unsigned, f); return (u + 0x7fffu + ((u >> 16) & 1u)) >> 16; }
__device__ __forceinline__ unsigned pk2(float lo, float hi) { return f2bf(lo) | (f2bf(hi) << 16); }

#define XB_TMO      128
#define XB_XCNT(j)  (256  + 64 * (j))
#define XB_XSUB(j)  (1280 + 64 * (j))
#define XB_XGEN(j)  (2304 + 64 * (j))
#define XB_TOP      3328
#define XB_TOPGEN   3392
#define XCD_BAR_WORDS 3456
#define XB_SPIN_CAP (1u << 20)

__device__ __forceinline__ unsigned xb_ld(unsigned* p)              { return __hip_atomic_load(p, __ATOMIC_RELAXED, __HIP_MEMORY_SCOPE_AGENT); }
__device__ __forceinline__ unsigned xb_add(unsigned* p, unsigned v) { return __hip_atomic_fetch_add(p, v, __ATOMIC_RELAXED, __HIP_MEMORY_SCOPE_AGENT); }
__device__ __forceinline__ unsigned xb_xcc_id() { return (unsigned)__builtin_amdgcn_s_getreg((3 << 11) | 20) & 0xFu; }
#define XB_SPIN(cond, bar) do { unsigned _sp = 0; while (cond) { __builtin_amdgcn_s_sleep(1); \
    if ((++_sp & 255u) == 0u) { if (xb_ld(&(bar)[XB_TMO])) break; if (_sp > XB_SPIN_CAP) { atomicAdd(&(bar)[XB_TMO], 1u); break; } } } } while (0)

struct XcdBarrier {
    unsigned* bar; unsigned x; unsigned gsz;
    volatile LAS unsigned* st;
};

__device__ __forceinline__ XcdBarrier xcd_barrier_post(unsigned* bar, volatile LAS unsigned* st, unsigned gsz) {
    XcdBarrier b; b.bar = bar; b.x = xb_xcc_id(); b.st = st; b.gsz = gsz;
    if (threadIdx.x == 0) (void)xb_add(&bar[XB_XCNT(b.x)], 1u);
    return b;
}
__device__ __forceinline__ void xcd_barrier_complete(unsigned* bar, unsigned x, unsigned& nloc, unsigned& nx, unsigned G) {
    unsigned sum, cnt, mine, sp = 0u;
    for (;;) {
        sum = 0u; cnt = 0u; mine = 0u;
#pragma unroll
        for (unsigned j = 0; j < 16; ++j) { const unsigned c = xb_ld(&bar[XB_XCNT(j)]); sum += c; cnt += (c > 0u) ? 1u : 0u; mine = (j == x) ? c : mine; }
        if (sum == G) break;
        __builtin_amdgcn_s_sleep(1);
        if ((++sp & 255u) == 0u) { if (xb_ld(&bar[XB_TMO])) break; if (sp > XB_SPIN_CAP) { atomicAdd(&bar[XB_TMO], 1u); break; } }
    }
    nloc = mine > 0u ? mine : 1u; nx = cnt > 0u ? cnt : 1u;
}

__device__ __forceinline__ void xcd_barrier(const XcdBarrier& b) {
    asm volatile("s_waitcnt vmcnt(0)" ::: "memory");
    __syncthreads();
    if (threadIdx.x == 0) {
        unsigned* bar = b.bar;
        __builtin_amdgcn_s_waitcnt(0);
        unsigned nloc = b.st[0], nx = b.st[1];
        if (nloc == 0u) { xcd_barrier_complete(bar, b.x, nloc, nx, b.gsz); b.st[0] = nloc; b.st[1] = nx; }
        const unsigned old = xb_add(&bar[XB_XSUB(b.x)], 1u);
        const unsigned gen = old / nloc;
        if (old + 1u == (gen + 1u) * nloc) {
            __builtin_amdgcn_fence(__ATOMIC_RELEASE, "agent");
            asm volatile("s_waitcnt vmcnt(0)" ::: "memory");
            const unsigned og = xb_add(&bar[XB_TOP], 1u);
            const unsigned tg = og / nx;
            if (og + 1u == (tg + 1u) * nx) xb_add(&bar[XB_TOPGEN], 1u);
            else XB_SPIN(xb_ld(&bar[XB_TOPGEN]) == tg, bar);
            __builtin_amdgcn_fence(__ATOMIC_ACQUIRE, "agent");
            xb_add(&bar[XB_XGEN(b.x)], 1u);
            asm volatile("s_waitcnt vmcnt(0)" ::: "memory");
        } else {
            XB_SPIN(xb_ld(&bar[XB_XGEN(b.x)]) == gen, bar);
            __builtin_amdgcn_fence(__ATOMIC_ACQUIRE, "agent");
            asm volatile("s_waitcnt vmcnt(0)" ::: "memory");
        }
    }
    __syncthreads();
}

constexpr int NWAVES = 8;
constexpr int NB = 16, SEQ = 4096, DMODEL = 1024, NTOK = NB * SEQ;
constexpr int RC = 1792, FQKV = 1536, NPROJ = 3328, ICOLS = 3336, NMOD = 6144;
constexpr int NEXP = 32, DEXP = 512;
constexpr size_t MiB = 1u << 20;
constexpr size_t WS_CTL = 0, CTL_ZERO_BYTES = 1 * MiB;
constexpr size_t WS_MOD = 1 * MiB, WS_FG = 2 * MiB, WS_WIN = 8 * MiB, WS_WOUT = 16 * MiB, WS_LORA = 18 * MiB, WS_TOKINFO = 19 * MiB;
constexpr size_t WS_SLOT_TOK = 24 * MiB, WS_SLOT_W = 32 * MiB, WS_W1 = 40 * MiB, WS_W2 = 104 * MiB;
constexpr size_t WS_H = 136 * MiB, WS_PR = 264 * MiB, WS_PF = 488 * MiB, WS_MIX = 680 * MiB, WS_END = 1024 * MiB;
constexpr int CW_TMO = 0, CW_CODE = 1, CW_BAR = 4096, CW_CNT = 16384, CW_BB = 32768;
constexpr int RING_OFF = 0, RING_BYTES = 131072, LDS_BYTES = 163840, LDSCTL_OFF = LDS_BYTES - 512, MISC_OFF = LDSCTL_OFF;
static_assert(attn_body::ATTN_LDS_BYTES <= LDSCTL_OFF, "attention LDS");

typedef decltype(__builtin_amdgcn_kernarg_segment_ptr()) kseg_t;
struct InTab { kseg_t k;
    __device__ __forceinline__ const float* operator[](int i) const { return (const float*)((const unsigned long long __attribute__((address_space(4)))*)k)[i]; } };
struct Frame {
    LAS unsigned char* lds;
    volatile LAS unsigned* MISC;
    gu32* ctl;
    int tid, lane, wave;
    int vcu, G;
    InTab in; float* out; unsigned char* ws;
};
#define IN_X 0
#define IN_C 1
#define IN_WADA 2
#define IN_BADA 3
#define IN_N1G 4
#define IN_WIN 5
#define IN_MU 6
#define IN_W0 7
#define IN_WUP 8
#define IN_A0 9
#define IN_AUP 10
#define IN_GUP 11
#define IN_KK 12
#define IN_KA 13
#define IN_RK 14
#define IN_LNG 15
#define IN_LNB 16
#define IN_FB 17
#define IN_WOUT 18
#define IN_N2G 19
#define IN_WGRP 20
#define IN_BGRP 21
#define IN_WRT 22
#define IN_BRT 23
#define IN_WGATE 24
#define IN_WUPM 25
#define IN_WDOWN 26
#define IN_NFG 27

template <int N> __device__ __forceinline__ float dpp_ror(float x) { return __int_as_float(__builtin_amdgcn_update_dpp(0, __float_as_int(x), 0x120 + N, 0xf, 0xf, false)); }
__device__ __forceinline__ float row_allsum(float x) { x += dpp_ror<8>(x); x += dpp_ror<4>(x); x += dpp_ror<2>(x); x += dpp_ror<1>(x); return x; }
__device__ __forceinline__ float rdl(float x, int l) { return __int_as_float(__builtin_amdgcn_readlane(__float_as_int(x), l)); }
__device__ __forceinline__ float wave_sum(float v) { v = row_allsum(v); return (rdl(v, 0) + rdl(v, 16)) + (rdl(v, 32) + rdl(v, 48)); }
__device__ __forceinline__ float xchg32(float s, bool upper) { auto rr = __builtin_amdgcn_permlane32_swap(__float_as_uint(s), __float_as_uint(s), false, false); return __uint_as_float(upper ? rr[0] : rr[1]); }
__device__ __forceinline__ void wave_reduce8(const float (&v)[8], float (&t)[8], int lane) {
    const bool up = lane & 32; float h[4];
#pragma unroll
    for (int j = 0; j < 4; ++j) { const float send = up ? v[j] : v[j + 4], keep = up ? v[j + 4] : v[j]; h[j] = row_allsum(keep + xchg32(send, up)); }
#pragma unroll
    for (int j = 0; j < 4; ++j) { t[j] = rdl(h[j], 0) + rdl(h[j], 16); t[j + 4] = rdl(h[j], 32) + rdl(h[j], 48); }
}
__device__ __forceinline__ void wave_reduce4(const float (&v)[4], float (&t)[4], int lane) {
    const bool up = lane & 32; float h[2];
#pragma unroll
    for (int j = 0; j < 2; ++j) { const float send = up ? v[j] : v[j + 2], keep = up ? v[j + 2] : v[j]; h[j] = row_allsum(keep + xchg32(send, up)); }
#pragma unroll
    for (int j = 0; j < 2; ++j) { t[j] = rdl(h[j], 0) + rdl(h[j], 16); t[j + 2] = rdl(h[j], 32) + rdl(h[j], 48); }
}

__device__ __forceinline__ void p0_transpose_item(const float* W, int ldw, bf16* WT, int ldt, int dst_row0, int k0, int n0, LAS float* scr, int lane) {
    float wv_[32];
#pragma unroll
    for (int i = 0; i < 32; ++i) wv_[i] = W[(size_t)(k0 + 2 * i + (lane >> 5)) * ldw + n0 + (lane & 31)];
#pragma unroll
    for (int i = 0; i < 32; ++i) scr[(2 * i + (lane >> 5)) * 33 + (lane & 31)] = wv_[i];
    LDS_WAIT(); asm volatile("" ::: "memory");
    const int c = lane & 7;
#pragma unroll
    for (int j = 0; j < 4; ++j) { const int n = (lane >> 3) + 8 * j; const LAS float* s = scr + (8 * c) * 33 + n;
        v4u o; o.x = pk2(s[0 * 33], s[1 * 33]); o.y = pk2(s[2 * 33], s[3 * 33]); o.z = pk2(s[4 * 33], s[5 * 33]); o.w = pk2(s[6 * 33], s[7 * 33]);
        *(GAS v4u*)(WT + (size_t)(dst_row0 + n) * ldt + k0 + 8 * c) = o; }
    LDS_WAIT(); asm volatile("" ::: "memory");
}
template <int PART> __device__ __forceinline__ void p0_prologue(Frame& F) {
  if (PART != 2)
    {
        LAS float* cond = (LAS float*)(F.lds);
        LAS float* red = (LAS float*)(F.lds + 65536);
        const float* c = F.in[IN_C]; const float* wada = F.in[IN_WADA]; const float* bada = F.in[IN_BADA]; float* mod = (float*)(F.ws + WS_MOD);
        for (int u = F.vcu; u < NMOD / 32; u += F.G) {
            for (int idx = F.tid; idx < 16384; idx += 512) { const int k = idx >> 4, b = idx & 15; const float v = c[b * 1024 + k]; cond[idx] = v / (1.f + __expf(-v)); }
            __syncthreads();
            const int ks = F.tid >> 5, cl = F.tid & 31, col = u * 32 + cl;
            float acc[16];
#pragma unroll
            for (int b = 0; b < 16; ++b) acc[b] = 0.f;
            for (int i0 = 0; i0 < 64; i0 += 16) { float wv[16];
#pragma unroll
                for (int i = 0; i < 16; ++i) wv[i] = wada[(size_t)(ks + 16 * (i0 + i)) * NMOD + col];
#pragma unroll
                for (int i = 0; i < 16; ++i) { const int k = ks + 16 * (i0 + i); const float w = wv[i];
                    const LAS f32x4* cv = (const LAS f32x4*)(cond + k * 16);
#pragma unroll
                    for (int q = 0; q < 4; ++q) { const f32x4 t = cv[q]; acc[4 * q] += t[0] * w; acc[4 * q + 1] += t[1] * w; acc[4 * q + 2] += t[2] * w; acc[4 * q + 3] += t[3] * w; } } }
#pragma unroll
            for (int b = 0; b < 16; ++b) red[(ks * 16 + b) * 32 + cl] = acc[b];
            __syncthreads();
            { const int b = F.tid >> 5; float s = bada[col];
#pragma unroll
              for (int k2 = 0; k2 < 16; ++k2) s += red[(k2 * 16 + b) * 32 + cl];
              mod[(size_t)b * NMOD + col] = s; }
            __syncthreads();
        }
    }
    {
        LAS float* scr = (LAS float*)(F.lds + F.wave * 16384);
        const int gw = F.vcu * NWAVES + F.wave, NGW = F.G * NWAVES;
        constexpr int I_IN = 16 * (NPROJ / 32), I_OUT = 16 * 32, I_E = 768, NITEMS = I_IN + I_OUT + NEXP * I_E;
        bf16* Win_t = (bf16*)(F.ws + WS_WIN); bf16* Wout_t = (bf16*)(F.ws + WS_WOUT); bf16* W1_t = (bf16*)(F.ws + WS_W1); bf16* W2_t = (bf16*)(F.ws + WS_W2);
        for (int it = gw + ((PART == 2) ? I_IN + I_OUT : 0); it < ((PART == 1) ? I_IN + I_OUT : NITEMS); it += NGW) {
            int r = it;
            if (r < I_IN) { const int nblk = NPROJ / 32, kb = r / nblk, nb = r % nblk; p0_transpose_item(F.in[IN_WIN], ICOLS, Win_t, 1024, 32 * nb, 64 * kb, 32 * nb, scr, F.lane); continue; } r -= I_IN;
            if (r < I_OUT) { const int kb = r / 32, nb = r % 32; p0_transpose_item(F.in[IN_WOUT], 1024, Wout_t, 1024, 32 * nb, 64 * kb, 32 * nb, scr, F.lane); continue; } r -= I_OUT;
            const int e = r / I_E; r -= e * I_E;
            if (r < 512) { const int up = r >> 8, q = r & 255, kb = q >> 4, nb = q & 15, n0 = 32 * nb;
                if (up) p0_transpose_item(F.in[IN_WUPM] + (size_t)e * 1024 * 512, 512, W1_t + (size_t)e * 1024 * 1024, 1024, 256 * (n0 >> 7) + 128 + (n0 & 127), 64 * kb, n0, scr, F.lane);
                else    p0_transpose_item(F.in[IN_WGATE] + (size_t)e * 1024 * 512, 512, W1_t + (size_t)e * 1024 * 1024, 1024, 256 * (n0 >> 7) + (n0 & 127), 64 * kb, n0, scr, F.lane); }
            else { const int q = r - 512, kb = q >> 5, nb = q & 31;
                p0_transpose_item(F.in[IN_WDOWN] + (size_t)e * 512 * 1024, 1024, W2_t + (size_t)e * 1024 * 512, 512, 32 * nb, 64 * kb, 32 * nb, scr, F.lane); }
        }
    }
}

__device__ __forceinline__ void p1_norm(Frame& F) {
    LAS f32x4* Wf4 = (LAS f32x4*)(F.lds);
    const float* win = F.in[IN_WIN];
    for (int idx = F.tid; idx < 8192; idx += 512) { const int c = idx >> 3, j = idx & 7; const float v = win[(size_t)c * ICOLS + NPROJ + j];
        const int l = (c & 255) >> 2, jq = c >> 8, i = c & 3, jj = jq * 4 + i; ((LAS float*)Wf4)[(((j >> 2) * 16 + jj) * 64 + l) * 4 + (j & 3)] = v; }
    __syncthreads();
    const float* x = F.in[IN_X]; const float* g1 = F.in[IN_N1G]; const float* mod = (const float*)(F.ws + WS_MOD);
    bf16* H = (bf16*)(F.ws + WS_H); float* FG = (float*)(F.ws + WS_FG);
    for (int rb = F.vcu; rb < NTOK / 256; rb += F.G) {
        const int b = (rb * 256) / SEQ;
        f32x4 A[4], Bc[4];
#pragma unroll
        for (int j = 0; j < 4; ++j) { const int c = 4 * F.lane + 256 * j; const f32x4 g = *(const f32x4*)(g1 + c), sc = *(const f32x4*)(mod + (size_t)b * NMOD + 1024 + c); A[j] = g * (sc + 1.0f); Bc[j] = *(const f32x4*)(mod + (size_t)b * NMOD + c); }
        f32x4 vn[4];
        { const GAS f32x4* xr0 = (const GAS f32x4*)(x + ((size_t)rb * 256 + F.wave) * 1024) + F.lane;
#pragma unroll
          for (int j = 0; j < 4; ++j) vn[j] = xr0[64 * j]; }
        for (int r = F.wave; r < 256; r += NWAVES) {
            const size_t m = (size_t)rb * 256 + r;
            f32x4 v[4]; float ss = 0.f;
#pragma unroll
            for (int j = 0; j < 4; ++j) v[j] = vn[j];
            if (r + NWAVES < 256) { const GAS f32x4* xr = (const GAS f32x4*)(x + (m + NWAVES) * 1024) + F.lane;
#pragma unroll
                for (int j = 0; j < 4; ++j) vn[j] = xr[64 * j]; }
#pragma unroll
            for (int j = 0; j < 4; ++j) ss += (v[j].x * v[j].x + v[j].y * v[j].y) + (v[j].z * v[j].z + v[j].w * v[j].w);
            const float rstd = 1.0f / sqrtf(wave_sum(ss) * (1.f / 1024.f) + 1e-6f);
            GAS unsigned long long* o8 = (GAS unsigned long long*)(H + m * 1024) + F.lane;
            float acc[8];
#pragma unroll
            for (int q = 0; q < 8; ++q) acc[q] = 0.f;
#pragma unroll
            for (int j = 0; j < 4; ++j) { v[j] = v[j] * rstd * A[j] + Bc[j];
                o8[64 * j] = (unsigned long long)attn_body::cvtpk_s(v[j].x, v[j].y) | ((unsigned long long)attn_body::cvtpk_s(v[j].z, v[j].w) << 32);
#pragma unroll
                for (int i = 0; i < 4; ++i) { const f32x4 w0 = Wf4[(j * 4 + i) * 64 + F.lane], w1 = Wf4[(16 + j * 4 + i) * 64 + F.lane]; const float hv = v[j][i];
                    acc[0] += hv * w0[0]; acc[1] += hv * w0[1]; acc[2] += hv * w0[2]; acc[3] += hv * w0[3]; acc[4] += hv * w1[0]; acc[5] += hv * w1[1]; acc[6] += hv * w1[2]; acc[7] += hv * w1[3]; } }
            float ft[8]; wave_reduce8(acc, ft, F.lane);
            if (F.lane == 0) { *(GAS f32x4*)(FG + m * 8) = (f32x4){ft[0], ft[1], ft[2], ft[3]}; *(GAS f32x4*)(FG + m * 8 + 4) = (f32x4){ft[4], ft[5], ft[6], ft[7]}; }
        }
    }
}

__device__ __forceinline__ void p_final_nomoe(Frame& F) {
    const float* gf = F.in[IN_NFG];
    f32x4 G4[4];
#pragma unroll
    for (int j = 0; j < 4; ++j) G4[j] = *(const f32x4*)(gf + 4 * F.lane + 256 * j);
    const int gw = F.vcu * NWAVES + F.wave, NGW = F.G * NWAVES;
    for (int m = gw; m < NTOK; m += NGW) {
        GAS f32x4* xr = (GAS f32x4*)(F.out + (size_t)m * 1024) + F.lane;
        f32x4 v[4]; float ss = 0.f;
#pragma unroll
        for (int j = 0; j < 4; ++j) { v[j] = xr[64 * j]; ss += (v[j].x * v[j].x + v[j].y * v[j].y) + (v[j].z * v[j].z + v[j].w * v[j].w); }
        const float rstd = 1.0f / sqrtf(wave_sum(ss) * (1.f / 1024.f) + 1e-6f);
#pragma unroll
        for (int j = 0; j < 4; ++j) xr[64 * j] = v[j] * rstd * G4[j];
    }
}


constexpr size_t WS_ALORA = 808 * MiB;
constexpr size_t OUT_Y = 0, OUT_GG = 128 * MiB, OUT_Z = 192 * MiB;
typedef unsigned v2u __attribute__((ext_vector_type(2)));
typedef float f32x2 __attribute__((ext_vector_type(2)));
__device__ __forceinline__ float bf2f(unsigned short u) { return __uint_as_float((unsigned)u << 16); }
__device__ __forceinline__ float sigmoidf_(float v) { return 1.0f / (1.0f + __expf(-v)); }

__device__ __forceinline__ void r0_lora_inputs(Frame& F) {
    const bf16* PR = (const bf16*)(F.ws + WS_PR); bf16* AL = (bf16*)(F.ws + WS_ALORA); const float* mu = F.in[IN_MU] + 1536;
    const int l = F.lane & 31, hwl = ((F.vcu & 15) * NWAVES + F.wave) * 2 + (F.lane >> 5);
    float m8[8];
#pragma unroll
    for (int i = 0; i < 8; ++i) m8[i] = mu[8 * l + i];
    for (int m0 = (F.vcu >> 4) * SEQ + hwl * 4, mend = ((F.vcu >> 4) + 1) * SEQ; m0 < mend; m0 += 1024) {
        v4u cur[4], prv[4];
#pragma unroll
        for (int u = 0; u < 4; ++u) { const int m = m0 + u; cur[u] = *(const GAS v4u*)(PR + (size_t)m * RC + 1536 + 8 * l);
            prv[u] = (v4u){0u, 0u, 0u, 0u}; if (u > 0) prv[u] = cur[u - 1]; else if ((m & (SEQ - 1)) != 0) prv[u] = *(const GAS v4u*)(PR + (size_t)(m - 1) * RC + 1536 + 8 * l); }
#pragma unroll
        for (int u = 0; u < 4; ++u) { float o[8];
#pragma unroll
            for (int i = 0; i < 4; ++i) { const unsigned cw = cur[u][i], pw = prv[u][i];
                const float c0 = __uint_as_float(cw << 16), c1 = __uint_as_float(cw & 0xffff0000u), p0 = __uint_as_float(pw << 16), p1 = __uint_as_float(pw & 0xffff0000u);
                o[2 * i] = c0 + (p0 - c0) * m8[2 * i]; o[2 * i + 1] = c1 + (p1 - c1) * m8[2 * i + 1]; }
            if (l < 8) {
#pragma unroll
                for (int i = 0; i < 8; ++i) { const float ex = __expf(2.0f * o[i]); o[i] = 1.0f - 2.0f * __builtin_amdgcn_rcpf(1.0f + ex); }
            } else if (l >= 16) {
#pragma unroll
                for (int i = 0; i < 8; ++i) o[i] = __builtin_amdgcn_rcpf(1.0f + __expf(-o[i]));
            }
            *(GAS v4u*)(AL + (size_t)(m0 + u) * 256 + 8 * l) = (v4u){pk2(o[0], o[1]), pk2(o[2], o[3]), pk2(o[4], o[5]), pk2(o[6], o[7])}; }
    }
}

namespace scan {
typedef _Float16 h16x4 __attribute__((ext_vector_type(4)));
constexpr int TC = 32;
constexpr int KSB = 80;
constexpr int RECB = 16 * KSB + 128;
constexpr int L_RAW = 0;
constexpr int L_AL = 13312;
constexpr int L_REC = L_AL + 16 * 1056;
constexpr int L_WL = L_REC + TC * RECB;
constexpr int L_AV = L_WL + 8192;
constexpr int L_GV = L_AV + 8192;
constexpr int L_YB = L_GV + 4096;
constexpr int L_BF = L_YB + 8192 + 256;
constexpr int L_END = L_BF + 24576;
template <int N> __device__ __forceinline__ float ror16(float x) { return __int_as_float(__builtin_amdgcn_update_dpp(0, __float_as_int(x), 0x120 + N, 0xf, 0xf, false)); }
__device__ __forceinline__ float allsum16(float x) { x += ror16<8>(x); x += ror16<4>(x); x += ror16<2>(x); x += ror16<1>(x); return x; }
typedef float f32x16 __attribute__((ext_vector_type(16)));
__device__ __forceinline__ float fmix_lo(float a, unsigned h2, float c) { float d; asm("v_fma_mix_f32 %0, %1, %2, %3 op_sel_hi:[0,1,0]" : "=v"(d) : "v"(a), "v"(h2), "v"(c)); return d; }
__device__ __forceinline__ float fmix_hi(float a, unsigned h2, float c) { float d; asm("v_fma_mix_f32 %0, %1, %2, %3 op_sel:[0,1,0] op_sel_hi:[0,1,0]" : "=v"(d) : "v"(a), "v"(h2), "v"(c)); return d; }
__device__ __forceinline__ float fmix_hi_nop(float a, unsigned h2, float c) { float d; asm("v_fma_mix_f32 %0, %1, %2, %3 op_sel:[0,1,0] op_sel_hi:[0,1,0]\n\ts_nop 1" : "=v"(d) : "v"(a), "v"(h2), "v"(c)); return d; }
__device__ __forceinline__ float fmix_lo0(float a, unsigned h2) { float d; asm("v_fma_mix_f32 %0, %1, %2, 0 op_sel_hi:[0,1,0]" : "=v"(d) : "v"(a), "v"(h2)); return d; }

__device__ __forceinline__ void phase(Frame& F) {
    const int tid = F.tid, lane = F.lane, wave = F.wave;
    const int half = F.vcu & 1, hd = (F.vcu >> 1) & 7, b = F.vcu >> 4;
    LAS unsigned char* L = F.lds;
    const unsigned lds0 = (unsigned)(uintptr_t)(unsigned char*)F.lds;
    const bf16* PR = (const bf16*)(F.ws + WS_PR); const bf16* AL = (const bf16*)(F.ws + WS_ALORA);
    float* Y = (float*)((unsigned char*)F.out + OUT_Y); bf16* GG = (bf16*)((unsigned char*)F.out + OUT_GG); bf16* Z = (bf16*)((unsigned char*)F.out + OUT_Z);
    const int et = tid >> 4, cg = tid & 15, chb = hd * 64 + 4 * cg;
    float mu_r[4], mu_k[4], mu_v[4], kkc[4], kac[4], rkc[4], lng[4], lnb[4], w0c[4], a0c[4];
#pragma unroll
    for (int i = 0; i < 4; ++i) { mu_r[i] = F.in[IN_MU][chb + i]; mu_k[i] = F.in[IN_MU][512 + chb + i]; kkc[i] = F.in[IN_KK][chb + i]; kac[i] = F.in[IN_KA][chb + i]; rkc[i] = F.in[IN_RK][chb + i]; w0c[i] = F.in[IN_W0][chb + i]; a0c[i] = F.in[IN_A0][chb + i]; }
    const int vch = hd * 64 + half * 32 + 4 * (cg & 7);
#pragma unroll
    for (int i = 0; i < 4; ++i) { mu_v[i] = F.in[IN_MU][1024 + vch + i]; lng[i] = F.in[IN_LNG][vch + i]; lnb[i] = F.in[IN_LNB][vch + i]; }
    if (wave < 5) {
        const int r32 = lane & 31, hi = lane >> 5;
        const int col = (wave < 4) ? hd * 64 + (wave & 1) * 32 + r32 : hd * 64 + half * 32 + r32;
        const int ns = (wave < 4) ? 4 : 8;
        const float* wup = F.in[IN_WUP]; const float* aup = F.in[IN_AUP]; const float* gup = F.in[IN_GUP];
        for (int s = 0; s < ns; ++s) { float f[8];
            if (wave < 2) {
#pragma unroll
                for (int jj = 0; jj < 8; ++jj) f[jj] = wup[(size_t)(16 * s + 8 * hi + jj) * 512 + col];
            } else if (wave < 4) {
#pragma unroll
                for (int jj = 0; jj < 8; ++jj) f[jj] = aup[(size_t)(16 * s + 8 * hi + jj) * 512 + col];
            } else {
#pragma unroll
                for (int jj = 0; jj < 8; ++jj) f[jj] = gup[(size_t)(16 * s + 8 * hi + jj) * 512 + col];
            }
            *(LAS v4u*)(L + L_BF + ((wave < 4 ? wave * 4 : 16) + s) * 1024 + lane * 16) = (v4u){pk2(f[0], f[1]), pk2(f[2], f[3]), pk2(f[4], f[5]), pk2(f[6], f[7])}; }
    }
    long raw_off[2];
#pragma unroll
    for (int i = 0; i < 2; ++i) { int q = 64 * (wave + 8 * i) + lane; if (q > 791) q = 791; const int row = q / 24, cc = q % 24; raw_off[i] = (long)(row - 1) * RC + (cc >> 3) * 512 + hd * 64 + (cc & 7) * 8; }
    const size_t mrow0 = (size_t)b * SEQ;
#define SCAN_DMA(c) do { const size_t m0_ = mrow0 + (size_t)(c) * TC; \
        _Pragma("unroll") for (int i_ = 0; i_ < 2; ++i_) { const int p_ = wave + 8 * i_; if (p_ < 13) { long o_ = raw_off[i_]; if ((c) == 0 && o_ < 0) o_ += RC; \
            attn_body::glds16(PR + m0_ * RC + o_, (unsigned)__builtin_amdgcn_readfirstlane(lds0 + L_RAW + p_ * 1024)); } } \
        _Pragma("unroll") for (int i_ = 0; i_ < 2; ++i_) { const int p_ = wave + 8 * i_; \
            attn_body::glds16(AL + (m0_ + 2 * p_) * 256 + lane * 8, (unsigned)__builtin_amdgcn_readfirstlane(lds0 + L_AL + p_ * 1056)); } } while (0)
#define STORE_Y(c) do { const int st_ = tid >> 4, v2_ = (tid & 15) * 2; const f32x2 y2_ = *(const LAS f32x2*)(L + L_YB + ((c) & 1) * 4096 + (st_ * 32 + v2_) * 4); \
        *(GAS f32x2*)(Y + (mrow0 + (size_t)(c) * TC + st_) * 512 + hd * 64 + half * 32 + v2_) = y2_; } while (0)
    f32x2 S01 = (f32x2){0.f, 0.f}, S23 = (f32x2){0.f, 0.f};
    const int vloc = 4 * wave + (lane >> 4), ks = lane & 15;
    SCAN_DMA(0);
    for (int c = 0; c < SEQ / TC; ++c) {
        asm volatile("s_waitcnt vmcnt(0)" ::: "memory"); __syncthreads();
        float rs[4], ksv[4], vs[4], rn;
#if defined(MK_PROBE_S2)
        for (int prep = 0; prep < 2; ++prep) {
#endif
        {
            const bool first = (c == 0 && et == 0);
            const LAS unsigned char* rowc = L + L_RAW + (et + 1) * 384; const LAS unsigned char* rowp = L + L_RAW + et * 384;
            const v2u rc = *(const LAS v2u*)(rowc + cg * 8), rp = *(const LAS v2u*)(rowp + cg * 8);
            const v2u kc = *(const LAS v2u*)(rowc + 128 + cg * 8), kp = *(const LAS v2u*)(rowp + 128 + cg * 8);
            const int vo = 256 + (half * 32 + 4 * (cg & 7)) * 2;
            const v2u vc = *(const LAS v2u*)(rowc + vo), vp = *(const LAS v2u*)(rowp + vo);
#define SH4(dst, cu, pr, mu) do { const float c0 = __uint_as_float(cu.x << 16), c1 = __uint_as_float(cu.x & 0xffff0000u), c2 = __uint_as_float(cu.y << 16), c3 = __uint_as_float(cu.y & 0xffff0000u); \
            const float p0 = first ? 0.f : __uint_as_float(pr.x << 16), p1 = first ? 0.f : __uint_as_float(pr.x & 0xffff0000u), p2 = first ? 0.f : __uint_as_float(pr.y << 16), p3 = first ? 0.f : __uint_as_float(pr.y & 0xffff0000u); \
            dst[0] = c0 + (p0 - c0) * mu[0]; dst[1] = c1 + (p1 - c1) * mu[1]; dst[2] = c2 + (p2 - c2) * mu[2]; dst[3] = c3 + (p3 - c3) * mu[3]; } while (0)
            SH4(rs, rc, rp, mu_r); SH4(ksv, kc, kp, mu_k); SH4(vs, vc, vp, mu_v);
#undef SH4
            float q = 0.f;
#pragma unroll
            for (int i = 0; i < 4; ++i) { const float u = ksv[i] * kkc[i]; q += u * u; }
            q = allsum16(q); rn = __builtin_amdgcn_rsqf(fmaxf(q, 1e-24f));
            LAS unsigned char* rec = L + L_REC + et * RECB;
            *(LAS h16x4*)(rec + cg * KSB) = (h16x4){(_Float16)rs[0], (_Float16)rs[1], (_Float16)rs[2], (_Float16)rs[3]};
            if (cg < 8) *(LAS f32x4*)(rec + 16 * KSB + cg * 16) = (f32x4){vs[0], vs[1], vs[2], vs[3]};
        }
        if (wave < 5) {
            const int r32 = lane & 31, hi = lane >> 5;
            const LAS unsigned char* arow = L + L_AL + (r32 >> 1) * 1056 + (r32 & 1) * 512 + hi * 16;
            const int colb = (wave < 2) ? 0 : (wave < 4) ? 128 : 256;
            const LAS unsigned char* bfr = L + L_BF + (wave < 4 ? wave * 4 : 16) * 1024 + lane * 16;
            f32x16 acc = f32x16{};
            if (wave < 4) {
#pragma unroll
                for (int s = 0; s < 4; ++s) acc = __builtin_amdgcn_mfma_f32_32x32x16_bf16(*(const LAS bf16x8*)(arow + colb + 32 * s), *(const LAS bf16x8*)(bfr + s * 1024), acc, 0, 0, 0);
            } else {
#pragma unroll
                for (int s = 0; s < 8; ++s) acc = __builtin_amdgcn_mfma_f32_32x32x16_bf16(*(const LAS bf16x8*)(arow + colb + 32 * s), *(const LAS bf16x8*)(bfr + s * 1024), acc, 0, 0, 0);
            }
            LAS float* dst = (wave < 2) ? (LAS float*)(L + L_WL) + (wave & 1) * 32 + r32 : (wave < 4) ? (LAS float*)(L + L_AV) + (wave & 1) * 32 + r32 : (LAS float*)(L + L_GV) + r32;
            const int pitch = (wave < 4) ? 64 : 32;
#pragma unroll
            for (int r = 0; r < 16; ++r) { const int t = (r & 3) + 8 * (r >> 2) + 4 * hi; dst[t * pitch] = acc[r]; }
        }
        __syncthreads();
        {
            const f32x4 wl = *(const LAS f32x4*)(L + L_WL + (et * 64 + 4 * cg) * 4), al = *(const LAS f32x4*)(L + L_AV + (et * 64 + 4 * cg) * 4);
            float kp[4], nk[4], bb[4], dec[4], rk = 0.f;
#pragma unroll
            for (int i = 0; i < 4; ++i) {
                const float z = -(wl[i] + w0c[i]); const float sp = fmaxf(z, 0.f) + __logf(1.0f + __expf(-fabsf(z)));
                dec[i] = __expf(-__expf(-sp - 0.5f));
                const float a = __builtin_amdgcn_rcpf(1.0f + __expf(-(al[i] + a0c[i])));
                const float kn = ksv[i] * kkc[i] * rn; nk[i] = -kn; bb[i] = kn * a; kp[i] = ksv[i] * (1.0f + (a - 1.0f) * kac[i]); rk += rs[i] * kp[i] * rkc[i]; }
            rk = allsum16(rk);
            LAS unsigned char* rec = L + L_REC + et * RECB + cg * KSB;
            *(LAS h16x4*)(rec + 8) = (h16x4){(_Float16)nk[0], (_Float16)nk[1], (_Float16)nk[2], (_Float16)nk[3]};
            *(LAS f32x4*)(rec + 16) = (f32x4){dec[0], dec[1], dec[2], dec[3]};
            *(LAS f32x4*)(rec + 32) = (f32x4){bb[0], bb[1], bb[2], bb[3]};
            *(LAS f32x4*)(rec + 48) = (f32x4){kp[0], kp[1], kp[2], kp[3]};
            if (cg < 8) {
                const f32x4 g4 = *(const LAS f32x4*)(L + L_GV + (et * 32 + 4 * cg) * 4);
                float zz[4], gg[4];
#pragma unroll
                for (int i = 0; i < 4; ++i) { zz[i] = (lnb[i] + rk * vs[i]) * g4[i]; gg[i] = g4[i] * lng[i]; }
                const size_t o = (mrow0 + (size_t)c * TC + et) * 512 + vch;
                *(GAS v2u*)(Z + o) = (v2u){pk2(zz[0], zz[1]), pk2(zz[2], zz[3])};
                *(GAS v2u*)(GG + o) = (v2u){pk2(gg[0], gg[1]), pk2(gg[2], gg[3])};
            }
        }
        if (c > 0) STORE_Y(c - 1);
        __syncthreads();
#if defined(MK_PROBE_S2)
        }
#endif
        if (c + 1 < SEQ / TC) SCAN_DMA(c + 1);
        {
            const LAS unsigned char* rec = L + L_REC + ks * KSB; const LAS unsigned char* vrow = L + L_REC + 16 * KSB + vloc * 4;
            const unsigned ybase = L_YB + (c & 1) * 4096, ydump = L_YB + 8192 + lane * 4;
            v4u ra[3]; f32x4 rw[3], rb[3], rk4[3]; float rv[3];
            const unsigned recA = (unsigned)(L_REC + ks * KSB), vrowA = (unsigned)(L_REC + 16 * KSB + vloc * 4);
#define LOADREC(q_, st_) asm volatile("ds_read_b128 %0, %5 offset:%c7\n\tds_read_b128 %1, %5 offset:%c8\n\tds_read_b128 %2, %5 offset:%c9\n\tds_read_b128 %3, %5 offset:%c10\n\tds_read_b32 %4, %6 offset:%c7" \
                : "=&v"(ra[q_]), "=&v"(rw[q_]), "=&v"(rb[q_]), "=&v"(rk4[q_]), "=&v"(rv[q_]) : "v"(recA), "v"(vrowA), "i"((st_) * RECB), "i"((st_) * RECB + 16), "i"((st_) * RECB + 32), "i"((st_) * RECB + 48) : "memory")
#define WAITREC(q_, n_) asm volatile("s_waitcnt lgkmcnt(" #n_ ")" : "+v"(ra[q_]), "+v"(rw[q_]), "+v"(rb[q_]), "+v"(rk4[q_]), "+v"(rv[q_]) :: "memory")
#if defined(MK_PROBE_S1)
            const f32x2 sv01 = S01, sv23 = S23;
            for (int prep = 0; prep < 2; ++prep) { if (prep == 1) { S01 = sv01; S23 = sv23; }
#endif
            asm volatile("s_waitcnt lgkmcnt(0)" ::: "memory");
            LOADREC(0, 0); LOADREC(1, 1); WAITREC(0, 5);
            float y4 = 0.f;
#define STEP(st) do { \
                if ((st) + 2 < TC) { LOADREC(((st) + 2) % 3, (st) + 2); WAITREC(((st) + 1) % 3, 5); } else if ((st) + 1 < TC) { WAITREC(((st) + 1) % 3, 0); } \
                const v4u ca = ra[(st) % 3]; const f32x4 cw = rw[(st) % 3], cb = rb[(st) % 3], ck = rk4[(st) % 3]; const float vv = rv[(st) % 3]; \
                float p1 = fmix_lo0(S01[0], ca[2]); p1 = fmix_hi(S01[1], ca[2], p1); p1 = fmix_lo(S23[0], ca[3], p1); p1 = fmix_hi_nop(S23[1], ca[3], p1); \
                const float sa = allsum16(p1); \
                { const f32x2 vv2 = (f32x2){vv, vv}, sa2 = (f32x2){sa, sa}; \
                  f32x2 t01 = vv2 * (f32x2){ck[0], ck[1]}, t23 = vv2 * (f32x2){ck[2], ck[3]}; \
                  t01 = __builtin_elementwise_fma(sa2, (f32x2){cb[0], cb[1]}, t01); t23 = __builtin_elementwise_fma(sa2, (f32x2){cb[2], cb[3]}, t23); \
                  S01 = __builtin_elementwise_fma(S01, (f32x2){cw[0], cw[1]}, t01); S23 = __builtin_elementwise_fma(S23, (f32x2){cw[2], cw[3]}, t23); } \
                float p2 = fmix_lo0(S01[0], ca[0]); p2 = fmix_hi(S01[1], ca[0], p2); p2 = fmix_lo(S23[0], ca[1], p2); p2 = fmix_hi_nop(S23[1], ca[1], p2); \
                const float yv = allsum16(p2); \
                y4 = (ks == ((st) & 3)) ? yv : y4; \
                if (((st) & 3) == 3) { const unsigned ya = (ks < 4) ? (unsigned)(ybase + ((((st) & ~3) + ks) * 32 + vloc) * 4) : ydump; *(LAS float*)(L + ya) = y4; } \
            } while (0)
#define STEP4(b_) STEP(b_); STEP((b_) + 1); STEP((b_) + 2); STEP((b_) + 3)
            STEP4(0); STEP4(4); STEP4(8); STEP4(12); STEP4(16); STEP4(20); STEP4(24); STEP4(28);
#undef STEP4
#undef STEP
#undef WAITREC
#if defined(MK_PROBE_S1)
            }
#endif
#undef LOADREC
        }
    }
    __syncthreads();
    STORE_Y(SEQ / TC - 1);
    asm volatile("s_waitcnt vmcnt(0)" ::: "memory"); __syncthreads();
#undef SCAN_DMA
#undef STORE_Y
}
}
static_assert(scan::L_END <= LDSCTL_OFF, "scan LDS");

__device__ __forceinline__ void r2_post(Frame& F) {
    const bf16* Y = (const bf16*)((unsigned char*)F.out + OUT_Y); const bf16* GG = (const bf16*)((unsigned char*)F.out + OUT_GG); const bf16* Z = (const bf16*)((unsigned char*)F.out + OUT_Z);
    bf16* MIX = (bf16*)(F.ws + WS_MIX);
    const int gw = (F.vcu >> 4) * SEQ + (F.vcu & 15) * NWAVES + F.wave, NGW = 16 * NWAVES, mend = ((F.vcu >> 4) + 1) * SEQ;
    v4u ny, ng, nz;
    { const size_t o = (size_t)gw * 512 + 8 * F.lane; ny = *(const GAS v4u*)(Y + o); ng = *(const GAS v4u*)(GG + o); nz = *(const GAS v4u*)(Z + o); }
    for (int m = gw; m < mend; m += NGW) {
        const v4u yq = ny, g = ng, z = nz;
        if (m + NGW < mend) { const size_t o = (size_t)(m + NGW) * 512 + 8 * F.lane; ny = *(const GAS v4u*)(Y + o); ng = *(const GAS v4u*)(GG + o); nz = *(const GAS v4u*)(Z + o); }
        float yv[8];
#pragma unroll
        for (int i = 0; i < 4; ++i) { yv[2 * i] = __uint_as_float(yq[i] << 16); yv[2 * i + 1] = __uint_as_float(yq[i] & 0xffff0000u); }
        float s = ((yv[0] + yv[1]) + (yv[2] + yv[3])) + ((yv[4] + yv[5]) + (yv[6] + yv[7]));
        s += __int_as_float(__builtin_amdgcn_update_dpp(0, __float_as_int(s), 0xB1, 0xf, 0xf, false));
        s += __int_as_float(__builtin_amdgcn_update_dpp(0, __float_as_int(s), 0x4E, 0xf, 0xf, false));
        s += __int_as_float(__builtin_amdgcn_update_dpp(0, __float_as_int(s), 0x141, 0xf, 0xf, false));
        const float mean = s * (1.f / 64.f);
        float q = 0.f;
#pragma unroll
        for (int i = 0; i < 8; ++i) { yv[i] -= mean; q += yv[i] * yv[i]; }
        q += __int_as_float(__builtin_amdgcn_update_dpp(0, __float_as_int(q), 0xB1, 0xf, 0xf, false));
        q += __int_as_float(__builtin_amdgcn_update_dpp(0, __float_as_int(q), 0x4E, 0xf, 0xf, false));
        q += __int_as_float(__builtin_amdgcn_update_dpp(0, __float_as_int(q), 0x141, 0xf, 0xf, false));
        const float rstd = __builtin_amdgcn_rsqf(q * (1.f / 64.f) + 64e-5f);
        unsigned ow[4];
#pragma unroll
        for (int i = 0; i < 4; ++i) ow[i] = attn_body::cvtpk_s(yv[2 * i] * rstd * __uint_as_float(g[i] << 16) + __uint_as_float(z[i] << 16), yv[2 * i + 1] * rstd * __uint_as_float(g[i] & 0xffff0000u) + __uint_as_float(z[i] & 0xffff0000u));
        *(GAS v4u*)(MIX + (size_t)m * 1024 + 8 * F.lane) = (v4u){ow[0], ow[1], ow[2], ow[3]};
    }
}

namespace scan2 {
using scan::allsum16; using scan::f32x16; using scan::TC;
typedef unsigned short u16;
constexpr size_t WS_QPH = 488 * MiB, WS_GT = 840 * MiB, WS_VT = 136 * MiB, WS_QPH_ODD = 984 * MiB, OUT_QPH_ODD = 64 * MiB;
constexpr int S64 = 144, S32 = 80;
constexpr int QPH_B = 12288, GT_B = 9216, VT_B = 6144, O_PM = 32 * S64, O_HT = O_PM + 32 * S32;
constexpr int B_RAW = 0, B_AL = 13312, B_BF = B_AL + 16 * 1056;
constexpr int B_WL = B_BF + 32768, B_AV = B_WL + 8192, B_GV = B_AV + 8192, B_EE = B_GV + 8192;
constexpr int B_OUT = B_WL, O_VT = 0, O_QPH = VT_B, O_GT = VT_B + QPH_B;
constexpr int B_ALP = B_EE + 8192, B_ALPT = B_ALP + 32 * S64, B_BET = B_ALPT + 64 * S32, B_BETT = B_BET + 32 * S64, B_KAP = B_BETT + 64 * S32, B_RHO = B_KAP + 32 * S64;
constexpr int B_GL = B_RHO + 32 * S64, B_PW0 = B_GL + 256, B_PW1 = B_PW0 + 2 * 32 * S32, B_PL = B_PW1 + 2 * 32 * S32, B_TL = B_PL + 32 * S32, B_AAKT = B_TL + 32 * S32;
constexpr int B_KAPT = B_AAKT + 32 * S32, B_VSL = B_KAPT + 64 * S32, B_ARB = B_VSL + 32 * S64, B_WMT = B_ARB + 32 * S32, B_UMT = B_WMT + 64 * S32, B_END = B_UMT + 32 * S32;
static_assert(B_END <= LDSCTL_OFF && VT_B + QPH_B + GT_B <= 32768, "scan2 build LDS");
__device__ __forceinline__ u16 f2h(float f) { return (u16)(attn_body::cvtpk_s(f, 0.f) & 0xffffu); }
__device__ __forceinline__ int crow(int r, int hi) { return (r & 3) + 8 * (r >> 2) + 4 * hi; }
__device__ __forceinline__ void tile_nt(f32x16& acc, const LAS unsigned char* A, int lda, int arow0, const LAS unsigned char* Bt, int ldb, int brow0, int ksteps, int lane) {
    const int r32 = lane & 31, hi = lane >> 5;
    const LAS unsigned char* ap = A + (arow0 + r32) * lda + hi * 16; const LAS unsigned char* bp = Bt + (brow0 + r32) * ldb + hi * 16;
    for (int s = 0; s < ksteps; ++s) acc = __builtin_amdgcn_mfma_f32_32x32x16_bf16(*(const LAS bf16x8*)(ap + 32 * s), *(const LAS bf16x8*)(bp + 32 * s), acc, 0, 0, 0);
}
#define LBAR() asm volatile("s_waitcnt lgkmcnt(0)\n\ts_barrier" ::: "memory")
#define ST16_(base, off, val) (*(LAS unsigned short*)((base) + (off)) = (unsigned short)(attn_body::cvtpk_s((val), 0.f) & 0xffffu))
__device__ __forceinline__ int crow_(int r, int hi) { return (r & 3) + 8 * (r >> 2) + 4 * hi; }
__device__ __forceinline__ void store_tr(LAS unsigned char* img, int stride, int ncol0, const f32x16& a, int lane) {
    LAS unsigned char* p = img + (ncol0 + (lane & 31)) * 2; const int hi = lane >> 5;
#pragma unroll
    for (int r = 0; r < 16; ++r) ST16_(p, crow_(r, hi) * stride, a[r]);
}
#define ST16(base, off, val) (*(LAS u16*)((base) + (off)) = f2h(val))
__device__ __forceinline__ void store_nat(LAS unsigned char* img, int stride, int nrow0, const f32x16& a, int lane, int mcol0 = 0) {
    LAS unsigned char* p = img + (nrow0 + (lane & 31)) * stride + (mcol0 + 4 * (lane >> 5)) * 2;
#pragma unroll
    for (int g = 0; g < 4; ++g) *(LAS v2u*)(p + 16 * g) = (v2u){attn_body::cvtpk_s(a[4 * g], a[4 * g + 1]), attn_body::cvtpk_s(a[4 * g + 2], a[4 * g + 3])};
}

__device__ __forceinline__ unsigned char* vt_home(const Frame& F, int b, int hd) { return F.ws + WS_VT + (size_t)b * (8 * MiB) + (size_t)hd * 128 * VT_B; }
__device__ __forceinline__ unsigned char* qph_home(const Frame& F, int b, int hd) {
    unsigned char* base = (b & 1) ? (((b >> 1) < 5) ? (unsigned char*)F.out + OUT_QPH_ODD + (size_t)(b >> 1) * (12 * MiB) : F.ws + WS_QPH_ODD + (size_t)((b >> 1) - 5) * (12 * MiB)) : F.ws + WS_QPH + (size_t)b * (12 * MiB);
    return base + (size_t)hd * 128 * QPH_B; }
__device__ __forceinline__ void build(Frame& F) {
    const int tid = F.tid, lane = F.lane, wave = F.wave;
    const int bh = F.vcu >> 1, hd = bh & 7, b = bh >> 3, c0 = (F.vcu & 1) * 64;
    LAS unsigned char* L = F.lds;
    const unsigned lds0 = (unsigned)(uintptr_t)(unsigned char*)F.lds;
    const bf16* PR = (const bf16*)(F.ws + WS_PR); const bf16* AL = (const bf16*)(F.ws + WS_ALORA);
    bf16* GG = (bf16*)((unsigned char*)F.out + OUT_GG); bf16* Z = (bf16*)((unsigned char*)F.out + OUT_Z);
    const int et = tid >> 4, cg = tid & 15, chb = hd * 64 + 4 * cg;
    float mu_r[4], mu_k[4], mu_v[4], kkc[4], kac[4], rkc[4], lng[4], lnb[4], w0c[4], a0c[4];
#pragma unroll
    for (int i = 0; i < 4; ++i) { mu_r[i] = F.in[IN_MU][chb + i]; mu_k[i] = F.in[IN_MU][512 + chb + i]; mu_v[i] = F.in[IN_MU][1024 + chb + i]; kkc[i] = F.in[IN_KK][chb + i]; kac[i] = F.in[IN_KA][chb + i]; rkc[i] = F.in[IN_RK][chb + i];
        w0c[i] = F.in[IN_W0][chb + i]; a0c[i] = F.in[IN_A0][chb + i]; lng[i] = F.in[IN_LNG][chb + i]; lnb[i] = F.in[IN_LNB][chb + i]; }
    if (wave < 6) {
        const int r32 = lane & 31, hi = lane >> 5, col = hd * 64 + (wave & 1) * 32 + r32, ns = (wave < 4) ? 4 : 8;
        const float* wup = F.in[IN_WUP]; const float* aup = F.in[IN_AUP]; const float* gup = F.in[IN_GUP];
        for (int s = 0; s < ns; ++s) { float f[8];
            if (wave < 2) {
#pragma unroll
                for (int jj = 0; jj < 8; ++jj) f[jj] = wup[(size_t)(16 * s + 8 * hi + jj) * 512 + col];
            } else if (wave < 4) {
#pragma unroll
                for (int jj = 0; jj < 8; ++jj) f[jj] = aup[(size_t)(16 * s + 8 * hi + jj) * 512 + col];
            } else {
#pragma unroll
                for (int jj = 0; jj < 8; ++jj) f[jj] = gup[(size_t)(16 * s + 8 * hi + jj) * 512 + col];
            }
            *(LAS v4u*)(L + B_BF + ((wave < 4 ? wave * 4 : 16 + (wave - 4) * 8) + s) * 1024 + lane * 16) = (v4u){pk2(f[0], f[1]), pk2(f[2], f[3]), pk2(f[4], f[5]), pk2(f[6], f[7])}; }
    }
    long raw_off[2];
#pragma unroll
    for (int i = 0; i < 2; ++i) { int q = 64 * (wave + 8 * i) + lane; if (q > 791) q = 791; const int row = q / 24, cc = q % 24; raw_off[i] = (long)(row - 1) * RC + (cc >> 3) * 512 + hd * 64 + (cc & 7) * 8; }
    const size_t mrow0 = (size_t)b * SEQ;
#define B_DMA(c) do { const size_t m0_ = mrow0 + (size_t)(c) * TC; \
        _Pragma("unroll") for (int i_ = 0; i_ < 2; ++i_) { const int p_ = wave + 8 * i_; if (p_ < 13) { long o_ = raw_off[i_]; if ((c) == 0 && o_ < 0) o_ += RC; \
            attn_body::glds16(PR + m0_ * RC + o_, (unsigned)__builtin_amdgcn_readfirstlane(lds0 + B_RAW + p_ * 1024)); } } \
        _Pragma("unroll") for (int i_ = 0; i_ < 2; ++i_) { const int p_ = wave + 8 * i_; \
            attn_body::glds16(AL + (m0_ + 2 * p_) * 256 + lane * 8, (unsigned)__builtin_amdgcn_readfirstlane(lds0 + B_AL + p_ * 1056)); } } while (0)
#define B_COPYOUT(cc) do { const size_t u_ = (size_t)bh * 128 + (cc); \
        for (int q_ = tid; q_ < 1728; q_ += 512) { const v4u v_ = *(const LAS v4u*)(L + B_OUT + q_ * 16); \
            unsigned char* d_ = (q_ < 384) ? vt_home(F, b, hd) + (size_t)(cc) * VT_B + (size_t)q_ * 16 : (q_ < 1152) ? qph_home(F, b, hd) + (size_t)(cc) * QPH_B + (size_t)(q_ - 384) * 16 : F.ws + WS_GT + u_ * GT_B + (size_t)(q_ - 1152) * 16; \
            *(GAS v4u*)d_ = v_; } } while (0)
#if defined(MK_TSTAGE)
    unsigned long long ts_acc = 0ull, ts_start = 0ull; bool ts_on = false;
#define TS(p) do { const unsigned long long now_ = __builtin_amdgcn_s_memrealtime(); if ((p) == (MK_TSTAGE + 1) % 8 && ts_on) { ts_acc += now_ - ts_start; ts_on = false; } if ((p) == MK_TSTAGE) { ts_start = now_; ts_on = true; } } while (0)
#else
#define TS(p) do {} while (0)
#endif
    B_DMA(c0);
    for (int ci = 0; ci < 64; ++ci) {
        const int c = c0 + ci;
        asm volatile("s_waitcnt vmcnt(0) lgkmcnt(0)\n\ts_barrier" ::: "memory"); TS(0);
        if (ci > 0) B_COPYOUT(c - 1);
        float rs[4], ksv[4], vs[4], rn;
        {
            const bool first = (c == 0 && et == 0);
            const LAS unsigned char* rowc = L + B_RAW + (et + 1) * 384; const LAS unsigned char* rowp = L + B_RAW + et * 384;
            const v2u rc = *(const LAS v2u*)(rowc + cg * 8), rp = *(const LAS v2u*)(rowp + cg * 8);
            const v2u kc = *(const LAS v2u*)(rowc + 128 + cg * 8), kp = *(const LAS v2u*)(rowp + 128 + cg * 8);
            const v2u vc = *(const LAS v2u*)(rowc + 256 + cg * 8), vp = *(const LAS v2u*)(rowp + 256 + cg * 8);
#define SH4(dst, cu, pr, mu) do { const float c0_ = __uint_as_float(cu.x << 16), c1_ = __uint_as_float(cu.x & 0xffff0000u), c2_ = __uint_as_float(cu.y << 16), c3_ = __uint_as_float(cu.y & 0xffff0000u); \
            const float p0_ = first ? 0.f : __uint_as_float(pr.x << 16), p1_ = first ? 0.f : __uint_as_float(pr.x & 0xffff0000u), p2_ = first ? 0.f : __uint_as_float(pr.y << 16), p3_ = first ? 0.f : __uint_as_float(pr.y & 0xffff0000u); \
            dst[0] = c0_ + (p0_ - c0_) * mu[0]; dst[1] = c1_ + (p1_ - c1_) * mu[1]; dst[2] = c2_ + (p2_ - c2_) * mu[2]; dst[3] = c3_ + (p3_ - c3_) * mu[3]; } while (0)
            SH4(rs, rc, rp, mu_r); SH4(ksv, kc, kp, mu_k); SH4(vs, vc, vp, mu_v);
#undef SH4
            float q = 0.f;
#pragma unroll
            for (int i = 0; i < 4; ++i) { const float u = ksv[i] * kkc[i]; q += u * u; }
            q = allsum16(q); rn = __builtin_amdgcn_rsqf(fmaxf(q, 1e-24f));
        }
        LBAR(); TS(1);
        if (wave < 6) {
            int l2 = lane; asm volatile("" : "+v"(l2)); const int r32 = l2 & 31, hi = l2 >> 5;
            const LAS unsigned char* arow = L + B_AL + (r32 >> 1) * 1056 + (r32 & 1) * 512 + hi * 16;
            const int colb = (wave < 2) ? 0 : (wave < 4) ? 128 : 256;
            const LAS unsigned char* bfr = L + B_BF + (wave < 4 ? wave * 4 : 16 + (wave - 4) * 8) * 1024 + lane * 16;
            f32x16 acc = f32x16{};
            if (wave < 4) {
#pragma unroll
                for (int s = 0; s < 4; ++s) acc = __builtin_amdgcn_mfma_f32_32x32x16_bf16(*(const LAS bf16x8*)(arow + colb + 32 * s), *(const LAS bf16x8*)(bfr + s * 1024), acc, 0, 0, 0);
            } else {
#pragma unroll
                for (int s = 0; s < 8; ++s) acc = __builtin_amdgcn_mfma_f32_32x32x16_bf16(*(const LAS bf16x8*)(arow + colb + 32 * s), *(const LAS bf16x8*)(bfr + s * 1024), acc, 0, 0, 0);
            }
            LAS float* dst = (LAS float*)(L + ((wave < 2) ? B_WL : (wave < 4) ? B_AV : B_GV)) + (wave & 1) * 32 + r32;
#pragma unroll
            for (int r = 0; r < 16; ++r) dst[crow(r, hi) * 64] = acc[r];
        }
        LBAR(); TS(2);
        if (ci + 1 < 64) B_DMA(c + 1);
        float ee[4], kn[4], bb[4], kp4[4];
        f32x4 E;
        {
            const f32x4 wl = *(const LAS f32x4*)(L + B_WL + (et * 64 + 4 * cg) * 4), al = *(const LAS f32x4*)(L + B_AV + (et * 64 + 4 * cg) * 4), g4 = *(const LAS f32x4*)(L + B_GV + (et * 64 + 4 * cg) * 4);
            float rk = 0.f;
#pragma unroll
            for (int i = 0; i < 4; ++i) {
                ee[i] = 0.6065306597f * __builtin_amdgcn_rcpf(1.0f + __expf(-(wl[i] + w0c[i])));
                const float a = __builtin_amdgcn_rcpf(1.0f + __expf(-(al[i] + a0c[i])));
                kn[i] = ksv[i] * kkc[i] * rn; bb[i] = kn[i] * a; kp4[i] = ksv[i] * (1.0f + (a - 1.0f) * kac[i]); rk += rs[i] * kp4[i] * rkc[i]; }
            rk = allsum16(rk);
            float zz[4], gg[4];
#pragma unroll
            for (int i = 0; i < 4; ++i) { zz[i] = (lnb[i] + rk * vs[i]) * g4[i]; gg[i] = g4[i] * lng[i]; }
            const size_t o = (mrow0 + (size_t)c * TC + et) * 512 + chb;
            *(GAS v2u*)(Z + o) = (v2u){attn_body::cvtpk_s(zz[0], zz[1]), attn_body::cvtpk_s(zz[2], zz[3])};
            *(GAS v2u*)(GG + o) = (v2u){attn_body::cvtpk_s(gg[0], gg[1]), attn_body::cvtpk_s(gg[2], gg[3])};
#pragma unroll
            for (int i = 0; i < 4; ++i) { float p = ee[i]; const float t1 = __shfl_up(p, 16); if (lane >= 16) p += t1;
                auto rr = __builtin_amdgcn_permlane32_swap(__float_as_uint(p), __float_as_uint(p), false, false); if (lane >= 32) p += __uint_as_float(rr[0]);
                E[i] = p; }
            if (lane >= 48) *(LAS f32x4*)(L + B_EE + (wave * 16 + cg) * 16) = E;
        }
        LBAR(); TS(3);
        {
#pragma unroll
            for (int w = 0; w < 7; ++w) { const f32x4 tw = *(const LAS f32x4*)(L + B_EE + (w * 16 + cg) * 16); if (w < wave) E += tw; }
            float al_[4], be_[4], ka_[4], rh_[4];
#pragma unroll
            for (int i = 0; i < 4; ++i) { const float gt = __expf(-E[i]), gp = __expf(-(E[i] - ee[i])), ig = __expf(E[i]);
                al_[i] = gp * kn[i]; be_[i] = bb[i] * ig; ka_[i] = kp4[i] * ig; rh_[i] = gt * rs[i];
                if (et == 31) *(LAS float*)(L + B_GL + (4 * cg + i) * 4) = gt; }
            *(LAS v2u*)(L + B_ALP + et * S64 + cg * 8) = (v2u){attn_body::cvtpk_s(al_[0], al_[1]), attn_body::cvtpk_s(al_[2], al_[3])};
            *(LAS v2u*)(L + B_BET + et * S64 + cg * 8) = (v2u){attn_body::cvtpk_s(be_[0], be_[1]), attn_body::cvtpk_s(be_[2], be_[3])};
            *(LAS v2u*)(L + B_KAP + et * S64 + cg * 8) = (v2u){attn_body::cvtpk_s(ka_[0], ka_[1]), attn_body::cvtpk_s(ka_[2], ka_[3])};
            *(LAS v2u*)(L + B_RHO + et * S64 + cg * 8) = (v2u){attn_body::cvtpk_s(rh_[0], rh_[1]), attn_body::cvtpk_s(rh_[2], rh_[3])};
            *(LAS v2u*)(L + B_VSL + et * S64 + cg * 8) = (v2u){attn_body::cvtpk_s(vs[0], vs[1]), attn_body::cvtpk_s(vs[2], vs[3])};
        }
        LBAR(); TS(4);
        {
            const int mtx = tid >> 7, cb = (tid >> 3) & 15, tb = tid & 7;
            const LAS unsigned char* src = L + ((mtx == 0) ? B_ALP : (mtx == 1) ? B_BET : (mtx == 2) ? B_KAP : B_VSL) + (4 * tb) * S64 + cb * 8;
            const v2u r0 = *(const LAS v2u*)(src), r1 = *(const LAS v2u*)(src + S64), r2 = *(const LAS v2u*)(src + 2 * S64), r3 = *(const LAS v2u*)(src + 3 * S64);
            LAS unsigned char* dst = (mtx == 3) ? L + B_OUT + O_VT + (cb >> 3) * 3072 + (4 * (cb & 7)) * S32 + tb * 8 : L + ((mtx == 0) ? B_ALPT : (mtx == 1) ? B_BETT : B_KAPT) + (4 * cb) * S32 + tb * 8;
            *(LAS v2u*)(dst)           = (v2u){(r0.x & 0xffffu) | (r1.x << 16), (r2.x & 0xffffu) | (r3.x << 16)};
            *(LAS v2u*)(dst + S32)     = (v2u){(r0.x >> 16) | (r1.x & 0xffff0000u), (r2.x >> 16) | (r3.x & 0xffff0000u)};
            *(LAS v2u*)(dst + 2 * S32) = (v2u){(r0.y & 0xffffu) | (r1.y << 16), (r2.y & 0xffffu) | (r3.y << 16)};
            *(LAS v2u*)(dst + 3 * S32) = (v2u){(r0.y >> 16) | (r1.y & 0xffff0000u), (r2.y >> 16) | (r3.y & 0xffff0000u)};
        }
        LBAR(); TS(5);
        int ln = lane; asm volatile("" : "+v"(ln));
        f32x16 X = f32x16{}, RK = f32x16{};
        {
            const int r32 = ln & 31, hi = ln >> 5;
            if (wave == 0) { f32x16 acc = f32x16{}; tile_nt(acc, L + B_ALP, S64, 0, L + B_BET, S64, 0, 4, ln);
#pragma unroll
                for (int r = 0; r < 16; ++r) acc[r] = (crow(r, hi) > r32) ? -acc[r] : 0.f;
                store_nat(L + B_PW0 + 32 * S32, S32, 0, acc, ln);
            } else if (wave == 4) { f32x16 acc = f32x16{}; tile_nt(acc, L + B_BET, S64, 0, L + B_ALP, S64, 0, 4, ln);
#pragma unroll
                for (int r = 0; r < 16; ++r) acc[r] = (r32 > crow(r, hi)) ? -acc[r] : 0.f;
                store_nat(L + B_PW0, S32, 0, acc, ln);
            } else if (wave == 1) { tile_nt(X, L + B_ALP, S64, 0, L + B_KAP, S64, 0, 4, ln);
#pragma unroll
                for (int r = 0; r < 16; ++r) X[r] = (crow(r, hi) > r32) ? X[r] : 0.f;
            } else if (wave == 2 || wave == 3) {
                const LAS unsigned char* ap = L + B_ALPT + ((wave - 2) * 32 + r32) * S32 + 8 * hi;
#pragma unroll
                for (int g4 = 0; g4 < 4; ++g4) { const v2u t2 = *(const LAS v2u*)(ap + 16 * g4);
                    X[4 * g4] = __uint_as_float(t2.x << 16); X[4 * g4 + 1] = __uint_as_float(t2.x & 0xffff0000u); X[4 * g4 + 2] = __uint_as_float(t2.y << 16); X[4 * g4 + 3] = __uint_as_float(t2.y & 0xffff0000u); }
            } else if (wave == 5) { f32x16 acc = f32x16{}; tile_nt(acc, L + B_BET, S64, 0, L + B_RHO, S64, 0, 4, ln);
#pragma unroll
                for (int r = 0; r < 16; ++r) acc[r] = (r32 >= crow(r, hi)) ? acc[r] : 0.f;
                store_nat(L + B_ARB, S32, 0, acc, ln);
            } else if (wave == 6) { tile_nt(RK, L + B_KAP, S64, 0, L + B_RHO, S64, 0, 4, ln);
#pragma unroll
                for (int r = 0; r < 16; ++r) RK[r] = (r32 >= crow(r, hi)) ? RK[r] : 0.f; }
        }
        LBAR(); TS(6);
#pragma unroll
        for (int j = 0; j < 5; ++j) {
            const LAS unsigned char* pw = L + ((j & 1) ? B_PW1 : B_PW0); LAS unsigned char* pn = L + ((j & 1) ? B_PW0 : B_PW1);
            asm volatile("" : "+v"(ln));
            if (wave >= 1 && wave <= 3) { LAS unsigned char* xt = (wave == 1) ? L + B_UMT : L + B_WMT + (wave - 2) * 32 * S32;
                store_nat(xt, S32, 0, X, ln);
                tile_nt(X, pw, S32, 0, xt, S32, 0, 2, ln);
                if (j == 4) store_nat(xt, S32, 0, X, ln);
            } else if (j < 4 && (wave == 0 || wave == 4)) { f32x16 sq = f32x16{};
                if (wave == 0) { tile_nt(sq, pw, S32, 0, pw + 32 * S32, S32, 0, 2, ln); store_nat(pn + 32 * S32, S32, 0, sq, ln); }
                else           { tile_nt(sq, pw + 32 * S32, S32, 0, pw, S32, 0, 2, ln); store_nat(pn, S32, 0, sq, ln); } }
            LBAR();
        }
        TS(7);
        {
            asm volatile("" : "+v"(ln)); const int r32 = ln & 31, hi = ln >> 5; LAS unsigned char* OQ = L + B_OUT + O_QPH; LAS unsigned char* OG = L + B_OUT + O_GT;
            if (wave < 2) { f32x16 acc = f32x16{}; tile_nt(acc, L + B_WMT, S32, wave * 32, L + B_ARB, S32, 0, 2, ln);
#pragma unroll
                for (int g4 = 0; g4 < 4; ++g4) { const v2u rr = *(const LAS v2u*)(L + B_RHO + r32 * S64 + (wave * 32 + 8 * g4 + 4 * hi) * 2);
                    acc[4 * g4] = __uint_as_float(rr.x << 16) - acc[4 * g4]; acc[4 * g4 + 1] = __uint_as_float(rr.x & 0xffff0000u) - acc[4 * g4 + 1]; acc[4 * g4 + 2] = __uint_as_float(rr.y << 16) - acc[4 * g4 + 2]; acc[4 * g4 + 3] = __uint_as_float(rr.y & 0xffff0000u) - acc[4 * g4 + 3]; }
                store_nat(OQ, S64, 0, acc, ln, wave * 32); }
            if (wave == 2 || wave == 3) { const int ni = wave - 2; f32x16 acc = f32x16{}; tile_nt(acc, L + B_UMT, S32, 0, L + B_BETT, S32, ni * 32, 2, ln);
                const int ch = ni * 32 + r32; const float gl = *(const LAS float*)(L + B_GL + ch * 4);
#pragma unroll
                for (int g4 = 0; g4 < 4; ++g4) { const v2u kk2 = *(const LAS v2u*)(L + B_KAPT + ch * S32 + (8 * g4 + 4 * hi) * 2);
                    acc[4 * g4] = (__uint_as_float(kk2.x << 16) - acc[4 * g4]) * gl; acc[4 * g4 + 1] = (__uint_as_float(kk2.x & 0xffff0000u) - acc[4 * g4 + 1]) * gl;
                    acc[4 * g4 + 2] = (__uint_as_float(kk2.y << 16) - acc[4 * g4 + 2]) * gl; acc[4 * g4 + 3] = (__uint_as_float(kk2.y & 0xffff0000u) - acc[4 * g4 + 3]) * gl; }
                store_nat(OQ + O_HT, S32, ni * 32, acc, ln); }
            if (wave == 6) { f32x16 acc = f32x16{}; tile_nt(acc, L + B_UMT, S32, 0, L + B_ARB, S32, 0, 2, ln);
#pragma unroll
                for (int r = 0; r < 16; ++r) acc[r] = RK[r] - acc[r];
                store_nat(OQ + O_PM, S32, 0, acc, ln); }
            if (wave >= 4) { const int gi = (wave == 4) ? 0 : (wave == 5) ? 1 : (wave == 7) ? 2 : 3, mi = gi >> 1, ni = gi & 1; f32x16 acc = f32x16{};
                tile_nt(acc, L + B_WMT, S32, mi * 32, L + B_BETT, S32, ni * 32, 2, ln);
                const int ch = ni * 32 + r32; const float gl = *(const LAS float*)(L + B_GL + ch * 4);
#pragma unroll
                for (int r = 0; r < 16; ++r) { const int chp = mi * 32 + crow(r, hi); acc[r] = (((chp == ch) ? 1.f : 0.f) - acc[r]) * gl; }
                store_nat(OG, S64, ni * 32, acc, ln, mi * 32); }
        }
    }
    __syncthreads();
#if defined(MK_TSTAGE)
    if (blockIdx.x == 0 && wave == 0) { const unsigned long long t0_ = __builtin_amdgcn_s_memrealtime(); while (__builtin_amdgcn_s_memrealtime() - t0_ < 4ull * ts_acc) __builtin_amdgcn_s_sleep(8); }
#endif
    B_COPYOUT(c0 + 63);
    asm volatile("s_waitcnt vmcnt(0)" ::: "memory"); __syncthreads();
#undef B_DMA
#undef B_COPYOUT
#undef TS
}

constexpr int A_IMG = 0, IMG_B = 3072 + QPH_B + GT_B;
constexpr int A_S = 3 * IMG_B, A_YB = A_S + 32 * S64, A_END = A_YB + 2 * 4096;
static_assert(A_END <= LDSCTL_OFF, "scan2 apply LDS");
__device__ __forceinline__ void apply(Frame& F) {
    const int tid = F.tid, lane = F.lane, wave = F.wave;
    const int half = F.vcu & 1, bh = F.vcu >> 1, hd = bh & 7, b = bh >> 3;
    LAS unsigned char* L = F.lds;
    const unsigned lds0 = (unsigned)(uintptr_t)(unsigned char*)F.lds;
    bf16* Y = (bf16*)((unsigned char*)F.out + OUT_Y);
    const size_t mrow0 = (size_t)b * SEQ;
    const int dw = (wave - 3) & 1;
#define A_DMA(c) do { const size_t u_ = (size_t)bh * 128 + (c); \
        _Pragma("unroll") for (int i_ = 0; i_ < 12; ++i_) { const int p_ = dw * 12 + i_; \
            const unsigned char* src_ = (p_ < 3) ? vt_home(F, b, hd) + (size_t)(c) * VT_B + half * 3072 + p_ * 1024 : (p_ < 15) ? qph_home(F, b, hd) + (size_t)(c) * QPH_B + (p_ - 3) * 1024 : F.ws + WS_GT + u_ * GT_B + (p_ - 15) * 1024; \
            attn_body::glds16(src_ + lane * 16, (unsigned)__builtin_amdgcn_readfirstlane(lds0 + A_IMG + ((c) % 3) * IMG_B + p_ * 1024)); } } while (0)
    for (int q = tid; q < 32 * S64 / 4; q += 512) ((LAS unsigned*)(L + A_S))[q] = 0u;
    if (wave == 3 || wave == 4) A_DMA(0);
    if (wave == 5 || wave == 6) A_DMA(1);
    for (int c = 0; c < SEQ / TC; ++c) {
        const bool mydma = (wave >= 3 && wave < 7) && ((((wave - 3) >> 1) & 1) == (c & 1));
        if (mydma) asm volatile("s_waitcnt vmcnt(0)" ::: "memory");
        LBAR();
        if (mydma && c + 2 < SEQ / TC) A_DMA(c + 2);
        const LAS unsigned char* I = L + A_IMG + (c % 3) * IMG_B; const LAS unsigned char* IVT = I; const LAS unsigned char* IQ = I + 3072; const LAS unsigned char* IG = I + 3072 + QPH_B;
        f32x16 acc = f32x16{};
        int ln = lane; asm volatile("" : "+v"(ln)); const int r32 = ln & 31, hi = ln >> 5;
        if (wave == 0) { tile_nt(acc, IQ, S64, 0, L + A_S, S64, 0, 4, ln); tile_nt(acc, IQ + O_PM, S32, 0, IVT, S32, 0, 2, ln); }
        else if (wave < 3) { const int ni = wave - 1; tile_nt(acc, IG, S64, ni * 32, L + A_S, S64, 0, 4, ln); tile_nt(acc, IQ + O_HT, S32, ni * 32, IVT, S32, 0, 2, ln); }
        if (wave == 7 && c > 0) {
#pragma unroll
            for (int i = 0; i < 2; ++i) { const int q = i * 64 + lane, st = q >> 2, v8 = (q & 3) * 8; const LAS f32x4* yp = (const LAS f32x4*)(L + A_YB + ((c - 1) & 1) * 4096 + (st * 32 + v8) * 4); const f32x4 ya = yp[0], yb = yp[1];
                *(GAS v4u*)(Y + (mrow0 + (size_t)(c - 1) * TC + st) * 512 + hd * 64 + half * 32 + v8) = (v4u){attn_body::cvtpk_s(ya[0], ya[1]), attn_body::cvtpk_s(ya[2], ya[3]), attn_body::cvtpk_s(yb[0], yb[1]), attn_body::cvtpk_s(yb[2], yb[3])}; } }
        LBAR();
        if (wave == 0) {
#pragma unroll
            for (int r = 0; r < 16; ++r) *(LAS float*)(L + A_YB + (c & 1) * 4096 + (crow(r, hi) * 32 + r32) * 4) = acc[r]; }
        else if (wave < 3) store_nat(L + A_S, S64, 0, acc, ln, (wave - 1) * 32);
    }
    __syncthreads();
    if (wave == 7) {
#pragma unroll
        for (int i = 0; i < 2; ++i) { const int q = i * 64 + lane, st = q >> 2, v8 = (q & 3) * 8; const LAS f32x4* yp = (const LAS f32x4*)(L + A_YB + ((SEQ / TC - 1) & 1) * 4096 + (st * 32 + v8) * 4); const f32x4 ya = yp[0], yb = yp[1];
            *(GAS v4u*)(Y + (mrow0 + (size_t)(SEQ / TC - 1) * TC + st) * 512 + hd * 64 + half * 32 + v8) = (v4u){attn_body::cvtpk_s(ya[0], ya[1]), attn_body::cvtpk_s(ya[2], ya[3]), attn_body::cvtpk_s(yb[0], yb[1]), attn_body::cvtpk_s(yb[2], yb[3])}; } }
    asm volatile("s_waitcnt vmcnt(0)" ::: "memory"); __syncthreads();
#undef A_DMA
}
constexpr int A2_IMG = 0, IMG2_B = VT_B + QPH_B + GT_B;
constexpr int A2_S = 3 * IMG2_B, A2_YB = A2_S + 64 * S64, A2_END = A2_YB + 2 * 8192;
static_assert(A2_END <= LDSCTL_OFF, "scan2 apply2 LDS");
__device__ __forceinline__ void a2_epilogue(const LAS float* yr, const v4u (&gq)[4], const v4u (&zq)[4], bf16* dst) {
    float y[32]; float s = 0.f;
#pragma unroll
    for (int i = 0; i < 8; ++i) { const f32x4 t4 = *(const LAS f32x4*)(yr + 4 * i); y[4 * i] = t4[0]; y[4 * i + 1] = t4[1]; y[4 * i + 2] = t4[2]; y[4 * i + 3] = t4[3]; s += (t4[0] + t4[1]) + (t4[2] + t4[3]); }
    s += __int_as_float(__builtin_amdgcn_update_dpp(0, __float_as_int(s), 0xB1, 0xf, 0xf, false));
    const float mean = s * (1.f / 64.f); float q = 0.f;
#pragma unroll
    for (int i = 0; i < 32; ++i) { y[i] -= mean; q += y[i] * y[i]; }
    q += __int_as_float(__builtin_amdgcn_update_dpp(0, __float_as_int(q), 0xB1, 0xf, 0xf, false));
    const float rstd = __builtin_amdgcn_rsqf(q * (1.f / 64.f) + 64e-5f);
#pragma unroll
    for (int h = 0; h < 4; ++h) { unsigned ow[4];
#pragma unroll
        for (int i = 0; i < 4; ++i) { const unsigned gw_ = gq[h][i], zw_ = zq[h][i]; const int k = 8 * h + 2 * i;
            const float o0 = y[k] * rstd * __uint_as_float(gw_ << 16) + __uint_as_float(zw_ << 16), o1 = y[k + 1] * rstd * __uint_as_float(gw_ & 0xffff0000u) + __uint_as_float(zw_ & 0xffff0000u);
            ow[i] = attn_body::cvtpk_s(o0, o1); }
        *(GAS v4u*)(dst + 8 * h) = (v4u){ow[0], ow[1], ow[2], ow[3]}; }
}
__device__ __forceinline__ void apply2(Frame& F) {
    if (F.vcu & 1) return;
    const int lane = F.lane, wave = F.wave;
    const int bh = F.vcu >> 1, hd = bh & 7, b = bh >> 3;
    LAS unsigned char* L = F.lds;
    const unsigned lds0 = (unsigned)(uintptr_t)(unsigned char*)F.lds;
    const bf16* GG = (const bf16*)((unsigned char*)F.out + OUT_GG); const bf16* Z = (const bf16*)((unsigned char*)F.out + OUT_Z); bf16* MIX = (bf16*)(F.ws + WS_MIX);
    const size_t mrow0 = (size_t)b * SEQ;
#define A2_DMA(c) do { const size_t u_ = (size_t)bh * 128 + (c); \
        _Pragma("unroll") for (int i_ = 0; i_ < 4; ++i_) { const int p_ = wave + 7 * i_; if (p_ < 27) { \
            const unsigned char* src_ = (p_ < 6) ? F.ws + WS_VT + u_ * VT_B + p_ * 1024 : (p_ < 18) ? F.ws + WS_QPH + u_ * QPH_B + (p_ - 6) * 1024 : F.ws + WS_GT + u_ * GT_B + (p_ - 18) * 1024; \
            attn_body::glds16(src_ + lane * 16, (unsigned)__builtin_amdgcn_readfirstlane(lds0 + A2_IMG + ((c) % 3) * IMG2_B + p_ * 1024)); } } } while (0)
    for (int q = F.tid; q < 64 * S64 / 4; q += 512) ((LAS unsigned*)(L + A2_S))[q] = 0u;
    if (wave < 7) { A2_DMA(0); A2_DMA(1); }
    const int est = lane >> 1, ev0 = 32 * (lane & 1);
    v4u gq[4], zq[4];
    for (int c = 0; c < SEQ / TC; ++c) {
        if (wave < 7) { if (c + 1 >= SEQ / TC) asm volatile("s_waitcnt vmcnt(0)" ::: "memory"); else if (wave < 6) asm volatile("s_waitcnt vmcnt(4)" ::: "memory"); else asm volatile("s_waitcnt vmcnt(3)" ::: "memory"); }
        LBAR();
        if (wave < 7 && c + 2 < SEQ / TC) A2_DMA(c + 2);
        const LAS unsigned char* I = L + A2_IMG + (c % 3) * IMG2_B; const LAS unsigned char* IVT = I; const LAS unsigned char* IQ = I + VT_B; const LAS unsigned char* IG = I + VT_B + QPH_B;
        f32x16 acc = f32x16{};
        int ln = lane; asm volatile("" : "+v"(ln)); const int r32 = ln & 31, hi = ln >> 5;
        if (wave < 2) { tile_nt(acc, IQ, S64, 0, L + A2_S, S64, wave * 32, 4, ln); tile_nt(acc, IQ + O_PM, S32, 0, IVT + wave * 3072, S32, 0, 2, ln); }
        else if (wave < 6) { const int ni = (wave - 2) & 1, vi = (wave - 2) >> 1;
            tile_nt(acc, IG, S64, ni * 32, L + A2_S, S64, vi * 32, 4, ln); tile_nt(acc, IQ + O_HT, S32, ni * 32, IVT + vi * 3072, S32, 0, 2, ln); }
        else if (wave == 7) {
            if (c > 0) a2_epilogue((const LAS float*)(L + A2_YB + ((c - 1) & 1) * 8192) + est * 64 + ev0, gq, zq, MIX + (mrow0 + (size_t)(c - 1) * TC + est) * 1024 + hd * 64 + ev0);
            const size_t o = (mrow0 + (size_t)c * TC + est) * 512 + hd * 64 + ev0;
#pragma unroll
            for (int i = 0; i < 4; ++i) { gq[i] = *(const GAS v4u*)(GG + o + 8 * i); zq[i] = *(const GAS v4u*)(Z + o + 8 * i); }
        }
        LBAR();
        if (wave < 2) {
#pragma unroll
            for (int r = 0; r < 16; ++r) *(LAS float*)(L + A2_YB + (c & 1) * 8192 + (crow(r, hi) * 64 + wave * 32 + r32) * 4) = acc[r]; }
        else if (wave < 6) store_nat(L + A2_S, S64, ((wave - 2) >> 1) * 32, acc, ln, ((wave - 2) & 1) * 32);
    }
    LBAR();
    if (wave == 7) a2_epilogue((const LAS float*)(L + A2_YB + ((SEQ / TC - 1) & 1) * 8192) + est * 64 + ev0, gq, zq, MIX + (mrow0 + (size_t)(SEQ / TC - 1) * TC + est) * 1024 + hd * 64 + ev0);
    asm volatile("s_waitcnt vmcnt(0)" ::: "memory");
#undef A2_DMA
}
#undef ST16
}

constexpr size_t WS_XS = 264 * MiB, WS_HID = 536 * MiB, WS_YB = 672 * MiB;
constexpr size_t WS_X1B = 264 * MiB, X1B_XTRA = 3 * 1024 * 1024;
constexpr int SLOT_CAP = 65536;
constexpr int L_TB = 131072;
__device__ __forceinline__ void moe_tile_table(Frame& F) {
    LAS int* cnt = (LAS int*)(F.lds + L_TB); LAS int* tb = cnt + 32;
    if (F.tid < 32) cnt[F.tid] = (int)__hip_atomic_load(F.ctl + CW_CNT + 64 * F.tid, RLX_AGENT);
    __syncthreads();
    if (F.tid == 0) { int s = 0; for (int e = 0; e < 32; ++e) { tb[e] = s; s += (cnt[e] + 255) >> 8; } tb[32] = s; }
    __syncthreads();
}
__device__ __forceinline__ void m0_route(Frame& F) {
    LAS f32x4* Wg4 = (LAS f32x4*)(F.lds);
    LAS f32x4* Wr4 = (LAS f32x4*)(F.lds + 16384);
    LAS int* tokE = (LAS int*)(F.lds + 147456);
    LAS float* tokW = (LAS float*)(F.lds + 147456 + 2048);
    LAS int* hist = (LAS int*)(F.lds + 147456 + 4096);
    const float* wgrp = F.in[IN_WGRP]; const float* wrt = F.in[IN_WRT];
    for (int idx = F.tid; idx < 1024 * 4; idx += 512) { const int c = idx >> 2, j = idx & 3; const int l = (c & 255) >> 2, jj = (c >> 8) * 4 + (c & 3); ((LAS float*)Wg4)[(jj * 64 + l) * 4 + j] = wgrp[idx]; }
    for (int i0 = 0; i0 < 64; i0 += 16) { float wv_[16];
#pragma unroll
        for (int i = 0; i < 16; ++i) wv_[i] = wrt[F.tid + 512 * (i0 + i)];
#pragma unroll
        for (int i = 0; i < 16; ++i) { const int idx = F.tid + 512 * (i0 + i); const int c = idx >> 5, e = idx & 31; const int l = (c & 255) >> 2, jj = (c >> 8) * 4 + (c & 3); ((LAS float*)Wr4)[(((e >> 2) * 16 + jj) * 64 + l) * 4 + (e & 3)] = wv_[i]; } }
    const float* g2 = F.in[IN_N2G]; const float* mod = (const float*)(F.ws + WS_MOD); const float* bgrp = F.in[IN_BGRP]; const float* brt = F.in[IN_BRT];
    bf16* H2 = (bf16*)(F.ws + WS_H); int* slot_tok = (int*)(F.ws + WS_SLOT_TOK); float* slot_w = (float*)(F.ws + WS_SLOT_W); unsigned* tokinfo = (unsigned*)(F.ws + WS_TOKINFO);
    const float bg0 = bgrp[0], bg1 = bgrp[1], bg2 = bgrp[2], bg3 = bgrp[3];
    for (int rb = F.vcu; rb < NTOK / 256; rb += F.G) {
        if (F.tid < 32) hist[F.tid] = 0;
        __syncthreads();
        const int b = (rb * 256) / SEQ;
        f32x4 A[4], Bc[4];
#pragma unroll
        for (int j = 0; j < 4; ++j) { const int c = 4 * F.lane + 256 * j; const f32x4 g = *(const f32x4*)(g2 + c), sc = *(const f32x4*)(mod + (size_t)b * NMOD + 4096 + c); A[j] = g * (sc + 1.0f); Bc[j] = *(const f32x4*)(mod + (size_t)b * NMOD + 3072 + c); }
        const bf16* X1B = (const bf16*)(F.ws + WS_X1B) + (size_t)b * X1B_XTRA;
        v2u vn[4];
        { const GAS v2u* xr0 = (const GAS v2u*)(X1B + ((size_t)rb * 256 + F.wave) * 1024) + F.lane;
#pragma unroll
          for (int j = 0; j < 4; ++j) vn[j] = xr0[64 * j]; }
        for (int r = F.wave; r < 256; r += NWAVES) {
            const size_t m = (size_t)rb * 256 + r;
            f32x4 v[4]; float ss = 0.f;
#pragma unroll
            for (int j = 0; j < 4; ++j) v[j] = (f32x4){__uint_as_float(vn[j][0] << 16), __uint_as_float(vn[j][0] & 0xffff0000u), __uint_as_float(vn[j][1] << 16), __uint_as_float(vn[j][1] & 0xffff0000u)};
            if (r + NWAVES < 256) { const GAS v2u* xr = (const GAS v2u*)(X1B + (m + NWAVES) * 1024) + F.lane;
#pragma unroll
                for (int j = 0; j < 4; ++j) vn[j] = xr[64 * j]; }
#pragma unroll
            for (int j = 0; j < 4; ++j) ss += (v[j].x * v[j].x + v[j].y * v[j].y) + (v[j].z * v[j].z + v[j].w * v[j].w);
            const float rstd = 1.0f / sqrtf(wave_sum(ss) * (1.f / 1024.f) + 1e-6f);
            GAS unsigned long long* o8 = (GAS unsigned long long*)(H2 + m * 1024) + F.lane;
            f32x4 ga = (f32x4){0.f, 0.f, 0.f, 0.f};
#pragma unroll
            for (int j = 0; j < 4; ++j) { v[j] = v[j] * rstd * A[j] + Bc[j];
                o8[64 * j] = (unsigned long long)attn_body::cvtpk_s(v[j].x, v[j].y) | ((unsigned long long)attn_body::cvtpk_s(v[j].z, v[j].w) << 32);
#pragma unroll
                for (int i = 0; i < 4; ++i) ga += Wg4[(j * 4 + i) * 64 + F.lane] * v[j][i]; }
            float gv_[4] = {ga[0], ga[1], ga[2], ga[3]}, gt_[4]; wave_reduce4(gv_, gt_, F.lane);
            const float l0 = gt_[0] + bg0, l1 = gt_[1] + bg1, l2 = gt_[2] + bg2, l3 = gt_[3] + bg3;
            int gs = 0; float lm = l0; if (l1 > lm) { lm = l1; gs = 1; } if (l2 > lm) { lm = l2; gs = 2; } if (l3 > lm) { lm = l3; gs = 3; }
            const float pg = 1.0f / (__expf(l0 - lm) + __expf(l1 - lm) + __expf(l2 - lm) + __expf(l3 - lm));
            gs = __builtin_amdgcn_readfirstlane(gs);
            f32x4 e0 = (f32x4){0.f, 0.f, 0.f, 0.f}, e1 = e0;
            const LAS f32x4* w0p = Wr4 + (gs * 2) * 1024 + F.lane; const LAS f32x4* w1p = w0p + 1024;
#pragma unroll
            for (int j = 0; j < 4; ++j)
#pragma unroll
                for (int i = 0; i < 4; ++i) { e0 += w0p[(j * 4 + i) * 64] * v[j][i]; e1 += w1p[(j * 4 + i) * 64] * v[j][i]; }
            float el[8], ev_[8] = {e0[0], e0[1], e0[2], e0[3], e1[0], e1[1], e1[2], e1[3]}; wave_reduce8(ev_, el, F.lane);
#pragma unroll
            for (int q = 0; q < 8; ++q) el[q] += brt[gs * 8 + q];
            int i1 = 0; float m1 = el[0];
#pragma unroll
            for (int q = 1; q < 8; ++q) if (el[q] > m1) { m1 = el[q]; i1 = q; }
            int i2 = -1; float m2 = -3.0e38f;
#pragma unroll
            for (int q = 0; q < 8; ++q) if (q != i1 && el[q] > m2) { m2 = el[q]; i2 = q; }
            const float t = __expf(m2 - m1), w1 = pg / (1.0f + t), w2 = pg * t / (1.0f + t);
            if (F.lane == 0) { tokE[2 * r] = gs * 8 + i1; tokE[2 * r + 1] = gs * 8 + i2; tokW[2 * r] = w1; tokW[2 * r + 1] = w2; }
        }
        __syncthreads();
        const int ar = F.tid >> 1, ak = F.tid & 1, ae = tokE[2 * ar + ak];
        const int lpos = __hip_atomic_fetch_add(hist + ae, 1, __ATOMIC_RELAXED, __HIP_MEMORY_SCOPE_WORKGROUP);
        __syncthreads();
        if (F.tid < 32) { const int n = hist[F.tid]; hist[32 + F.tid] = n ? (int)__hip_atomic_fetch_add(F.ctl + CW_CNT + 64 * F.tid, (unsigned)n, RLX_AGENT) : 0; }
        __syncthreads();
        { const int pos = hist[32 + ae] + lpos; const int tok = rb * 256 + ar;
          slot_tok[(size_t)ae * SLOT_CAP + pos] = tok; slot_w[(size_t)ae * SLOT_CAP + pos] = tokW[2 * ar + ak]; tokinfo[2 * tok + ak] = ((unsigned)ae << 20) | (unsigned)pos; }
        __syncthreads();
    }
}
__device__ __forceinline__ void m1_permute(Frame& F) {
    moe_tile_table(F);
    const LAS int* cnt = (const LAS int*)(F.lds + L_TB); const LAS int* tb = cnt + 32;
    const bf16* H2 = (const bf16*)(F.ws + WS_H); bf16* XS = (bf16*)(F.ws + WS_XS); const int* slot_tok = (const int*)(F.ws + WS_SLOT_TOK);
    const int nrows = tb[32] * 256, gw = F.vcu * NWAVES + F.wave, NGW = F.G * NWAVES;
    for (int R = gw; R < nrows; R += NGW) {
        const int rt = R >> 8; int e = 0;
        for (int q = 1; q < 32; ++q) if (tb[q] <= rt) e = q;
        const int slot = (rt - tb[e]) * 256 + (R & 255);
        v4u a = (v4u){0u, 0u, 0u, 0u}, c = a;
        if (slot < cnt[e]) { const int tok = slot_tok[(size_t)e * SLOT_CAP + slot]; const GAS v4u* src = (const GAS v4u*)(H2 + (size_t)tok * 1024) + F.lane; a = src[0]; c = src[64]; }
        GAS v4u* dst = (GAS v4u*)(XS + (size_t)R * 1024) + F.lane; dst[0] = a; dst[64] = c;
    }
}
constexpr int L_TOKL = L_TB + 1024;
template <bool GATHER_> struct MoeOrder {
    static constexpr bool GATHER = GATHER_;
    const LAS int* tb; const LAS int* tokl; int G, c, nwg;
    __device__ __forceinline__ bool next(int i, pg8::Unit& u) const {
        const int Lq = i * G + c; if (Lq >= nwg) return false;
        const int rt = Lq >> 2; int e = 0;
        for (int q = 1; q < 32; ++q) if (tb[q] <= rt) e = q;
        u.pm = rt; u.pn = 4 * e + (Lq & 3); u.e = e; u.j = GATHER_ ? rt - tb[e] : i; return true;
    }
    __device__ __forceinline__ unsigned a_row(int ui, int row) const { return (unsigned)tokl[ui * 256 + row]; }
    __device__ __forceinline__ void a_ready(const pg8::Unit&) const {}
    __device__ __forceinline__ void done(const pg8::Unit&) const {}
};
__device__ __forceinline__ void moe_fill_tokl(Frame& F) {
    const LAS int* cnt = (const LAS int*)(F.lds + L_TB); const LAS int* tb = cnt + 32; LAS int* tokl = (LAS int*)(F.lds + L_TOKL);
    const int* slot_tok = (const int*)(F.ws + WS_SLOT_TOK); const int nwg = tb[32] * 4;
    for (int i = 0; i < 12; ++i) { const int Lq = i * F.G + F.vcu; if (Lq >= nwg) break;
        const int rt = Lq >> 2; int e = 0;
        for (int q = 1; q < 32; ++q) if (tb[q] <= rt) e = q;
        if (F.tid < 256) { const int slot = (rt - tb[e]) * 256 + F.tid; tokl[i * 256 + F.tid] = slot < cnt[e] ? slot_tok[(size_t)e * SLOT_CAP + slot] : 0; } }
    __syncthreads();
}
__device__ __forceinline__ void moe_fill_wl(Frame& F) {
    const LAS int* cnt = (const LAS int*)(F.lds + L_TB); const LAS int* tb = cnt + 32; LAS float* wl = (LAS float*)(F.lds + L_TOKL);
    const float* slot_w = (const float*)(F.ws + WS_SLOT_W); const int nwg = tb[32] * 4;
    for (int i = 0; i < 12; ++i) { const int Lq = i * F.G + F.vcu; if (Lq >= nwg) break;
        const int rt = Lq >> 2; int e = 0;
        for (int q = 1; q < 32; ++q) if (tb[q] <= rt) e = q;
        if (F.tid < 256) { const int slot = (rt - tb[e]) * 256 + F.tid; wl[i * 256 + F.tid] = slot < cnt[e] ? slot_w[(size_t)e * SLOT_CAP + slot] : 0.f; } }
    __syncthreads();
}
namespace pg8 {
struct EpiSwiGLU {
    static constexpr bool PERM = true, AFTER_DRAIN = false;
    bf16_t* HID;
    __device__ __forceinline__ void operator()(const f32x4 (&acc)[2][2][4][2], const Unit& u, int wr, int wc, int fr, int fq) const {
        const int row0 = u.pm * BM + wr * 64 + fr, col0 = (u.pn & 3) * 128 + wc * 32 + 8 * fq;
#pragma unroll
        for (int ai = 0; ai < 2; ++ai)
#pragma unroll
            for (int m = 0; m < 4; ++m) { f32x4 h[2];
#pragma unroll
                for (int n = 0; n < 2; ++n) { const f32x4 g = acc[ai][0][m][n], up = acc[ai][1][m][n];
#pragma unroll
                    for (int i = 0; i < 4; ++i) h[n][i] = g[i] / (1.0f + __expf(-g[i])) * up[i]; }
                u32x4 w; w.x = cvt_pk_bf16(h[0][0], h[0][1]); w.y = cvt_pk_bf16(h[0][2], h[0][3]); w.z = cvt_pk_bf16(h[1][0], h[1][1]); w.w = cvt_pk_bf16(h[1][2], h[1][3]);
                *(u32x4*)(HID + (size_t)(row0 + ai * HALF + m * 16) * 512 + col0) = w; }
    }
};
struct EpiDown {
    static constexpr bool PERM = true, AFTER_DRAIN = false;
    bf16_t* YB; const PG8_LAS float* wl;
    __device__ __forceinline__ void operator()(const f32x4 (&acc)[2][2][4][2], const Unit& u, int wr, int wc, int fr, int fq) const {
        const int rloc0 = wr * 64 + fr, col0 = (u.pn & 3) * BM + wc * 32 + 8 * fq;
#pragma unroll
        for (int ai = 0; ai < 2; ++ai)
#pragma unroll
            for (int m = 0; m < 4; ++m) { const int rloc = rloc0 + ai * HALF + m * 16; const float sc = wl[u.j * BM + rloc];
                bf16_t* rowp = YB + (size_t)(u.pm * BM + rloc) * 1024 + col0;
#pragma unroll
                for (int bj = 0; bj < 2; ++bj) { const f32x4 v0 = acc[ai][bj][m][0] * sc, v1 = acc[ai][bj][m][1] * sc;
                    u32x4 w; w.x = cvt_pk_bf16(v0[0], v0[1]); w.y = cvt_pk_bf16(v0[2], v0[3]); w.z = cvt_pk_bf16(v1[0], v1[1]); w.w = cvt_pk_bf16(v1[2], v1[3]);
                    *(u32x4*)(rowp + bj * HALF) = w; } }
    }
};
}
__device__ __forceinline__ void p_final(Frame& F) {
    moe_tile_table(F);
    const LAS int* tb = (const LAS int*)(F.lds + L_TB) + 32;
    const float* gf = F.in[IN_NFG]; const float* mod = (const float*)(F.ws + WS_MOD); const bf16* YB = (const bf16*)(F.ws + WS_YB); const unsigned* tokinfo = (const unsigned*)(F.ws + WS_TOKINFO);
    f32x4 G4[4];
#pragma unroll
    for (int j = 0; j < 4; ++j) G4[j] = *(const f32x4*)(gf + 4 * F.lane + 256 * j);
    const int gw = F.vcu * NWAVES + F.wave, NGW = F.G * NWAVES;
    const bf16* X1B = (const bf16*)(F.ws + WS_X1B);
    v2u xn[4], an[4], cn[4];
#define FIN_LOAD(mm) do { const unsigned i0_ = tokinfo[2 * (mm)], i1_ = tokinfo[2 * (mm) + 1]; \
        const size_t r0_ = (size_t)tb[i0_ >> 20] * 256 + (i0_ & 0xfffffu), r1_ = (size_t)tb[i1_ >> 20] * 256 + (i1_ & 0xfffffu); \
        const GAS v2u* xr_ = (const GAS v2u*)(X1B + (size_t)(mm) * 1024 + (size_t)((mm) / SEQ) * X1B_XTRA) + F.lane; const GAS v2u* y0_ = (const GAS v2u*)(YB + r0_ * 1024) + F.lane; const GAS v2u* y1_ = (const GAS v2u*)(YB + r1_ * 1024) + F.lane; \
        _Pragma("unroll") for (int j_ = 0; j_ < 4; ++j_) { xn[j_] = xr_[64 * j_]; an[j_] = y0_[64 * j_]; cn[j_] = y1_[64 * j_]; } } while (0)
    if (gw < NTOK) FIN_LOAD(gw);
    for (int m = gw; m < NTOK; m += NGW) {
        const int b = m / SEQ;
        GAS f32x4* xr = (GAS f32x4*)(F.out + (size_t)m * 1024) + F.lane;
        v2u xc[4], ac[4], cc[4];
#pragma unroll
        for (int j = 0; j < 4; ++j) { xc[j] = xn[j]; ac[j] = an[j]; cc[j] = cn[j]; }
        if (m + NGW < NTOK) FIN_LOAD(m + NGW);
        f32x4 v[4]; float ss = 0.f;
#pragma unroll
        for (int j = 0; j < 4; ++j) { const f32x4 gt = *(const f32x4*)(mod + (size_t)b * NMOD + 5120 + 4 * F.lane + 256 * j); const v2u a = ac[j], c = cc[j];
            f32x4 ff; ff[0] = __uint_as_float(a[0] << 16) + __uint_as_float(c[0] << 16); ff[1] = __uint_as_float(a[0] & 0xffff0000u) + __uint_as_float(c[0] & 0xffff0000u);
            ff[2] = __uint_as_float(a[1] << 16) + __uint_as_float(c[1] << 16); ff[3] = __uint_as_float(a[1] & 0xffff0000u) + __uint_as_float(c[1] & 0xffff0000u);
            const f32x4 x1 = (f32x4){__uint_as_float(xc[j][0] << 16), __uint_as_float(xc[j][0] & 0xffff0000u), __uint_as_float(xc[j][1] << 16), __uint_as_float(xc[j][1] & 0xffff0000u)};
            v[j] = x1 + gt * ff; ss += (v[j].x * v[j].x + v[j].y * v[j].y) + (v[j].z * v[j].z + v[j].w * v[j].w); }
        const float rstd = 1.0f / sqrtf(wave_sum(ss) * (1.f / 1024.f) + 1e-6f);
#if defined(MK_PROBE_A)
        { const unsigned long long* st = (const unsigned long long*)(F.ws + WS_CTL + 32768);
          const float ta = (float)(st[MK_PROBE_A + 1] - st[MK_PROBE_A]) * 0.01f, tb_ = (float)(st[MK_PROBE_B + 1] - st[MK_PROBE_B]) * 0.01f;
          const float sc = 1.0f + ta * 1e-4f;
#pragma unroll
          for (int j = 0; j < 4; ++j) v[j] = v[j] * sc;
          if (m == 0 && F.lane == 0) v[0][0] += tb_ * 0.02f / (rstd * G4[0][0]); }
#endif
#pragma unroll
        for (int j = 0; j < 4; ++j) xr[64 * j] = v[j] * rstd * G4[j];
    }
#undef FIN_LOAD
}
#ifndef MK_ONE_LAUNCH
#define MK_ONE_LAUNCH 1
#endif
constexpr int CW_ATT = 131072;
constexpr size_t WS_KXG_A = 19 * MiB + 512 * 1024, WS_KXG_B = 4 * MiB; constexpr int KXG_NA = 70;
static_assert((size_t)KXG_NA * attn_body::KX_IMG_BYTES <= 4 * MiB + 512 * 1024 && (size_t)(128 - KXG_NA) * attn_body::KX_IMG_BYTES <= 4 * MiB, "kx images");
__device__ __forceinline__ char* kxg_home(const Frame& F, int bh) { return (char*)F.ws + (bh < KXG_NA ? WS_KXG_A + (size_t)bh * attn_body::KX_IMG_BYTES : WS_KXG_B + (size_t)(bh - KXG_NA) * attn_body::KX_IMG_BYTES); }
struct AttnDyn {
    gu32* cnt; volatile LAS int* box; int bh_;
    __device__ __forceinline__ bool next(int, attn_body::AttnUnit& u) const {
        if (threadIdx.x == 0) *box = (int)__hip_atomic_fetch_add(cnt, 1u, RLX_AGENT);
        __syncthreads(); const int v = __builtin_amdgcn_readfirstlane(*box); __syncthreads();
        if (v >= 16) return false;
        u.bh = bh_; u.qb = 15 - v; return true; }
    __device__ __forceinline__ void a_ready(const attn_body::AttnUnit&) const {}
    __device__ __forceinline__ void done(const attn_body::AttnUnit&) const {}
};
__device__ __forceinline__ int attn_pick(gu32* cntb, volatile LAS int* box) {
    if (threadIdx.x == 0) { int best = -1, bw = 0;
        for (int h = 0; h < 8; ++h) { const int c = (int)__hip_atomic_load(cntb + 16 * h, RLX_AGENT); const int w = (c < 16) ? (16 - c) * (h + 2) : 0; if (w > bw) { bw = w; best = h; } }
        *box = best; }
    __syncthreads(); const int v = __builtin_amdgcn_readfirstlane(*box); __syncthreads();
    return v; }
constexpr int N_PHASES = 12;
struct Args { const float* in[28]; float* out; unsigned char* ws; int ph_lo, ph_hi; };
__global__ void __launch_bounds__(NWAVES * 64, 2) mk_fwd(Args args) {
    extern __shared__ __attribute__((aligned(16))) unsigned char lds[];
    Frame F;
    F.lds = (LAS unsigned char*)lds;
    F.MISC = (volatile LAS unsigned*)(F.lds + MISC_OFF);
    F.tid = threadIdx.x; F.lane = F.tid & 63; F.wave = __builtin_amdgcn_readfirstlane(F.tid >> 6);
    F.G = gridDim.x; { const int bx = blockIdx.x; F.vcu = (F.G % 8 == 0) ? (bx % 8) * (F.G / 8) + bx / 8 : bx; }
    F.ws = args.ws; F.out = args.out; F.ctl = (gu32*)(args.ws + WS_CTL);
    F.in.k = __builtin_amdgcn_kernarg_segment_ptr();
#define RELOAD_IN() do { kseg_t kp_ = __builtin_amdgcn_kernarg_segment_ptr(); asm volatile("" : "+s"(kp_)); F.in.k = kp_; } while (0)
    for (int u = F.tid; u < (LDS_BYTES - LDSCTL_OFF) / 4; u += NWAVES * 64) ((LAS unsigned*)(F.lds + LDSCTL_OFF))[u] = 0u;
    __syncthreads();
    const int lo = args.ph_lo, hi = args.ph_hi;
    int multi_ = __builtin_amdgcn_readfirstlane(((hi - lo) > 1) ? 1 : 0); asm volatile("" : "+s"(multi_)); const bool multi = multi_ != 0;
    XcdBarrier bar; bar.bar = (unsigned*)(F.ctl + CW_BAR); bar.x = 0; bar.st = nullptr; bar.gsz = 0; XcdBarrier bb = bar;
    if (multi) { bar = xcd_barrier_post((unsigned*)(F.ctl + CW_BAR), F.MISC + 8, gridDim.x);
        bb = xcd_barrier_post((unsigned*)(F.ctl + CW_BB + (F.vcu >> 4) * 4096), F.MISC + 10, 16u); }
#ifndef MK_REP_MASK
#define MK_REP_MASK 0
#endif
#ifndef MK_BATCH_BAR
#define MK_BATCH_BAR 1
#endif
#ifndef MK_ODD_ORDER
#define MK_ODD_ORDER 1
#endif
#define IN(k) (lo <= (k) && (k) < hi)
#define BOTH(k) (IN(k) && IN((k) + 1))
#define GRID_BAR() xcd_barrier(bar)
#define BATCH_BAR() do { if (MK_BATCH_BAR && F.G == 256) xcd_barrier(bb); else xcd_barrier(bar); } while (0)
#define STAMP(k) do {} while (0)
#ifndef MK_STAGN
#define MK_STAGN 4
#endif
#ifndef MK_STAG2
#define MK_STAG2 0
#endif
#ifndef MK_STAG7
#define MK_STAG7 0
#endif
#ifndef MK_STAG9
#define MK_STAG9 0
#endif
#ifndef MK_STAG10
#define MK_STAG10 0
#endif
#define STAGGER(step_) do { if ((step_) > 0) { const unsigned long long t0_ = __builtin_amdgcn_s_memrealtime(), d_ = (unsigned long long)((blockIdx.x >> 3) % MK_STAGN) * (step_); while (__builtin_amdgcn_s_memrealtime() - t0_ < d_) __builtin_amdgcn_s_sleep(8); } } while (0)
#define REDERIVE() do { int t_ = threadIdx.x; asm volatile("" : "+v"(t_)); F.tid = t_; F.lane = t_ & 63; F.wave = __builtin_amdgcn_readfirstlane(t_ >> 6); } while (0)

#ifndef MK_SPLIT_P0
#define MK_SPLIT_P0 0
#endif
    if (IN(0)) { RELOAD_IN(); if (MK_SPLIT_P0 && multi) p0_prologue<1>(F); else p0_prologue<0>(F); if (BOTH(0)) GRID_BAR(); }
    if (MK_SPLIT_P0 && multi && !((F.vcu >> 4) & 1)) { RELOAD_IN(); p0_prologue<2>(F); __syncthreads(); REDERIVE(); }
    if (IN(1)) { RELOAD_IN(); p1_norm(F); if (BOTH(1)) BATCH_BAR(); }

    if (IN(2)) { RELOAD_IN();
        pg8::Gemm g{(const pg8::bf16_t*)(F.ws + WS_H), (const pg8::bf16_t*)(F.ws + WS_WIN), NTOK, NPROJ, DMODEL}; pg8::BatchOrder S; S.init(NPROJ, F.vcu);
        pg8::EpiProj E{(pg8::bf16_t*)(F.ws + WS_PR), (pg8::bf16_t*)(F.ws + WS_PF), attn_body::C2};
        STAGGER(MK_STAG2);
        pg8::gemm_phase<pg8::EpiProj, pg8::BatchOrder, PG8_ALIGN, PG8_SP2>(F.lds + RING_OFF, g, S, E);
        if (BOTH(2)) BATCH_BAR();
    }
    REDERIVE();
    if (IN(3)) { RELOAD_IN(); r0_lora_inputs(F);
        if (F.G == 256 && (F.vcu & 15) < 8) {
            REDERIVE(); RELOAD_IN(); int vc = F.vcu; asm volatile("" : "+s"(vc)); const int b = vc >> 4, h = vc & 7; const attn_body::bf16* PF = (const attn_body::bf16*)(F.ws + WS_PF);
            int tt = threadIdx.x; asm volatile("" : "+v"(tt));
            __syncthreads();
            attn_body::fill_kx((char*)lds, (const float*)(F.ws + WS_FG), F.in[IN_FB][h], b, h, PF, PF + 512, tt);
            attn_body::kx_store((const char*)lds, kxg_home(F, b * 8 + h), tt); }
        if (multi) BATCH_BAR(); }
#ifndef MK_MID_ORDER
#define MK_MID_ORDER 1
#endif
    int odd = __builtin_amdgcn_readfirstlane(MK_ODD_ORDER ? (multi_ & (F.vcu >> 4) & 1) : 0); asm volatile("" : "+s"(odd));
    int mid = __builtin_amdgcn_readfirstlane(MK_MID_ORDER ? (odd & (F.vcu >> 5) & 1) : 0); asm volatile("" : "+s"(mid));
#ifndef MK_ATT_DYN
#define MK_ATT_DYN 0
#endif
#if MK_ATT_DYN
#define ATTN_GROUP() do { if (IN(3) && F.G == 256) { RELOAD_IN(); int vc = F.vcu; asm volatile("" : "+s"(vc)); \
            const int b = vc >> 4; int h = (vc & 15) >> 1; \
            const attn_body::bf16* PF = (const attn_body::bf16*)(F.ws + WS_PF); \
            const attn_body::AttnTensors AT{PF, PF + 512, PF + 1024, (attn_body::bf16*)(F.ws + WS_MIX) + 512}; \
            gu32* cntb = F.ctl + CW_ATT + b * 128; \
            _Pragma("nounroll") for (;;) { int tt = threadIdx.x; asm volatile("" : "+v"(tt)); \
                attn_body::kx_load((char*)lds, kxg_home(F, b * 8 + h), tt); \
                const AttnDyn S{cntb + 16 * h, (volatile LAS int*)(F.MISC + 12), b * 8 + h}; \
                attn_body::attn_phase<AttnDyn>((char*)lds + RING_OFF, AT, S); \
                h = attn_pick(cntb, (volatile LAS int*)(F.MISC + 12)); if (h < 0) break; } \
            __syncthreads(); } REDERIVE(); } while (0)
#else
#define ATTN_PASS(pass_) do { int vc = F.vcu; asm volatile("" : "+s"(vc)); \
                const int g4 = vc >> 2, b = g4 >> 2, hp = g4 & 3, h = (pass_) ? 7 - hp : hp; \
                const attn_body::bf16* PF = (const attn_body::bf16*)(F.ws + WS_PF); \
                const attn_body::AttnTensors AT{PF, PF + 512, PF + 1024, (attn_body::bf16*)(F.ws + WS_MIX) + 512}; \
                int tt = threadIdx.x; asm volatile("" : "+v"(tt)); \
                attn_body::kx_load((char*)lds, kxg_home(F, b * 8 + h), tt); \
                const attn_body::StaticOrder S(vc, b * 8 + h); \
                attn_body::attn_phase<attn_body::StaticOrder>((char*)lds + RING_OFF, AT, S); \
                __syncthreads(); } while (0)
#define ATTN_GROUP() do { if (IN(3) && F.G == 256) { RELOAD_IN(); ATTN_PASS(0); ATTN_PASS(1); } REDERIVE(); } while (0)
#endif
#if defined(MK_TWAITV)
    if (!odd) { ATTN_GROUP(); const unsigned long long tw0_ = __builtin_amdgcn_s_memrealtime(); if (multi) BATCH_BAR();
        if (F.vcu == MK_TWAITV && threadIdx.x == 0) { const unsigned long long w_ = 4ull * (__builtin_amdgcn_s_memrealtime() - tw0_), t0_ = __builtin_amdgcn_s_memrealtime(); while (__builtin_amdgcn_s_memrealtime() - t0_ < w_) __builtin_amdgcn_s_sleep(8); }
        __syncthreads(); }
#else
    if (!odd) { ATTN_GROUP(); if (multi) BATCH_BAR(); }
#endif
    if (IN(4)) { RELOAD_IN(); if (F.G == 256) scan2::build(F); if (BOTH(4)) BATCH_BAR(); }
    REDERIVE();
#if MK_ODD_ORDER && MK_MID_ORDER
    asm volatile("" : "+s"(mid));
    if (mid) ATTN_GROUP();
#endif
    if (IN(5)) { RELOAD_IN(); if (F.G == 256) scan2::apply(F); if (BOTH(5)) BATCH_BAR(); }
    REDERIVE();
    if (IN(6)) { RELOAD_IN(); r2_post(F); }
    REDERIVE();
#if MK_ODD_ORDER
    asm volatile("" : "+s"(odd), "+s"(mid));
    if (odd && !mid) ATTN_GROUP();
#endif
#undef ATTN_GROUP
    if (multi) BATCH_BAR();
    if (IN(7)) { RELOAD_IN();
        pg8::Gemm g{(const pg8::bf16_t*)(F.ws + WS_MIX), (const pg8::bf16_t*)(F.ws + WS_WOUT), NTOK, DMODEL, DMODEL}; pg8::BatchOrder S; S.init(DMODEL, F.vcu);
        pg8::EpiResB E{F.in[IN_X], (pg8::bf16_t*)(F.ws + WS_X1B), (const float*)(F.ws + WS_MOD) + 2048, SEQ, X1B_XTRA};
        STAGGER(MK_STAG7);
        pg8::gemm_phase<pg8::EpiResB, pg8::BatchOrder, PG8_ALIGN, PG8_SP2>(F.lds + RING_OFF, g, S, E);
        if (BOTH(7)) BATCH_BAR();
    }
    REDERIVE();
    if (IN(8)) { RELOAD_IN(); m0_route(F); if (MK_SPLIT_P0 && multi && ((F.vcu >> 4) & 1)) { __syncthreads(); REDERIVE(); RELOAD_IN(); p0_prologue<2>(F); }
#if defined(MK_TWAIT8)
        { const unsigned long long tw0_ = __builtin_amdgcn_s_memrealtime(); if (BOTH(8)) GRID_BAR();
          if (F.vcu == MK_TWAIT8 && threadIdx.x == 0) { const unsigned long long w_ = 4ull * (__builtin_amdgcn_s_memrealtime() - tw0_), t0_ = __builtin_amdgcn_s_memrealtime(); while (__builtin_amdgcn_s_memrealtime() - t0_ < w_) __builtin_amdgcn_s_sleep(8); }
          __syncthreads(); } }
#else
        if (BOTH(8)) GRID_BAR(); }
#endif
    REDERIVE();
    if (IN(9)) { RELOAD_IN();
        moe_tile_table(F); moe_fill_tokl(F);
        const LAS int* tb = (const LAS int*)(F.lds + L_TB) + 32;
        pg8::Gemm g{(const pg8::bf16_t*)(F.ws + WS_H), (const pg8::bf16_t*)(F.ws + WS_W1), 0, 0, DMODEL}; MoeOrder<true> S{tb, (const LAS int*)(F.lds + L_TOKL), F.G, F.vcu, tb[32] * 4};
        pg8::EpiSwiGLU E{(pg8::bf16_t*)(F.ws + WS_HID)};
        STAGGER(MK_STAG9);
        pg8::gemm_phase<pg8::EpiSwiGLU, MoeOrder<true>, PG8_ALIGN, PG8_SP2>(F.lds + RING_OFF, g, S, E);
        if (BOTH(9)) GRID_BAR();
    }
    REDERIVE();
    if (IN(10)) { RELOAD_IN();
        moe_tile_table(F); moe_fill_wl(F);
        const LAS int* tb = (const LAS int*)(F.lds + L_TB) + 32;
        pg8::Gemm g{(const pg8::bf16_t*)(F.ws + WS_HID), (const pg8::bf16_t*)(F.ws + WS_W2), 0, 0, DEXP}; MoeOrder<false> S{tb, nullptr, F.G, F.vcu, tb[32] * 4};
        pg8::EpiDown E{(pg8::bf16_t*)(F.ws + WS_YB), (const LAS float*)(F.lds + L_TOKL)};
        STAGGER(MK_STAG10);
        pg8::gemm_phase<pg8::EpiDown, MoeOrder<false>, PG8_ALIGN, PG8_SP2>(F.lds + RING_OFF, g, S, E);
        if (BOTH(10)) GRID_BAR();
    }
    REDERIVE();
    if (IN(11)) { RELOAD_IN(); p_final(F); }
#undef IN
#undef BOTH
}

extern "C" void kernel_launch(void* const* d_in, const int* in_sizes, int n_in, void* d_out, int out_size, void* d_ws, size_t ws_size, hipStream_t stream) {
    static int grid = 0;
    if (grid == 0) {
        if (n_in != 28 || in_sizes[0] != NTOK * DMODEL || out_size != NTOK * DMODEL || ws_size < WS_END) {
            fprintf(stderr, "kernel_launch: unexpected shapes: n_in %d in0 %d out %d ws %zu (need %zu); nothing launched\n", n_in, n_in > 0 ? in_sizes[0] : -1, out_size, ws_size, (size_t)WS_END); grid = -1; return; }
        int dev = 0, cus = 0, per_cu = 0;
        if (hipGetDevice(&dev) != hipSuccess || hipDeviceGetAttribute(&cus, hipDeviceAttributeMultiprocessorCount, dev) != hipSuccess) { grid = -1; return; }
        if (hipFuncSetAttribute((const void*)mk_fwd, hipFuncAttributeMaxDynamicSharedMemorySize, LDS_BYTES) != hipSuccess) { fprintf(stderr, "kernel_launch: hipFuncSetAttribute failed\n"); grid = -1; return; }
        if (hipOccupancyMaxActiveBlocksPerMultiprocessor(&per_cu, (const void*)mk_fwd, NWAVES * 64, LDS_BYTES) != hipSuccess || per_cu < 1) { fprintf(stderr, "kernel_launch: occupancy query says %d blocks per CU\n", per_cu); per_cu = 1; }
        (void)hipGetLastError();
        grid = cus;
        if (grid != 256) fprintf(stderr, "kernel_launch: %d CUs; this kernel is tuned for 256\n", grid);
    }
    if (grid < 0) return;
    if (hipMemsetAsync((char*)d_ws + WS_CTL, 0, CTL_ZERO_BYTES, stream) != hipSuccess) return;
    Args a{};
    for (int i = 0; i < 28; ++i) a.in[i] = (const float*)d_in[i];
    a.out = (float*)d_out; a.ws = (unsigned char*)d_ws;
#if MK_ONE_LAUNCH
    a.ph_lo = 0; a.ph_hi = N_PHASES;
    hipLaunchKernelGGL(mk_fwd, dim3(grid), dim3(NWAVES * 64), LDS_BYTES, stream, a);
#else
    for (int p = 0; p < N_PHASES; ++p) for (int rep = 0; rep < 1 + ((MK_REP_MASK >> p) & 1); ++rep) { a.ph_lo = p; a.ph_hi = p + 1; hipLaunchKernelGGL(mk_fwd, dim3(grid), dim3(NWAVES * 64), LDS_BYTES, stream, a); }
#endif
}
```

```cpp
#include <hip/hip_runtime.h>
#include <hip/hip_bf16.h>
#include <hip/hip_fp16.h>
#include <cstdio>
#include <cstdint>
#include <cmath>
namespace pg8 {
#define PG8_LAS __attribute__((address_space(3)))
typedef unsigned short bf16_t;
typedef short bf16x8 __attribute__((ext_vector_type(8)));
typedef float f32x4 __attribute__((ext_vector_type(4)));
typedef unsigned u32x4 __attribute__((ext_vector_type(4)));
constexpr int BM = 256, BK = 64, HALF = 128, HTB = HALF * BK * 2  , STAGE_BYTES = 8 * HTB, NXCD = 8, WGM = 2;

__host__ __device__ __forceinline__ int lds_byte(int r, int c) { const int st = (r >> 4) * 2 + (c >> 5), rr = r & 15, cc = c & 31, ob = rr * 64 + cc * 2; return st * 1024 + (ob ^ (((ob >> 9) & 1) << 5)); }
__host__ __device__ __forceinline__ void stage_rc(int b, int& R, int& C) { const int st = b / 1024, sb = b % 1024, swz = sb ^ (((sb >> 9) & 1) << 5); R = (st >> 1) * 16 + swz / 64; C = (st & 1) * 32 + (swz % 64) / 2; }
__host__ __device__ __forceinline__ int perm32(int rho) { const int n = rho >> 4, i = rho & 15; return 8 * (i >> 2) + 4 * n + (i & 3); }

struct Unit { int pm, pn, e, j; };
struct Gemm { const bf16_t* A; const bf16_t* Bt; int M, N, K; };

#ifndef MK_BWGM
#define MK_BWGM 2
#endif
constexpr int BWGM = MK_BWGM;
struct BatchOrder {
    static constexpr bool GATHER = false;
    __device__ __forceinline__ unsigned a_row(int, int) const { return 0u; }
    int nN, nwb, vcu;
    __host__ __device__ void init(int N, int vcu_) { nN = N / BM; nwb = 16 * nN; vcu = vcu_; }
    __host__ __device__ bool next(int i, Unit& u) const {
        const int w = i * 16 + (vcu & 15); if (w >= nwb) return false;
        const int nig = BWGM * nN, gid = w / nig, r = w % nig;
        u.pm = (vcu >> 4) * 16 + gid * BWGM + r % BWGM; u.pn = r / BWGM; u.e = 0; u.j = 0; return true;
    }
    __device__ __forceinline__ void a_ready(const Unit&) const {}
    __device__ __forceinline__ void done(const Unit&) const {}
};
struct RowOrder {
    static constexpr bool GATHER = false;
    __device__ __forceinline__ unsigned a_row(int, int) const { return 0u; }
    int nN, vcu;
    __host__ __device__ void init(int N, int vcu_) { nN = N / BM; vcu = vcu_; }
    __host__ __device__ bool next(int i, Unit& u) const { if (i >= nN) return false; u.pm = vcu; u.pn = (i + (vcu & 3)) % nN; u.e = 0; u.j = 0; return true; }
    __device__ __forceinline__ void a_ready(const Unit&) const {}
    __device__ __forceinline__ void done(const Unit&) const {}
};
struct StaticOrder {
    static constexpr bool GATHER = false;
    __device__ __forceinline__ unsigned a_row(int, int) const { return 0u; }
    int nM, nN, nwg, G, c;
    __host__ __device__ void init(int M, int N, int G_, int c_) { nM = M / BM; nN = N / BM; nwg = nM * nN; G = G_; c = c_; }
    __host__ __device__ bool next(int i, Unit& u) const {
        const long L = (long)i * G + c; if (L >= nwg) return false;
        int wgid = (int)L; { const int q = nwg / NXCD, r = nwg % NXCD, xcd = wgid % NXCD, off = wgid / NXCD; wgid = (xcd < r ? xcd * (q + 1) : r * (q + 1) + (xcd - r) * q) + off; }
        const int nig = WGM * nN, gid = wgid / nig, fm = gid * WGM, gsz = (nM - fm) < WGM ? (nM - fm) : WGM;
        u.pm = fm + ((wgid % nig) % gsz); u.pn = (wgid % nig) / gsz; u.e = 0; u.j = 0; return true;
    }
    __device__ __forceinline__ void a_ready(const Unit&) const {}
    __device__ __forceinline__ void done(const Unit&) const {}
};


__device__ __forceinline__ unsigned cvt_pk_bf16(float lo, float hi) { unsigned r; asm volatile("v_cvt_pk_bf16_f32 %0, %1, %2" : "=v"(r) : "v"(lo), "v"(hi)); return r; }

struct EpiProj {
    static constexpr bool PERM = true, AFTER_DRAIN = false; static constexpr int PART_STORES = 8, PF_LOADS = 0;
    bf16_t* PR; bf16_t* PF; float qscale;
    __device__ __forceinline__ void operator()(const f32x4 (&acc)[2][2][4][2], const Unit& u, int wr, int wc, int fr, int fq) const { part(acc, u, wr, wc, fr, fq, 0); part(acc, u, wr, wc, fr, fq, 1); }
    __device__ __forceinline__ void part(const f32x4 (&acc)[2][2][4][2], const Unit& u, int wr, int wc, int fr, int fq, const int ai) const {
        const int row0 = u.pm * BM + wr * 64 + fr;
        bf16_t* base; int ldc, colt; float sc = 1.f;
        if (u.pn < 7) { base = PR; ldc = 1792; colt = u.pn * BM; } else { base = PF; ldc = 1536; colt = (u.pn - 7) * BM; if (u.pn < 9) sc = qscale; }
        const int col0 = colt + wc * 32 + 8 * fq;
#pragma unroll
            for (int m = 0; m < 4; ++m) { bf16_t* rowp = base + (size_t)(row0 + ai * HALF + m * 16) * ldc + col0;
#pragma unroll
                for (int bj = 0; bj < 2; ++bj) { const f32x4 v0 = acc[ai][bj][m][0] * sc, v1 = acc[ai][bj][m][1] * sc;
                    u32x4 w; w.x = cvt_pk_bf16(v0[0], v0[1]); w.y = cvt_pk_bf16(v0[2], v0[3]); w.z = cvt_pk_bf16(v1[0], v1[1]); w.w = cvt_pk_bf16(v1[2], v1[3]);
                    *(u32x4*)(rowp + bj * HALF) = w; } }
    }
};
struct EpiRes {
    static constexpr bool PERM = false, AFTER_DRAIN = false; static constexpr int PF_LOADS = 0;
    const float* x; float* out; const float* gate; int rows_per_batch;
    __device__ __forceinline__ void operator()(const f32x4 (&acc)[2][2][4][2], const Unit& u, int wr, int wc, int fr, int fq) const {
        const int b = (u.pm * BM) / rows_per_batch; const float* g = gate + (size_t)b * 6144;
        const int col0 = u.pn * BM + wc * 32 + 4 * fq;
#pragma unroll
        for (int bj = 0; bj < 2; ++bj)
#pragma unroll
            for (int n = 0; n < 2; ++n) { const f32x4 gv = *(const f32x4*)(g + col0 + bj * HALF + n * 16);
#pragma unroll
                for (int ai = 0; ai < 2; ++ai)
#pragma unroll
                    for (int m = 0; m < 4; ++m) { const size_t off = (size_t)(u.pm * BM + ai * HALF + wr * 64 + m * 16 + fr) * 1024 + col0 + bj * HALF + n * 16;
                        const f32x4 xv = *(const f32x4*)(x + off); *(f32x4*)(out + off) = xv + gv * acc[ai][bj][m][n]; } }
    }
};

struct EpiResB {
    static constexpr bool PERM = true, AFTER_DRAIN = false;
#ifndef PG8_XPF
#define PG8_XPF 0
#endif
    static constexpr int PF_LOADS = PG8_XPF;
    const float* x; bf16_t* out; const float* gate; int rows_per_batch; size_t out_xtra;
    __device__ __forceinline__ void prefetch(const Unit& u, int wr, int wc, int fr, int fq) const { const int lane = fq * 16 + fr;
        unsigned o_ = (unsigned)((u.pm * BM + wr * 64 + lane) * 1024 + u.pn * BM + wc * 32) * 4u, d_;
        asm volatile("global_load_dword %0, %1, %2\n\tglobal_load_dword %0, %1, %2 offset:512" : "=&v"(d_) : "v"(o_), "s"(x) : "memory");
        o_ += (unsigned)HALF * 4096u;
        asm volatile("global_load_dword %0, %1, %2\n\tglobal_load_dword %0, %1, %2 offset:512" : "=&v"(d_) : "v"(o_), "s"(x) : "memory");
    }
    __device__ __forceinline__ void operator()(const f32x4 (&acc)[2][2][4][2], const Unit& u, int wr, int wc, int fr, int fq) const {
        const int b = (u.pm * BM) / rows_per_batch; const float* g = gate + (size_t)b * 6144; bf16_t* outb = out + (size_t)b * out_xtra;
        const int col0 = u.pn * BM + wc * 32 + 8 * fq;
#pragma unroll
        for (int bj = 0; bj < 2; ++bj) { const f32x4 g0 = *(const f32x4*)(g + col0 + bj * HALF), g1 = *(const f32x4*)(g + col0 + bj * HALF + 4);
#pragma unroll
            for (int ai = 0; ai < 2; ++ai)
#pragma unroll
                for (int m = 0; m < 4; ++m) { const size_t off = (size_t)(u.pm * BM + ai * HALF + wr * 64 + m * 16 + fr) * 1024 + col0 + bj * HALF;
                    const f32x4 v0 = *(const f32x4*)(x + off) + g0 * acc[ai][bj][m][0], v1 = *(const f32x4*)(x + off + 4) + g1 * acc[ai][bj][m][1];
                    u32x4 w; w.x = cvt_pk_bf16(v0[0], v0[1]); w.y = cvt_pk_bf16(v0[2], v0[3]); w.z = cvt_pk_bf16(v1[0], v1[1]); w.w = cvt_pk_bf16(v1[2], v1[3]);
                    *(u32x4*)(outb + off) = w; } }
    }
};
template <int N> __device__ __forceinline__ void pg8_wait_vn() { asm volatile("s_waitcnt vmcnt(%0)" :: "n"(N) : "memory"); }
template <class Epi, class Sched, bool ALIGN_EPI = false, bool SP2 = false, bool DEFER = false>
__device__ __forceinline__ void gemm_phase(PG8_LAS unsigned char* lds, const Gemm g, const Sched& S, const Epi& E) {
    int tid_ = threadIdx.x; asm volatile("" : "+v"(tid_));
    const int tid = tid_, wid = __builtin_amdgcn_readfirstlane(tid >> 6), lane = tid & 63, wr = wid >> 2, wc = wid & 3, fr = lane & 15, fq = lane >> 4;
    const int K = g.K, nt = K / BK;
    unsigned voffA[2], voffB[2];
#pragma unroll
    for (int i = 0; i < 2; ++i) { int R, C; stage_rc(tid * 16 + i * 8192, R, C); const int Rb = Epi::PERM ? ((R & ~31) + perm32(R & 31)) : R;
        voffA[i] = (unsigned)(R * K + C) * 2u; voffB[i] = (unsigned)(Rb * K + C) * 2u; }
    constexpr bool GATHER = Sched::GATHER;
    int gR[2], gC[2];
#pragma unroll
    for (int i = 0; i < 2; ++i) stage_rc(tid * 16 + i * 8192, gR[i], gC[i]);
    unsigned offC[2][2] = {{0u, 0u}, {0u, 0u}}, offN[2][2] = {{0u, 0u}, {0u, 0u}};
#define PG8_GOFF(dst, ui_) do { _Pragma("unroll") for (int h_ = 0; h_ < 2; ++h_) _Pragma("unroll") for (int i_ = 0; i_ < 2; ++i_) dst[h_][i_] = (unsigned)(S.a_row((ui_), 128 * h_ + gR[i_]) * (unsigned)K + (unsigned)gC[i_]) * 2u; } while (0)
#define PG8_STAGE_A(bufoff, ptr, h, nx) do { if constexpr (GATHER) { unsigned o_[2] = {(nx) ? offN[h][0] : offC[h][0], (nx) ? offN[h][1] : offC[h][1]}; PG8_STAGE(bufoff, ptr, o_); } else { PG8_STAGE(bufoff, (ptr) + (h) * hstep, voffA); } } while (0)
    const size_t kstep = (size_t)(BK * 2);
    const size_t hstep = (size_t)HALF * K * 2;
    const size_t tstep = 2 * hstep;
    const unsigned ldsw = (unsigned)wid * 1024u;
    const int aoff = lds_byte(wr * 64 + fr, fq * 8), boff = lds_byte(wc * 32 + fr, fq * 8);
#define PG8_SA(b, h) (((b) * 2 + (h)) * HTB)
#define PG8_SB(b, h) ((4 + (b) * 2 + (h)) * HTB)
#define PG8_STAGE(bufoff, gbase, voff) do { _Pragma("unroll") for (int _i = 0; _i < 2; ++_i) \
        __builtin_amdgcn_global_load_lds((const unsigned*)((const char*)(gbase) + (voff)[_i]), (PG8_LAS unsigned*)(lds + (bufoff) + ldsw + _i * 8192), 16, 0, 0); } while (0)
#define PG8_LDA(dst, b, h) do { _Pragma("unroll") for (int m = 0; m < 4; ++m) _Pragma("unroll") for (int k = 0; k < 2; ++k) dst[m][k] = *(const PG8_LAS bf16x8*)(lds + PG8_SA(b, h) + aoff + m * 2048 + k * 1024); } while (0)
#define PG8_LDB(dst, b, h) do { _Pragma("unroll") for (int n = 0; n < 2; ++n) _Pragma("unroll") for (int k = 0; k < 2; ++k) dst[n][k] = *(const PG8_LAS bf16x8*)(lds + PG8_SB(b, h) + boff + n * 2048 + k * 1024); } while (0)
#define PG8_MMA(ai, bj, At, Bt) do { __builtin_amdgcn_s_setprio(1); _Pragma("unroll") for (int m = 0; m < 4; ++m) _Pragma("unroll") for (int n = 0; n < 2; ++n) _Pragma("unroll") for (int k = 0; k < 2; ++k) \
        acc[ai][bj][m][n] = __builtin_amdgcn_mfma_f32_16x16x32_bf16(Bt[n][k], At[m][k], acc[ai][bj][m][n], 0, 0, 0); __builtin_amdgcn_s_setprio(0); } while (0)
#define PG8_WAIT_V(n) asm volatile("s_waitcnt vmcnt(" #n ")" ::: "memory")
#define PG8_WAIT_L(n) asm volatile("s_waitcnt lgkmcnt(" #n ")" ::: "memory")
#define PG8_BAR __builtin_amdgcn_s_barrier()
#define PG8_SCHED __builtin_amdgcn_sched_barrier(0)
    Unit cur, nxt, prv; int ui = 0; bool pend = false;
    static_assert(!DEFER || (SP2 && !ALIGN_EPI), "DEFER needs the SP2 loop without ALIGN_EPI");
    if (!S.next(0, cur)) return;
    prv = cur;
    f32x4 acc[2][2][4][2];
#pragma unroll
    for (int a = 0; a < 2; ++a)
#pragma unroll
        for (int b = 0; b < 2; ++b)
#pragma unroll
            for (int m = 0; m < 4; ++m)
#pragma unroll
                for (int n = 0; n < 2; ++n) acc[a][b][m][n] = (f32x4){0.f, 0.f, 0.f, 0.f};
    bf16x8 At[4][2], B0[2][2], B1[2][2];
    const char* cA = GATHER ? (const char*)g.A : (const char*)g.A + (size_t)cur.pm * tstep; const char* cB = (const char*)g.Bt + (size_t)cur.pn * tstep;
    if constexpr (GATHER) PG8_GOFF(offC, 0);
    S.a_ready(cur);
    if constexpr (SP2) {
        PG8_STAGE(PG8_SB(0, 0), cB, voffB); PG8_STAGE(PG8_SB(0, 1), cB + hstep, voffB); PG8_STAGE_A(PG8_SA(0, 0), cA, 0, false); PG8_STAGE_A(PG8_SA(0, 1), cA, 1, false);
        if (wr == 1) PG8_BAR;
        PG8_WAIT_V(2); PG8_BAR;
        PG8_STAGE(PG8_SB(1, 0), cB + kstep, voffB); PG8_STAGE_A(PG8_SA(1, 0), cA + kstep, 0, false); PG8_STAGE(PG8_SB(1, 1), cB + hstep + kstep, voffB);
        PG8_WAIT_V(6); PG8_BAR;
    } else {
        PG8_STAGE(PG8_SB(0, 0), cB, voffB); PG8_STAGE(PG8_SA(0, 0), cA, voffA); PG8_STAGE(PG8_SB(0, 1), cB + hstep, voffB); PG8_STAGE(PG8_SA(0, 1), cA + hstep, voffA);
        if (wr == 1) PG8_BAR;
        PG8_WAIT_V(4); PG8_BAR;
        PG8_STAGE(PG8_SB(1, 0), cB + kstep, voffB); PG8_STAGE(PG8_SA(1, 0), cA + kstep, voffA); PG8_STAGE(PG8_SB(1, 1), cB + hstep + kstep, voffB);
        PG8_WAIT_V(6); PG8_BAR;
    }
    for (;;) {
        const bool has_next = S.next(ui + 1, nxt);
        const char* nA = GATHER ? cA : (has_next ? (const char*)g.A + (size_t)nxt.pm * tstep : cA); const char* nB = has_next ? (const char*)g.Bt + (size_t)nxt.pn * tstep : cB;
        if constexpr (GATHER) { if (has_next) PG8_GOFF(offN, ui + 1); else { _Pragma("unroll") for (int h_ = 0; h_ < 2; ++h_) _Pragma("unroll") for (int i_ = 0; i_ < 2; ++i_) offN[h_][i_] = offC[h_][i_]; } }
        for (int t = 0; t < nt; t += 2) {
            const bool last = (t == nt - 2);
            const char* a1 = cA + (size_t)(t + 1) * kstep;
            const char* a2 = last ? nA : cA + (size_t)(t + 2) * kstep; const char* b2 = last ? nB : cB + (size_t)(t + 2) * kstep;
            const char* a3 = a2 + kstep; const char* b3 = b2 + kstep;
            if (last && has_next) S.a_ready(nxt);
            if constexpr (SP2) {
            bool df = false; if constexpr (DEFER) df = pend && (t == 0);
            bool pf = false; if constexpr (Epi::PF_LOADS > 0) pf = (t == 2);
#define PG8_ZERO_AI(ai_) do { _Pragma("unroll") for (int b_ = 0; b_ < 2; ++b_) _Pragma("unroll") for (int m_ = 0; m_ < 4; ++m_) _Pragma("unroll") for (int n_ = 0; n_ < 2; ++n_) acc[ai_][b_][m_][n_] = (f32x4){0.f, 0.f, 0.f, 0.f}; } while (0)
            if constexpr (DEFER) { if (df) { PG8_STAGE_A(PG8_SA(1, 1), a1, 1, false); E.part(acc, prv, wr, wc, fr, fq, 0); PG8_ZERO_AI(0); PG8_SCHED;
                                             PG8_LDB(B0, 0, 0); PG8_LDB(B1, 0, 1); PG8_SCHED; PG8_LDA(At, 0, 0); pg8_wait_vn<8 + Epi::PART_STORES>(); }
                                   else    { PG8_LDB(B0, 0, 0); PG8_LDB(B1, 0, 1); PG8_SCHED; PG8_LDA(At, 0, 0); PG8_STAGE_A(PG8_SA(1, 1), a1, 1, false); PG8_WAIT_V(8); } }
            else { if constexpr (Epi::PF_LOADS > 0) { if (pf) { E.prefetch(cur, wr, wc, fr, fq); PG8_SCHED; } }
                   PG8_LDB(B0, 0, 0); PG8_LDB(B1, 0, 1); PG8_SCHED; PG8_LDA(At, 0, 0); PG8_STAGE_A(PG8_SA(1, 1), a1, 1, false);
                   if constexpr (Epi::PF_LOADS > 0) { if (pf) pg8_wait_vn<8 + Epi::PF_LOADS>(); else PG8_WAIT_V(8); } else PG8_WAIT_V(8); }
            PG8_WAIT_L(0); PG8_BAR; PG8_MMA(0, 0, At, B0); PG8_MMA(0, 1, At, B1); PG8_BAR; PG8_SCHED;
            if constexpr (DEFER) { if (df) { PG8_STAGE(PG8_SB(0, 0), b2, voffB); PG8_STAGE(PG8_SB(0, 1), b2 + hstep, voffB); PG8_STAGE_A(PG8_SA(0, 0), a2, 0, last); E.part(acc, prv, wr, wc, fr, fq, 1); PG8_ZERO_AI(1); PG8_SCHED;
                                             PG8_LDA(At, 0, 1); pg8_wait_vn<8 + 2 * Epi::PART_STORES>(); }
                                   else    { PG8_LDA(At, 0, 1); PG8_STAGE(PG8_SB(0, 0), b2, voffB); PG8_STAGE(PG8_SB(0, 1), b2 + hstep, voffB); PG8_STAGE_A(PG8_SA(0, 0), a2, 0, last); PG8_WAIT_V(8); } }
            else { PG8_LDA(At, 0, 1); PG8_STAGE(PG8_SB(0, 0), b2, voffB); PG8_STAGE(PG8_SB(0, 1), b2 + hstep, voffB); PG8_STAGE_A(PG8_SA(0, 0), a2, 0, last);
                   if constexpr (Epi::PF_LOADS > 0) { if (pf) pg8_wait_vn<8 + Epi::PF_LOADS>(); else PG8_WAIT_V(8); } else PG8_WAIT_V(8); }
            PG8_WAIT_L(0); PG8_BAR; PG8_MMA(1, 0, At, B0); PG8_MMA(1, 1, At, B1); PG8_BAR; PG8_SCHED;
            PG8_LDB(B0, 1, 0); PG8_LDB(B1, 1, 1); PG8_SCHED; PG8_LDA(At, 1, 0); PG8_STAGE_A(PG8_SA(0, 1), a2, 1, last);
            if constexpr (DEFER) { if (df) pg8_wait_vn<8 + 2 * Epi::PART_STORES>(); else PG8_WAIT_V(8); } else PG8_WAIT_V(8);
            PG8_WAIT_L(0); PG8_BAR; PG8_MMA(0, 0, At, B0); PG8_MMA(0, 1, At, B1); PG8_BAR; PG8_SCHED;
            PG8_LDA(At, 1, 1); PG8_STAGE(PG8_SB(1, 0), b3, voffB); PG8_STAGE(PG8_SB(1, 1), b3 + hstep, voffB); PG8_STAGE_A(PG8_SA(1, 0), a3, 0, last);
            if constexpr (DEFER) { if (df) { pg8_wait_vn<8 + Epi::PART_STORES>(); S.done(prv); pend = false; } else PG8_WAIT_V(8); } else PG8_WAIT_V(8);
            PG8_WAIT_L(0); PG8_BAR; PG8_MMA(1, 0, At, B0); PG8_MMA(1, 1, At, B1); PG8_BAR; PG8_SCHED;
            } else {
            PG8_LDB(B0, 0, 0); PG8_SCHED; PG8_LDA(At, 0, 0); PG8_STAGE(PG8_SA(1, 1), a1 + hstep, voffA);
            PG8_WAIT_L(8); PG8_BAR; PG8_WAIT_L(0); PG8_MMA(0, 0, At, B0); PG8_BAR; PG8_SCHED;
            PG8_LDB(B1, 0, 1); PG8_STAGE(PG8_SB(0, 0), b2, voffB);
            PG8_BAR; PG8_WAIT_L(0); PG8_MMA(0, 1, At, B1); PG8_BAR;
            PG8_LDA(At, 0, 1); PG8_STAGE(PG8_SA(0, 0), a2, voffA);
            PG8_BAR; PG8_WAIT_L(0); PG8_MMA(1, 0, At, B0); PG8_BAR; PG8_SCHED;
            PG8_STAGE(PG8_SB(0, 1), b2 + hstep, voffB);
            PG8_WAIT_V(6); PG8_BAR; PG8_MMA(1, 1, At, B1); PG8_BAR;
            PG8_LDB(B0, 1, 0); PG8_SCHED; PG8_LDA(At, 1, 0); PG8_STAGE(PG8_SA(0, 1), a2 + hstep, voffA);
            PG8_WAIT_L(8); PG8_BAR; PG8_WAIT_L(0); PG8_MMA(0, 0, At, B0); PG8_BAR; PG8_SCHED;
            PG8_LDB(B1, 1, 1); PG8_STAGE(PG8_SB(1, 0), b3, voffB);
            PG8_BAR; PG8_WAIT_L(0); PG8_MMA(0, 1, At, B1); PG8_BAR;
            PG8_LDA(At, 1, 1); PG8_STAGE(PG8_SA(1, 0), a3, voffA);
            PG8_BAR; PG8_WAIT_L(0); PG8_MMA(1, 0, At, B0); PG8_BAR; PG8_SCHED;
            PG8_STAGE(PG8_SB(1, 1), b3 + hstep, voffB);
            PG8_WAIT_V(6); PG8_BAR; PG8_MMA(1, 1, At, B1); PG8_BAR;
            }
        }
        if constexpr (ALIGN_EPI) { if (wr == 0) PG8_BAR; }
#if defined(MK_EPI2)
        if constexpr (!Epi::AFTER_DRAIN) { E(acc, cur, wr, wc, fr, fq); asm volatile("" ::: "memory"); }
#endif
        if constexpr (DEFER) { if (has_next) { pend = true; prv = cur; } else { E(acc, cur, wr, wc, fr, fq); S.done(cur); } }
        else if constexpr (!Epi::AFTER_DRAIN) { E(acc, cur, wr, wc, fr, fq); S.done(cur); }
        if (!has_next) break;
        if constexpr (!DEFER) {
#pragma unroll
        for (int a = 0; a < 2; ++a)
#pragma unroll
            for (int b = 0; b < 2; ++b)
#pragma unroll
                for (int m = 0; m < 4; ++m)
#pragma unroll
                    for (int n = 0; n < 2; ++n) acc[a][b][m][n] = (f32x4){0.f, 0.f, 0.f, 0.f};
        }
        cur = nxt; cA = nA; cB = nB; ++ui;
        if constexpr (GATHER) { _Pragma("unroll") for (int h_ = 0; h_ < 2; ++h_) _Pragma("unroll") for (int i_ = 0; i_ < 2; ++i_) offC[h_][i_] = offN[h_][i_]; }
        if constexpr (ALIGN_EPI) { if (wr == 1) PG8_BAR; }
    }
    PG8_WAIT_V(0);
    if constexpr (!ALIGN_EPI) { if (wr == 0) PG8_BAR; }
    PG8_BAR;
    if constexpr (Epi::AFTER_DRAIN) { E.fused(acc, cur, wr, wc, fr, fq, lds, wid, lane); S.done(cur); }
#undef PG8_SA
#undef PG8_SB
#undef PG8_STAGE
#undef PG8_STAGE_A
#undef PG8_GOFF
#undef PG8_LDA
#undef PG8_LDB
#undef PG8_MMA
#undef PG8_WAIT_V
#undef PG8_WAIT_L
#undef PG8_BAR
#undef PG8_SCHED
#undef PG8_ZERO_AI
}
}

#ifndef PG8_SP2
#define PG8_SP2 true
#endif
#ifndef PG8_ALIGN
#define PG8_ALIGN true
#endif
namespace attn_body {
using bf16=__hip_bfloat16;
using bf16x8=__attribute__((ext_vector_type(8)))short;
using s16x4=__attribute__((ext_vector_type(4)))short;
using f32x16=__attribute__((ext_vector_type(16)))float;
using u32x4=__attribute__((ext_vector_type(4)))unsigned;
constexpr int BATCH=16,NHEAD=8,SEQ=4096,D=64,DMQ=1536,DMO=1024;
constexpr int NW=8,QBLK=32,QB=QBLK*NW,KVBLK=64,NQB=SEQ/QB;
constexpr int ATTN_UNIT_ROWS=QB;
__device__ __forceinline__ int crow(int r,int hi){return (r&3)+8*(r>>2)+4*hi;}
#define SBAR() __builtin_amdgcn_sched_barrier(0)
__device__ __forceinline__ void cmask(f32x16&p0,f32x16&p1,int jb,int qrel,int hi){
  const float NEG=-INFINITY; asm volatile("":"+v"(hi)); int kb=64*jb+4*hi;
  #pragma unroll
  for(int r=0;r<16;++r){int kv=kb+(r&3)+8*(r>>2); if(kv>qrel)p0[r]=NEG; if(kv+32>qrel)p1[r]=NEG;}
}

constexpr int NSLOT=3, SLOTB=8192;
constexpr int LDS_K=0, LDS_V=NSLOT*SLOTB, LDS_WS=2*NSLOT*SLOTB, LDS_OST=LDS_WS+NW*64*4, LDS_KX=LDS_OST+NW*4096, LDS_CB=LDS_KX+SEQ*16+16, LDS_BYTES=LDS_CB+1024;
constexpr float C2=0.125f*1.4426950408889634f;
__device__ __forceinline__ void glds16(const void*gsrc,unsigned lds_dst){unsigned keep;
  asm volatile("s_mov_b32 %0, m0\n\ts_mov_b32 m0, %2\n\ts_nop 0\n\tglobal_load_lds_dwordx4 %1, off\n\ts_mov_b32 m0, %0":"=&s"(keep):"v"(gsrc),"s"(lds_dst):"memory");}
__device__ __forceinline__ float max3f(float a,float b,float c){float r;asm("v_max3_f32 %0, %1, %2, %3":"=v"(r):"v"(a),"v"(b),"v"(c));return r;}
__device__ __forceinline__ float max2f(float a,float b){float r;asm("v_max_f32_e32 %0, %1, %2":"=v"(r):"v"(a),"v"(b));return r;}
__device__ __forceinline__ float fadd_s(float a,float b){float r;asm("v_add_f32_e32 %0, %1, %2":"=v"(r):"v"(a),"v"(b));return r;}
__device__ __forceinline__ float fsub_s(float a,float b){float r;asm("v_sub_f32_e32 %0, %1, %2":"=v"(r):"v"(a),"v"(b));return r;}
typedef float f32x2_t __attribute__((ext_vector_type(2))); typedef __bf16 bf16x2_t __attribute__((ext_vector_type(2)));
__device__ __forceinline__ unsigned cvtpk_s(float lo,float hi){f32x2_t v={lo,hi};bf16x2_t b=__builtin_convertvector(v,bf16x2_t);return __builtin_bit_cast(unsigned,b);}
#define WAIT_BAR(N) asm volatile("s_waitcnt vmcnt(" #N ") lgkmcnt(0)\n\ts_barrier":::"memory")

__device__ __forceinline__ void qkt(f32x16&p0,f32x16&p1,const char*Kslot,const bf16x8*qr,bf16x8 kx0,bf16x8 kx1,bf16x8 qx,int r32,int hi){
  const char*kb=Kslot+hi*1024+r32*16; const f32x16 z16=f32x16{};
  p0=__builtin_amdgcn_mfma_f32_32x32x16_bf16(kx0,qx,z16,0,0,0);p1=__builtin_amdgcn_mfma_f32_32x32x16_bf16(kx1,qx,z16,0,0,0);
  #pragma unroll
  for(int d0=0;d0<4;++d0){
    const bf16x8 b0=*reinterpret_cast<const bf16x8*>(kb+d0*2048);
    const bf16x8 b1=*reinterpret_cast<const bf16x8*>(kb+d0*2048+512);
    p0=__builtin_amdgcn_mfma_f32_32x32x16_bf16(b0,qr[d0],p0,0,0,0);p1=__builtin_amdgcn_mfma_f32_32x32x16_bf16(b1,qr[d0],p1,0,0,0);}
}
typedef __attribute__((address_space(3))) const char* lds_cptr;
typedef short v4i16_t __attribute__((ext_vector_type(4)));
__device__ __forceinline__ void kload8(bf16x8*kf,lds_cptr kp){
  kf[0]=*(const __attribute__((address_space(3))) bf16x8*)(kp);      kf[1]=*(const __attribute__((address_space(3))) bf16x8*)(kp+512);
  kf[2]=*(const __attribute__((address_space(3))) bf16x8*)(kp+2048); kf[3]=*(const __attribute__((address_space(3))) bf16x8*)(kp+2560);
  kf[4]=*(const __attribute__((address_space(3))) bf16x8*)(kp+4096); kf[5]=*(const __attribute__((address_space(3))) bf16x8*)(kp+4608);
  kf[6]=*(const __attribute__((address_space(3))) bf16x8*)(kp+6144); kf[7]=*(const __attribute__((address_space(3))) bf16x8*)(kp+6656);
}
__device__ __forceinline__ void kload2(bf16x8*kf,lds_cptr kp,int j){ kf[2*j]=*(const __attribute__((address_space(3))) bf16x8*)(kp+j*2048); kf[2*j+1]=*(const __attribute__((address_space(3))) bf16x8*)(kp+j*2048+512); }
__device__ __forceinline__ s16x4 vtr(lds_cptr p){ return __builtin_bit_cast(s16x4,__builtin_amdgcn_ds_read_tr16_b64_v4i16((__attribute__((address_space(3))) v4i16_t*)p)); }
__device__ __forceinline__ float rowmax(const f32x16&p0,const f32x16&p1){
  float a=max3f(p0[0],p0[1],p1[0]),b=max3f(p0[2],p0[3],p1[1]);a=max3f(a,p1[2],p1[3]);
  #pragma unroll
  for(int r=4;r<16;r+=4){a=max3f(a,p0[r],p0[r+1]);b=max3f(b,p0[r+2],p0[r+3]);a=max3f(a,p1[r],p1[r+1]);b=max3f(b,p1[r+2],p1[r+3]);}
  const float m=max2f(a,b);
  auto rr=__builtin_amdgcn_permlane32_swap(__float_as_uint(m),__float_as_uint(m),false,false);
  return max2f(__uint_as_float(rr[0]),__uint_as_float(rr[1]));
}
__device__ __forceinline__ void pv(f32x16*o,int vb,bf16x8 pa0,bf16x8 pa1,bf16x8 pa2,bf16x8 pa3){
  #pragma unroll
  for(int d0=0;d0<2;++d0){s16x4 lo[4],hi[4];
    #pragma unroll
    for(int ks=0;ks<4;++ks){
      asm volatile("ds_read_b64_tr_b16 %0,%1 offset:%c2":"=&v"(lo[ks]):"v"(vb),"i"(d0*4096+ks*1024):"memory");
      asm volatile("ds_read_b64_tr_b16 %0,%1 offset:%c2":"=&v"(hi[ks]):"v"(vb),"i"(d0*4096+ks*1024+512):"memory");}
    asm volatile("s_waitcnt lgkmcnt(0)":::"memory");SBAR();
    #define PK(k) (bf16x8){lo[k][0],lo[k][1],lo[k][2],lo[k][3],hi[k][0],hi[k][1],hi[k][2],hi[k][3]}
    o[d0]=__builtin_amdgcn_mfma_f32_32x32x16_bf16(pa0,PK(0),o[d0],0,0,0);
    o[d0]=__builtin_amdgcn_mfma_f32_32x32x16_bf16(pa1,PK(1),o[d0],0,0,0);
    o[d0]=__builtin_amdgcn_mfma_f32_32x32x16_bf16(pa2,PK(2),o[d0],0,0,0);
    o[d0]=__builtin_amdgcn_mfma_f32_32x32x16_bf16(pa3,PK(3),o[d0],0,0,0);
    #undef PK
  }
}

#ifndef ATTN_STORE16
#define ATTN_STORE16(p,v) (*(u32x4*)(p)=(v))
#endif
template<int THRL> __device__ __forceinline__ void attn_unit(int b,int h,int qb,int ts,const bf16*Q,const bf16*__restrict__ K,const bf16*__restrict__ V,bf16*O,char*shm){
#if defined(MK_TATT)
  const unsigned long long tu0_=__builtin_amdgcn_s_memrealtime();
#endif
  int tid_=threadIdx.x; asm volatile("":"+v"(tid_));
  const int tid=tid_,lane=tid&63,r32=lane&31,hi=lane>>5; const int wid=__builtin_amdgcn_readfirstlane(tid>>6);
  const long rowbase=(long)b*SEQ; const int q0=qb*QB;
  const bf16*Qw=Q+(rowbase+q0+wid*QBLK)*DMQ+h*D;
  const bf16*Kh=K+(rowbase+(long)ts*KVBLK)*DMQ+h*D,*Vh=V+(rowbase+(long)ts*KVBLK)*DMQ+h*D;
  const unsigned lds0=(unsigned)(uintptr_t)shm;
  float*wsf=(float*)(shm+LDS_WS)+wid*64;
  auto wsh_=[&]()->const float*{ int h_=hi; asm volatile("":"+v"(h_)); return wsf+4*h_; };
  const bf16*ksrc=Kh+(long)lane*DMQ+wid*8;
  const bf16*vsrc=Vh+(long)(16*(wid&3)+(lane>>2))*DMQ+(wid>>2)*32+(lane&3)*8;
  const unsigned kdst=lds0+LDS_K+wid*1024, vdst=lds0+LDS_V+wid*1024;
  #define DMA_K(t,slot) glds16(ksrc+(long)(t)*KVBLK*DMQ,(unsigned)__builtin_amdgcn_readfirstlane(kdst+(slot)))
  #define DMA_V(t,slot) glds16(vsrc+(long)(t)*KVBLK*DMQ,(unsigned)__builtin_amdgcn_readfirstlane(vdst+(slot)))
  const int vb0=(int)(lds0+LDS_V)+((lane>>4)&1)*32+(lane&3)*8+(4*hi+((lane&15)>>2))*64;
  const char*Kbase=shm+LDS_K; bf16x8 kf[8];
  const lds_cptr shm3=(lds_cptr)shm; const lds_cptr kp0=shm3+LDS_K+hi*1024+r32*16; const lds_cptr vp0=shm3+LDS_V+((lane>>4)&1)*32+(lane&3)*8+(4*hi+((lane&15)>>2))*64;
  const int NT=(q0+QB)/KVBLK-ts;
  DMA_K(0,0);DMA_V(0,0);DMA_K(1,SLOTB);
  bf16x8 qr[4];
  #pragma unroll
  for(int d0=0;d0<4;++d0)qr[d0]=*reinterpret_cast<const bf16x8*>(&Qw[(long)r32*DMQ+d0*16+hi*8]);
  float mhat=0.f,l_reg=0.f;f32x16 o[2];o[0]=f32x16{};o[1]=f32x16{};
  const lds_cptr kxp0=(lds_cptr)shm+LDS_KX+ts*1024+r32*16;
  u32x4 qxw; qxw[0]=hi?0u:0x3F803F80u; qxw[1]=hi?0u:0x00003F80u; qxw[2]=0u; qxw[3]=0u;
  #define SETQX() do{ const float m_=-mhat; const unsigned h1_=cvtpk_s(m_,0.f)&0xffffu; const float r1_=m_-__uint_as_float(h1_<<16); const unsigned h2_=cvtpk_s(r1_,0.f)&0xffffu; const float r2_=r1_-__uint_as_float(h2_<<16); \
      const unsigned h3_=cvtpk_s(r2_,0.f)&0xffffu; qxw[1]=hi?0u:(0x3F80u|(h1_<<16)); qxw[2]=hi?0u:(h2_|(h3_<<16)); asm volatile("":"+v"(qxw)); }while(0)
  #define QX __builtin_bit_cast(bf16x8,qxw)
  #define KXF(t,n) (*(const __attribute__((address_space(3))) bf16x8*)(kxp0+(t)*1024+(n)*512))
  const int qrel=wid*QBLK+r32;
  #define CMASK(P0,P1,t) do{int jb_=(t)-(NT-4); if(jb_>=0)cmask(P0,P1,jb_,qrel,hi);}while(0)
  bool resc=false;
  #define START(P0,P1) do{ const float rm=rowmax(P0,P1); resc=false; \
    { const float dl=rm; mhat=fadd_s(mhat,dl); \
      _Pragma("unroll") for(int r=0;r<16;++r){P0[r]=fsub_s(P0[r],dl);P1[r]=fsub_s(P1[r],dl);} \
      SETQX(); } \
    _Pragma("unroll") for(int r=0;r<16;++r)P0[r]=__builtin_amdgcn_exp2f(P0[r]); }while(0)
  #define RESC() do{ if(resc){ asm volatile("s_waitcnt lgkmcnt(0)":::"memory"); \
      _Pragma("unroll") for(int d_=0;d_<2;++d_) _Pragma("unroll") for(int r=0;r<16;++r)o[d_][r]*=wsh_()[(r&3)+8*(r>>2)]; } }while(0)
  f32x16 pA0,pA1,pB0,pB1;
  int sl_prev=0,sl_cur=0,sl_next=SLOTB;
  #define ROT() do{sl_prev=sl_cur;sl_cur=sl_next;sl_next=(sl_next==(NSLOT-1)*SLOTB)?0:sl_next+SLOTB;}while(0)
  DMA_K(2,2*SLOTB);
  WAIT_BAR(3);
  qkt(pA0,pA1,Kbase,qr,KXF(0,0),KXF(0,1),QX,r32,hi);asm volatile("s_nop 15\n\ts_nop 7":"+v"(pA0),"+v"(pA1));CMASK(pA0,pA1,0);
  START(pA0,pA1);
  _Pragma("unroll") for(int r=0;r<16;++r)pA1[r]=__builtin_amdgcn_exp2f(pA1[r]);
  WAIT_BAR(0);
  DMA_K(3,0);DMA_V(1,SLOTB);
  ROT();
  kload8(kf,kp0+sl_cur);
  WAIT_BAR(2);
  s16x4 vlo[8],vhi[8]; u32x4 pw0,pw1,pw2,pw3;
  #define PKW(P,B) cvtpk_s(P[B],P[B+1])
  #define PAF(k) __builtin_bit_cast(bf16x8,pw##k)
  #define VFR(i) (bf16x8){vlo[i][0],vlo[i][1],vlo[i][2],vlo[i][3],vhi[i][0],vhi[i][1],vhi[i][2],vhi[i][3]}
  #define PIN(x) asm volatile("":"+v"(x))
  #define MX3(a,b,c) __builtin_fmaxf(__builtin_fmaxf((a),(b)),(c))
  #define GAPA(MF,A0,A1,A2,A3,W0,W1,PW) do{ MF; sacc+=A0; sacc+=A1; sacc+=A2; sacc+=A3; PIN(sacc); W0; W1; PIN(PW); SBAR(); }while(0)
  #define EX(v) __builtin_amdgcn_exp2f(v)
  #define GAPB(MF,X,B) do{ MF; X[B]=EX(X[B]); X[B+1]=EX(X[B+1]); X[B+2]=EX(X[B+2]); X[B+3]=EX(X[B+3]); PIN(X); SBAR(); }while(0)
  #define VRD(i) do{ vlo[i]=vtr(vp_+(((i)>>2)*4096+((i)&3)*1024)); vhi[i]=vtr(vp_+(((i)>>2)*4096+((i)&3)*1024+512)); }while(0)
  #define KRD(G,j) do{ if(G){ kload2(kf,kp0+sl_next,j); SBAR(); } }while(0)
  #define STEP(C0,C1,P0,P1,t,GK,GV,GL) do{ SBAR(); \
    const lds_cptr vp_=vp0+sl_prev; const f32x16 z16_=f32x16{}; \
    const bf16x8 kx0_=KXF(t,0), kx1_=KXF(t,1); \
    VRD(0); SBAR(); float sacc=(P0[0]+P0[1]); \
    GAPA(C0=__builtin_amdgcn_mfma_f32_32x32x16_bf16(kf[0],qr[0],z16_,0,0,0), P0[2],P0[3],P0[4],P0[5],     pw0[0]=PKW(P0,0), pw0[1]=PKW(P0,2), pw0); \
    VRD(4); SBAR(); GAPA(C1=__builtin_amdgcn_mfma_f32_32x32x16_bf16(kf[1],qr[0],z16_,0,0,0), P0[6],P0[7],P0[8],P0[9],     pw0[2]=PKW(P0,4), pw0[3]=PKW(P0,6), pw0); \
    VRD(1); SBAR(); GAPA(C0=__builtin_amdgcn_mfma_f32_32x32x16_bf16(kf[2],qr[1],C0,0,0,0),   P0[10],P0[11],P0[12],P0[13], pw1[0]=PKW(P0,8), pw1[1]=PKW(P0,10), pw1); \
    VRD(5); SBAR(); GAPA(C1=__builtin_amdgcn_mfma_f32_32x32x16_bf16(kf[3],qr[1],C1,0,0,0),   P0[14],P0[15],P1[0],P1[1],   pw1[2]=PKW(P0,12),pw1[3]=PKW(P0,14), pw1); \
    VRD(2); SBAR(); GAPA(C0=__builtin_amdgcn_mfma_f32_32x32x16_bf16(kf[4],qr[2],C0,0,0,0),   P1[2],P1[3],P1[4],P1[5],     pw2[0]=PKW(P1,0), pw2[1]=PKW(P1,2), pw2); \
    VRD(6); SBAR(); GAPA(C1=__builtin_amdgcn_mfma_f32_32x32x16_bf16(kf[5],qr[2],C1,0,0,0),   P1[6],P1[7],P1[8],P1[9],     pw2[2]=PKW(P1,4), pw2[3]=PKW(P1,6), pw2); \
    VRD(3); SBAR(); GAPA(C0=__builtin_amdgcn_mfma_f32_32x32x16_bf16(kf[6],qr[3],C0,0,0,0),   P1[10],P1[11],P1[12],P1[13], pw3[0]=PKW(P1,8), pw3[1]=PKW(P1,10), pw3); \
    VRD(7); SBAR(); GAPA(C1=__builtin_amdgcn_mfma_f32_32x32x16_bf16(kf[7],qr[3],C1,0,0,0),   P1[14],P1[15],0.f,0.f,       pw3[2]=PKW(P1,12),pw3[3]=PKW(P1,14), pw3); \
    C0=__builtin_amdgcn_mfma_f32_32x32x16_bf16(kx0_,QX,C0,0,0,0); SBAR(); C1=__builtin_amdgcn_mfma_f32_32x32x16_bf16(kx1_,QX,C1,0,0,0); SBAR(); \
    l_reg+=sacc; \
    if(GK){DMA_K((t)+3,sl_cur);} if(GV){DMA_V((t)+1,sl_next);} \
    CMASK(C0,C1,t); \
    { float a=MX3(C0[0],C0[1],C1[0]),b=MX3(C0[2],C0[3],C1[1]); a=MX3(a,C1[2],C1[3]); \
      _Pragma("unroll") for(int r=4;r<16;r+=4){a=MX3(a,C0[r],C0[r+1]);b=MX3(b,C0[r+2],C0[r+3]);a=MX3(a,C1[r],C1[r+1]);b=MX3(b,C1[r+2],C1[r+3]);} \
      float rm=__builtin_fmaxf(a,b); { auto rr=__builtin_amdgcn_permlane32_swap(__float_as_uint(rm),__float_as_uint(rm),false,false); rm=__builtin_fmaxf(__uint_as_float(rr[0]),__uint_as_float(rr[1])); } \
      resc=false; \
      if(__builtin_expect(__any(rm>(float)THRL),0)){ const float dl=__builtin_fmaxf(rm,0.f); mhat+=dl; \
        _Pragma("unroll") for(int r=0;r<16;++r){C0[r]-=dl;C1[r]-=dl;} \
        SETQX(); \
        const float f=__builtin_amdgcn_exp2f(-dl); l_reg*=f; if(hi==0)wsf[r32]=f; resc=true; } } \
    SBAR(); \
    GAPB(o[0]=__builtin_amdgcn_mfma_f32_32x32x16_bf16(PAF(0),VFR(0),o[0],0,0,0), C0,0); \
    GAPB(o[1]=__builtin_amdgcn_mfma_f32_32x32x16_bf16(PAF(0),VFR(4),o[1],0,0,0), C0,4); \
    KRD(GL,0); GAPB(o[0]=__builtin_amdgcn_mfma_f32_32x32x16_bf16(PAF(1),VFR(1),o[0],0,0,0), C0,8); \
    KRD(GL,1); GAPB(o[1]=__builtin_amdgcn_mfma_f32_32x32x16_bf16(PAF(1),VFR(5),o[1],0,0,0), C0,12); \
    KRD(GL,2); GAPB(o[0]=__builtin_amdgcn_mfma_f32_32x32x16_bf16(PAF(2),VFR(2),o[0],0,0,0), C1,0); \
    KRD(GL,3); GAPB(o[1]=__builtin_amdgcn_mfma_f32_32x32x16_bf16(PAF(2),VFR(6),o[1],0,0,0), C1,4); \
    GAPB(o[0]=__builtin_amdgcn_mfma_f32_32x32x16_bf16(PAF(3),VFR(3),o[0],0,0,0), C1,8); \
    GAPB(o[1]=__builtin_amdgcn_mfma_f32_32x32x16_bf16(PAF(3),VFR(7),o[1],0,0,0), C1,12); \
    }while(0)
#if defined(MK_TATT)
  if(MK_TATT==1&&threadIdx.x==0)((unsigned long long*)(shm+LDS_CB))[90]+=__builtin_amdgcn_s_memrealtime()-tu0_;
#endif
  int t=1;
  #undef CMASK
  #define CMASK(P0,P1,t) do{}while(0)
  for(;t+5<NT;t+=2){
    STEP(pB0,pB1,pA0,pA1,t,true,true,true);     WAIT_BAR(2); RESC(); ROT();
    STEP(pA0,pA1,pB0,pB1,t+1,true,true,true);   WAIT_BAR(2); RESC(); ROT();
  }
  #undef CMASK
  #define CMASK(P0,P1,t) do{int jb_=(t)-(NT-4); if(jb_>=0)cmask(P0,P1,jb_,qrel,hi);}while(0)
  #define ENDW(tt) do{ if((tt)+3<NT){WAIT_BAR(2);} else if((tt)+2<NT){WAIT_BAR(1);} else {WAIT_BAR(0);} }while(0)
  for(;t+1<NT;t+=2){
    STEP(pB0,pB1,pA0,pA1,t,(t+3<NT),(t+1<NT),(t+1<NT));       ENDW(t);   RESC(); ROT();
    STEP(pA0,pA1,pB0,pB1,t+1,(t+4<NT),(t+2<NT),(t+2<NT));     ENDW(t+1); RESC(); ROT();
  }
  STEP(pB0,pB1,pA0,pA1,NT-1,false,false,false); RESC();
#if defined(MK_TATT)
  const unsigned long long tu1_=__builtin_amdgcn_s_memrealtime();
  if(MK_TATT==3&&threadIdx.x==0)((unsigned long long*)(shm+LDS_CB))[90]+=(unsigned long long)NT;
#endif
  { float sacc=pB0[0]+pB0[1]; _Pragma("unroll") for(int r=2;r<16;++r)sacc+=pB0[r]; _Pragma("unroll") for(int r=0;r<16;++r)sacc+=pB1[r]; l_reg+=sacc;
    pw0=(u32x4){PKW(pB0,0),PKW(pB0,2),PKW(pB0,4),PKW(pB0,6)};pw1=(u32x4){PKW(pB0,8),PKW(pB0,10),PKW(pB0,12),PKW(pB0,14)};pw2=(u32x4){PKW(pB1,0),PKW(pB1,2),PKW(pB1,4),PKW(pB1,6)};pw3=(u32x4){PKW(pB1,8),PKW(pB1,10),PKW(pB1,12),PKW(pB1,14)};
    SBAR(); pv(o,vb0+sl_cur,PAF(0),PAF(1),PAF(2),PAF(3)); }
  #undef PKW
  #undef PAF
  #undef VFR
  #undef PIN
  #undef MX3
  #undef GAPA
  #undef GAPB
  #undef EX
  #undef VRD
  #undef KRD
  #undef STEP
  #undef ENDW
  {auto rr=__builtin_amdgcn_permlane32_swap(__float_as_uint(l_reg),__float_as_uint(l_reg),false,false);l_reg=__uint_as_float(rr[0])+__uint_as_float(rr[1]);}
  if(hi==0)wsf[32+r32]=l_reg;asm volatile("s_waitcnt lgkmcnt(0)":::"memory");
  float rli[16];
  #pragma unroll
  for(int r=0;r<16;++r)rli[r]=__builtin_amdgcn_rcpf(wsh_()[32+(r&3)+8*(r>>2)]);
  bf16*Ow=O+(rowbase+q0+wid*QBLK)*DMO+h*D;
  { bf16*stg=(bf16*)(shm+LDS_OST)+wid*2048;
    #pragma unroll
    for(int r=0;r<16;++r){const int orow=crow(r,hi);
      #pragma unroll
      for(int d0=0;d0<2;++d0)stg[orow*64+d0*32+r32]=__float2bfloat16(o[d0][r]*rli[r]);}
    asm volatile("s_waitcnt lgkmcnt(0)":::"memory");
    #pragma unroll
    for(int i=0;i<4;++i){const int row=i*8+(lane>>3),ch=lane&7; const u32x4 v=*(const u32x4*)(stg+row*64+ch*8); ATTN_STORE16(Ow+(long)row*DMO+ch*8,v);} }
  asm volatile("s_waitcnt lgkmcnt(0)\n\ts_barrier":::"memory");
#if defined(MK_TATT)
  if(MK_TATT==2&&threadIdx.x==0)((unsigned long long*)(shm+LDS_CB))[90]+=__builtin_amdgcn_s_memrealtime()-tu1_;
#endif
  #undef DMA_K
  #undef DMA_V
  #undef SETQX
  #undef QX
  #undef KXF
  #undef CMASK
  #undef START
  #undef RESC
  #undef ROT
}
constexpr int ATTN_LDS_BYTES=LDS_BYTES;
constexpr int KX_GA=3;
template<int MODE=0> __device__ __forceinline__ void fill_kx(char*shm,const float*FG,float fbias,int b,int h,const bf16*Q,const bf16*K,int tid,float*gbound=nullptr){
  const int lane=tid&63,wid=tid>>6;
  if constexpr(MODE!=2){
  double*wtot=(double*)(shm+LDS_WS);
  float ls[8]; double run=0.0;
  { float*stg=(float*)(shm+LDS_K);
    #pragma unroll
    for(int j=0;j<8;++j)stg[j*512+tid]=FG[((long)b*SEQ+j*512+tid)*8+h];
    __syncthreads();
    #pragma unroll
    for(int j=0;j<8;++j){ const float x=stg[8*tid+j]+fbias; const float e=__expf(-fabsf(x)); ls[j]=fminf(x,0.f)-log1pf(e); } }
  #pragma unroll
  for(int j=0;j<8;++j)run+=(double)ls[j];
  double inc=run;
  #pragma unroll
  for(int o=1;o<64;o<<=1){ const int src_=((lane>=o)?lane-o:lane)<<2; const long long bits=__builtin_bit_cast(long long,inc);
    const int lo_=__builtin_amdgcn_ds_bpermute(src_,(int)bits), hi_=__builtin_amdgcn_ds_bpermute(src_,(int)(bits>>32));
    const double v=__builtin_bit_cast(double,((long long)(unsigned)hi_<<32)|(unsigned)lo_); if(lane>=o)inc+=v; }
  if(lane==63)wtot[wid]=inc;
  __syncthreads();
  double base=inc-run;
  for(int w=0;w<wid;++w)base+=wtot[w];
  u32x4*dst=(u32x4*)(shm+LDS_KX)+8*tid;
  #pragma unroll
  for(int j=0;j<8;++j){ base+=(double)ls[j]; const float c=(float)(-base*1.4426950408889634);
    const unsigned h1=cvtpk_s(c,0.f)&0xffffu; const float r1=c-__uint_as_float(h1<<16); const unsigned h2=cvtpk_s(r1,0.f)&0xffffu; const float r2=r1-__uint_as_float(h2<<16); const unsigned h3=cvtpk_s(r2,0.f)&0xffffu;
    dst[j]=(u32x4){h1|(h2<<16),h3|0x3F800000u,0x3F803F80u,0u};
    if(j==0&&(tid&7)==0)((float*)(shm+LDS_CB))[tid>>3]=c; if(j==7&&(tid&7)==7)((float*)(shm+LDS_CB))[64+(tid>>3)]=c; }
  if(tid==0){ unsigned z_=0u; asm volatile("":"+v"(z_)); ((u32x4*)(shm+LDS_KX))[SEQ]=(u32x4){z_,z_,z_,z_}; }
  }
  { float qm=0.f,km=0.f;
    const long row0=(long)b*SEQ+wid*512+(lane>>3); const int cho=h*D+(lane&7)*8;
    #define KXN_LOAD(V_,g_) do{ const bf16*P_=((g_)>>3)?K:Q; _Pragma("unroll") for(int i=0;i<8;++i)V_[i]=*(const u32x4*)(P_+(row0+8*(((g_)&7)*8+i))*DMQ+cho); }while(0)
    #define KXN_RED(V_,g_) do{ _Pragma("unroll") for(int i=0;i<8;++i){ float s=0.f; \
          _Pragma("unroll") for(int e=0;e<4;++e){ const bf16x2_t p_=__builtin_bit_cast(bf16x2_t,V_[i][e]); s=__builtin_amdgcn_fdot2_f32_bf16(p_,p_,s,false); }     \
          s+=__int_as_float(__builtin_amdgcn_update_dpp(0,__float_as_int(s),0xB1,0xf,0xf,false)); s+=__int_as_float(__builtin_amdgcn_update_dpp(0,__float_as_int(s),0x4E,0xf,0xf,false)); \
          s+=__int_as_float(__builtin_amdgcn_update_dpp(0,__float_as_int(s),0x141,0xf,0xf,false)); \
          if((g_)>>3)km=fmaxf(km,s); else qm=fmaxf(qm,s); } }while(0)
    { u32x4 va[8];
      #pragma unroll 1
      for(int g=0;g<16;++g){ const bool mine=(MODE==0)||((MODE==1)==((g&7)<KX_GA)); if(!mine)continue;
        KXN_LOAD(va,g); __builtin_amdgcn_sched_barrier(0); KXN_RED(va,g); __builtin_amdgcn_sched_barrier(0); } }
    #undef KXN_LOAD
    #undef KXN_RED
    #pragma unroll
    for(int o=1;o<64;o<<=1){ const int src_=(lane^o)<<2; qm=fmaxf(qm,__int_as_float(__builtin_amdgcn_ds_bpermute(src_,__float_as_int(qm)))); km=fmaxf(km,__int_as_float(__builtin_amdgcn_ds_bpermute(src_,__float_as_int(km)))); }
    if(lane==0){ ((float*)(shm+LDS_CB))[128+2*wid]=qm; ((float*)(shm+LDS_CB))[129+2*wid]=km; } }
  __syncthreads();
  if(tid==0){ float qm=0.f,km=0.f; for(int w=0;w<8;++w){ qm=fmaxf(qm,((float*)(shm+LDS_CB))[128+2*w]); km=fmaxf(km,((float*)(shm+LDS_CB))[129+2*w]); } ((float*)(shm+LDS_CB))[160]=2.0f*sqrtf(qm*km)*1.001f; if constexpr(MODE!=0){ gbound[0]=qm; gbound[1]=km; } }
  __syncthreads();
}
constexpr int KX_IMG_BYTES=SEQ*16+16+1024;
__device__ __forceinline__ void kx_store(const char*shm,char*g,int tid){
  for(int i=tid;i<KX_IMG_BYTES/16;i+=NW*64)((u32x4*)g)[i]=((const u32x4*)(shm+LDS_KX))[i];
}
__device__ __forceinline__ void kx_load(char*shm,const char*g,int tid,const float*gbound=nullptr){
  u32x4 v[9];
  #pragma unroll
  for(int j=0;j<9;++j){ const int i=tid+j*NW*64; if(i<KX_IMG_BYTES/16)v[j]=((const u32x4*)g)[i]; }
  #pragma unroll
  for(int j=0;j<9;++j){ const int i=tid+j*NW*64; if(i<KX_IMG_BYTES/16)((u32x4*)(shm+LDS_KX))[i]=v[j]; }
  if(gbound){ const float qa_=gbound[0],ka_=gbound[1],qb_=gbound[2],kb_=gbound[3]; __syncthreads(); if(tid==0)((float*)(shm+LDS_CB))[160]=2.0f*sqrtf(fmaxf(qa_,qb_)*fmaxf(ka_,kb_))*1.001f; }
  __syncthreads();
}
__device__ __forceinline__ int tile_start(const char*shm,int qb,int lane){
  const float*cb=(const float*)(shm+LDS_CB); const float bound=cb[4*qb]-48.0f-cb[160];
  const int t=2*(lane+1); const bool ok=(t<=4*qb)&&(t<=64)&&(cb[64+((t-1)&63)]<=bound);
  return 2*__popcll(__ballot(ok));
}
struct AttnTensors { const bf16* Q; const bf16* K; const bf16* V; bf16* O; };
struct AttnUnit { int bh; int qb; };
struct StaticOrder {
  int vcu,bh_;
  __device__ __forceinline__ explicit StaticOrder(int vcu_,int bh):vcu(vcu_),bh_(bh){}
  __device__ __forceinline__ bool next(int i,AttnUnit&u)const{ if(i>=4)return false; const int s=vcu&3, j=4*(i>>1)+s; u.bh=bh_; u.qb=(i&1)?15-j:j; return true; }
  __device__ __forceinline__ void a_ready(const AttnUnit&)const{}
  __device__ __forceinline__ void done(const AttnUnit&)const{}
};
template<class Sched,int THRL=96> __device__ __forceinline__ void attn_phase(char*lds,const AttnTensors&T,const Sched&S){
  AttnUnit u;
  for(int i=0;S.next(i,u);++i){ S.a_ready(u); attn_unit<THRL>(u.bh/NHEAD,u.bh%NHEAD,u.qb,
#if defined(MK_NOSKIP_HEAD)
      ((u.bh%NHEAD)==MK_NOSKIP_HEAD||MK_NOSKIP_HEAD<0)?0:
#endif
      tile_start(lds,u.qb,threadIdx.x&63),T.Q,T.K,T.V,T.O,lds); S.done(u); }
}
#undef SBAR
#undef WAIT_BAR
}
#define GAS __attribute__((address_space(1)))
#define LAS __attribute__((address_space(3)))
typedef unsigned short bf16;
typedef unsigned v4u __attribute__((ext_vector_type(4)));
typedef float f32x4 __attribute__((ext_vector_type(4)));
typedef short bf16x8 __attribute__((ext_vector_type(8)));
typedef GAS unsigned gu32;
typedef GAS unsigned long long gu64;
#define RLX_AGENT __ATOMIC_RELAXED, __HIP_MEMORY_SCOPE_AGENT
#define LDS_WAIT() asm volatile("s_waitcnt lgkmcnt(0)" ::: "memory")
#define VM_WAIT() asm volatile("s_waitcnt vmcnt(0)" ::: "memory")
__device__ __forceinline__ unsigned long long rt() { return __builtin_amdgcn_s_memrealtime(); }
__device__ __forceinline__ unsigned f2bf(float f) { unsigned u = __builtin_bit_cast(unsigned, f); return (u + 0x7fffu + ((u >> 16) & 1u)) >> 16; }
__device__ __forceinline__ unsigned pk2(float lo, float hi) { return f2bf(lo) | (f2bf(hi) << 16); }

#define XB_TMO      128
#define XB_XCNT(j)  (256  + 64 * (j))
#define XB_XSUB(j)  (1280 + 64 * (j))
#define XB_XGEN(j)  (2304 + 64 * (j))
#define XB_TOP      3328
#define XB_TOPGEN   3392
#define XCD_BAR_WORDS 3456
#define XB_SPIN_CAP (1u << 20)

__device__ __forceinline__ unsigned xb_ld(unsigned* p)              { return __hip_atomic_load(p, __ATOMIC_RELAXED, __HIP_MEMORY_SCOPE_AGENT); }
__device__ __forceinline__ unsigned xb_add(unsigned* p, unsigned v) { return __hip_atomic_fetch_add(p, v, __ATOMIC_RELAXED, __HIP_MEMORY_SCOPE_AGENT); }
__device__ __forceinline__ unsigned xb_xcc_id() { return (unsigned)__builtin_amdgcn_s_getreg((3 << 11) | 20) & 0xFu; }
#define XB_SPIN(cond, bar) do { unsigned _sp = 0; while (cond) { __builtin_amdgcn_s_sleep(1); \
    if ((++_sp & 255u) == 0u) { if (xb_ld(&(bar)[XB_TMO])) break; if (_sp > XB_SPIN_CAP) { atomicAdd(&(bar)[XB_TMO], 1u); break; } } } } while (0)

struct XcdBarrier {
    unsigned* bar; unsigned x; unsigned gsz;
    volatile LAS unsigned* st;
};

__device__ __forceinline__ XcdBarrier xcd_barrier_post(unsigned* bar, volatile LAS unsigned* st, unsigned gsz) {
    XcdBarrier b; b.bar = bar; b.x = xb_xcc_id(); b.st = st; b.gsz = gsz;
    if (threadIdx.x == 0) (void)xb_add(&bar[XB_XCNT(b.x)], 1u);
    return b;
}
__device__ __forceinline__ void xcd_barrier_complete(unsigned* bar, unsigned x, unsigned& nloc, unsigned& nx, unsigned G) {
    unsigned sum, cnt, mine, sp = 0u;
    for (;;) {
        sum = 0u; cnt = 0u; mine = 0u;
#pragma unroll
        for (unsigned j = 0; j < 16; ++j) { const unsigned c = xb_ld(&bar[XB_XCNT(j)]); sum += c; cnt += (c > 0u) ? 1u : 0u; mine = (j == x) ? c : mine; }
        if (sum == G) break;
        __builtin_amdgcn_s_sleep(1);
        if ((++sp & 255u) == 0u) { if (xb_ld(&bar[XB_TMO])) break; if (sp > XB_SPIN_CAP) { atomicAdd(&bar[XB_TMO], 1u); break; } }
    }
    nloc = mine > 0u ? mine : 1u; nx = cnt > 0u ? cnt : 1u;
}

__device__ __forceinline__ void xcd_barrier(const XcdBarrier& b) {
    asm volatile("s_waitcnt vmcnt(0)" ::: "memory");
    __syncthreads();
    if (threadIdx.x == 0) {
        unsigned* bar = b.bar;
        __builtin_amdgcn_s_waitcnt(0);
        unsigned nloc = b.st[0], nx = b.st[1];
        if (nloc == 0u) { xcd_barrier_complete(bar, b.x, nloc, nx, b.gsz); b.st[0] = nloc; b.st[1] = nx; }
        const unsigned old = xb_add(&bar[XB_XSUB(b.x)], 1u);
        const unsigned gen = old / nloc;
        if (old + 1u == (gen + 1u) * nloc) {
            if (nx > 1u) {
            __builtin_amdgcn_fence(__ATOMIC_RELEASE, "agent");
            asm volatile("s_waitcnt vmcnt(0)" ::: "memory"); }
            if (nx > 1u) {
            const unsigned og = xb_add(&bar[XB_TOP], 1u);
            const unsigned tg = og / nx;
            if (og + 1u == (tg + 1u) * nx) xb_add(&bar[XB_TOPGEN], 1u);
            else XB_SPIN(xb_ld(&bar[XB_TOPGEN]) == tg, bar); }
            __builtin_amdgcn_fence(__ATOMIC_ACQUIRE, "agent");
            xb_add(&bar[XB_XGEN(b.x)], 1u);
            asm volatile("s_waitcnt vmcnt(0)" ::: "memory");
        } else {
            XB_SPIN(xb_ld(&bar[XB_XGEN(b.x)]) == gen, bar);
            __builtin_amdgcn_fence(__ATOMIC_ACQUIRE, "agent");
            asm volatile("s_waitcnt vmcnt(0)" ::: "memory");
        }
    }
    __syncthreads();
}

constexpr int NWAVES = 8;
constexpr int NB = 16, SEQ = 4096, DMODEL = 1024, NTOK = NB * SEQ;
constexpr int RC = 1792, FQKV = 1536, NPROJ = 3328, ICOLS = 3336, NMOD = 6144;
constexpr int NEXP = 32, DEXP = 512;
constexpr size_t MiB = 1u << 20;
constexpr size_t WS_CTL = 0, CTL_ZERO_BYTES = 1 * MiB;
constexpr size_t WS_MOD = 1 * MiB, WS_FG = 2 * MiB, WS_WIN = 8 * MiB, WS_WOUT = 16 * MiB, WS_LORA = 18 * MiB, WS_TOKINFO = 19 * MiB;
constexpr size_t WS_SLOT_TOK = 24 * MiB, WS_SLOT_W = 32 * MiB, WS_W1 = 40 * MiB, WS_W2 = 104 * MiB;
constexpr size_t WS_H = 136 * MiB, WS_PR = 264 * MiB, WS_PF = 488 * MiB, WS_MIX = 680 * MiB, WS_END = 1024 * MiB;
constexpr int CW_TMO = 0, CW_CODE = 1, CW_BAR = 4096, CW_CNT = 16384, CW_BB = 32768;
constexpr int RING_OFF = 0, RING_BYTES = 131072, LDS_BYTES = 163840, LDSCTL_OFF = LDS_BYTES - 512, MISC_OFF = LDSCTL_OFF;
static_assert(attn_body::ATTN_LDS_BYTES <= LDSCTL_OFF, "attention LDS");

typedef decltype(__builtin_amdgcn_kernarg_segment_ptr()) kseg_t;
struct InTab { kseg_t k;
    __device__ __forceinline__ const float* operator[](int i) const { return (const float*)((const unsigned long long __attribute__((address_space(4)))*)k)[i]; } };
struct Frame {
    LAS unsigned char* lds;
    volatile LAS unsigned* MISC;
    gu32* ctl;
    int tid, lane, wave;
    int vcu, G;
    InTab in; float* out; unsigned char* ws;
};
#define IN_X 0
#define IN_C 1
#define IN_WADA 2
#define IN_BADA 3
#define IN_N1G 4
#define IN_WIN 5
#define IN_MU 6
#define IN_W0 7
#define IN_WUP 8
#define IN_A0 9
#define IN_AUP 10
#define IN_GUP 11
#define IN_KK 12
#define IN_KA 13
#define IN_RK 14
#define IN_LNG 15
#define IN_LNB 16
#define IN_FB 17
#define IN_WOUT 18
#define IN_N2G 19
#define IN_WGRP 20
#define IN_BGRP 21
#define IN_WRT 22
#define IN_BRT 23
#define IN_WGATE 24
#define IN_WUPM 25
#define IN_WDOWN 26
#define IN_NFG 27

template <int N> __device__ __forceinline__ float dpp_ror(float x) { return __int_as_float(__builtin_amdgcn_update_dpp(0, __float_as_int(x), 0x120 + N, 0xf, 0xf, false)); }
__device__ __forceinline__ float row_allsum(float x) { x += dpp_ror<8>(x); x += dpp_ror<4>(x); x += dpp_ror<2>(x); x += dpp_ror<1>(x); return x; }
__device__ __forceinline__ float rdl(float x, int l) { return __int_as_float(__builtin_amdgcn_readlane(__float_as_int(x), l)); }
__device__ __forceinline__ float wave_sum(float v) { v = row_allsum(v); return (rdl(v, 0) + rdl(v, 16)) + (rdl(v, 32) + rdl(v, 48)); }
__device__ __forceinline__ float xchg32(float s, bool upper) { auto rr = __builtin_amdgcn_permlane32_swap(__float_as_uint(s), __float_as_uint(s), false, false); return __uint_as_float(upper ? rr[0] : rr[1]); }
__device__ __forceinline__ void wave_reduce8(const float (&v)[8], float (&t)[8], int lane) {
    const bool up = lane & 32; float h[4];
#pragma unroll
    for (int j = 0; j < 4; ++j) { const float send = up ? v[j] : v[j + 4], keep = up ? v[j + 4] : v[j]; h[j] = row_allsum(keep + xchg32(send, up)); }
#pragma unroll
    for (int j = 0; j < 4; ++j) { t[j] = rdl(h[j], 0) + rdl(h[j], 16); t[j + 4] = rdl(h[j], 32) + rdl(h[j], 48); }
}
__device__ __forceinline__ void wave_reduce4(const float (&v)[4], float (&t)[4], int lane) {
    const bool up = lane & 32; float h[2];
#pragma unroll
    for (int j = 0; j < 2; ++j) { const float send = up ? v[j] : v[j + 2], keep = up ? v[j + 2] : v[j]; h[j] = row_allsum(keep + xchg32(send, up)); }
#pragma unroll
    for (int j = 0; j < 2; ++j) { t[j] = rdl(h[j], 0) + rdl(h[j], 16); t[j + 2] = rdl(h[j], 32) + rdl(h[j], 48); }
}

__device__ __forceinline__ void p0_transpose_item(const float* W, int ldw, bf16* WT, int ldt, int dst_row0, int k0, int n0, LAS float* scr, int lane) {
    float wv_[32];
#pragma unroll
    for (int i = 0; i < 32; ++i) wv_[i] = W[(size_t)(k0 + 2 * i + (lane >> 5)) * ldw + n0 + (lane & 31)];
#pragma unroll
    for (int i = 0; i < 32; ++i) scr[(2 * i + (lane >> 5)) * 33 + (lane & 31)] = wv_[i];
    LDS_WAIT(); asm volatile("" ::: "memory");
    const int c = lane & 7;
#pragma unroll
    for (int j = 0; j < 4; ++j) { const int n = (lane >> 3) + 8 * j; const LAS float* s = scr + (8 * c) * 33 + n;
        v4u o; o.x = pk2(s[0 * 33], s[1 * 33]); o.y = pk2(s[2 * 33], s[3 * 33]); o.z = pk2(s[4 * 33], s[5 * 33]); o.w = pk2(s[6 * 33], s[7 * 33]);
        *(GAS v4u*)(WT + (size_t)(dst_row0 + n) * ldt + k0 + 8 * c) = o; }
    LDS_WAIT(); asm volatile("" ::: "memory");
}
template <int PART> __device__ __forceinline__ void p0_prologue(Frame& F) {
  if (PART != 2)
    {
        LAS float* cond = (LAS float*)(F.lds);
        LAS float* red = (LAS float*)(F.lds + 65536);
        const float* c = F.in[IN_C]; const float* wada = F.in[IN_WADA]; const float* bada = F.in[IN_BADA]; float* mod = (float*)(F.ws + WS_MOD);
        for (int u = F.vcu; u < NMOD / 32; u += F.G) {
            for (int idx = F.tid; idx < 16384; idx += 512) { const int k = idx >> 4, b = idx & 15; const float v = c[b * 1024 + k]; cond[idx] = v / (1.f + __expf(-v)); }
            __syncthreads();
            const int ks = F.tid >> 5, cl = F.tid & 31, col = u * 32 + cl;
            float acc[16];
#pragma unroll
            for (int b = 0; b < 16; ++b) acc[b] = 0.f;
            for (int i0 = 0; i0 < 64; i0 += 16) { float wv[16];
#pragma unroll
                for (int i = 0; i < 16; ++i) wv[i] = wada[(size_t)(ks + 16 * (i0 + i)) * NMOD + col];
#pragma unroll
                for (int i = 0; i < 16; ++i) { const int k = ks + 16 * (i0 + i); const float w = wv[i];
                    const LAS f32x4* cv = (const LAS f32x4*)(cond + k * 16);
#pragma unroll
                    for (int q = 0; q < 4; ++q) { const f32x4 t = cv[q]; acc[4 * q] += t[0] * w; acc[4 * q + 1] += t[1] * w; acc[4 * q + 2] += t[2] * w; acc[4 * q + 3] += t[3] * w; } } }
#pragma unroll
            for (int b = 0; b < 16; ++b) red[(ks * 16 + b) * 32 + cl] = acc[b];
            __syncthreads();
            { const int b = F.tid >> 5; float s = bada[col];
#pragma unroll
              for (int k2 = 0; k2 < 16; ++k2) s += red[(k2 * 16 + b) * 32 + cl];
              mod[(size_t)b * NMOD + col] = s; }
            __syncthreads();
        }
    }
    {
        LAS float* scr = (LAS float*)(F.lds + F.wave * 16384);
        const int gw = F.vcu * NWAVES + F.wave, NGW = F.G * NWAVES;
        constexpr int I_IN = 16 * (NPROJ / 32), I_OUT = 16 * 32, I_E = 768, NITEMS = I_IN + I_OUT + NEXP * I_E;
        bf16* Win_t = (bf16*)(F.ws + WS_WIN); bf16* Wout_t = (bf16*)(F.ws + WS_WOUT); bf16* W1_t = (bf16*)(F.ws + WS_W1); bf16* W2_t = (bf16*)(F.ws + WS_W2);
        for (int it = gw + ((PART == 2) ? I_IN + I_OUT : 0); it < ((PART == 1) ? I_IN + I_OUT : NITEMS); it += NGW) {
            int r = it;
            if (r < I_IN) { const int nblk = NPROJ / 32, kb = r / nblk, nb = r % nblk; p0_transpose_item(F.in[IN_WIN], ICOLS, Win_t, 1024, 32 * nb, 64 * kb, 32 * nb, scr, F.lane); continue; } r -= I_IN;
            if (r < I_OUT) { const int kb = r / 32, nb = r % 32; p0_transpose_item(F.in[IN_WOUT], 1024, Wout_t, 1024, 32 * nb, 64 * kb, 32 * nb, scr, F.lane); continue; } r -= I_OUT;
            const int e = r / I_E; r -= e * I_E;
            if (r < 512) { const int up = r >> 8, q = r & 255, kb = q >> 4, nb = q & 15, n0 = 32 * nb;
                if (up) p0_transpose_item(F.in[IN_WUPM] + (size_t)e * 1024 * 512, 512, W1_t + (size_t)e * 1024 * 1024, 1024, 256 * (n0 >> 7) + 128 + (n0 & 127), 64 * kb, n0, scr, F.lane);
                else    p0_transpose_item(F.in[IN_WGATE] + (size_t)e * 1024 * 512, 512, W1_t + (size_t)e * 1024 * 1024, 1024, 256 * (n0 >> 7) + (n0 & 127), 64 * kb, n0, scr, F.lane); }
            else { const int q = r - 512, kb = q >> 5, nb = q & 31;
                p0_transpose_item(F.in[IN_WDOWN] + (size_t)e * 512 * 1024, 1024, W2_t + (size_t)e * 1024 * 512, 512, 32 * nb, 64 * kb, 32 * nb, scr, F.lane); }
        }
    }
}

__device__ __forceinline__ void p1_norm(Frame& F) {
    LAS f32x4* Wf4 = (LAS f32x4*)(F.lds);
    const float* win = F.in[IN_WIN];
    for (int idx = F.tid; idx < 8192; idx += 512) { const int c = idx >> 3, j = idx & 7; const float v = win[(size_t)c * ICOLS + NPROJ + j];
        const int l = (c & 255) >> 2, jq = c >> 8, i = c & 3, jj = jq * 4 + i; ((LAS float*)Wf4)[(((j >> 2) * 16 + jj) * 64 + l) * 4 + (j & 3)] = v; }
    __syncthreads();
    const float* x = F.in[IN_X]; const float* g1 = F.in[IN_N1G]; const float* mod = (const float*)(F.ws + WS_MOD);
    bf16* H = (bf16*)(F.ws + WS_H); float* FG = (float*)(F.ws + WS_FG);
    f32x4 WF0[16], WF1[16];
#pragma unroll
    for (int q = 0; q < 16; ++q) { WF0[q] = Wf4[q * 64 + F.lane]; WF1[q] = Wf4[(16 + q) * 64 + F.lane]; }
    for (int rb = F.vcu; rb < NTOK / 256; rb += F.G) {
        const int b = (rb * 256) / SEQ;
        f32x4 A[4], Bc[4];
#pragma unroll
        for (int j = 0; j < 4; ++j) { const int c = 4 * F.lane + 256 * j; const f32x4 g = *(const f32x4*)(g1 + c), sc = *(const f32x4*)(mod + (size_t)b * NMOD + 1024 + c); A[j] = g * (sc + 1.0f); Bc[j] = *(const f32x4*)(mod + (size_t)b * NMOD + c); }
        f32x4 vn[4];
        { const GAS f32x4* xr0 = (const GAS f32x4*)(x + ((size_t)rb * 256 + F.wave) * 1024) + F.lane;
#pragma unroll
          for (int j = 0; j < 4; ++j) vn[j] = xr0[64 * j]; }
        for (int r = F.wave; r < 256; r += NWAVES) {
            const size_t m = (size_t)rb * 256 + r;
            f32x4 v[4]; float ss = 0.f;
#pragma unroll
            for (int j = 0; j < 4; ++j) v[j] = vn[j];
            if (r + NWAVES < 256) { const GAS f32x4* xr = (const GAS f32x4*)(x + (m + NWAVES) * 1024) + F.lane;
#pragma unroll
                for (int j = 0; j < 4; ++j) vn[j] = xr[64 * j]; }
#pragma unroll
            for (int j = 0; j < 4; ++j) ss += (v[j].x * v[j].x + v[j].y * v[j].y) + (v[j].z * v[j].z + v[j].w * v[j].w);
            const float rstd = __builtin_amdgcn_rsqf(wave_sum(ss) * (1.f / 1024.f) + 1e-6f);
            GAS unsigned long long* o8 = (GAS unsigned long long*)(H + m * 1024) + F.lane;
            float acc[8];
#pragma unroll
            for (int q = 0; q < 8; ++q) acc[q] = 0.f;
#pragma unroll
            for (int j = 0; j < 4; ++j) { v[j] = v[j] * rstd * A[j] + Bc[j];
                o8[64 * j] = (unsigned long long)attn_body::cvtpk_s(v[j].x, v[j].y) | ((unsigned long long)attn_body::cvtpk_s(v[j].z, v[j].w) << 32);
#pragma unroll
                for (int i = 0; i < 4; ++i) { const f32x4 w0 = WF0[j * 4 + i], w1 = WF1[j * 4 + i]; const float hv = v[j][i];
                    acc[0] += hv * w0[0]; acc[1] += hv * w0[1]; acc[2] += hv * w0[2]; acc[3] += hv * w0[3]; acc[4] += hv * w1[0]; acc[5] += hv * w1[1]; acc[6] += hv * w1[2]; acc[7] += hv * w1[3]; } }
            float ft[8]; wave_reduce8(acc, ft, F.lane);
            if (F.lane == 0) { *(GAS f32x4*)(FG + m * 8) = (f32x4){ft[0], ft[1], ft[2], ft[3]}; *(GAS f32x4*)(FG + m * 8 + 4) = (f32x4){ft[4], ft[5], ft[6], ft[7]}; }
        }
    }
}

__device__ __forceinline__ void p_final_nomoe(Frame& F) {
    const float* gf = F.in[IN_NFG];
    f32x4 G4[4];
#pragma unroll
    for (int j = 0; j < 4; ++j) G4[j] = *(const f32x4*)(gf + 4 * F.lane + 256 * j);
    const int gw = F.vcu * NWAVES + F.wave, NGW = F.G * NWAVES;
    for (int m = gw; m < NTOK; m += NGW) {
        GAS f32x4* xr = (GAS f32x4*)(F.out + (size_t)m * 1024) + F.lane;
        f32x4 v[4]; float ss = 0.f;
#pragma unroll
        for (int j = 0; j < 4; ++j) { v[j] = xr[64 * j]; ss += (v[j].x * v[j].x + v[j].y * v[j].y) + (v[j].z * v[j].z + v[j].w * v[j].w); }
        const float rstd = __builtin_amdgcn_rsqf(wave_sum(ss) * (1.f / 1024.f) + 1e-6f);
#pragma unroll
        for (int j = 0; j < 4; ++j) xr[64 * j] = v[j] * rstd * G4[j];
    }
}


constexpr size_t WS_ALORA = 808 * MiB;
constexpr size_t OUT_Y = 0, OUT_GG = 128 * MiB, OUT_Z = 192 * MiB;
typedef unsigned v2u __attribute__((ext_vector_type(2)));
typedef float f32x2 __attribute__((ext_vector_type(2)));
__device__ __forceinline__ float bf2f(unsigned short u) { return __uint_as_float((unsigned)u << 16); }
__device__ __forceinline__ float sigmoidf_(float v) { return 1.0f / (1.0f + __expf(-v)); }

__device__ __forceinline__ void r0_lora_inputs(Frame& F) {
    const bf16* PR = (const bf16*)(F.ws + WS_PR); bf16* AL = (bf16*)(F.ws + WS_ALORA); const float* mu = F.in[IN_MU] + 1536;
    const int l = F.lane & 31, hwl = ((F.vcu & 15) * NWAVES + F.wave) * 2 + (F.lane >> 5);
    float m8[8];
#pragma unroll
    for (int i = 0; i < 8; ++i) m8[i] = mu[8 * l + i];
    for (int m0 = (F.vcu >> 4) * SEQ + hwl * 4, mend = ((F.vcu >> 4) + 1) * SEQ; m0 < mend; m0 += 1024) {
        v4u cur[4], prv[4];
#pragma unroll
        for (int u = 0; u < 4; ++u) { const int m = m0 + u; cur[u] = *(const GAS v4u*)(PR + (size_t)m * RC + 1536 + 8 * l);
            prv[u] = (v4u){0u, 0u, 0u, 0u}; if (u > 0) prv[u] = cur[u - 1]; else if ((m & (SEQ - 1)) != 0) prv[u] = *(const GAS v4u*)(PR + (size_t)(m - 1) * RC + 1536 + 8 * l); }
#pragma unroll
        for (int u = 0; u < 4; ++u) { float o[8];
#pragma unroll
            for (int i = 0; i < 4; ++i) { const unsigned cw = cur[u][i], pw = prv[u][i];
                const float c0 = __uint_as_float(cw << 16), c1 = __uint_as_float(cw & 0xffff0000u), p0 = __uint_as_float(pw << 16), p1 = __uint_as_float(pw & 0xffff0000u);
                o[2 * i] = c0 + (p0 - c0) * m8[2 * i]; o[2 * i + 1] = c1 + (p1 - c1) * m8[2 * i + 1]; }
            if (l < 8) {
#pragma unroll
                for (int i = 0; i < 8; ++i) { const float ex = __expf(2.0f * o[i]); o[i] = 1.0f - 2.0f * __builtin_amdgcn_rcpf(1.0f + ex); }
            } else if (l >= 16) {
#pragma unroll
                for (int i = 0; i < 8; ++i) o[i] = __builtin_amdgcn_rcpf(1.0f + __expf(-o[i]));
            }
            *(GAS v4u*)(AL + (size_t)(m0 + u) * 256 + 8 * l) = (v4u){pk2(o[0], o[1]), pk2(o[2], o[3]), pk2(o[4], o[5]), pk2(o[6], o[7])}; }
    }
}

namespace scan {
typedef _Float16 h16x4 __attribute__((ext_vector_type(4)));
constexpr int TC = 32;
constexpr int KSB = 80;
constexpr int RECB = 16 * KSB + 128;
constexpr int L_RAW = 0;
constexpr int L_AL = 13312;
constexpr int L_REC = L_AL + 16 * 1056;
constexpr int L_WL = L_REC + TC * RECB;
constexpr int L_AV = L_WL + 8192;
constexpr int L_GV = L_AV + 8192;
constexpr int L_YB = L_GV + 4096;
constexpr int L_BF = L_YB + 8192 + 256;
constexpr int L_END = L_BF + 24576;
template <int N> __device__ __forceinline__ float ror16(float x) { return __int_as_float(__builtin_amdgcn_update_dpp(0, __float_as_int(x), 0x120 + N, 0xf, 0xf, false)); }
__device__ __forceinline__ float allsum16(float x) { x += ror16<8>(x); x += ror16<4>(x); x += ror16<2>(x); x += ror16<1>(x); return x; }
typedef float f32x16 __attribute__((ext_vector_type(16)));
__device__ __forceinline__ float fmix_lo(float a, unsigned h2, float c) { float d; asm("v_fma_mix_f32 %0, %1, %2, %3 op_sel_hi:[0,1,0]" : "=v"(d) : "v"(a), "v"(h2), "v"(c)); return d; }
__device__ __forceinline__ float fmix_hi(float a, unsigned h2, float c) { float d; asm("v_fma_mix_f32 %0, %1, %2, %3 op_sel:[0,1,0] op_sel_hi:[0,1,0]" : "=v"(d) : "v"(a), "v"(h2), "v"(c)); return d; }
__device__ __forceinline__ float fmix_hi_nop(float a, unsigned h2, float c) { float d; asm("v_fma_mix_f32 %0, %1, %2, %3 op_sel:[0,1,0] op_sel_hi:[0,1,0]\n\ts_nop 1" : "=v"(d) : "v"(a), "v"(h2), "v"(c)); return d; }
__device__ __forceinline__ float fmix_lo0(float a, unsigned h2) { float d; asm("v_fma_mix_f32 %0, %1, %2, 0 op_sel_hi:[0,1,0]" : "=v"(d) : "v"(a), "v"(h2)); return d; }

__device__ __forceinline__ void phase(Frame& F) {
    const int tid = F.tid, lane = F.lane, wave = F.wave;
    const int half = F.vcu & 1, hd = (F.vcu >> 1) & 7, b = F.vcu >> 4;
    LAS unsigned char* L = F.lds;
    const unsigned lds0 = (unsigned)(uintptr_t)(unsigned char*)F.lds;
    const bf16* PR = (const bf16*)(F.ws + WS_PR); const bf16* AL = (const bf16*)(F.ws + WS_ALORA);
    float* Y = (float*)((unsigned char*)F.out + OUT_Y); bf16* GG = (bf16*)((unsigned char*)F.out + OUT_GG); bf16* Z = (bf16*)((unsigned char*)F.out + OUT_Z);
    const int et = tid >> 4, cg = tid & 15, chb = hd * 64 + 4 * cg;
    float mu_r[4], mu_k[4], mu_v[4], kkc[4], kac[4], rkc[4], lng[4], lnb[4], w0c[4], a0c[4];
#pragma unroll
    for (int i = 0; i < 4; ++i) { mu_r[i] = F.in[IN_MU][chb + i]; mu_k[i] = F.in[IN_MU][512 + chb + i]; kkc[i] = F.in[IN_KK][chb + i]; kac[i] = F.in[IN_KA][chb + i]; rkc[i] = F.in[IN_RK][chb + i]; w0c[i] = F.in[IN_W0][chb + i]; a0c[i] = F.in[IN_A0][chb + i]; }
    const int vch = hd * 64 + half * 32 + 4 * (cg & 7);
#pragma unroll
    for (int i = 0; i < 4; ++i) { mu_v[i] = F.in[IN_MU][1024 + vch + i]; lng[i] = F.in[IN_LNG][vch + i]; lnb[i] = F.in[IN_LNB][vch + i]; }
    if (wave < 5) {
        const int r32 = lane & 31, hi = lane >> 5;
        const int col = (wave < 4) ? hd * 64 + (wave & 1) * 32 + r32 : hd * 64 + half * 32 + r32;
        const int ns = (wave < 4) ? 4 : 8;
        const float* wup = F.in[IN_WUP]; const float* aup = F.in[IN_AUP]; const float* gup = F.in[IN_GUP];
        for (int s = 0; s < ns; ++s) { float f[8];
            if (wave < 2) {
#pragma unroll
                for (int jj = 0; jj < 8; ++jj) f[jj] = wup[(size_t)(16 * s + 8 * hi + jj) * 512 + col];
            } else if (wave < 4) {
#pragma unroll
                for (int jj = 0; jj < 8; ++jj) f[jj] = aup[(size_t)(16 * s + 8 * hi + jj) * 512 + col];
            } else {
#pragma unroll
                for (int jj = 0; jj < 8; ++jj) f[jj] = gup[(size_t)(16 * s + 8 * hi + jj) * 512 + col];
            }
            *(LAS v4u*)(L + L_BF + ((wave < 4 ? wave * 4 : 16) + s) * 1024 + lane * 16) = (v4u){pk2(f[0], f[1]), pk2(f[2], f[3]), pk2(f[4], f[5]), pk2(f[6], f[7])}; }
    }
    long raw_off[2];
#pragma unroll
    for (int i = 0; i < 2; ++i) { int q = 64 * (wave + 8 * i) + lane; if (q > 791) q = 791; const int row = q / 24, cc = q % 24; raw_off[i] = (long)(row - 1) * RC + (cc >> 3) * 512 + hd * 64 + (cc & 7) * 8; }
    const size_t mrow0 = (size_t)b * SEQ;
#define SCAN_DMA(c) do { const size_t m0_ = mrow0 + (size_t)(c) * TC; \
        _Pragma("unroll") for (int i_ = 0; i_ < 2; ++i_) { const int p_ = wave + 8 * i_; if (p_ < 13) { long o_ = raw_off[i_]; if ((c) == 0 && o_ < 0) o_ += RC; \
            attn_body::glds16(PR + m0_ * RC + o_, (unsigned)__builtin_amdgcn_readfirstlane(lds0 + L_RAW + p_ * 1024)); } } \
        _Pragma("unroll") for (int i_ = 0; i_ < 2; ++i_) { const int p_ = wave + 8 * i_; \
            attn_body::glds16(AL + (m0_ + 2 * p_) * 256 + lane * 8, (unsigned)__builtin_amdgcn_readfirstlane(lds0 + L_AL + p_ * 1056)); } } while (0)
#define STORE_Y(c) do { const int st_ = tid >> 4, v2_ = (tid & 15) * 2; const f32x2 y2_ = *(const LAS f32x2*)(L + L_YB + ((c) & 1) * 4096 + (st_ * 32 + v2_) * 4); \
        *(GAS f32x2*)(Y + (mrow0 + (size_t)(c) * TC + st_) * 512 + hd * 64 + half * 32 + v2_) = y2_; } while (0)
    f32x2 S01 = (f32x2){0.f, 0.f}, S23 = (f32x2){0.f, 0.f};
    const int vloc = 4 * wave + (lane >> 4), ks = lane & 15;
    SCAN_DMA(0);
    for (int c = 0; c < SEQ / TC; ++c) {
        asm volatile("s_waitcnt vmcnt(0)" ::: "memory"); __syncthreads();
        float rs[4], ksv[4], vs[4], rn;
#if defined(MK_PROBE_S2)
        for (int prep = 0; prep < 2; ++prep) {
#endif
        {
            const bool first = (c == 0 && et == 0);
            const LAS unsigned char* rowc = L + L_RAW + (et + 1) * 384; const LAS unsigned char* rowp = L + L_RAW + et * 384;
            const v2u rc = *(const LAS v2u*)(rowc + cg * 8), rp = *(const LAS v2u*)(rowp + cg * 8);
            const v2u kc = *(const LAS v2u*)(rowc + 128 + cg * 8), kp = *(const LAS v2u*)(rowp + 128 + cg * 8);
            const int vo = 256 + (half * 32 + 4 * (cg & 7)) * 2;
            const v2u vc = *(const LAS v2u*)(rowc + vo), vp = *(const LAS v2u*)(rowp + vo);
#define SH4(dst, cu, pr, mu) do { const float c0 = __uint_as_float(cu.x << 16), c1 = __uint_as_float(cu.x & 0xffff0000u), c2 = __uint_as_float(cu.y << 16), c3 = __uint_as_float(cu.y & 0xffff0000u); \
            const float p0 = first ? 0.f : __uint_as_float(pr.x << 16), p1 = first ? 0.f : __uint_as_float(pr.x & 0xffff0000u), p2 = first ? 0.f : __uint_as_float(pr.y << 16), p3 = first ? 0.f : __uint_as_float(pr.y & 0xffff0000u); \
            dst[0] = c0 + (p0 - c0) * mu[0]; dst[1] = c1 + (p1 - c1) * mu[1]; dst[2] = c2 + (p2 - c2) * mu[2]; dst[3] = c3 + (p3 - c3) * mu[3]; } while (0)
            SH4(rs, rc, rp, mu_r); SH4(ksv, kc, kp, mu_k); SH4(vs, vc, vp, mu_v);
#undef SH4
            float q = 0.f;
#pragma unroll
            for (int i = 0; i < 4; ++i) { const float u = ksv[i] * kkc[i]; q += u * u; }
            q = allsum16(q); rn = __builtin_amdgcn_rsqf(fmaxf(q, 1e-24f));
            LAS unsigned char* rec = L + L_REC + et * RECB;
            *(LAS h16x4*)(rec + cg * KSB) = (h16x4){(_Float16)rs[0], (_Float16)rs[1], (_Float16)rs[2], (_Float16)rs[3]};
            if (cg < 8) *(LAS f32x4*)(rec + 16 * KSB + cg * 16) = (f32x4){vs[0], vs[1], vs[2], vs[3]};
        }
        if (wave < 5) {
            const int r32 = lane & 31, hi = lane >> 5;
            const LAS unsigned char* arow = L + L_AL + (r32 >> 1) * 1056 + (r32 & 1) * 512 + hi * 16;
            const int colb = (wave < 2) ? 0 : (wave < 4) ? 128 : 256;
            const LAS unsigned char* bfr = L + L_BF + (wave < 4 ? wave * 4 : 16) * 1024 + lane * 16;
            f32x16 acc = f32x16{};
            if (wave < 4) {
#pragma unroll
                for (int s = 0; s < 4; ++s) acc = __builtin_amdgcn_mfma_f32_32x32x16_bf16(*(const LAS bf16x8*)(arow + colb + 32 * s), *(const LAS bf16x8*)(bfr + s * 1024), acc, 0, 0, 0);
            } else {
#pragma unroll
                for (int s = 0; s < 8; ++s) acc = __builtin_amdgcn_mfma_f32_32x32x16_bf16(*(const LAS bf16x8*)(arow + colb + 32 * s), *(const LAS bf16x8*)(bfr + s * 1024), acc, 0, 0, 0);
            }
            LAS float* dst = (wave < 2) ? (LAS float*)(L + L_WL) + (wave & 1) * 32 + r32 : (wave < 4) ? (LAS float*)(L + L_AV) + (wave & 1) * 32 + r32 : (LAS float*)(L + L_GV) + r32;
            const int pitch = (wave < 4) ? 64 : 32;
#pragma unroll
            for (int r = 0; r < 16; ++r) { const int t = (r & 3) + 8 * (r >> 2) + 4 * hi; dst[t * pitch] = acc[r]; }
        }
        __syncthreads();
        {
            const f32x4 wl = *(const LAS f32x4*)(L + L_WL + (et * 64 + 4 * cg) * 4), al = *(const LAS f32x4*)(L + L_AV + (et * 64 + 4 * cg) * 4);
            float kp[4], nk[4], bb[4], dec[4], rk = 0.f;
#pragma unroll
            for (int i = 0; i < 4; ++i) {
                const float z = -(wl[i] + w0c[i]); const float sp = fmaxf(z, 0.f) + __logf(1.0f + __expf(-fabsf(z)));
                dec[i] = __expf(-__expf(-sp - 0.5f));
                const float a = __builtin_amdgcn_rcpf(1.0f + __expf(-(al[i] + a0c[i])));
                const float kn = ksv[i] * kkc[i] * rn; nk[i] = -kn; bb[i] = kn * a; kp[i] = ksv[i] * (1.0f + (a - 1.0f) * kac[i]); rk += rs[i] * kp[i] * rkc[i]; }
            rk = allsum16(rk);
            LAS unsigned char* rec = L + L_REC + et * RECB + cg * KSB;
            *(LAS h16x4*)(rec + 8) = (h16x4){(_Float16)nk[0], (_Float16)nk[1], (_Float16)nk[2], (_Float16)nk[3]};
            *(LAS f32x4*)(rec + 16) = (f32x4){dec[0], dec[1], dec[2], dec[3]};
            *(LAS f32x4*)(rec + 32) = (f32x4){bb[0], bb[1], bb[2], bb[3]};
            *(LAS f32x4*)(rec + 48) = (f32x4){kp[0], kp[1], kp[2], kp[3]};
            if (cg < 8) {
                const f32x4 g4 = *(const LAS f32x4*)(L + L_GV + (et * 32 + 4 * cg) * 4);
                float zz[4], gg[4];
#pragma unroll
                for (int i = 0; i < 4; ++i) { zz[i] = (lnb[i] + rk * vs[i]) * g4[i]; gg[i] = g4[i] * lng[i]; }
                const size_t o = (mrow0 + (size_t)c * TC + et) * 512 + vch;
                *(GAS v2u*)(Z + o) = (v2u){pk2(zz[0], zz[1]), pk2(zz[2], zz[3])};
                *(GAS v2u*)(GG + o) = (v2u){pk2(gg[0], gg[1]), pk2(gg[2], gg[3])};
            }
        }
        if (c > 0) STORE_Y(c - 1);
        __syncthreads();
#if defined(MK_PROBE_S2)
        }
#endif
        if (c + 1 < SEQ / TC) SCAN_DMA(c + 1);
        {
            const LAS unsigned char* rec = L + L_REC + ks * KSB; const LAS unsigned char* vrow = L + L_REC + 16 * KSB + vloc * 4;
            const unsigned ybase = L_YB + (c & 1) * 4096, ydump = L_YB + 8192 + lane * 4;
            v4u ra[3]; f32x4 rw[3], rb[3], rk4[3]; float rv[3];
            const unsigned recA = (unsigned)(L_REC + ks * KSB), vrowA = (unsigned)(L_REC + 16 * KSB + vloc * 4);
#define LOADREC(q_, st_) asm volatile("ds_read_b128 %0, %5 offset:%c7\n\tds_read_b128 %1, %5 offset:%c8\n\tds_read_b128 %2, %5 offset:%c9\n\tds_read_b128 %3, %5 offset:%c10\n\tds_read_b32 %4, %6 offset:%c7" \
                : "=&v"(ra[q_]), "=&v"(rw[q_]), "=&v"(rb[q_]), "=&v"(rk4[q_]), "=&v"(rv[q_]) : "v"(recA), "v"(vrowA), "i"((st_) * RECB), "i"((st_) * RECB + 16), "i"((st_) * RECB + 32), "i"((st_) * RECB + 48) : "memory")
#define WAITREC(q_, n_) asm volatile("s_waitcnt lgkmcnt(" #n_ ")" : "+v"(ra[q_]), "+v"(rw[q_]), "+v"(rb[q_]), "+v"(rk4[q_]), "+v"(rv[q_]) :: "memory")
#if defined(MK_PROBE_S1)
            const f32x2 sv01 = S01, sv23 = S23;
            for (int prep = 0; prep < 2; ++prep) { if (prep == 1) { S01 = sv01; S23 = sv23; }
#endif
            asm volatile("s_waitcnt lgkmcnt(0)" ::: "memory");
            LOADREC(0, 0); LOADREC(1, 1); WAITREC(0, 5);
            float y4 = 0.f;
#define STEP(st) do { \
                if ((st) + 2 < TC) { LOADREC(((st) + 2) % 3, (st) + 2); WAITREC(((st) + 1) % 3, 5); } else if ((st) + 1 < TC) { WAITREC(((st) + 1) % 3, 0); } \
                const v4u ca = ra[(st) % 3]; const f32x4 cw = rw[(st) % 3], cb = rb[(st) % 3], ck = rk4[(st) % 3]; const float vv = rv[(st) % 3]; \
                float p1 = fmix_lo0(S01[0], ca[2]); p1 = fmix_hi(S01[1], ca[2], p1); p1 = fmix_lo(S23[0], ca[3], p1); p1 = fmix_hi_nop(S23[1], ca[3], p1); \
                const float sa = allsum16(p1); \
                { const f32x2 vv2 = (f32x2){vv, vv}, sa2 = (f32x2){sa, sa}; \
                  f32x2 t01 = vv2 * (f32x2){ck[0], ck[1]}, t23 = vv2 * (f32x2){ck[2], ck[3]}; \
                  t01 = __builtin_elementwise_fma(sa2, (f32x2){cb[0], cb[1]}, t01); t23 = __builtin_elementwise_fma(sa2, (f32x2){cb[2], cb[3]}, t23); \
                  S01 = __builtin_elementwise_fma(S01, (f32x2){cw[0], cw[1]}, t01); S23 = __builtin_elementwise_fma(S23, (f32x2){cw[2], cw[3]}, t23); } \
                float p2 = fmix_lo0(S01[0], ca[0]); p2 = fmix_hi(S01[1], ca[0], p2); p2 = fmix_lo(S23[0], ca[1], p2); p2 = fmix_hi_nop(S23[1], ca[1], p2); \
                const float yv = allsum16(p2); \
                y4 = (ks == ((st) & 3)) ? yv : y4; \
                if (((st) & 3) == 3) { const unsigned ya = (ks < 4) ? (unsigned)(ybase + ((((st) & ~3) + ks) * 32 + vloc) * 4) : ydump; *(LAS float*)(L + ya) = y4; } \
            } while (0)
#define STEP4(b_) STEP(b_); STEP((b_) + 1); STEP((b_) + 2); STEP((b_) + 3)
            STEP4(0); STEP4(4); STEP4(8); STEP4(12); STEP4(16); STEP4(20); STEP4(24); STEP4(28);
#undef STEP4
#undef STEP
#undef WAITREC
#if defined(MK_PROBE_S1)
            }
#endif
#undef LOADREC
        }
    }
    __syncthreads();
    STORE_Y(SEQ / TC - 1);
    asm volatile("s_waitcnt vmcnt(0)" ::: "memory"); __syncthreads();
#undef SCAN_DMA
#undef STORE_Y
}
}
static_assert(scan::L_END <= LDSCTL_OFF, "scan LDS");

__device__ __forceinline__ void r2_post(Frame& F) {
    const bf16* Y = (const bf16*)((unsigned char*)F.out + OUT_Y); const bf16* GG = (const bf16*)((unsigned char*)F.out + OUT_GG); const bf16* Z = (const bf16*)((unsigned char*)F.out + OUT_Z);
    bf16* MIX = (bf16*)(F.ws + WS_MIX);
    const int gw = (F.vcu >> 4) * SEQ + (F.vcu & 15) * NWAVES + F.wave, NGW = 16 * NWAVES, mend = ((F.vcu >> 4) + 1) * SEQ;
    v4u ny, ng, nz;
    { const size_t o = (size_t)gw * 512 + 8 * F.lane; ny = *(const GAS v4u*)(Y + o); ng = *(const GAS v4u*)(GG + o); nz = *(const GAS v4u*)(Z + o); }
    for (int m = gw; m < mend; m += NGW) {
        const v4u yq = ny, g = ng, z = nz;
        if (m + NGW < mend) { const size_t o = (size_t)(m + NGW) * 512 + 8 * F.lane; ny = *(const GAS v4u*)(Y + o); ng = *(const GAS v4u*)(GG + o); nz = *(const GAS v4u*)(Z + o); }
        float yv[8];
#pragma unroll
        for (int i = 0; i < 4; ++i) { yv[2 * i] = __uint_as_float(yq[i] << 16); yv[2 * i + 1] = __uint_as_float(yq[i] & 0xffff0000u); }
        float s = ((yv[0] + yv[1]) + (yv[2] + yv[3])) + ((yv[4] + yv[5]) + (yv[6] + yv[7]));
        s += __int_as_float(__builtin_amdgcn_update_dpp(0, __float_as_int(s), 0xB1, 0xf, 0xf, false));
        s += __int_as_float(__builtin_amdgcn_update_dpp(0, __float_as_int(s), 0x4E, 0xf, 0xf, false));
        s += __int_as_float(__builtin_amdgcn_update_dpp(0, __float_as_int(s), 0x141, 0xf, 0xf, false));
        const float mean = s * (1.f / 64.f);
        float q = 0.f;
#pragma unroll
        for (int i = 0; i < 8; ++i) { yv[i] -= mean; q += yv[i] * yv[i]; }
        q += __int_as_float(__builtin_amdgcn_update_dpp(0, __float_as_int(q), 0xB1, 0xf, 0xf, false));
        q += __int_as_float(__builtin_amdgcn_update_dpp(0, __float_as_int(q), 0x4E, 0xf, 0xf, false));
        q += __int_as_float(__builtin_amdgcn_update_dpp(0, __float_as_int(q), 0x141, 0xf, 0xf, false));
        const float rstd = __builtin_amdgcn_rsqf(q * (1.f / 64.f) + 64e-5f);
        unsigned ow[4];
#pragma unroll
        for (int i = 0; i < 4; ++i) ow[i] = attn_body::cvtpk_s(yv[2 * i] * rstd * __uint_as_float(g[i] << 16) + __uint_as_float(z[i] << 16), yv[2 * i + 1] * rstd * __uint_as_float(g[i] & 0xffff0000u) + __uint_as_float(z[i] & 0xffff0000u));
        *(GAS v4u*)(MIX + (size_t)m * 1024 + 8 * F.lane) = (v4u){ow[0], ow[1], ow[2], ow[3]};
    }
}

namespace scan2 {
using scan::allsum16; using scan::f32x16; using scan::TC;
typedef unsigned short u16;
constexpr size_t WS_QPH = 488 * MiB, WS_GT = 840 * MiB, WS_VT = 136 * MiB, WS_QPH_ODD = 984 * MiB, OUT_QPH_ODD = 64 * MiB;
constexpr int S64 = 144, S32 = 80;
constexpr int QPH_B = 12288, GT_B = 9216, VT_B = 6144, O_PM = 32 * S64, O_HT = O_PM + 32 * S32;
constexpr int B_RAW = 0, B_AL = 13312, B_BF = B_AL + 16 * 1056;
constexpr int B_WL = B_BF + 32768, B_AV = B_WL + 8192, B_GV = B_AV + 8192, B_EE = B_GV + 8192;
constexpr int B_OUT = B_WL, O_VT = 0, O_QPH = VT_B, O_GT = VT_B + QPH_B;
constexpr int B_ALP = B_EE + 8192, B_ALPT = B_ALP + 32 * S64, B_BET = B_ALPT + 64 * S32, B_BETT = B_BET + 32 * S64, B_KAP = B_BETT + 64 * S32, B_RHO = B_KAP + 32 * S64;
constexpr int B_GL = B_RHO + 32 * S64, B_PW0 = B_GL + 256, B_PW1 = B_PW0 + 2 * 32 * S32, B_PL = B_PW1 + 2 * 32 * S32, B_TL = B_PL + 32 * S32, B_AAKT = B_TL + 32 * S32;
constexpr int B_KAPT = B_AAKT + 32 * S32, B_VSL = B_KAPT + 64 * S32, B_ARB = B_VSL + 32 * S64, B_WMT = B_ARB + 32 * S32, B_UMT = B_WMT + 64 * S32, B_END = B_UMT + 32 * S32;
static_assert(B_END <= LDSCTL_OFF && VT_B + QPH_B + GT_B <= 32768, "scan2 build LDS");
__device__ __forceinline__ u16 f2h(float f) { return (u16)(attn_body::cvtpk_s(f, 0.f) & 0xffffu); }
__device__ __forceinline__ int crow(int r, int hi) { return (r & 3) + 8 * (r >> 2) + 4 * hi; }
__device__ __forceinline__ void tile_nt(f32x16& acc, const LAS unsigned char* A, int lda, int arow0, const LAS unsigned char* Bt, int ldb, int brow0, int ksteps, int lane) {
    const int r32 = lane & 31, hi = lane >> 5;
    const LAS unsigned char* ap = A + (arow0 + r32) * lda + hi * 16; const LAS unsigned char* bp = Bt + (brow0 + r32) * ldb + hi * 16;
    for (int s = 0; s < ksteps; ++s) acc = __builtin_amdgcn_mfma_f32_32x32x16_bf16(*(const LAS bf16x8*)(ap + 32 * s), *(const LAS bf16x8*)(bp + 32 * s), acc, 0, 0, 0);
}
#define LBAR() asm volatile("s_waitcnt lgkmcnt(0)\n\ts_barrier" ::: "memory")
#define ST16_(base, off, val) (*(LAS unsigned short*)((base) + (off)) = (unsigned short)(attn_body::cvtpk_s((val), 0.f) & 0xffffu))
__device__ __forceinline__ int crow_(int r, int hi) { return (r & 3) + 8 * (r >> 2) + 4 * hi; }
__device__ __forceinline__ void store_tr(LAS unsigned char* img, int stride, int ncol0, const f32x16& a, int lane) {
    LAS unsigned char* p = img + (ncol0 + (lane & 31)) * 2; const int hi = lane >> 5;
#pragma unroll
    for (int r = 0; r < 16; ++r) ST16_(p, crow_(r, hi) * stride, a[r]);
}
#define ST16(base, off, val) (*(LAS u16*)((base) + (off)) = f2h(val))
__device__ __forceinline__ void store_nat(LAS unsigned char* img, int stride, int nrow0, const f32x16& a, int lane, int mcol0 = 0) {
    LAS unsigned char* p = img + (nrow0 + (lane & 31)) * stride + (mcol0 + 4 * (lane >> 5)) * 2;
#pragma unroll
    for (int g = 0; g < 4; ++g) *(LAS v2u*)(p + 16 * g) = (v2u){attn_body::cvtpk_s(a[4 * g], a[4 * g + 1]), attn_body::cvtpk_s(a[4 * g + 2], a[4 * g + 3])};
}

__device__ __forceinline__ unsigned char* vt_home(const Frame& F, int b, int hd) { return F.ws + WS_VT + (size_t)b * (8 * MiB) + (size_t)hd * 128 * VT_B; }
__device__ __forceinline__ unsigned char* qph_home(const Frame& F, int b, int hd) {
    unsigned char* base = (b & 1) ? (((b >> 1) < 5) ? (unsigned char*)F.out + OUT_QPH_ODD + (size_t)(b >> 1) * (12 * MiB) : F.ws + WS_QPH_ODD + (size_t)((b >> 1) - 5) * (12 * MiB)) : F.ws + WS_QPH + (size_t)b * (12 * MiB);
    return base + (size_t)hd * 128 * QPH_B; }
__device__ __forceinline__ void build(Frame& F) {
    const int tid = F.tid, lane = F.lane, wave = F.wave;
    const int bh = F.vcu >> 1, hd = bh & 7, b = bh >> 3, c0 = (F.vcu & 1) * 64;
    LAS unsigned char* L = F.lds;
    const unsigned lds0 = (unsigned)(uintptr_t)(unsigned char*)F.lds;
    const bf16* PR = (const bf16*)(F.ws + WS_PR); const bf16* AL = (const bf16*)(F.ws + WS_ALORA);
    bf16* GG = (bf16*)((unsigned char*)F.out + OUT_GG); bf16* Z = (bf16*)((unsigned char*)F.out + OUT_Z);
    const int et = tid >> 4, cg = tid & 15, chb = hd * 64 + 4 * cg;
    float mu_r[4], mu_k[4], mu_v[4], kkc[4], kac[4], rkc[4], lng[4], lnb[4], w0c[4], a0c[4];
#pragma unroll
    for (int i = 0; i < 4; ++i) { mu_r[i] = F.in[IN_MU][chb + i]; mu_k[i] = F.in[IN_MU][512 + chb + i]; mu_v[i] = F.in[IN_MU][1024 + chb + i]; kkc[i] = F.in[IN_KK][chb + i]; kac[i] = F.in[IN_KA][chb + i]; rkc[i] = F.in[IN_RK][chb + i];
        w0c[i] = F.in[IN_W0][chb + i]; a0c[i] = F.in[IN_A0][chb + i]; lng[i] = F.in[IN_LNG][chb + i]; lnb[i] = F.in[IN_LNB][chb + i]; }
    if (wave < 6) {
        const int r32 = lane & 31, hi = lane >> 5, col = hd * 64 + (wave & 1) * 32 + r32, ns = (wave < 4) ? 4 : 8;
        const float* wup = F.in[IN_WUP]; const float* aup = F.in[IN_AUP]; const float* gup = F.in[IN_GUP];
        for (int s = 0; s < ns; ++s) { float f[8];
            if (wave < 2) {
#pragma unroll
                for (int jj = 0; jj < 8; ++jj) f[jj] = wup[(size_t)(16 * s + 8 * hi + jj) * 512 + col];
            } else if (wave < 4) {
#pragma unroll
                for (int jj = 0; jj < 8; ++jj) f[jj] = aup[(size_t)(16 * s + 8 * hi + jj) * 512 + col];
            } else {
#pragma unroll
                for (int jj = 0; jj < 8; ++jj) f[jj] = gup[(size_t)(16 * s + 8 * hi + jj) * 512 + col];
            }
            *(LAS v4u*)(L + B_BF + ((wave < 4 ? wave * 4 : 16 + (wave - 4) * 8) + s) * 1024 + lane * 16) = (v4u){pk2(f[0], f[1]), pk2(f[2], f[3]), pk2(f[4], f[5]), pk2(f[6], f[7])}; }
    }
    long raw_off[2];
#pragma unroll
    for (int i = 0; i < 2; ++i) { int q = 64 * (wave + 8 * i) + lane; if (q > 791) q = 791; const int row = q / 24, cc = q % 24; raw_off[i] = (long)(row - 1) * RC + (cc >> 3) * 512 + hd * 64 + (cc & 7) * 8; }
    const size_t mrow0 = (size_t)b * SEQ;
#define B_DMA(c) do { const size_t m0_ = mrow0 + (size_t)(c) * TC; \
        _Pragma("unroll") for (int i_ = 0; i_ < 2; ++i_) { const int p_ = wave + 8 * i_; if (p_ < 13) { long o_ = raw_off[i_]; if ((c) == 0 && o_ < 0) o_ += RC; \
            attn_body::glds16(PR + m0_ * RC + o_, (unsigned)__builtin_amdgcn_readfirstlane(lds0 + B_RAW + p_ * 1024)); } } \
        _Pragma("unroll") for (int i_ = 0; i_ < 2; ++i_) { const int p_ = wave + 8 * i_; \
            attn_body::glds16(AL + (m0_ + 2 * p_) * 256 + lane * 8, (unsigned)__builtin_amdgcn_readfirstlane(lds0 + B_AL + p_ * 1056)); } } while (0)
#define B_COPYOUT(cc) do { const size_t u_ = (size_t)bh * 128 + (cc); \
        for (int q_ = tid; q_ < 1728; q_ += 512) { const v4u v_ = *(const LAS v4u*)(L + B_OUT + q_ * 16); \
            unsigned char* d_ = (q_ < 384) ? vt_home(F, b, hd) + (size_t)(cc) * VT_B + (size_t)q_ * 16 : (q_ < 1152) ? qph_home(F, b, hd) + (size_t)(cc) * QPH_B + (size_t)(q_ - 384) * 16 : F.ws + WS_GT + u_ * GT_B + (size_t)(q_ - 1152) * 16; \
            *(GAS v4u*)d_ = v_; } } while (0)
#if defined(MK_TSTAGE)
    unsigned long long ts_acc = 0ull, ts_start = 0ull; bool ts_on = false;
#define TS(p) do { const unsigned long long now_ = __builtin_amdgcn_s_memrealtime(); if ((p) == (MK_TSTAGE + 1) % 8 && ts_on) { ts_acc += now_ - ts_start; ts_on = false; } if ((p) == MK_TSTAGE) { ts_start = now_; ts_on = true; } } while (0)
#else
#define TS(p) do {} while (0)
#endif
    B_DMA(c0);
    for (int ci = 0; ci < 64; ++ci) {
        const int c = c0 + ci;
        asm volatile("s_waitcnt vmcnt(0) lgkmcnt(0)\n\ts_barrier" ::: "memory"); TS(0);
        if (ci > 0) B_COPYOUT(c - 1);
        float rs[4], ksv[4], vs[4], rn;
        {
            const bool first = (c == 0 && et == 0);
            const LAS unsigned char* rowc = L + B_RAW + (et + 1) * 384; const LAS unsigned char* rowp = L + B_RAW + et * 384;
            const v2u rc = *(const LAS v2u*)(rowc + cg * 8), rp = *(const LAS v2u*)(rowp + cg * 8);
            const v2u kc = *(const LAS v2u*)(rowc + 128 + cg * 8), kp = *(const LAS v2u*)(rowp + 128 + cg * 8);
            const v2u vc = *(const LAS v2u*)(rowc + 256 + cg * 8), vp = *(const LAS v2u*)(rowp + 256 + cg * 8);
#define SH4(dst, cu, pr, mu) do { const float c0_ = __uint_as_float(cu.x << 16), c1_ = __uint_as_float(cu.x & 0xffff0000u), c2_ = __uint_as_float(cu.y << 16), c3_ = __uint_as_float(cu.y & 0xffff0000u); \
            const float p0_ = first ? 0.f : __uint_as_float(pr.x << 16), p1_ = first ? 0.f : __uint_as_float(pr.x & 0xffff0000u), p2_ = first ? 0.f : __uint_as_float(pr.y << 16), p3_ = first ? 0.f : __uint_as_float(pr.y & 0xffff0000u); \
            dst[0] = c0_ + (p0_ - c0_) * mu[0]; dst[1] = c1_ + (p1_ - c1_) * mu[1]; dst[2] = c2_ + (p2_ - c2_) * mu[2]; dst[3] = c3_ + (p3_ - c3_) * mu[3]; } while (0)
            SH4(rs, rc, rp, mu_r); SH4(ksv, kc, kp, mu_k); SH4(vs, vc, vp, mu_v);
#undef SH4
            float q = 0.f;
#pragma unroll
            for (int i = 0; i < 4; ++i) { const float u = ksv[i] * kkc[i]; q += u * u; }
            q = allsum16(q); rn = __builtin_amdgcn_rsqf(fmaxf(q, 1e-24f));
        }
        LBAR(); TS(1);
        if (wave < 6) {
            int l2 = lane; asm volatile("" : "+v"(l2)); const int r32 = l2 & 31, hi = l2 >> 5;
            const LAS unsigned char* arow = L + B_AL + (r32 >> 1) * 1056 + (r32 & 1) * 512 + hi * 16;
            const int colb = (wave < 2) ? 0 : (wave < 4) ? 128 : 256;
            const LAS unsigned char* bfr = L + B_BF + (wave < 4 ? wave * 4 : 16 + (wave - 4) * 8) * 1024 + lane * 16;
            f32x16 acc = f32x16{};
            if (wave < 4) {
#pragma unroll
                for (int s = 0; s < 4; ++s) acc = __builtin_amdgcn_mfma_f32_32x32x16_bf16(*(const LAS bf16x8*)(arow + colb + 32 * s), *(const LAS bf16x8*)(bfr + s * 1024), acc, 0, 0, 0);
            } else {
#pragma unroll
                for (int s = 0; s < 8; ++s) acc = __builtin_amdgcn_mfma_f32_32x32x16_bf16(*(const LAS bf16x8*)(arow + colb + 32 * s), *(const LAS bf16x8*)(bfr + s * 1024), acc, 0, 0, 0);
            }
            LAS float* dst = (LAS float*)(L + ((wave < 2) ? B_WL : (wave < 4) ? B_AV : B_GV)) + (wave & 1) * 32 + r32;
#pragma unroll
            for (int r = 0; r < 16; ++r) dst[crow(r, hi) * 64] = acc[r];
        }
        LBAR(); TS(2);
        if (ci + 1 < 64) B_DMA(c + 1);
        float ee[4], kn[4], bb[4], kp4[4];
        f32x4 E;
        {
            const f32x4 wl = *(const LAS f32x4*)(L + B_WL + (et * 64 + 4 * cg) * 4), al = *(const LAS f32x4*)(L + B_AV + (et * 64 + 4 * cg) * 4), g4 = *(const LAS f32x4*)(L + B_GV + (et * 64 + 4 * cg) * 4);
            float rk = 0.f;
#pragma unroll
            for (int i = 0; i < 4; ++i) {
                ee[i] = 0.6065306597f * __builtin_amdgcn_rcpf(1.0f + __expf(-(wl[i] + w0c[i])));
                const float a = __builtin_amdgcn_rcpf(1.0f + __expf(-(al[i] + a0c[i])));
                kn[i] = ksv[i] * kkc[i] * rn; bb[i] = kn[i] * a; kp4[i] = ksv[i] * (1.0f + (a - 1.0f) * kac[i]); rk += rs[i] * kp4[i] * rkc[i]; }
            rk = allsum16(rk);
            float zz[4], gg[4];
#pragma unroll
            for (int i = 0; i < 4; ++i) { zz[i] = (lnb[i] + rk * vs[i]) * g4[i]; gg[i] = g4[i] * lng[i]; }
            const size_t o = (mrow0 + (size_t)c * TC + et) * 512 + chb;
            *(GAS v2u*)(Z + o) = (v2u){attn_body::cvtpk_s(zz[0], zz[1]), attn_body::cvtpk_s(zz[2], zz[3])};
            *(GAS v2u*)(GG + o) = (v2u){attn_body::cvtpk_s(gg[0], gg[1]), attn_body::cvtpk_s(gg[2], gg[3])};
#pragma unroll
            for (int i = 0; i < 4; ++i) { float p = ee[i]; const float t1 = __shfl_up(p, 16); if (lane >= 16) p += t1;
                auto rr = __builtin_amdgcn_permlane32_swap(__float_as_uint(p), __float_as_uint(p), false, false); if (lane >= 32) p += __uint_as_float(rr[0]);
                E[i] = p; }
            if (lane >= 48) *(LAS f32x4*)(L + B_EE + (wave * 16 + cg) * 16) = E;
        }
        LBAR(); TS(3);
        {
#pragma unroll
            for (int w = 0; w < 7; ++w) { const f32x4 tw = *(const LAS f32x4*)(L + B_EE + (w * 16 + cg) * 16); if (w < wave) E += tw; }
            float al_[4], be_[4], ka_[4], rh_[4];
#pragma unroll
            for (int i = 0; i < 4; ++i) { const float gt = __expf(-E[i]), gp = __expf(-(E[i] - ee[i])), ig = __expf(E[i]);
                al_[i] = gp * kn[i]; be_[i] = bb[i] * ig; ka_[i] = kp4[i] * ig; rh_[i] = gt * rs[i];
                if (et == 31) *(LAS float*)(L + B_GL + (4 * cg + i) * 4) = gt; }
            *(LAS v2u*)(L + B_ALP + et * S64 + cg * 8) = (v2u){attn_body::cvtpk_s(al_[0], al_[1]), attn_body::cvtpk_s(al_[2], al_[3])};
            *(LAS v2u*)(L + B_BET + et * S64 + cg * 8) = (v2u){attn_body::cvtpk_s(be_[0], be_[1]), attn_body::cvtpk_s(be_[2], be_[3])};
            *(LAS v2u*)(L + B_KAP + et * S64 + cg * 8) = (v2u){attn_body::cvtpk_s(ka_[0], ka_[1]), attn_body::cvtpk_s(ka_[2], ka_[3])};
            *(LAS v2u*)(L + B_RHO + et * S64 + cg * 8) = (v2u){attn_body::cvtpk_s(rh_[0], rh_[1]), attn_body::cvtpk_s(rh_[2], rh_[3])};
            *(LAS v2u*)(L + B_VSL + et * S64 + cg * 8) = (v2u){attn_body::cvtpk_s(vs[0], vs[1]), attn_body::cvtpk_s(vs[2], vs[3])};
        }
        LBAR(); TS(4);
        {
            const int mtx = tid >> 7, cb = (tid >> 3) & 15, tb = tid & 7;
            const LAS unsigned char* src = L + ((mtx == 0) ? B_ALP : (mtx == 1) ? B_BET : (mtx == 2) ? B_KAP : B_VSL) + (4 * tb) * S64 + cb * 8;
            const v2u r0 = *(const LAS v2u*)(src), r1 = *(const LAS v2u*)(src + S64), r2 = *(const LAS v2u*)(src + 2 * S64), r3 = *(const LAS v2u*)(src + 3 * S64);
            LAS unsigned char* dst = (mtx == 3) ? L + B_OUT + O_VT + (cb >> 3) * 3072 + (4 * (cb & 7)) * S32 + tb * 8 : L + ((mtx == 0) ? B_ALPT : (mtx == 1) ? B_BETT : B_KAPT) + (4 * cb) * S32 + tb * 8;
            *(LAS v2u*)(dst)           = (v2u){(r0.x & 0xffffu) | (r1.x << 16), (r2.x & 0xffffu) | (r3.x << 16)};
            *(LAS v2u*)(dst + S32)     = (v2u){(r0.x >> 16) | (r1.x & 0xffff0000u), (r2.x >> 16) | (r3.x & 0xffff0000u)};
            *(LAS v2u*)(dst + 2 * S32) = (v2u){(r0.y & 0xffffu) | (r1.y << 16), (r2.y & 0xffffu) | (r3.y << 16)};
            *(LAS v2u*)(dst + 3 * S32) = (v2u){(r0.y >> 16) | (r1.y & 0xffff0000u), (r2.y >> 16) | (r3.y & 0xffff0000u)};
        }
        LBAR(); TS(5);
        int ln = lane; asm volatile("" : "+v"(ln));
        f32x16 X = f32x16{}, RK = f32x16{};
        {
            const int r32 = ln & 31, hi = ln >> 5;
            if (wave == 0) { f32x16 acc = f32x16{}; tile_nt(acc, L + B_ALP, S64, 0, L + B_BET, S64, 0, 4, ln);
#pragma unroll
                for (int r = 0; r < 16; ++r) acc[r] = (crow(r, hi) > r32) ? -acc[r] : 0.f;
                store_nat(L + B_PW0 + 32 * S32, S32, 0, acc, ln);
            } else if (wave == 4) { f32x16 acc = f32x16{}; tile_nt(acc, L + B_BET, S64, 0, L + B_ALP, S64, 0, 4, ln);
#pragma unroll
                for (int r = 0; r < 16; ++r) acc[r] = (r32 > crow(r, hi)) ? -acc[r] : 0.f;
                store_nat(L + B_PW0, S32, 0, acc, ln);
            } else if (wave == 1) { tile_nt(X, L + B_ALP, S64, 0, L + B_KAP, S64, 0, 4, ln);
#pragma unroll
                for (int r = 0; r < 16; ++r) X[r] = (crow(r, hi) > r32) ? X[r] : 0.f;
            } else if (wave == 2 || wave == 3) {
                const LAS unsigned char* ap = L + B_ALPT + ((wave - 2) * 32 + r32) * S32 + 8 * hi;
#pragma unroll
                for (int g4 = 0; g4 < 4; ++g4) { const v2u t2 = *(const LAS v2u*)(ap + 16 * g4);
                    X[4 * g4] = __uint_as_float(t2.x << 16); X[4 * g4 + 1] = __uint_as_float(t2.x & 0xffff0000u); X[4 * g4 + 2] = __uint_as_float(t2.y << 16); X[4 * g4 + 3] = __uint_as_float(t2.y & 0xffff0000u); }
            } else if (wave == 5) { f32x16 acc = f32x16{}; tile_nt(acc, L + B_BET, S64, 0, L + B_RHO, S64, 0, 4, ln);
#pragma unroll
                for (int r = 0; r < 16; ++r) acc[r] = (r32 >= crow(r, hi)) ? acc[r] : 0.f;
                store_nat(L + B_ARB, S32, 0, acc, ln);
            } else if (wave == 6) { tile_nt(RK, L + B_KAP, S64, 0, L + B_RHO, S64, 0, 4, ln);
#pragma unroll
                for (int r = 0; r < 16; ++r) RK[r] = (r32 >= crow(r, hi)) ? RK[r] : 0.f; }
        }
        LBAR(); TS(6);
#pragma unroll
        for (int j = 0; j < 5; ++j) {
            const LAS unsigned char* pw = L + ((j & 1) ? B_PW1 : B_PW0); LAS unsigned char* pn = L + ((j & 1) ? B_PW0 : B_PW1);
            asm volatile("" : "+v"(ln));
            if (wave >= 1 && wave <= 3) { LAS unsigned char* xt = (wave == 1) ? L + B_UMT : L + B_WMT + (wave - 2) * 32 * S32;
                store_nat(xt, S32, 0, X, ln);
                tile_nt(X, pw, S32, 0, xt, S32, 0, 2, ln);
                if (j == 4) store_nat(xt, S32, 0, X, ln);
            } else if (j < 4 && (wave == 0 || wave == 4)) { f32x16 sq = f32x16{};
                if (wave == 0) { tile_nt(sq, pw, S32, 0, pw + 32 * S32, S32, 0, 2, ln); store_nat(pn + 32 * S32, S32, 0, sq, ln); }
                else           { tile_nt(sq, pw + 32 * S32, S32, 0, pw, S32, 0, 2, ln); store_nat(pn, S32, 0, sq, ln); } }
            LBAR();
        }
        TS(7);
        {
            asm volatile("" : "+v"(ln)); const int r32 = ln & 31, hi = ln >> 5; LAS unsigned char* OQ = L + B_OUT + O_QPH; LAS unsigned char* OG = L + B_OUT + O_GT;
            if (wave < 2) { f32x16 acc = f32x16{}; tile_nt(acc, L + B_WMT, S32, wave * 32, L + B_ARB, S32, 0, 2, ln);
#pragma unroll
                for (int g4 = 0; g4 < 4; ++g4) { const v2u rr = *(const LAS v2u*)(L + B_RHO + r32 * S64 + (wave * 32 + 8 * g4 + 4 * hi) * 2);
                    acc[4 * g4] = __uint_as_float(rr.x << 16) - acc[4 * g4]; acc[4 * g4 + 1] = __uint_as_float(rr.x & 0xffff0000u) - acc[4 * g4 + 1]; acc[4 * g4 + 2] = __uint_as_float(rr.y << 16) - acc[4 * g4 + 2]; acc[4 * g4 + 3] = __uint_as_float(rr.y & 0xffff0000u) - acc[4 * g4 + 3]; }
                store_nat(OQ, S64, 0, acc, ln, wave * 32); }
            if (wave == 2 || wave == 3) { const int ni = wave - 2; f32x16 acc = f32x16{}; tile_nt(acc, L + B_UMT, S32, 0, L + B_BETT, S32, ni * 32, 2, ln);
                const int ch = ni * 32 + r32; const float gl = *(const LAS float*)(L + B_GL + ch * 4);
#pragma unroll
                for (int g4 = 0; g4 < 4; ++g4) { const v2u kk2 = *(const LAS v2u*)(L + B_KAPT + ch * S32 + (8 * g4 + 4 * hi) * 2);
                    acc[4 * g4] = (__uint_as_float(kk2.x << 16) - acc[4 * g4]) * gl; acc[4 * g4 + 1] = (__uint_as_float(kk2.x & 0xffff0000u) - acc[4 * g4 + 1]) * gl;
                    acc[4 * g4 + 2] = (__uint_as_float(kk2.y << 16) - acc[4 * g4 + 2]) * gl; acc[4 * g4 + 3] = (__uint_as_float(kk2.y & 0xffff0000u) - acc[4 * g4 + 3]) * gl; }
                store_nat(OQ + O_HT, S32, ni * 32, acc, ln); }
            if (wave == 6) { f32x16 acc = f32x16{}; tile_nt(acc, L + B_UMT, S32, 0, L + B_ARB, S32, 0, 2, ln);
#pragma unroll
                for (int r = 0; r < 16; ++r) acc[r] = RK[r] - acc[r];
                store_nat(OQ + O_PM, S32, 0, acc, ln); }
            if (wave >= 4) { const int gi = (wave == 4) ? 0 : (wave == 5) ? 1 : (wave == 7) ? 2 : 3, mi = gi >> 1, ni = gi & 1; f32x16 acc = f32x16{};
                tile_nt(acc, L + B_WMT, S32, mi * 32, L + B_BETT, S32, ni * 32, 2, ln);
                const int ch = ni * 32 + r32; const float gl = *(const LAS float*)(L + B_GL + ch * 4);
#pragma unroll
                for (int r = 0; r < 16; ++r) { const int chp = mi * 32 + crow(r, hi); acc[r] = (((chp == ch) ? 1.f : 0.f) - acc[r]) * gl; }
                store_nat(OG, S64, ni * 32, acc, ln, mi * 32); }
        }
    }
    __syncthreads();
#if defined(MK_TSTAGE)
    if (blockIdx.x == 0 && wave == 0) { const unsigned long long t0_ = __builtin_amdgcn_s_memrealtime(); while (__builtin_amdgcn_s_memrealtime() - t0_ < 4ull * ts_acc) __builtin_amdgcn_s_sleep(8); }
#endif
    B_COPYOUT(c0 + 63);
    asm volatile("s_waitcnt vmcnt(0)" ::: "memory"); __syncthreads();
#undef B_DMA
#undef B_COPYOUT
#undef TS
}

constexpr int A_IMG = 0, IMG_B = 3072 + QPH_B + GT_B;
constexpr int A_S = 3 * IMG_B, A_SB = 32 * S64, A_YB = A_S + 2 * A_SB, A_END = A_YB + 2 * 4096;
static_assert(A_END <= LDSCTL_OFF, "scan2 apply LDS");
__device__ __forceinline__ void apply(Frame& F) {
    const int tid = F.tid, lane = F.lane, wave = F.wave;
    const int half = F.vcu & 1, bh = F.vcu >> 1, hd = bh & 7, b = bh >> 3;
    LAS unsigned char* L = F.lds;
    const unsigned lds0 = (unsigned)(uintptr_t)(unsigned char*)F.lds;
    bf16* Y = (bf16*)((unsigned char*)F.out + OUT_Y);
    const size_t mrow0 = (size_t)b * SEQ;
    const int dw = (wave - 3) & 1;
#define A_DMA(c) do { const size_t u_ = (size_t)bh * 128 + (c); \
        _Pragma("unroll") for (int i_ = 0; i_ < 12; ++i_) { const int p_ = dw * 12 + i_; \
            const unsigned char* src_ = (p_ < 3) ? vt_home(F, b, hd) + (size_t)(c) * VT_B + half * 3072 + p_ * 1024 : (p_ < 15) ? qph_home(F, b, hd) + (size_t)(c) * QPH_B + (p_ - 3) * 1024 : F.ws + WS_GT + u_ * GT_B + (p_ - 15) * 1024; \
            attn_body::glds16(src_ + lane * 16, (unsigned)__builtin_amdgcn_readfirstlane(lds0 + A_IMG + ((c) % 3) * IMG_B + p_ * 1024)); } } while (0)
    for (int q = tid; q < 32 * S64 / 4; q += 512) ((LAS unsigned*)(L + A_S))[q] = 0u;
    if (wave == 3 || wave == 4) A_DMA(0);
    if (wave == 5 || wave == 6) A_DMA(1);
    for (int c = 0; c < SEQ / TC; ++c) {
        const bool mydma = (wave >= 3 && wave < 7) && ((((wave - 3) >> 1) & 1) == (c & 1));
        if (mydma) asm volatile("s_waitcnt vmcnt(0)" ::: "memory");
        LBAR();
        if (mydma && c + 2 < SEQ / TC) A_DMA(c + 2);
        const LAS unsigned char* I = L + A_IMG + (c % 3) * IMG_B; const LAS unsigned char* IVT = I; const LAS unsigned char* IQ = I + 3072; const LAS unsigned char* IG = I + 3072 + QPH_B;
        f32x16 acc = f32x16{};
        int ln = lane; asm volatile("" : "+v"(ln)); const int r32 = ln & 31, hi = ln >> 5;
        const LAS unsigned char* Sc = L + A_S + (c & 1) * A_SB; LAS unsigned char* Sn = L + A_S + ((c + 1) & 1) * A_SB;
        if (wave == 0) { tile_nt(acc, IQ, S64, 0, Sc, S64, 0, 4, ln); tile_nt(acc, IQ + O_PM, S32, 0, IVT, S32, 0, 2, ln); }
        else if (wave < 3) { const int ni = wave - 1; tile_nt(acc, IG, S64, ni * 32, Sc, S64, 0, 4, ln); tile_nt(acc, IQ + O_HT, S32, ni * 32, IVT, S32, 0, 2, ln); }
        if (wave == 7 && c > 0) {
#pragma unroll
            for (int i = 0; i < 2; ++i) { const int q = i * 64 + lane, st = q >> 2, v8 = (q & 3) * 8; const LAS f32x4* yp = (const LAS f32x4*)(L + A_YB + ((c - 1) & 1) * 4096 + (st * 32 + v8) * 4); const f32x4 ya = yp[0], yb = yp[1];
                *(GAS v4u*)(Y + (mrow0 + (size_t)(c - 1) * TC + st) * 512 + hd * 64 + half * 32 + v8) = (v4u){attn_body::cvtpk_s(ya[0], ya[1]), attn_body::cvtpk_s(ya[2], ya[3]), attn_body::cvtpk_s(yb[0], yb[1]), attn_body::cvtpk_s(yb[2], yb[3])}; } }
        if (wave == 0) {
#pragma unroll
            for (int r = 0; r < 16; ++r) *(LAS float*)(L + A_YB + (c & 1) * 4096 + (crow(r, hi) * 32 + r32) * 4) = acc[r]; }
        else if (wave < 3) store_nat(Sn, S64, 0, acc, ln, (wave - 1) * 32);
    }
    __syncthreads();
    if (wave == 7) {
#pragma unroll
        for (int i = 0; i < 2; ++i) { const int q = i * 64 + lane, st = q >> 2, v8 = (q & 3) * 8; const LAS f32x4* yp = (const LAS f32x4*)(L + A_YB + ((SEQ / TC - 1) & 1) * 4096 + (st * 32 + v8) * 4); const f32x4 ya = yp[0], yb = yp[1];
            *(GAS v4u*)(Y + (mrow0 + (size_t)(SEQ / TC - 1) * TC + st) * 512 + hd * 64 + half * 32 + v8) = (v4u){attn_body::cvtpk_s(ya[0], ya[1]), attn_body::cvtpk_s(ya[2], ya[3]), attn_body::cvtpk_s(yb[0], yb[1]), attn_body::cvtpk_s(yb[2], yb[3])}; } }
    asm volatile("s_waitcnt vmcnt(0)" ::: "memory"); __syncthreads();
#undef A_DMA
}
constexpr int A2_IMG = 0, IMG2_B = VT_B + QPH_B + GT_B;
constexpr int A2_S = 3 * IMG2_B, A2_YB = A2_S + 64 * S64, A2_END = A2_YB + 2 * 8192;
static_assert(A2_END <= LDSCTL_OFF, "scan2 apply2 LDS");
__device__ __forceinline__ void a2_epilogue(const LAS float* yr, const v4u (&gq)[4], const v4u (&zq)[4], bf16* dst) {
    float y[32]; float s = 0.f;
#pragma unroll
    for (int i = 0; i < 8; ++i) { const f32x4 t4 = *(const LAS f32x4*)(yr + 4 * i); y[4 * i] = t4[0]; y[4 * i + 1] = t4[1]; y[4 * i + 2] = t4[2]; y[4 * i + 3] = t4[3]; s += (t4[0] + t4[1]) + (t4[2] + t4[3]); }
    s += __int_as_float(__builtin_amdgcn_update_dpp(0, __float_as_int(s), 0xB1, 0xf, 0xf, false));
    const float mean = s * (1.f / 64.f); float q = 0.f;
#pragma unroll
    for (int i = 0; i < 32; ++i) { y[i] -= mean; q += y[i] * y[i]; }
    q += __int_as_float(__builtin_amdgcn_update_dpp(0, __float_as_int(q), 0xB1, 0xf, 0xf, false));
    const float rstd = __builtin_amdgcn_rsqf(q * (1.f / 64.f) + 64e-5f);
#pragma unroll
    for (int h = 0; h < 4; ++h) { unsigned ow[4];
#pragma unroll
        for (int i = 0; i < 4; ++i) { const unsigned gw_ = gq[h][i], zw_ = zq[h][i]; const int k = 8 * h + 2 * i;
            const float o0 = y[k] * rstd * __uint_as_float(gw_ << 16) + __uint_as_float(zw_ << 16), o1 = y[k + 1] * rstd * __uint_as_float(gw_ & 0xffff0000u) + __uint_as_float(zw_ & 0xffff0000u);
            ow[i] = attn_body::cvtpk_s(o0, o1); }
        *(GAS v4u*)(dst + 8 * h) = (v4u){ow[0], ow[1], ow[2], ow[3]}; }
}
__device__ __forceinline__ void apply2(Frame& F) {
    if (F.vcu & 1) return;
    const int lane = F.lane, wave = F.wave;
    const int bh = F.vcu >> 1, hd = bh & 7, b = bh >> 3;
    LAS unsigned char* L = F.lds;
    const unsigned lds0 = (unsigned)(uintptr_t)(unsigned char*)F.lds;
    const bf16* GG = (const bf16*)((unsigned char*)F.out + OUT_GG); const bf16* Z = (const bf16*)((unsigned char*)F.out + OUT_Z); bf16* MIX = (bf16*)(F.ws + WS_MIX);
    const size_t mrow0 = (size_t)b * SEQ;
#define A2_DMA(c) do { const size_t u_ = (size_t)bh * 128 + (c); \
        _Pragma("unroll") for (int i_ = 0; i_ < 4; ++i_) { const int p_ = wave + 7 * i_; if (p_ < 27) { \
            const unsigned char* src_ = (p_ < 6) ? F.ws + WS_VT + u_ * VT_B + p_ * 1024 : (p_ < 18) ? F.ws + WS_QPH + u_ * QPH_B + (p_ - 6) * 1024 : F.ws + WS_GT + u_ * GT_B + (p_ - 18) * 1024; \
            attn_body::glds16(src_ + lane * 16, (unsigned)__builtin_amdgcn_readfirstlane(lds0 + A2_IMG + ((c) % 3) * IMG2_B + p_ * 1024)); } } } while (0)
    for (int q = F.tid; q < 64 * S64 / 4; q += 512) ((LAS unsigned*)(L + A2_S))[q] = 0u;
    if (wave < 7) { A2_DMA(0); A2_DMA(1); }
    const int est = lane >> 1, ev0 = 32 * (lane & 1);
    v4u gq[4], zq[4];
    for (int c = 0; c < SEQ / TC; ++c) {
        if (wave < 7) { if (c + 1 >= SEQ / TC) asm volatile("s_waitcnt vmcnt(0)" ::: "memory"); else if (wave < 6) asm volatile("s_waitcnt vmcnt(4)" ::: "memory"); else asm volatile("s_waitcnt vmcnt(3)" ::: "memory"); }
        LBAR();
        if (wave < 7 && c + 2 < SEQ / TC) A2_DMA(c + 2);
        const LAS unsigned char* I = L + A2_IMG + (c % 3) * IMG2_B; const LAS unsigned char* IVT = I; const LAS unsigned char* IQ = I + VT_B; const LAS unsigned char* IG = I + VT_B + QPH_B;
        f32x16 acc = f32x16{};
        int ln = lane; asm volatile("" : "+v"(ln)); const int r32 = ln & 31, hi = ln >> 5;
        if (wave < 2) { tile_nt(acc, IQ, S64, 0, L + A2_S, S64, wave * 32, 4, ln); tile_nt(acc, IQ + O_PM, S32, 0, IVT + wave * 3072, S32, 0, 2, ln); }
        else if (wave < 6) { const int ni = (wave - 2) & 1, vi = (wave - 2) >> 1;
            tile_nt(acc, IG, S64, ni * 32, L + A2_S, S64, vi * 32, 4, ln); tile_nt(acc, IQ + O_HT, S32, ni * 32, IVT + vi * 3072, S32, 0, 2, ln); }
        else if (wave == 7) {
            if (c > 0) a2_epilogue((const LAS float*)(L + A2_YB + ((c - 1) & 1) * 8192) + est * 64 + ev0, gq, zq, MIX + (mrow0 + (size_t)(c - 1) * TC + est) * 1024 + hd * 64 + ev0);
            const size_t o = (mrow0 + (size_t)c * TC + est) * 512 + hd * 64 + ev0;
#pragma unroll
            for (int i = 0; i < 4; ++i) { gq[i] = *(const GAS v4u*)(GG + o + 8 * i); zq[i] = *(const GAS v4u*)(Z + o + 8 * i); }
        }
        LBAR();
        if (wave < 2) {
#pragma unroll
            for (int r = 0; r < 16; ++r) *(LAS float*)(L + A2_YB + (c & 1) * 8192 + (crow(r, hi) * 64 + wave * 32 + r32) * 4) = acc[r]; }
        else if (wave < 6) store_nat(L + A2_S, S64, ((wave - 2) >> 1) * 32, acc, ln, ((wave - 2) & 1) * 32);
    }
    LBAR();
    if (wave == 7) a2_epilogue((const LAS float*)(L + A2_YB + ((SEQ / TC - 1) & 1) * 8192) + est * 64 + ev0, gq, zq, MIX + (mrow0 + (size_t)(SEQ / TC - 1) * TC + est) * 1024 + hd * 64 + ev0);
    asm volatile("s_waitcnt vmcnt(0)" ::: "memory");
#undef A2_DMA
}
#undef ST16
}

constexpr size_t WS_XS = 264 * MiB, WS_HID = 536 * MiB, WS_YB = 672 * MiB;
constexpr size_t WS_X1B = 264 * MiB, X1B_XTRA = 3 * 1024 * 1024;
constexpr int SLOT_CAP = 65536;
constexpr int L_TB = 131072;
__device__ __forceinline__ void moe_tile_table(Frame& F) {
    LAS int* cnt = (LAS int*)(F.lds + L_TB); LAS int* tb = cnt + 32;
    if (F.tid < 32) cnt[F.tid] = (int)__hip_atomic_load(F.ctl + CW_CNT + 64 * F.tid, RLX_AGENT);
    __syncthreads();
    if (F.tid == 0) { int s = 0; for (int e = 0; e < 32; ++e) { tb[e] = s; s += (cnt[e] + 255) >> 8; } tb[32] = s; }
    __syncthreads();
}
__device__ __forceinline__ void m0_route(Frame& F) {
    LAS f32x4* Wg4 = (LAS f32x4*)(F.lds);
    LAS f32x4* Wr4 = (LAS f32x4*)(F.lds + 16384);
    LAS int* tokE = (LAS int*)(F.lds + 147456);
    LAS float* tokW = (LAS float*)(F.lds + 147456 + 2048);
    LAS int* hist = (LAS int*)(F.lds + 147456 + 4096);
    const float* wgrp = F.in[IN_WGRP]; const float* wrt = F.in[IN_WRT];
    for (int idx = F.tid; idx < 1024 * 4; idx += 512) { const int c = idx >> 2, j = idx & 3; const int l = (c & 255) >> 2, jj = (c >> 8) * 4 + (c & 3); ((LAS float*)Wg4)[(jj * 64 + l) * 4 + j] = wgrp[idx]; }
    for (int i0 = 0; i0 < 64; i0 += 16) { float wv_[16];
#pragma unroll
        for (int i = 0; i < 16; ++i) wv_[i] = wrt[F.tid + 512 * (i0 + i)];
#pragma unroll
        for (int i = 0; i < 16; ++i) { const int idx = F.tid + 512 * (i0 + i); const int c = idx >> 5, e = idx & 31; const int l = (c & 255) >> 2, jj = (c >> 8) * 4 + (c & 3); ((LAS float*)Wr4)[(((e >> 2) * 16 + jj) * 64 + l) * 4 + (e & 3)] = wv_[i]; } }
    const float* g2 = F.in[IN_N2G]; const float* mod = (const float*)(F.ws + WS_MOD); const float* bgrp = F.in[IN_BGRP]; const float* brt = F.in[IN_BRT];
    bf16* H2 = (bf16*)(F.ws + WS_H); int* slot_tok = (int*)(F.ws + WS_SLOT_TOK); float* slot_w = (float*)(F.ws + WS_SLOT_W); unsigned* tokinfo = (unsigned*)(F.ws + WS_TOKINFO);
    const float bg0 = bgrp[0], bg1 = bgrp[1], bg2 = bgrp[2], bg3 = bgrp[3];
    f32x4 WG[16];
#pragma unroll
    for (int q = 0; q < 16; ++q) WG[q] = *(const f32x4*)(wgrp + (size_t)(4 * F.lane + 256 * (q >> 2) + (q & 3)) * 4);
    for (int rb = F.vcu; rb < NTOK / 256; rb += F.G) {
        if (F.tid < 32) hist[F.tid] = 0;
        __syncthreads();
        const int b = (rb * 256) / SEQ;
        f32x4 A[4], Bc[4];
#pragma unroll
        for (int j = 0; j < 4; ++j) { const int c = 4 * F.lane + 256 * j; const f32x4 g = *(const f32x4*)(g2 + c), sc = *(const f32x4*)(mod + (size_t)b * NMOD + 4096 + c); A[j] = g * (sc + 1.0f); Bc[j] = *(const f32x4*)(mod + (size_t)b * NMOD + 3072 + c); }
        const bf16* X1B = (const bf16*)(F.ws + WS_X1B) + (size_t)b * X1B_XTRA;
        v2u vn[4];
        { const GAS v2u* xr0 = (const GAS v2u*)(X1B + ((size_t)rb * 256 + F.wave) * 1024) + F.lane;
#pragma unroll
          for (int j = 0; j < 4; ++j) vn[j] = xr0[64 * j]; }
        for (int r = F.wave; r < 256; r += NWAVES) {
            const size_t m = (size_t)rb * 256 + r;
            f32x4 v[4]; float ss = 0.f;
#pragma unroll
            for (int j = 0; j < 4; ++j) v[j] = (f32x4){__uint_as_float(vn[j][0] << 16), __uint_as_float(vn[j][0] & 0xffff0000u), __uint_as_float(vn[j][1] << 16), __uint_as_float(vn[j][1] & 0xffff0000u)};
            if (r + NWAVES < 256) { const GAS v2u* xr = (const GAS v2u*)(X1B + (m + NWAVES) * 1024) + F.lane;
#pragma unroll
                for (int j = 0; j < 4; ++j) vn[j] = xr[64 * j]; }
#pragma unroll
            for (int j = 0; j < 4; ++j) ss += (v[j].x * v[j].x + v[j].y * v[j].y) + (v[j].z * v[j].z + v[j].w * v[j].w);
            const float rstd = __builtin_amdgcn_rsqf(wave_sum(ss) * (1.f / 1024.f) + 1e-6f);
            GAS unsigned long long* o8 = (GAS unsigned long long*)(H2 + m * 1024) + F.lane;
            f32x4 ga = (f32x4){0.f, 0.f, 0.f, 0.f};
#pragma unroll
            for (int j = 0; j < 4; ++j) { v[j] = v[j] * rstd * A[j] + Bc[j];
                o8[64 * j] = (unsigned long long)attn_body::cvtpk_s(v[j].x, v[j].y) | ((unsigned long long)attn_body::cvtpk_s(v[j].z, v[j].w) << 32);
#pragma unroll
                for (int i = 0; i < 4; ++i) ga += WG[j * 4 + i] * v[j][i]; }
            float gv_[4] = {ga[0], ga[1], ga[2], ga[3]}, gt_[4]; wave_reduce4(gv_, gt_, F.lane);
            const float l0 = gt_[0] + bg0, l1 = gt_[1] + bg1, l2 = gt_[2] + bg2, l3 = gt_[3] + bg3;
            int gs = 0; float lm = l0; if (l1 > lm) { lm = l1; gs = 1; } if (l2 > lm) { lm = l2; gs = 2; } if (l3 > lm) { lm = l3; gs = 3; }
            const float pg = __builtin_amdgcn_rcpf(__expf(l0 - lm) + __expf(l1 - lm) + __expf(l2 - lm) + __expf(l3 - lm));
            gs = __builtin_amdgcn_readfirstlane(gs);
            f32x4 e0 = (f32x4){0.f, 0.f, 0.f, 0.f}, e1 = e0;
            const LAS f32x4* w0p = Wr4 + (gs * 2) * 1024 + F.lane; const LAS f32x4* w1p = w0p + 1024;
#pragma unroll
            for (int j = 0; j < 4; ++j)
#pragma unroll
                for (int i = 0; i < 4; ++i) { e0 += w0p[(j * 4 + i) * 64] * v[j][i]; e1 += w1p[(j * 4 + i) * 64] * v[j][i]; }
            float el[8], ev_[8] = {e0[0], e0[1], e0[2], e0[3], e1[0], e1[1], e1[2], e1[3]}; wave_reduce8(ev_, el, F.lane);
#pragma unroll
            for (int q = 0; q < 8; ++q) el[q] += brt[gs * 8 + q];
            int i1 = 0; float m1 = el[0];
#pragma unroll
            for (int q = 1; q < 8; ++q) if (el[q] > m1) { m1 = el[q]; i1 = q; }
            int i2 = -1; float m2 = -3.0e38f;
#pragma unroll
            for (int q = 0; q < 8; ++q) if (q != i1 && el[q] > m2) { m2 = el[q]; i2 = q; }
            const float t = __expf(m2 - m1), w1 = pg * __builtin_amdgcn_rcpf(1.0f + t), w2 = w1 * t;
            if (F.lane == 0) { tokE[2 * r] = gs * 8 + i1; tokE[2 * r + 1] = gs * 8 + i2; tokW[2 * r] = w1; tokW[2 * r + 1] = w2; }
        }
        __syncthreads();
        const int ar = F.tid >> 1, ak = F.tid & 1, ae = tokE[2 * ar + ak];
        const int lpos = __hip_atomic_fetch_add(hist + ae, 1, __ATOMIC_RELAXED, __HIP_MEMORY_SCOPE_WORKGROUP);
        __syncthreads();
        if (F.tid < 32) { const int n = hist[F.tid]; hist[32 + F.tid] = n ? (int)__hip_atomic_fetch_add(F.ctl + CW_CNT + 64 * F.tid, (unsigned)n, RLX_AGENT) : 0; }
        __syncthreads();
        { const int pos = hist[32 + ae] + lpos; const int tok = rb * 256 + ar;
          slot_tok[(size_t)ae * SLOT_CAP + pos] = tok; slot_w[(size_t)ae * SLOT_CAP + pos] = tokW[2 * ar + ak]; tokinfo[2 * tok + ak] = ((unsigned)ae << 20) | (unsigned)pos; }
        __syncthreads();
    }
}
__device__ __forceinline__ void m1_permute(Frame& F) {
    moe_tile_table(F);
    const LAS int* cnt = (const LAS int*)(F.lds + L_TB); const LAS int* tb = cnt + 32;
    const bf16* H2 = (const bf16*)(F.ws + WS_H); bf16* XS = (bf16*)(F.ws + WS_XS); const int* slot_tok = (const int*)(F.ws + WS_SLOT_TOK);
    const int nrows = tb[32] * 256, gw = F.vcu * NWAVES + F.wave, NGW = F.G * NWAVES;
    for (int R = gw; R < nrows; R += NGW) {
        const int rt = R >> 8; int e = 0;
        for (int q = 1; q < 32; ++q) if (tb[q] <= rt) e = q;
        const int slot = (rt - tb[e]) * 256 + (R & 255);
        v4u a = (v4u){0u, 0u, 0u, 0u}, c = a;
        if (slot < cnt[e]) { const int tok = slot_tok[(size_t)e * SLOT_CAP + slot]; const GAS v4u* src = (const GAS v4u*)(H2 + (size_t)tok * 1024) + F.lane; a = src[0]; c = src[64]; }
        GAS v4u* dst = (GAS v4u*)(XS + (size_t)R * 1024) + F.lane; dst[0] = a; dst[64] = c;
    }
}
constexpr int L_TOKL = L_TB + 1024;
template <bool GATHER_> struct MoeOrder {
    static constexpr bool GATHER = GATHER_;
    const LAS int* tb; const LAS int* tokl; int G, c, nwg;
    __device__ __forceinline__ bool next(int i, pg8::Unit& u) const {
        const int Lq = i * G + c; if (Lq >= nwg) return false;
        const int rt = Lq >> 2; int e = 0;
        for (int q = 1; q < 32; ++q) if (tb[q] <= rt) e = q;
        u.pm = rt; u.pn = 4 * e + (Lq & 3); u.e = e; u.j = GATHER_ ? rt - tb[e] : i; return true;
    }
    __device__ __forceinline__ unsigned a_row(int ui, int row) const { return (unsigned)tokl[ui * 256 + row]; }
    __device__ __forceinline__ void a_ready(const pg8::Unit&) const {}
    __device__ __forceinline__ void done(const pg8::Unit&) const {}
};
__device__ __forceinline__ void moe_fill_tokl(Frame& F) {
    const LAS int* cnt = (const LAS int*)(F.lds + L_TB); const LAS int* tb = cnt + 32; LAS int* tokl = (LAS int*)(F.lds + L_TOKL);
    const int* slot_tok = (const int*)(F.ws + WS_SLOT_TOK); const int T_ = tb[32], q0 = (((F.vcu >> 4) * T_) >> 4) * 4 + (F.vcu & 15), nwg = ((((F.vcu >> 4) + 1) * T_) >> 4) * 4;
    for (int i = 0; i < 12; ++i) { const int Lq = i * 16 + q0; if (Lq >= nwg) break;
        const int rt = Lq >> 2; int e = 0;
        for (int q = 1; q < 32; ++q) if (tb[q] <= rt) e = q;
        if (F.tid < 256) { const int slot = (rt - tb[e]) * 256 + F.tid; tokl[i * 256 + F.tid] = slot < cnt[e] ? slot_tok[(size_t)e * SLOT_CAP + slot] : 0; } }
    __syncthreads();
}
__device__ __forceinline__ void moe_fill_wl(Frame& F) {
    const LAS int* cnt = (const LAS int*)(F.lds + L_TB); const LAS int* tb = cnt + 32; LAS float* wl = (LAS float*)(F.lds + L_TOKL);
    const float* slot_w = (const float*)(F.ws + WS_SLOT_W); const int T_ = tb[32], q0 = (((F.vcu >> 4) * T_) >> 4) * 4 + (F.vcu & 15), nwg = ((((F.vcu >> 4) + 1) * T_) >> 4) * 4;
    for (int i = 0; i < 12; ++i) { const int Lq = i * 16 + q0; if (Lq >= nwg) break;
        const int rt = Lq >> 2; int e = 0;
        for (int q = 1; q < 32; ++q) if (tb[q] <= rt) e = q;
        if (F.tid < 256) { const int slot = (rt - tb[e]) * 256 + F.tid; wl[i * 256 + F.tid] = slot < cnt[e] ? slot_w[(size_t)e * SLOT_CAP + slot] : 0.f; } }
    __syncthreads();
}
namespace pg8 {
struct EpiSwiGLU {
    static constexpr bool PERM = true, AFTER_DRAIN = false;
    bf16_t* HID; static constexpr int PART_STORES = 4, PF_LOADS = 0;
    __device__ __forceinline__ void operator()(const f32x4 (&acc)[2][2][4][2], const Unit& u, int wr, int wc, int fr, int fq) const { part(acc, u, wr, wc, fr, fq, 0); part(acc, u, wr, wc, fr, fq, 1); }
    __device__ __forceinline__ void part(const f32x4 (&acc)[2][2][4][2], const Unit& u, int wr, int wc, int fr, int fq, const int ai) const {
        const int row0 = u.pm * BM + wr * 64 + fr, col0 = (u.pn & 3) * 128 + wc * 32 + 8 * fq;
#pragma unroll
            for (int m = 0; m < 4; ++m) { f32x4 h[2];
#pragma unroll
                for (int n = 0; n < 2; ++n) { const f32x4 g = acc[ai][0][m][n], up = acc[ai][1][m][n];
#pragma unroll
                    for (int i = 0; i < 4; ++i) h[n][i] = g[i] * __builtin_amdgcn_rcpf(1.0f + __expf(-g[i])) * up[i]; }
                u32x4 w; w.x = cvt_pk_bf16(h[0][0], h[0][1]); w.y = cvt_pk_bf16(h[0][2], h[0][3]); w.z = cvt_pk_bf16(h[1][0], h[1][1]); w.w = cvt_pk_bf16(h[1][2], h[1][3]);
                *(u32x4*)(HID + (size_t)(row0 + ai * HALF + m * 16) * 512 + col0) = w; }
    }
};
struct EpiDown {
    static constexpr bool PERM = true, AFTER_DRAIN = false;
    bf16_t* YB; const PG8_LAS float* wl;
    static constexpr int PART_STORES = 8, PF_LOADS = 0;
    __device__ __forceinline__ void operator()(const f32x4 (&acc)[2][2][4][2], const Unit& u, int wr, int wc, int fr, int fq) const { part(acc, u, wr, wc, fr, fq, 0); part(acc, u, wr, wc, fr, fq, 1); }
    __device__ __forceinline__ void part(const f32x4 (&acc)[2][2][4][2], const Unit& u, int wr, int wc, int fr, int fq, const int ai) const {
        const int rloc0 = wr * 64 + fr, col0 = (u.pn & 3) * BM + wc * 32 + 8 * fq;
#pragma unroll
            for (int m = 0; m < 4; ++m) { const int rloc = rloc0 + ai * HALF + m * 16; const float sc = wl[u.j * BM + rloc];
                bf16_t* rowp = YB + (size_t)(u.pm * BM + rloc) * 1024 + col0;
#pragma unroll
                for (int bj = 0; bj < 2; ++bj) { const f32x4 v0 = acc[ai][bj][m][0] * sc, v1 = acc[ai][bj][m][1] * sc;
                    u32x4 w; w.x = cvt_pk_bf16(v0[0], v0[1]); w.y = cvt_pk_bf16(v0[2], v0[3]); w.z = cvt_pk_bf16(v1[0], v1[1]); w.w = cvt_pk_bf16(v1[2], v1[3]);
                    *(u32x4*)(rowp + bj * HALF) = w; } }
    }
};
}
__device__ __forceinline__ void p_final(Frame& F) {
    moe_tile_table(F);
    const LAS int* tb = (const LAS int*)(F.lds + L_TB) + 32;
    const float* gf = F.in[IN_NFG]; const float* mod = (const float*)(F.ws + WS_MOD); const bf16* YB = (const bf16*)(F.ws + WS_YB); const unsigned* tokinfo = (const unsigned*)(F.ws + WS_TOKINFO);
    f32x4 G4[4];
#pragma unroll
    for (int j = 0; j < 4; ++j) G4[j] = *(const f32x4*)(gf + 4 * F.lane + 256 * j);
    const int gw = F.vcu * NWAVES + F.wave, NGW = F.G * NWAVES;
    const bf16* X1B = (const bf16*)(F.ws + WS_X1B);
    v2u xn[4], an[4], cn[4];
#define FIN_LOAD(mm) do { const unsigned i0_ = tokinfo[2 * (mm)], i1_ = tokinfo[2 * (mm) + 1]; \
        const size_t r0_ = (size_t)tb[i0_ >> 20] * 256 + (i0_ & 0xfffffu), r1_ = (size_t)tb[i1_ >> 20] * 256 + (i1_ & 0xfffffu); \
        const GAS v2u* xr_ = (const GAS v2u*)(X1B + (size_t)(mm) * 1024 + (size_t)((mm) / SEQ) * X1B_XTRA) + F.lane; const GAS v2u* y0_ = (const GAS v2u*)(YB + r0_ * 1024) + F.lane; const GAS v2u* y1_ = (const GAS v2u*)(YB + r1_ * 1024) + F.lane; \
        _Pragma("unroll") for (int j_ = 0; j_ < 4; ++j_) { xn[j_] = xr_[64 * j_]; an[j_] = y0_[64 * j_]; cn[j_] = y1_[64 * j_]; } } while (0)
    if (gw < NTOK) FIN_LOAD(gw);
    for (int m = gw; m < NTOK; m += NGW) {
        const int b = m / SEQ;
        GAS f32x4* xr = (GAS f32x4*)(F.out + (size_t)m * 1024) + F.lane;
        v2u xc[4], ac[4], cc[4];
#pragma unroll
        for (int j = 0; j < 4; ++j) { xc[j] = xn[j]; ac[j] = an[j]; cc[j] = cn[j]; }
        if (m + NGW < NTOK) FIN_LOAD(m + NGW);
        f32x4 v[4]; float ss = 0.f;
#pragma unroll
        for (int j = 0; j < 4; ++j) { const f32x4 gt = *(const f32x4*)(mod + (size_t)b * NMOD + 5120 + 4 * F.lane + 256 * j); const v2u a = ac[j], c = cc[j];
            f32x4 ff; ff[0] = __uint_as_float(a[0] << 16) + __uint_as_float(c[0] << 16); ff[1] = __uint_as_float(a[0] & 0xffff0000u) + __uint_as_float(c[0] & 0xffff0000u);
            ff[2] = __uint_as_float(a[1] << 16) + __uint_as_float(c[1] << 16); ff[3] = __uint_as_float(a[1] & 0xffff0000u) + __uint_as_float(c[1] & 0xffff0000u);
            const f32x4 x1 = (f32x4){__uint_as_float(xc[j][0] << 16), __uint_as_float(xc[j][0] & 0xffff0000u), __uint_as_float(xc[j][1] << 16), __uint_as_float(xc[j][1] & 0xffff0000u)};
            v[j] = x1 + gt * ff; ss += (v[j].x * v[j].x + v[j].y * v[j].y) + (v[j].z * v[j].z + v[j].w * v[j].w); }
        const float rstd = __builtin_amdgcn_rsqf(wave_sum(ss) * (1.f / 1024.f) + 1e-6f);
#if defined(MK_PROBE_A)
        { const unsigned long long* st = (const unsigned long long*)(F.ws + WS_CTL + 32768);
          const float ta = (float)(st[MK_PROBE_A + 1] - st[MK_PROBE_A]) * 0.01f, tb_ = (float)(st[MK_PROBE_B + 1] - st[MK_PROBE_B]) * 0.01f;
          const float sc = 1.0f + ta * 1e-4f;
#pragma unroll
          for (int j = 0; j < 4; ++j) v[j] = v[j] * sc;
          if (m == 0 && F.lane == 0) v[0][0] += tb_ * 0.02f / (rstd * G4[0][0]); }
#endif
#pragma unroll
        for (int j = 0; j < 4; ++j) xr[64 * j] = v[j] * rstd * G4[j];
    }
#undef FIN_LOAD
}
#ifndef MK_ONE_LAUNCH
#define MK_ONE_LAUNCH 1
#endif
#ifndef PG8_ALIGN_WOUT
#define PG8_ALIGN_WOUT PG8_ALIGN
#endif
#ifndef PG8_DEFER
#define PG8_DEFER true
#endif
constexpr int CW_ATT = 131072, CW_KXN = 135168;
constexpr size_t WS_KXG_A = 19 * MiB + 512 * 1024, WS_KXG_B = 4 * MiB; constexpr int KXG_NA = 70;
static_assert((size_t)KXG_NA * attn_body::KX_IMG_BYTES <= 4 * MiB + 512 * 1024 && (size_t)(128 - KXG_NA) * attn_body::KX_IMG_BYTES <= 4 * MiB, "kx images");
__device__ __forceinline__ char* kxg_home(const Frame& F, int bh) { return (char*)F.ws + (bh < KXG_NA ? WS_KXG_A + (size_t)bh * attn_body::KX_IMG_BYTES : WS_KXG_B + (size_t)(bh - KXG_NA) * attn_body::KX_IMG_BYTES); }
struct AttnDyn {
    gu32* cnt; volatile LAS int* box; int bh_;
    __device__ __forceinline__ bool next(int i, attn_body::AttnUnit& u) const {
        if (threadIdx.x == 0) { if ((i & 1) == 0) *box = (int)__hip_atomic_fetch_add(cnt, 2u, RLX_AGENT); else *box = *box + 1; }
        __syncthreads(); const int v = __builtin_amdgcn_readfirstlane(*box); __syncthreads();
        if (v >= 16) return false;
        u.bh = bh_; u.qb = 15 - v; return true; }
    __device__ __forceinline__ void a_ready(const attn_body::AttnUnit&) const {}
    __device__ __forceinline__ void done(const attn_body::AttnUnit&) const {}
};
__device__ __forceinline__ int attn_pick(gu32* cntb, volatile LAS int* box) {
    if (threadIdx.x == 0) { int best = -1, bw = 0;
        for (int h = 0; h < 8; ++h) { const int c = (int)__hip_atomic_load(cntb + 16 * h, RLX_AGENT); const int w = (c < 16) ? (16 - c) * (h + 2) : 0; if (w > bw) { bw = w; best = h; } }
        *box = best; }
    __syncthreads(); const int v = __builtin_amdgcn_readfirstlane(*box); __syncthreads();
    return v; }
constexpr int N_PHASES = 12;
struct Args { const float* in[28]; float* out; unsigned char* ws; int ph_lo, ph_hi; };
__global__ void __launch_bounds__(NWAVES * 64, 2) mk_fwd(Args args) {
    extern __shared__ __attribute__((aligned(16))) unsigned char lds[];
    Frame F;
    F.lds = (LAS unsigned char*)lds;
    F.MISC = (volatile LAS unsigned*)(F.lds + MISC_OFF);
    F.tid = threadIdx.x; F.lane = F.tid & 63; F.wave = __builtin_amdgcn_readfirstlane(F.tid >> 6);
    F.G = gridDim.x; { const int bx = blockIdx.x; F.vcu = (F.G % 8 == 0) ? (bx % 8) * (F.G / 8) + bx / 8 : bx; }
    F.ws = args.ws; F.out = args.out; F.ctl = (gu32*)(args.ws + WS_CTL);
    F.in.k = __builtin_amdgcn_kernarg_segment_ptr();
#define RELOAD_IN() do { kseg_t kp_ = __builtin_amdgcn_kernarg_segment_ptr(); asm volatile("" : "+s"(kp_)); F.in.k = kp_; } while (0)
    for (int u = F.tid; u < (LDS_BYTES - LDSCTL_OFF) / 4; u += NWAVES * 64) ((LAS unsigned*)(F.lds + LDSCTL_OFF))[u] = 0u;
    __syncthreads();
    const int lo = args.ph_lo, hi = args.ph_hi;
    int multi_ = __builtin_amdgcn_readfirstlane(((hi - lo) > 1) ? 1 : 0); asm volatile("" : "+s"(multi_)); const bool multi = multi_ != 0;
    XcdBarrier bar; bar.bar = (unsigned*)(F.ctl + CW_BAR); bar.x = 0; bar.st = nullptr; bar.gsz = 0; XcdBarrier bb = bar;
    if (multi) { bar = xcd_barrier_post((unsigned*)(F.ctl + CW_BAR), F.MISC + 8, gridDim.x);
        bb = xcd_barrier_post((unsigned*)(F.ctl + CW_BB + (F.vcu >> 4) * 4096), F.MISC + 10, 16u); }
#ifndef MK_REP_MASK
#define MK_REP_MASK 0
#endif
#ifndef MK_BATCH_BAR
#define MK_BATCH_BAR 1
#endif
#ifndef MK_ODD_ORDER
#define MK_ODD_ORDER 1
#endif
#define IN(k) (lo <= (k) && (k) < hi)
#define BOTH(k) (IN(k) && IN((k) + 1))
#if defined(MK_TBARV)
    unsigned long long tbar_acc_ = 0ull;
#define GRID_BAR() do { const unsigned long long tb0_ = __builtin_amdgcn_s_memrealtime(); xcd_barrier(bar); tbar_acc_ += __builtin_amdgcn_s_memrealtime() - tb0_; } while (0)
#else
#define GRID_BAR() xcd_barrier(bar)
#endif
#if defined(MK_TBARV)
#define BATCH_BAR() do { const unsigned long long tb0_ = __builtin_amdgcn_s_memrealtime(); if (MK_BATCH_BAR && F.G == 256) xcd_barrier(bb); else xcd_barrier(bar); if (!(MK_TBARV_GRIDONLY)) tbar_acc_ += __builtin_amdgcn_s_memrealtime() - tb0_; } while (0)
#ifndef MK_TBARV_GRIDONLY
#define MK_TBARV_GRIDONLY 0
#endif
#else
#define BATCH_BAR() do { if (MK_BATCH_BAR && F.G == 256) xcd_barrier(bb); else xcd_barrier(bar); } while (0)
#endif
#define STAMP(k) do {} while (0)
#ifndef MK_STAGN
#define MK_STAGN 4
#endif
#ifndef MK_STAG2
#define MK_STAG2 0
#endif
#ifndef MK_STAG7
#define MK_STAG7 0
#endif
#ifndef MK_STAG9
#define MK_STAG9 0
#endif
#ifndef MK_STAG10
#define MK_STAG10 0
#endif
#define STAGGER(step_) do { if ((step_) > 0) { const unsigned long long t0_ = __builtin_amdgcn_s_memrealtime(), d_ = (unsigned long long)((blockIdx.x >> 3) % MK_STAGN) * (step_); while (__builtin_amdgcn_s_memrealtime() - t0_ < d_) __builtin_amdgcn_s_sleep(8); } } while (0)
#if defined(MK_TPH)
#ifndef MK_TPHV
#define MK_TPHV 0
#endif
#ifndef MK_TAMP
#define MK_TAMP 8
#endif
    unsigned long long tph_t0_ = 0ull;
#define TPH_BEGIN(k) do { if ((k) == MK_TPH) tph_t0_ = __builtin_amdgcn_s_memrealtime(); } while (0)
#define TPH_END(k) do { if ((k) == MK_TPH) { __syncthreads(); if (F.vcu == MK_TPHV && threadIdx.x == 0) { const unsigned long long w_ = (unsigned long long)MK_TAMP * (__builtin_amdgcn_s_memrealtime() - tph_t0_), t0_ = __builtin_amdgcn_s_memrealtime(); while (__builtin_amdgcn_s_memrealtime() - t0_ < w_) __builtin_amdgcn_s_sleep(8); } __syncthreads(); } } while (0)
#else
#define TPH_BEGIN(k) do {} while (0)
#define TPH_END(k) do {} while (0)
#endif
#define REDERIVE() do { int t_ = threadIdx.x; asm volatile("" : "+v"(t_)); F.tid = t_; F.lane = t_ & 63; F.wave = __builtin_amdgcn_readfirstlane(t_ >> 6); } while (0)

#ifndef MK_SPLIT_P0
#define MK_SPLIT_P0 1
#endif
#define EXPERT_COPIES(cls_) do { if (MK_SPLIT_P0 && multi && ((F.vcu >> 4) & 3) == (cls_)) { __syncthreads(); REDERIVE(); RELOAD_IN(); TPH_BEGIN(14); p0_prologue<2>(F); TPH_END(14); __syncthreads(); REDERIVE(); } } while (0)
    if (IN(0)) { RELOAD_IN(); TPH_BEGIN(0); if (MK_SPLIT_P0 && multi) p0_prologue<1>(F); else p0_prologue<0>(F); TPH_END(0); if (BOTH(0)) GRID_BAR(); }
    if (IN(1)) { RELOAD_IN(); TPH_BEGIN(1); p1_norm(F); TPH_END(1); if (BOTH(1)) BATCH_BAR(); }

    if (IN(2)) { RELOAD_IN();
        pg8::Gemm g{(const pg8::bf16_t*)(F.ws + WS_H), (const pg8::bf16_t*)(F.ws + WS_WIN), NTOK, NPROJ, DMODEL}; pg8::BatchOrder S; S.init(NPROJ, F.vcu);
        pg8::EpiProj E{(pg8::bf16_t*)(F.ws + WS_PR), (pg8::bf16_t*)(F.ws + WS_PF), attn_body::C2};
        STAGGER(MK_STAG2);
#if defined(MK_CLK)
        const unsigned long long ck0_ = __builtin_amdgcn_s_memtime(), rt0_ = __builtin_amdgcn_s_memrealtime();
#endif
        TPH_BEGIN(2); pg8::gemm_phase<pg8::EpiProj, pg8::BatchOrder, PG8_ALIGN && !PG8_DEFER, PG8_SP2, PG8_DEFER>(F.lds + RING_OFF, g, S, E); TPH_END(2);
#if defined(MK_CLK)
        if (F.vcu == 0 && threadIdx.x == 0) { const unsigned long long ck1_ = __builtin_amdgcn_s_memtime(), rt1_ = __builtin_amdgcn_s_memrealtime();
            const unsigned long long w_ = (ck1_ - ck0_) * 1000ull / (rt1_ - rt0_);
            const unsigned long long t0_ = __builtin_amdgcn_s_memrealtime(); while (__builtin_amdgcn_s_memrealtime() - t0_ < w_) __builtin_amdgcn_s_sleep(8); }
        __syncthreads();
#endif
        if (BOTH(2)) BATCH_BAR();
    }
    REDERIVE();
    EXPERT_COPIES(0);
    if (IN(3)) { RELOAD_IN(); TPH_BEGIN(12); r0_lora_inputs(F);
        if (F.G == 256) {
            REDERIVE(); RELOAD_IN(); int vc = F.vcu; asm volatile("" : "+s"(vc)); const int b = vc >> 4, h = vc & 7; const attn_body::bf16* PF = (const attn_body::bf16*)(F.ws + WS_PF);
            int tt = threadIdx.x; asm volatile("" : "+v"(tt));
            __syncthreads();
            float* gb = (float*)(F.ctl + CW_KXN) + (b * 8 + h) * 4;
            if ((vc & 15) < 8) { attn_body::fill_kx<1>((char*)lds, (const float*)(F.ws + WS_FG), F.in[IN_FB][h], b, h, PF, PF + 512, tt, gb);
                                 attn_body::kx_store((const char*)lds, kxg_home(F, b * 8 + h), tt); }
            else attn_body::fill_kx<2>((char*)lds, (const float*)(F.ws + WS_FG), 0.f, b, h, PF, PF + 512, tt, gb + 2); }
        TPH_END(12);
        if (multi) BATCH_BAR(); }
#ifndef MK_MID_ORDER
#define MK_MID_ORDER 1
#endif
    int odd = __builtin_amdgcn_readfirstlane(MK_ODD_ORDER ? (multi_ & (F.vcu >> 4) & 1) : 0); asm volatile("" : "+s"(odd));
#ifndef MK_POS4
#define MK_POS4 0
#endif
    int mid = __builtin_amdgcn_readfirstlane(MK_MID_ORDER ? (MK_POS4 ? (odd ? 1 + ((F.vcu >> 5) % 3) : 0) : (odd ? (((F.vcu >> 5) & 1) ? 1 : 3) : 0)) : (odd ? 3 : 0)); asm volatile("" : "+s"(mid));
#ifndef MK_ATT_DYN
#define MK_ATT_DYN 0
#endif
#if MK_ATT_DYN
#define ATTN_GROUP() do { if (IN(3) && F.G == 256) { RELOAD_IN(); int vc = F.vcu; asm volatile("" : "+s"(vc)); \
            const int b = vc >> 4; int h = (vc & 15) >> 1; \
            const attn_body::bf16* PF = (const attn_body::bf16*)(F.ws + WS_PF); \
            const attn_body::AttnTensors AT{PF, PF + 512, PF + 1024, (attn_body::bf16*)(F.ws + WS_MIX) + 512}; \
            gu32* cntb = F.ctl + CW_ATT + b * 128; \
            _Pragma("nounroll") for (;;) { int tt = threadIdx.x; asm volatile("" : "+v"(tt)); \
                attn_body::kx_load((char*)lds, kxg_home(F, b * 8 + h), tt, (const float*)(F.ctl + CW_KXN) + (b * 8 + h) * 4); \
                const AttnDyn S{cntb + 16 * h, (volatile LAS int*)(F.MISC + 12), b * 8 + h}; \
                attn_body::attn_phase<AttnDyn>((char*)lds + RING_OFF, AT, S); \
                h = attn_pick(cntb, (volatile LAS int*)(F.MISC + 12)); if (h < 0) break; } \
            __syncthreads(); } REDERIVE(); } while (0)
#else
#define ATTN_PASS(pass_) do { int vc = F.vcu; asm volatile("" : "+s"(vc)); \
                const int g4 = vc >> 2, b = g4 >> 2, hp = g4 & 3, h = (pass_) ? 7 - hp : hp; \
                const attn_body::bf16* PF = (const attn_body::bf16*)(F.ws + WS_PF); \
                const attn_body::AttnTensors AT{PF, PF + 512, PF + 1024, (attn_body::bf16*)(F.ws + WS_MIX) + 512}; \
                int tt = threadIdx.x; asm volatile("" : "+v"(tt)); \
                attn_body::kx_load((char*)lds, kxg_home(F, b * 8 + h), tt, (const float*)(F.ctl + CW_KXN) + (b * 8 + h) * 4); \
                NTPROBE_RESET(); \
                const attn_body::StaticOrder S(vc, b * 8 + h); \
                attn_body::attn_phase<attn_body::StaticOrder>((char*)lds + RING_OFF, AT, S); \
                __syncthreads(); } while (0)
#if defined(MK_NTPROBE)
#define NTPROBE_RESET() do { if (threadIdx.x == 0) ((unsigned long long*)((char*)lds + attn_body::LDS_CB))[90] = 0ull; __syncthreads(); } while (0)
#define NTPROBE_READ(p_) do { if ((p_) == MK_NTPROBE) { __syncthreads(); if (F.vcu == MK_TPHV && threadIdx.x == 0) { const unsigned long long w_ = 1000ull * ((unsigned long long*)((char*)lds + attn_body::LDS_CB))[90], t0_ = __builtin_amdgcn_s_memrealtime(); while (__builtin_amdgcn_s_memrealtime() - t0_ < w_) __builtin_amdgcn_s_sleep(8); } __syncthreads(); } } while (0)
#else
#define NTPROBE_RESET() do {} while (0)
#define NTPROBE_READ(p_) do {} while (0)
#endif
#define ATTN_GROUP() do { if (IN(3) && F.G == 256) { RELOAD_IN(); TPH_BEGIN(13); ATTN_PASS(0); TPH_END(13); NTPROBE_READ(0); ATTN_PASS(1); NTPROBE_READ(1); } REDERIVE(); } while (0)
#endif
#if defined(MK_TWAITV)
    if (!odd) { ATTN_GROUP(); const unsigned long long tw0_ = __builtin_amdgcn_s_memrealtime(); if (multi) BATCH_BAR();
        if (F.vcu == MK_TWAITV && threadIdx.x == 0) { const unsigned long long w_ = 4ull * (__builtin_amdgcn_s_memrealtime() - tw0_), t0_ = __builtin_amdgcn_s_memrealtime(); while (__builtin_amdgcn_s_memrealtime() - t0_ < w_) __builtin_amdgcn_s_sleep(8); }
        __syncthreads(); }
#else
    if (!odd) { TPH_BEGIN(15); TPH_BEGIN(3); ATTN_GROUP(); TPH_END(3); if (multi) BATCH_BAR(); TPH_END(15); }
#endif
    if (IN(4)) { RELOAD_IN(); TPH_BEGIN(4); if (F.G == 256) scan2::build(F); TPH_END(4); if (BOTH(4)) BATCH_BAR(); }
    EXPERT_COPIES(1);
    REDERIVE();
#if MK_ODD_ORDER && MK_MID_ORDER
    asm volatile("" : "+s"(mid));
    if (mid == 1) ATTN_GROUP();
#endif
    if (IN(5)) { RELOAD_IN(); TPH_BEGIN(5); if (F.G == 256) scan2::apply(F); TPH_END(5); if (BOTH(5)) BATCH_BAR(); }
    REDERIVE();
#if MK_ODD_ORDER && MK_MID_ORDER && MK_POS4
    asm volatile("" : "+s"(mid));
    if (mid == 2) ATTN_GROUP();
#endif
    if (IN(6)) { RELOAD_IN(); TPH_BEGIN(6); r2_post(F); TPH_END(6); }
    REDERIVE();
#if MK_ODD_ORDER
    asm volatile("" : "+s"(mid));
    if (mid == 3) ATTN_GROUP();
#endif
#undef ATTN_GROUP
    if (multi) BATCH_BAR();
    EXPERT_COPIES(2);
#if defined(MK_TPH7)
    const unsigned long long tph7_ = __builtin_amdgcn_s_memrealtime();
#endif
    if (IN(7)) { RELOAD_IN();
        pg8::Gemm g{(const pg8::bf16_t*)(F.ws + WS_MIX), (const pg8::bf16_t*)(F.ws + WS_WOUT), NTOK, DMODEL, DMODEL}; pg8::BatchOrder S; S.init(DMODEL, F.vcu);
        pg8::EpiResB E{F.in[IN_X], (pg8::bf16_t*)(F.ws + WS_X1B), (const float*)(F.ws + WS_MOD) + 2048, SEQ, X1B_XTRA};
        STAGGER(MK_STAG7);
        pg8::gemm_phase<pg8::EpiResB, pg8::BatchOrder, PG8_ALIGN_WOUT, PG8_SP2>(F.lds + RING_OFF, g, S, E);
#if defined(MK_TPH7)
        if (F.vcu == MK_TPH7 && threadIdx.x == 0) { const unsigned long long w_ = 4ull * (__builtin_amdgcn_s_memrealtime() - tph7_), t0_ = __builtin_amdgcn_s_memrealtime(); while (__builtin_amdgcn_s_memrealtime() - t0_ < w_) __builtin_amdgcn_s_sleep(8); }
        __syncthreads();
#endif
        if (BOTH(7)) BATCH_BAR();
    }
    REDERIVE();
    EXPERT_COPIES(3);
    if (IN(8)) { RELOAD_IN(); TPH_BEGIN(8); m0_route(F); TPH_END(8);
#if defined(MK_TWAIT8)
        { const unsigned long long tw0_ = __builtin_amdgcn_s_memrealtime(); if (BOTH(8)) GRID_BAR();
          if (F.vcu == MK_TWAIT8 && threadIdx.x == 0) { const unsigned long long w_ = 4ull * (__builtin_amdgcn_s_memrealtime() - tw0_), t0_ = __builtin_amdgcn_s_memrealtime(); while (__builtin_amdgcn_s_memrealtime() - t0_ < w_) __builtin_amdgcn_s_sleep(8); }
          __syncthreads(); } }
#else
        if (BOTH(8)) GRID_BAR(); }
#endif
    REDERIVE();
    if (IN(9)) { RELOAD_IN();
        moe_tile_table(F); moe_fill_tokl(F);
        const LAS int* tb = (const LAS int*)(F.lds + L_TB) + 32;
        pg8::Gemm g{(const pg8::bf16_t*)(F.ws + WS_H), (const pg8::bf16_t*)(F.ws + WS_W1), 0, 0, DMODEL}; const int T_ = tb[32]; MoeOrder<true> S{tb, (const LAS int*)(F.lds + L_TOKL), 16, (((F.vcu >> 4) * T_) >> 4) * 4 + (F.vcu & 15), ((((F.vcu >> 4) + 1) * T_) >> 4) * 4};
        pg8::EpiSwiGLU E{(pg8::bf16_t*)(F.ws + WS_HID)};
        STAGGER(MK_STAG9);
        TPH_BEGIN(9); pg8::gemm_phase<pg8::EpiSwiGLU, MoeOrder<true>, PG8_ALIGN, PG8_SP2, false>(F.lds + RING_OFF, g, S, E); TPH_END(9);
        if (BOTH(9)) BATCH_BAR();
    }
    REDERIVE();
    if (IN(10)) { RELOAD_IN();
        moe_tile_table(F); moe_fill_wl(F);
        const LAS int* tb = (const LAS int*)(F.lds + L_TB) + 32;
        pg8::Gemm g{(const pg8::bf16_t*)(F.ws + WS_HID), (const pg8::bf16_t*)(F.ws + WS_W2), 0, 0, DEXP}; const int T_ = tb[32]; MoeOrder<false> S{tb, nullptr, 16, (((F.vcu >> 4) * T_) >> 4) * 4 + (F.vcu & 15), ((((F.vcu >> 4) + 1) * T_) >> 4) * 4};
        pg8::EpiDown E{(pg8::bf16_t*)(F.ws + WS_YB), (const LAS float*)(F.lds + L_TOKL)};
        STAGGER(MK_STAG10);
        TPH_BEGIN(10); pg8::gemm_phase<pg8::EpiDown, MoeOrder<false>, PG8_ALIGN && !PG8_DEFER, PG8_SP2, PG8_DEFER>(F.lds + RING_OFF, g, S, E); TPH_END(10);
        if (BOTH(10)) GRID_BAR();
    }
    REDERIVE();
    if (IN(11)) { RELOAD_IN(); TPH_BEGIN(11); p_final(F); TPH_END(11); }
#if defined(MK_TBARV)
    __syncthreads();
    if (F.vcu == MK_TBARV && threadIdx.x == 0) { const unsigned long long w_ = 2ull * tbar_acc_, t0_ = __builtin_amdgcn_s_memrealtime(); while (__builtin_amdgcn_s_memrealtime() - t0_ < w_) __builtin_amdgcn_s_sleep(8); }
    __syncthreads();
#endif
#undef IN
#undef BOTH
}

extern "C" void kernel_launch(void* const* d_in, const int* in_sizes, int n_in, void* d_out, int out_size, void* d_ws, size_t ws_size, hipStream_t stream) {
    static int grid = 0;
    if (grid == 0) {
        if (n_in != 28 || in_sizes[0] != NTOK * DMODEL || out_size != NTOK * DMODEL || ws_size < WS_END) {
            fprintf(stderr, "kernel_launch: unexpected shapes: n_in %d in0 %d out %d ws %zu (need %zu); nothing launched\n", n_in, n_in > 0 ? in_sizes[0] : -1, out_size, ws_size, (size_t)WS_END); grid = -1; return; }
        int dev = 0, cus = 0, per_cu = 0;
        if (hipGetDevice(&dev) != hipSuccess || hipDeviceGetAttribute(&cus, hipDeviceAttributeMultiprocessorCount, dev) != hipSuccess) { grid = -1; return; }
        if (hipFuncSetAttribute((const void*)mk_fwd, hipFuncAttributeMaxDynamicSharedMemorySize, LDS_BYTES) != hipSuccess) { fprintf(stderr, "kernel_launch: hipFuncSetAttribute failed\n"); grid = -1; return; }
        if (hipOccupancyMaxActiveBlocksPerMultiprocessor(&per_cu, (const void*)mk_fwd, NWAVES * 64, LDS_BYTES) != hipSuccess || per_cu < 1) { fprintf(stderr, "kernel_launch: occupancy query says %d blocks per CU\n", per_cu); per_cu = 1; }
        (void)hipGetLastError();
        grid = cus;
        if (grid != 256) fprintf(stderr, "kernel_launch: %d CUs; this kernel is tuned for 256\n", grid);
    }
    if (grid < 0) return;
    if (hipMemsetAsync((char*)d_ws + WS_CTL, 0, CTL_ZERO_BYTES, stream) != hipSuccess) return;
    Args a{};
    for (int i = 0; i < 28; ++i) a.in[i] = (const float*)d_in[i];
    a.out = (float*)d_out; a.ws = (unsigned char*)d_ws;
#if MK_ONE_LAUNCH
    a.ph_lo = 0; a.ph_hi = N_PHASES;
    hipLaunchKernelGGL(mk_fwd, dim3(grid), dim3(NWAVES * 64), LDS_BYTES, stream, a);
#else
    for (int p = 0; p < N_PHASES; ++p) for (int rep = 0; rep < 1 + ((MK_REP_MASK >> p) & 1); ++rep) { a.ph_lo = p; a.ph_hi = p + 1; hipLaunchKernelGGL(mk_fwd, dim3(grid), dim3(NWAVES * 64), LDS_BYTES, stream, a); }
#endif
}
```
